# Optimizing an MI355X kernel written in HIP

```python
import jax
import jax.numpy as jnp
from jax import lax
import numpy as np

D_MODEL = 1024
BATCH = 8
SEQ = 4096
DEPTH = 4

N_BRANCH = 4
ROPE_THETA = 500000.0
NORM_EPS = 1e-6
NEG_INF = -1e30
QBLOCK = 128
MAX_POS_OFFSET = 1024

A_GROUPS = 4
A_GROUP_DIM = 64
A_WIDTH = A_GROUPS * A_GROUP_DIM
A_CHUNK = 128
B_HEADS = 4
B_HEAD_DIM = 64
B_WIDTH = B_HEADS * B_HEAD_DIM
B_ROT_DIM = B_HEAD_DIM // 4
MOBA_BLOCK = 256
MOBA_TOPK = 3
MOBA_QCHUNK = 64
C_HEADS = 4
C_Q_RANK = 192
C_KV_RANK = 128
C_NOPE_DIM = 64
C_ROPE_DIM = 32
C_V_DIM = 64
C_QK_DIM = C_NOPE_DIM + C_ROPE_DIM
C_WIDTH = C_HEADS * C_V_DIM
D_WIDTH = 256
D_CONV = 31
FFN_DIM = 2816
N_EXPERTS = 8
TOP_K = 2
EXPERT_DIM = 1408
EXPERT_ROWS = 512
N_DENSE = (DEPTH + 1) // 2
N_MOE = DEPTH // 2

GATE_COLS = N_BRANCH * D_MODEL
A_COLS = 2 * A_WIDTH
B_COLS = 3 * B_WIDTH
C_COLS = C_Q_RANK + C_KV_RANK + C_ROPE_DIM
D_COLS = 2 * D_WIDTH
IN_COLS = GATE_COLS + A_COLS + B_COLS + C_COLS + D_COLS
IN_SPLITS = [GATE_COLS, GATE_COLS + A_COLS, GATE_COLS + A_COLS + B_COLS, GATE_COLS + A_COLS + B_COLS + C_COLS]

kernel_name = 'hybrid_gated_gmlp_moba_mla_conv_moe_trunk'


def rmsnorm(x, g):
    xf = x.astype(jnp.float32)
    y = xf * lax.rsqrt(jnp.mean(xf * xf, axis=-1, keepdims=True) + NORM_EPS)
    return (y * g.astype(jnp.float32)).astype(x.dtype)


def layernorm(x, g, b):
    xf = x.astype(jnp.float32)
    mu = jnp.mean(xf, axis=-1, keepdims=True)
    xc = xf - mu
    y = xc * lax.rsqrt(jnp.mean(xc * xc, axis=-1, keepdims=True) + NORM_EPS)
    return (y * g.astype(jnp.float32) + b.astype(jnp.float32)).astype(x.dtype)


def rope(x, pos):
    r = x.shape[-1]
    inv = jnp.float32(ROPE_THETA) ** (-jnp.arange(0, r, 2, dtype=jnp.float32) / r)
    ang = pos.astype(jnp.float32)[:, :, None, None] * inv
    cos, sin = jnp.cos(ang), jnp.sin(ang)
    xf = x.astype(jnp.float32)
    x1, x2 = xf[..., : r // 2], xf[..., r // 2:]
    return jnp.concatenate([x1 * cos - x2 * sin, x2 * cos + x1 * sin], axis=-1).astype(x.dtype)


def dense_causal_attention(q, k, v):
    _, S, _, dk = q.shape
    scale = dk ** -0.5
    outs = []
    for i in range(S // QBLOCK):
        lo, hi = i * QBLOCK, (i + 1) * QBLOCK
        s = jnp.einsum('bqhd,bkhd->bhqk', q[:, lo:hi], k[:, :hi]).astype(jnp.float32) * scale
        causal = jnp.arange(hi)[None, :] <= jnp.arange(lo, hi)[:, None]
        p = jax.nn.softmax(jnp.where(causal, s, NEG_INF), axis=-1).astype(v.dtype)
        outs.append(jnp.einsum('bhqk,bkhd->bqhd', p, v[:, :hi]))
    return jnp.concatenate(outs, axis=1)


def moba_attention(q, k, v):
    B, S, H, D = q.shape
    nb = -(-S // MOBA_BLOCK)
    sp = nb * MOBA_BLOCK
    pad = [(0, 0), (0, sp - S), (0, 0), (0, 0)]
    q = jnp.pad(q, pad).transpose(0, 2, 1, 3)
    k = jnp.pad(k, pad).transpose(0, 2, 1, 3)
    v = jnp.pad(v, pad).transpose(0, 2, 1, 3)
    kb = k.reshape(B, H, nb, MOBA_BLOCK, D)
    vb = v.reshape(B, H, nb, MOBA_BLOCK, D)
    k_mean = jnp.mean(kb.astype(jnp.float32), axis=3)
    q_block = jnp.arange(sp) // MOBA_BLOCK
    score = jnp.einsum('bhsd,bhnd->bhsn', q.astype(jnp.float32), k_mean)
    past = jnp.arange(nb)[None, :] < q_block[:, None]
    score = jnp.where(past, score, NEG_INF)
    n_sel = min(MOBA_TOPK, nb)
    _, sel = lax.top_k(score, n_sel)
    sel_ok = sel < q_block[None, None, :, None]
    bi = jnp.arange(B)[:, None, None, None]
    hi = jnp.arange(H)[None, :, None, None]
    scale = D ** -0.5

    def chunk(c):
        start = c * MOBA_QCHUNK
        qc = lax.dynamic_slice_in_dim(q, start, MOBA_QCHUNK, axis=2)
        idx = lax.dynamic_slice_in_dim(sel, start, MOBA_QCHUNK, axis=2)
        ok = lax.dynamic_slice_in_dim(sel_ok, start, MOBA_QCHUNK, axis=2)
        kg = kb[bi, hi, idx]
        vg = vb[bi, hi, idx]
        own = start // MOBA_BLOCK
        ko = lax.dynamic_index_in_dim(kb, own, axis=2, keepdims=False)
        vo = lax.dynamic_index_in_dim(vb, own, axis=2, keepdims=False)
        s_sel = jnp.einsum('bhqd,bhqnkd->bhqnk', qc, kg).astype(jnp.float32) * scale
        s_sel = jnp.where(ok[..., None], s_sel, NEG_INF).reshape(B, H, MOBA_QCHUNK, n_sel * MOBA_BLOCK)
        s_own = jnp.einsum('bhqd,bhkd->bhqk', qc, ko).astype(jnp.float32) * scale
        qpos = start + jnp.arange(MOBA_QCHUNK)[:, None]
        kpos = own * MOBA_BLOCK + jnp.arange(MOBA_BLOCK)[None, :]
        s_own = jnp.where(kpos <= qpos, s_own, NEG_INF)
        p = jax.nn.softmax(jnp.concatenate([s_sel, s_own], axis=-1), axis=-1).astype(v.dtype)
        p_sel = p[..., : n_sel * MOBA_BLOCK].reshape(B, H, MOBA_QCHUNK, n_sel, MOBA_BLOCK)
        p_own = p[..., n_sel * MOBA_BLOCK:]
        return (jnp.einsum('bhqnk,bhqnkd->bhqd', p_sel, vg)
                + jnp.einsum('bhqk,bhkd->bhqd', p_own, vo))

    out = lax.map(chunk, jnp.arange(sp // MOBA_QCHUNK))
    out = out.transpose(1, 0, 3, 2, 4).reshape(B, sp, H, D)
    return out[:, :S]


def chunked_sgu(u, v, ln_g, ln_b, w_s, b_s):
    B, S, _ = v.shape
    v = layernorm(v, ln_g, ln_b).reshape(B, S // A_CHUNK, A_CHUNK, A_GROUPS, A_GROUP_DIM)
    causal = jnp.tril(jnp.ones((A_CHUNK, A_CHUNK), w_s.dtype))
    z = jnp.einsum('gts,bcsgd->bctgd', w_s * causal, v) + b_s.T[None, None, :, :, None]
    return u * z.reshape(B, S, A_WIDTH)


def mla_attention(cq, ckv, kr, pos, cq_g, ckv_g, w_uq, w_ukv, qn_g, kn_g):
    B, S, _ = cq.shape
    q = (rmsnorm(cq, cq_g) @ w_uq).reshape(B, S, C_HEADS, C_QK_DIM)
    kv = (rmsnorm(ckv, ckv_g) @ w_ukv).reshape(B, S, C_HEADS, C_NOPE_DIM + C_V_DIM)
    k_nope, v = kv[..., :C_NOPE_DIM], kv[..., C_NOPE_DIM:]
    k_rope = jnp.broadcast_to(kr[:, :, None, :], (B, S, C_HEADS, C_ROPE_DIM))
    k = jnp.concatenate([k_nope, k_rope], axis=-1)
    q = rmsnorm(q, qn_g)
    k = rmsnorm(k, kn_g)
    q = jnp.concatenate([q[..., :C_NOPE_DIM], rope(q[..., C_NOPE_DIM:], pos)], axis=-1)
    k = jnp.concatenate([k[..., :C_NOPE_DIM], rope(k[..., C_NOPE_DIM:], pos)], axis=-1)
    return dense_causal_attention(q, k, v).reshape(B, S, C_WIDTH)


def conformer_conv(a, g, conv_w, conv_b, ln_g, ln_b):
    z = a * jax.nn.sigmoid(g)
    z = lax.conv_general_dilated(z, conv_w[:, None, :], window_strides=(1,),
                                 padding=[(D_CONV - 1, 0)],
                                 dimension_numbers=('NWC', 'WIO', 'NWC'),
                                 feature_group_count=D_WIDTH) + conv_b
    return jax.nn.silu(layernorm(z, ln_g, ln_b))


def hybrid_mixer(h, pos, w_in, a_ln_g, a_ln_b, a_ws, a_bs, b_qn, b_kn, c_cq_norm, c_ckv_norm,
                 c_w_uq, c_w_ukv, c_qn, c_kn, d_conv_w, d_conv_b, d_ln_g, d_ln_b, w_branch, w_out):
    B, S, _ = h.shape
    proj = h @ w_in
    gates, pa, pb, pc, pd = jnp.split(proj, IN_SPLITS, axis=-1)
    u, v = jnp.split(pa, 2, axis=-1)
    o_a = chunked_sgu(u, v, a_ln_g, a_ln_b, a_ws, a_bs)
    qkv = pb.reshape(B, S, 3, B_HEADS, B_HEAD_DIM)
    qb = rmsnorm(qkv[:, :, 0], b_qn)
    kb = rmsnorm(qkv[:, :, 1], b_kn)
    qb = jnp.concatenate([rope(qb[..., :B_ROT_DIM], pos), qb[..., B_ROT_DIM:]], axis=-1)
    kb = jnp.concatenate([rope(kb[..., :B_ROT_DIM], pos), kb[..., B_ROT_DIM:]], axis=-1)
    o_b = moba_attention(qb, kb, qkv[:, :, 2]).reshape(B, S, B_WIDTH)
    cq, ckv, kr = jnp.split(pc, [C_Q_RANK, C_Q_RANK + C_KV_RANK], axis=-1)
    o_c = mla_attention(cq, ckv, kr, pos, c_cq_norm, c_ckv_norm, c_w_uq, c_w_ukv, c_qn, c_kn)
    da, dg = jnp.split(pd, 2, axis=-1)
    o_d = conformer_conv(da, dg, d_conv_w, d_conv_b, d_ln_g, d_ln_b)
    y = sum(jax.nn.sigmoid(gates[..., n * D_MODEL:(n + 1) * D_MODEL]) * (o @ w_branch[n])
            for n, o in enumerate((o_a, o_b, o_c, o_d)))
    return y @ w_out


def swiglu(h, w_gate, w_up, w_down):
    return (jax.nn.silu(h @ w_gate) * (h @ w_up)) @ w_down


def moe_swiglu(h, w_router, b_router, w_gate, w_up, w_down):
    B, S, D = h.shape
    T = B * S
    TK = T * TOP_K
    xt = h.reshape(T, D)
    logits = (xt @ w_router).astype(jnp.float32) + b_router.astype(jnp.float32)
    top_logit, top_e = lax.top_k(logits, TOP_K)
    top_w = jax.nn.softmax(top_logit, axis=-1)
    flat_e = top_e.reshape(TK)
    flat_tok = jnp.repeat(jnp.arange(T, dtype=jnp.int32), TOP_K)
    flat_w = top_w.reshape(TK)
    order = jnp.argsort(flat_e)
    sorted_e = flat_e[order]
    counts = jnp.bincount(flat_e, length=N_EXPERTS)
    starts = jnp.cumsum(counts) - counts
    padded = (counts + EXPERT_ROWS - 1) // EXPERT_ROWS * EXPERT_ROWS
    pends = jnp.cumsum(padded)
    pstarts = pends - padded
    dest = pstarts[sorted_e] + jnp.arange(TK) - starts[sorted_e]
    n_blocks = -(-TK // EXPERT_ROWS) + N_EXPERTS
    rows = n_blocks * EXPERT_ROWS
    row_tok = jnp.zeros((rows,), jnp.int32).at[dest].set(flat_tok[order])
    row_w = jnp.zeros((rows,), jnp.float32).at[dest].set(flat_w[order])
    block_e = jnp.minimum(jnp.searchsorted(pends, jnp.arange(n_blocks) * EXPERT_ROWS, side='right'),
                          N_EXPERTS - 1)
    xs = xt[row_tok].reshape(n_blocks, EXPERT_ROWS, D)

    def expert_block(args):
        xb, e = args
        return (jax.nn.silu(xb @ w_gate[e]) * (xb @ w_up[e])) @ w_down[e]

    ys = lax.map(expert_block, (xs, block_e)).reshape(rows, D)
    out = jnp.zeros((T, D), h.dtype).at[row_tok].add(ys * row_w[:, None].astype(ys.dtype))
    return out.reshape(B, S, D)


def setup_inputs(seed: int = 0) -> dict:
    key = jax.random.key(seed)
    ks = jax.random.split(key, 32)
    f32 = jnp.float32

    def nrm(k, shape, fan_in):
        return jax.random.normal(k, shape, f32) * (fan_in ** -0.5)

    def gain(k, shape):
        return 1.0 + 0.02 * jax.random.normal(k, shape, f32)

    def small(k, shape, s=0.02):
        return s * jax.random.normal(k, shape, f32)

    x = jax.random.normal(ks[0], (BATCH, SEQ, D_MODEL), f32)
    offset = jax.random.randint(ks[1], (BATCH, 1), 0, MAX_POS_OFFSET, dtype=jnp.int32)
    positions = offset + jnp.arange(SEQ, dtype=jnp.int32)[None, :]
    return {
        'x': x,
        'positions': positions,
        'attn_norm': gain(ks[2], (DEPTH, D_MODEL)),
        'ffn_norm': gain(ks[3], (DEPTH, D_MODEL)),
        'w_in': nrm(ks[4], (DEPTH, D_MODEL, IN_COLS), D_MODEL),
        'a_ln_g': gain(ks[5], (DEPTH, A_WIDTH)),
        'a_ln_b': small(ks[6], (DEPTH, A_WIDTH)),
        'a_ws': nrm(ks[7], (DEPTH, A_GROUPS, A_CHUNK, A_CHUNK), A_CHUNK),
        'a_bs': gain(ks[8], (DEPTH, A_GROUPS, A_CHUNK)),
        'b_qn': gain(ks[9], (DEPTH, B_HEAD_DIM)),
        'b_kn': gain(ks[10], (DEPTH, B_HEAD_DIM)),
        'c_cq_norm': gain(ks[11], (DEPTH, C_Q_RANK)),
        'c_ckv_norm': gain(ks[12], (DEPTH, C_KV_RANK)),
        'c_w_uq': nrm(ks[13], (DEPTH, C_Q_RANK, C_HEADS * C_QK_DIM), C_Q_RANK),
        'c_w_ukv': nrm(ks[14], (DEPTH, C_KV_RANK, C_HEADS * (C_NOPE_DIM + C_V_DIM)), C_KV_RANK),
        'c_qn': gain(ks[15], (DEPTH, C_QK_DIM)),
        'c_kn': gain(ks[16], (DEPTH, C_QK_DIM)),
        'd_conv_w': nrm(ks[17], (DEPTH, D_CONV, D_WIDTH), D_CONV),
        'd_conv_b': small(ks[18], (DEPTH, D_WIDTH)),
        'd_ln_g': gain(ks[19], (DEPTH, D_WIDTH)),
        'd_ln_b': small(ks[20], (DEPTH, D_WIDTH)),
        'w_branch': nrm(ks[21], (DEPTH, N_BRANCH, A_WIDTH, D_MODEL), A_WIDTH),
        'w_out': nrm(ks[22], (DEPTH, D_MODEL, D_MODEL), D_MODEL),
        'ffn_w_gate': nrm(ks[23], (N_DENSE, D_MODEL, FFN_DIM), D_MODEL),
        'ffn_w_up': nrm(ks[24], (N_DENSE, D_MODEL, FFN_DIM), D_MODEL),
        'ffn_w_down': nrm(ks[25], (N_DENSE, FFN_DIM, D_MODEL), FFN_DIM),
        'moe_router': nrm(ks[26], (N_MOE, D_MODEL, N_EXPERTS), D_MODEL),
        'moe_router_b': small(ks[27], (N_MOE, N_EXPERTS), 0.01),
        'moe_w_gate': nrm(ks[28], (N_MOE, N_EXPERTS, D_MODEL, EXPERT_DIM), D_MODEL),
        'moe_w_up': nrm(ks[29], (N_MOE, N_EXPERTS, D_MODEL, EXPERT_DIM), D_MODEL),
        'moe_w_down': nrm(ks[30], (N_MOE, N_EXPERTS, EXPERT_DIM, D_MODEL), EXPERT_DIM),
    }


def reference(x, positions, attn_norm, ffn_norm, w_in, a_ln_g, a_ln_b, a_ws, a_bs, b_qn, b_kn,
              c_cq_norm, c_ckv_norm, c_w_uq, c_w_ukv, c_qn, c_kn, d_conv_w, d_conv_b, d_ln_g, d_ln_b,
              w_branch, w_out, ffn_w_gate, ffn_w_up, ffn_w_down, moe_router, moe_router_b,
              moe_w_gate, moe_w_up, moe_w_down):
    for l in range(DEPTH):
        h = rmsnorm(x, attn_norm[l])
        x = x + hybrid_mixer(h, positions, w_in[l], a_ln_g[l], a_ln_b[l], a_ws[l], a_bs[l],
                             b_qn[l], b_kn[l], c_cq_norm[l], c_ckv_norm[l], c_w_uq[l], c_w_ukv[l],
                             c_qn[l], c_kn[l], d_conv_w[l], d_conv_b[l], d_ln_g[l], d_ln_b[l],
                             w_branch[l], w_out[l])
        h = rmsnorm(x, ffn_norm[l])
        i = l // 2
        if l % 2 == 0:
            x = x + swiglu(h, ffn_w_gate[i], ffn_w_up[i], ffn_w_down[i])
        else:
            x = x + moe_swiglu(h, moe_router[i], moe_router_b[i], moe_w_gate[i], moe_w_up[i],
                               moe_w_down[i])
    return x
```

```cpp
#include <hip/hip_runtime.h>
#include <cstdio>
#include <cstdint>
#include <cmath>
namespace pg8 {
#define PG8_LAS __attribute__((address_space(3)))
typedef unsigned short bf16_t;
typedef short bf16x8 __attribute__((ext_vector_type(8)));
typedef float f32x4 __attribute__((ext_vector_type(4)));
typedef unsigned u32x4 __attribute__((ext_vector_type(4)));
constexpr int BM = 256, BK = 64, HALF = 128, HTB = HALF * BK * 2  , STAGE_BYTES = 8 * HTB, NXCD = 8, WGM = 8;

__host__ __device__ __forceinline__ int lds_byte(int r, int c) { const int st = (r >> 4) * 2 + (c >> 5), rr = r & 15, cc = c & 31, ob = rr * 64 + cc * 2; return st * 1024 + (ob ^ (((ob >> 9) & 1) << 5)); }
__host__ __device__ __forceinline__ void stage_rc(int b, int& R, int& C) { const int st = b / 1024, sb = b % 1024, swz = sb ^ (((sb >> 9) & 1) << 5); R = (st >> 1) * 16 + swz / 64; C = (st & 1) * 32 + (swz % 64) / 2; }
__host__ __device__ __forceinline__ int perm32(int rho) { const int n = rho >> 4, i = rho & 15; return 8 * (i >> 2) + 4 * n + (i & 3); }

struct Unit { int pm, pn, pb, ak; };
struct Gemm { const bf16_t* A; const bf16_t* Bt; int lda, ldb, K; };

struct StaticOrder {
    int nM, nN, nwg, G, c;
    __host__ __device__ void init(int M, int N, int G_, int c_) { nM = M / BM; nN = N / BM; nwg = nM * nN; G = G_; c = c_; }
    __host__ __device__ bool next(int i, Unit& u) const {
        const long L = (long)i * G + c; if (L >= nwg) return false;
        int wgid = (int)L; { const int q = nwg / NXCD, r = nwg % NXCD, xcd = wgid % NXCD, off = wgid / NXCD; wgid = (xcd < r ? xcd * (q + 1) : r * (q + 1) + (xcd - r) * q) + off; }
        const int nig = WGM * nN, gid = wgid / nig, fm = gid * WGM, gsz = (nM - fm) < WGM ? (nM - fm) : WGM;
        u.pm = fm + ((wgid % nig) % gsz); u.pn = (wgid % nig) / gsz; u.pb = u.pn; u.ak = 0; return true;
    }
    __device__ __forceinline__ void a_ready(const Unit&) const {}
    __device__ __forceinline__ void done(const Unit&) const {}
};

template <class Epi, class Sched, bool ALIGN_EPI = false, bool SP2 = false>
__device__ __forceinline__ void gemm_phase(PG8_LAS unsigned char* lds, const Gemm g, const Sched& S, const Epi& E, const int tid) {
    const int wid = __builtin_amdgcn_readfirstlane(tid >> 6), lane = tid & 63, wr = wid >> 2, wc = wid & 3, fr = lane & 15, fq = lane >> 4;
    const int K = g.K, nt = K / BK;
    unsigned voffA[2], voffB[2];
#pragma unroll
    for (int i = 0; i < 2; ++i) { int R, C; stage_rc(tid * 16 + i * 8192, R, C); const int Rb = Epi::PERM ? ((R & ~31) + perm32(R & 31)) : R;
        voffA[i] = (unsigned)(R * g.lda + C) * 2u; voffB[i] = (unsigned)(Rb * g.ldb + C) * 2u; }
    const size_t kstep = (size_t)(BK * 2);
    const size_t hstepA = (size_t)HALF * g.lda * 2, hstepB = (size_t)HALF * g.ldb * 2;
    const size_t tstepA = 2 * hstepA, tstepB = 2 * hstepB;
    const unsigned ldsw = (unsigned)wid * 1024u;
    const int aoff = lds_byte(wr * 64 + fr, fq * 8), boff = lds_byte(wc * 32 + fr, fq * 8);
#define PG8_SA(b, h) (((b) * 2 + (h)) * HTB)
#define PG8_SB(b, h) ((4 + (b) * 2 + (h)) * HTB)
#define PG8_STAGE(bufoff, gbase, voff) do { _Pragma("unroll") for (int _i = 0; _i < 2; ++_i) \
        __builtin_amdgcn_global_load_lds((const unsigned*)((const char*)(gbase) + (voff)[_i]), (PG8_LAS unsigned*)(lds + (bufoff) + ldsw + _i * 8192), 16, 0, 0); } while (0)
#define PG8_LDA(dst, b, h) do { _Pragma("unroll") for (int m = 0; m < 4; ++m) _Pragma("unroll") for (int k = 0; k < 2; ++k) dst[m][k] = *(const PG8_LAS bf16x8*)(lds + PG8_SA(b, h) + aoff + m * 2048 + k * 1024); } while (0)
#define PG8_LDB(dst, b, h) do { _Pragma("unroll") for (int n = 0; n < 2; ++n) _Pragma("unroll") for (int k = 0; k < 2; ++k) dst[n][k] = *(const PG8_LAS bf16x8*)(lds + PG8_SB(b, h) + boff + n * 2048 + k * 1024); } while (0)
#define PG8_MMA(ai, bj, At, Bt) do { __builtin_amdgcn_s_setprio(1); _Pragma("unroll") for (int m = 0; m < 4; ++m) _Pragma("unroll") for (int n = 0; n < 2; ++n) _Pragma("unroll") for (int k = 0; k < 2; ++k) \
        acc[ai][bj][m][n] = __builtin_amdgcn_mfma_f32_16x16x32_bf16(Bt[n][k], At[m][k], acc[ai][bj][m][n], 0, 0, 0); __builtin_amdgcn_s_setprio(0); } while (0)
#define PG8_WAIT_V(n) asm volatile("s_waitcnt vmcnt(" #n ")" ::: "memory")
#define PG8_WAIT_L(n) asm volatile("s_waitcnt lgkmcnt(" #n ")" ::: "memory")
#define PG8_BAR __builtin_amdgcn_s_barrier()
#define PG8_SCHED __builtin_amdgcn_sched_barrier(0)
    Unit cur, nxt; int ui = 0;
    if (!S.next(0, cur)) return;
    f32x4 acc[2][2][4][2];
#pragma unroll
    for (int a = 0; a < 2; ++a)
#pragma unroll
        for (int b = 0; b < 2; ++b)
#pragma unroll
            for (int m = 0; m < 4; ++m)
#pragma unroll
                for (int n = 0; n < 2; ++n) acc[a][b][m][n] = (f32x4){0.f, 0.f, 0.f, 0.f};
    bf16x8 At[4][2], B0[2][2], B1[2][2];
    const char* cA = (const char*)g.A + (size_t)cur.pm * tstepA + (size_t)cur.ak * 2; const char* cB = (const char*)g.Bt + (size_t)cur.pb * tstepB;
    S.a_ready(cur);
    if constexpr (SP2) {
        PG8_STAGE(PG8_SB(0, 0), cB, voffB); PG8_STAGE(PG8_SB(0, 1), cB + hstepB, voffB); PG8_STAGE(PG8_SA(0, 0), cA, voffA); PG8_STAGE(PG8_SA(0, 1), cA + hstepA, voffA);
        if (wr == 1) PG8_BAR;
        PG8_WAIT_V(2); PG8_BAR;
        PG8_STAGE(PG8_SB(1, 0), cB + kstep, voffB); PG8_STAGE(PG8_SA(1, 0), cA + kstep, voffA); PG8_STAGE(PG8_SB(1, 1), cB + hstepB + kstep, voffB);
        PG8_WAIT_V(6); PG8_BAR;
    } else {
        PG8_STAGE(PG8_SB(0, 0), cB, voffB); PG8_STAGE(PG8_SA(0, 0), cA, voffA); PG8_STAGE(PG8_SB(0, 1), cB + hstepB, voffB); PG8_STAGE(PG8_SA(0, 1), cA + hstepA, voffA);
        if (wr == 1) PG8_BAR;
        PG8_WAIT_V(4); PG8_BAR;
        PG8_STAGE(PG8_SB(1, 0), cB + kstep, voffB); PG8_STAGE(PG8_SA(1, 0), cA + kstep, voffA); PG8_STAGE(PG8_SB(1, 1), cB + hstepB + kstep, voffB);
        PG8_WAIT_V(6); PG8_BAR;
    }
    for (;;) {
        const bool has_next = S.next(ui + 1, nxt);
        const char* nA = has_next ? (const char*)g.A + (size_t)nxt.pm * tstepA + (size_t)nxt.ak * 2 : cA; const char* nB = has_next ? (const char*)g.Bt + (size_t)nxt.pb * tstepB : cB;
        for (int t = 0; t < nt; t += 2) {
            const bool last = (t == nt - 2);
            const char* a1 = cA + (size_t)(t + 1) * kstep;
            const char* a2 = last ? nA : cA + (size_t)(t + 2) * kstep; const char* b2 = last ? nB : cB + (size_t)(t + 2) * kstep;
            const char* a3 = a2 + kstep; const char* b3 = b2 + kstep;
            if (last && has_next) S.a_ready(nxt);
            if constexpr (SP2) {
            PG8_LDB(B0, 0, 0); PG8_LDB(B1, 0, 1); PG8_SCHED; PG8_LDA(At, 0, 0); PG8_STAGE(PG8_SA(1, 1), a1 + hstepA, voffA);
            PG8_WAIT_V(8); PG8_WAIT_L(0); PG8_BAR; PG8_MMA(0, 0, At, B0); PG8_MMA(0, 1, At, B1); PG8_BAR; PG8_SCHED;
            PG8_LDA(At, 0, 1); PG8_STAGE(PG8_SB(0, 0), b2, voffB); PG8_STAGE(PG8_SB(0, 1), b2 + hstepB, voffB); PG8_STAGE(PG8_SA(0, 0), a2, voffA);
            PG8_WAIT_V(8); PG8_WAIT_L(0); PG8_BAR; PG8_MMA(1, 0, At, B0); PG8_MMA(1, 1, At, B1); PG8_BAR; PG8_SCHED;
            PG8_LDB(B0, 1, 0); PG8_LDB(B1, 1, 1); PG8_SCHED; PG8_LDA(At, 1, 0); PG8_STAGE(PG8_SA(0, 1), a2 + hstepA, voffA);
            PG8_WAIT_V(8); PG8_WAIT_L(0); PG8_BAR; PG8_MMA(0, 0, At, B0); PG8_MMA(0, 1, At, B1); PG8_BAR; PG8_SCHED;
            PG8_LDA(At, 1, 1); PG8_STAGE(PG8_SB(1, 0), b3, voffB); PG8_STAGE(PG8_SB(1, 1), b3 + hstepB, voffB); PG8_STAGE(PG8_SA(1, 0), a3, voffA);
            PG8_WAIT_V(8); PG8_WAIT_L(0); PG8_BAR; PG8_MMA(1, 0, At, B0); PG8_MMA(1, 1, At, B1); PG8_BAR; PG8_SCHED;
            } else {
            PG8_LDB(B0, 0, 0); PG8_SCHED; PG8_LDA(At, 0, 0); PG8_STAGE(PG8_SA(1, 1), a1 + hstepA, voffA);
            PG8_WAIT_L(8); PG8_BAR; PG8_WAIT_L(0); PG8_MMA(0, 0, At, B0); PG8_BAR; PG8_SCHED;
            PG8_LDB(B1, 0, 1); PG8_STAGE(PG8_SB(0, 0), b2, voffB);
            PG8_BAR; PG8_WAIT_L(0); PG8_MMA(0, 1, At, B1); PG8_BAR;
            PG8_LDA(At, 0, 1); PG8_STAGE(PG8_SA(0, 0), a2, voffA);
            PG8_BAR; PG8_WAIT_L(0); PG8_MMA(1, 0, At, B0); PG8_BAR; PG8_SCHED;
            PG8_STAGE(PG8_SB(0, 1), b2 + hstepB, voffB);
            PG8_WAIT_V(6); PG8_BAR; PG8_MMA(1, 1, At, B1); PG8_BAR;
            PG8_LDB(B0, 1, 0); PG8_SCHED; PG8_LDA(At, 1, 0); PG8_STAGE(PG8_SA(0, 1), a2 + hstepA, voffA);
            PG8_WAIT_L(8); PG8_BAR; PG8_WAIT_L(0); PG8_MMA(0, 0, At, B0); PG8_BAR; PG8_SCHED;
            PG8_LDB(B1, 1, 1); PG8_STAGE(PG8_SB(1, 0), b3, voffB);
            PG8_BAR; PG8_WAIT_L(0); PG8_MMA(0, 1, At, B1); PG8_BAR;
            PG8_LDA(At, 1, 1); PG8_STAGE(PG8_SA(1, 0), a3, voffA);
            PG8_BAR; PG8_WAIT_L(0); PG8_MMA(1, 0, At, B0); PG8_BAR; PG8_SCHED;
            PG8_STAGE(PG8_SB(1, 1), b3 + hstepB, voffB);
            PG8_WAIT_V(6); PG8_BAR; PG8_MMA(1, 1, At, B1); PG8_BAR;
            }
        }
        if constexpr (ALIGN_EPI) { if (wr == 0) PG8_BAR; }
        const bool keep = E(acc, cur, wr, wc, fr, fq);
        if (!has_next) break;
        if (!keep) {
#pragma unroll
        for (int a = 0; a < 2; ++a)
#pragma unroll
            for (int b = 0; b < 2; ++b)
#pragma unroll
                for (int m = 0; m < 4; ++m)
#pragma unroll
                    for (int n = 0; n < 2; ++n) acc[a][b][m][n] = (f32x4){0.f, 0.f, 0.f, 0.f};
        }
        cur = nxt; cA = nA; cB = nB; ++ui;
        if constexpr (ALIGN_EPI) { if (wr == 1) PG8_BAR; }
    }
    PG8_WAIT_V(0);
    if constexpr (!ALIGN_EPI) { if (wr == 0) PG8_BAR; }
    PG8_BAR;
#undef PG8_SA
#undef PG8_SB
#undef PG8_STAGE
#undef PG8_LDA
#undef PG8_LDB
#undef PG8_MMA
#undef PG8_WAIT_V
#undef PG8_WAIT_L
#undef PG8_BAR
#undef PG8_SCHED
}
}
#define GAS __attribute__((address_space(1)))
#define LAS __attribute__((address_space(3)))
typedef unsigned short bf16;
typedef unsigned v4u __attribute__((ext_vector_type(4)));
typedef float f32x4 __attribute__((ext_vector_type(4)));
typedef short bf16x8 __attribute__((ext_vector_type(8)));
typedef GAS unsigned gu32;
typedef GAS unsigned long long gu64;
#define RLX_AGENT __ATOMIC_RELAXED, __HIP_MEMORY_SCOPE_AGENT
#define LDS_WAIT() asm volatile("s_waitcnt lgkmcnt(0)" ::: "memory")
#define VM_WAIT() asm volatile("s_waitcnt vmcnt(0)" ::: "memory")
__device__ __forceinline__ unsigned long long rt() { return __builtin_amdgcn_s_memrealtime(); }
__device__ __forceinline__ unsigned f2bf(float f) { unsigned u = __builtin_bit_cast(unsigned, f); return (u + 0x7fffu + ((u >> 16) & 1u)) >> 16; }
__device__ __forceinline__ unsigned pk2(float lo, float hi) { return f2bf(lo) | (f2bf(hi) << 16); }

#define XB_TMO      128
#define XB_XCNT(j)  (256  + 64 * (j))
#define XB_XSUB(j)  (1280 + 64 * (j))
#define XB_XGEN(j)  (2304 + 64 * (j))
#define XB_TOP      3328
#define XB_TOPGEN   3392
#define XCD_BAR_WORDS 3456
#define XB_SPIN_CAP (1u << 18)

__device__ __forceinline__ unsigned xb_ld(unsigned* p)              { return __hip_atomic_load(p, __ATOMIC_RELAXED, __HIP_MEMORY_SCOPE_AGENT); }
__device__ __forceinline__ unsigned xb_add(unsigned* p, unsigned v) { return __hip_atomic_fetch_add(p, v, __ATOMIC_RELAXED, __HIP_MEMORY_SCOPE_AGENT); }
__device__ __forceinline__ unsigned xb_xcc_id() { return (unsigned)__builtin_amdgcn_s_getreg((3 << 11) | 20) & 0xFu; }
#define XB_SPIN(cond, bar) do { unsigned _sp = 0; while (cond) { __builtin_amdgcn_s_sleep(1); \
    if ((++_sp & 255u) == 0u) { if (xb_ld(&(bar)[XB_TMO])) break; if (_sp > XB_SPIN_CAP) { atomicAdd(&(bar)[XB_TMO], 1u); break; } } } } while (0)

struct XcdBarrier {
    unsigned* bar; unsigned x;
    volatile LAS unsigned* st;
};

__device__ __forceinline__ XcdBarrier xcd_barrier_post(unsigned* bar, volatile LAS unsigned* st, const int tid) {
    XcdBarrier b; b.bar = bar; b.x = xb_xcc_id(); b.st = st;
    if (tid == 0) (void)xb_add(&bar[XB_XCNT(b.x)], 1u);
    return b;
}
__device__ __forceinline__ void xcd_barrier_complete(unsigned* bar, unsigned x, unsigned& nloc, unsigned& nx) {
    const unsigned G = gridDim.x * gridDim.y * gridDim.z;
    unsigned sum, cnt, mine, sp = 0u;
    for (;;) {
        sum = 0u; cnt = 0u; mine = 0u;
#pragma unroll
        for (unsigned j = 0; j < 16; ++j) { const unsigned c = xb_ld(&bar[XB_XCNT(j)]); sum += c; cnt += (c > 0u) ? 1u : 0u; mine = (j == x) ? c : mine; }
        if (sum == G) break;
        __builtin_amdgcn_s_sleep(1);
        if ((++sp & 255u) == 0u) { if (xb_ld(&bar[XB_TMO])) break; if (sp > XB_SPIN_CAP) { atomicAdd(&bar[XB_TMO], 1u); break; } }
    }
    nloc = mine > 0u ? mine : 1u; nx = cnt > 0u ? cnt : 1u;
}

__device__ __forceinline__ void xcd_barrier(const XcdBarrier& b, const int tid) {
    asm volatile("s_waitcnt vmcnt(0)" ::: "memory");
    __syncthreads();
    if (tid == 0) {
        unsigned* bar = b.bar;
        __builtin_amdgcn_s_waitcnt(0);
        unsigned nloc = b.st[0], nx = b.st[1];
        if (nloc == 0u) { xcd_barrier_complete(bar, b.x, nloc, nx); b.st[0] = nloc; b.st[1] = nx; }
        const unsigned old = xb_add(&bar[XB_XSUB(b.x)], 1u);
        const unsigned gen = old / nloc;
        if (old + 1u == (gen + 1u) * nloc) {
            __builtin_amdgcn_fence(__ATOMIC_RELEASE, "agent");
            asm volatile("s_waitcnt vmcnt(0)" ::: "memory");
            const unsigned og = xb_add(&bar[XB_TOP], 1u);
            const unsigned tg = og / nx;
            if (og + 1u == (tg + 1u) * nx) xb_add(&bar[XB_TOPGEN], 1u);
            else XB_SPIN(xb_ld(&bar[XB_TOPGEN]) == tg, bar);
            __builtin_amdgcn_fence(__ATOMIC_ACQUIRE, "agent");
            xb_add(&bar[XB_XGEN(b.x)], 1u);
            asm volatile("s_waitcnt vmcnt(0)" ::: "memory");
        } else {
            XB_SPIN(xb_ld(&bar[XB_XGEN(b.x)]) == gen, bar);
            __builtin_amdgcn_fence(__ATOMIC_ACQUIRE, "agent");
            asm volatile("s_waitcnt vmcnt(0)" ::: "memory");
        }
    }
    __syncthreads();
}
constexpr int NB = 8, SEQ = 4096, DM = 1024, T = NB * SEQ, DEPTH = 4, IN_COLS = 6240;
constexpr int FFN = 2816, NE = 8, EDIM = 1408;
constexpr float EPS = 1e-6f, LOG2E = 1.4426950408889634f;
constexpr int PJ_LD = 2304, PJ_U = 0, PJ_V = 256, PJ_BQ = 512, PJ_BK = 768, PJ_BV = 1024, PJ_DA = 1280, PJ_DG = 1536, PJ_CQ = 1792, PJ_CKV = 1984, PJ_KR = 2112;
constexpr float QS_B = 0.125f * LOG2E;
constexpr float QS_C = 0.10206207261596577f * LOG2E;
constexpr int NWAVES = 8, NTHR = 512;

constexpr size_t MiB = 1u << 20;
constexpr size_t WS_CTL = 0, CTL_ZERO_BYTES = 1 * MiB;
constexpr size_t WS_SSA = 1 * MiB, WS_SSB = 3 * MiB;
constexpr size_t WS_ROPE = 5 * MiB;
constexpr size_t WS_MISC = 11 * MiB;
constexpr size_t MS_RSCQ = WS_MISC, MS_RSCKV = WS_MISC + 128 * 1024, MS_SEL = WS_MISC + 256 * 1024, MS_KMEAN = WS_MISC + 768 * 1024,
                 MS_TOKE = WS_MISC + 1024 * 1024, MS_TOKW = WS_MISC + 1280 * 1024, MS_TOKS = WS_MISC + 1536 * 1024, MS_RSSLOT = WS_MISC + 1792 * 1024;
constexpr size_t WS_W = 14 * MiB;
constexpr size_t W_INR = WS_W, W_G = WS_W + 4 * MiB + 512 * 1024, W_UQ = WS_W + 12 * MiB + 512 * 1024, W_UKV = W_UQ + 256 * 1024, W_B = WS_W + 13 * MiB, W_OUT = WS_W + 15 * MiB,
                 W_F1 = WS_W + 17 * MiB, W_F2 = WS_W + 61 * MiB;
constexpr size_t WS_XB = 100 * MiB;
constexpr size_t WS_BIG = 164 * MiB;
constexpr size_t B_PROJ = WS_BIG, B_QPRE = WS_BIG + 144 * MiB, B_KVPRE = WS_BIG + 176 * MiB, B_CQ = WS_BIG + 208 * MiB, B_CK = WS_BIG + 232 * MiB, B_O = WS_BIG + 256 * MiB;
constexpr size_t B_SG = WS_BIG, B_Y = WS_BIG + 320 * MiB;
constexpr size_t B_HID = WS_BIG;
constexpr size_t B_XS = WS_BIG, B_HIDM = WS_BIG + 132 * MiB, B_Y2 = WS_BIG;
constexpr size_t WS_END = WS_BIG + 384 * MiB;
constexpr int MOE_ROWS_MAX = 65536 + 8 * 256;
static_assert(B_HIDM + (size_t)MOE_ROWS_MAX * EDIM * 2 <= WS_END && (size_t)MOE_ROWS_MAX * 1024 * 2 <= 132 * MiB, "moe map");
constexpr int CW_TMO = 0, CW_BAR = 4096, CW_MOE = 8192;

constexpr int RING_OFF = 0, RING_BYTES = 131072;
constexpr int LDSCTL_OFF = RING_BYTES, MISC_OFF = LDSCTL_OFF + 320;
constexpr int LDS_BYTES = 147456;

typedef float f32x2 __attribute__((ext_vector_type(2)));
typedef __bf16 bf16x2_t __attribute__((ext_vector_type(2)));
__device__ __forceinline__ unsigned pkbf(float lo, float hi) { f32x2 v = {lo, hi}; bf16x2_t b = __builtin_convertvector(v, bf16x2_t); return __builtin_bit_cast(unsigned, b); }
__device__ __forceinline__ float bflo(unsigned w) { return __uint_as_float(w << 16); }
__device__ __forceinline__ float bfhi(unsigned w) { return __uint_as_float(w & 0xffff0000u); }
__device__ __forceinline__ float bf1(bf16 b) { return __uint_as_float((unsigned)b << 16); }
__device__ __forceinline__ void unpack8(const v4u w, float* o) { o[0] = bflo(w.x); o[1] = bfhi(w.x); o[2] = bflo(w.y); o[3] = bfhi(w.y); o[4] = bflo(w.z); o[5] = bfhi(w.z); o[6] = bflo(w.w); o[7] = bfhi(w.w); }
__device__ __forceinline__ v4u pack8(const float* o) { v4u w; w.x = pkbf(o[0], o[1]); w.y = pkbf(o[2], o[3]); w.z = pkbf(o[4], o[5]); w.w = pkbf(o[6], o[7]); return w; }
template <int X> __device__ __forceinline__ float swz_xor(float v) { return __int_as_float(__builtin_amdgcn_ds_swizzle(__float_as_int(v), (X << 10) | 0x1f)); }
__device__ __forceinline__ float half_sum(float v) { auto rr = __builtin_amdgcn_permlane32_swap(__float_as_uint(v), __float_as_uint(v), false, false); return __uint_as_float(rr[0]) + __uint_as_float(rr[1]); }
__device__ __forceinline__ float wave_sum(float v) {
    v += swz_xor<1>(v); v += swz_xor<2>(v); v += swz_xor<4>(v); v += swz_xor<8>(v); v += swz_xor<16>(v);
    return half_sum(v);
}
__device__ __forceinline__ float fast_sigmoid(float x) { return __builtin_amdgcn_rcpf(1.0f + __builtin_amdgcn_exp2f(-x * LOG2E)); }
__device__ __forceinline__ float fast_silu(float x) { return x * fast_sigmoid(x); }
__device__ __forceinline__ float ss16(const float* p) {
    const f32x4* q = (const f32x4*)p; const f32x4 a = q[0], b = q[1], c = q[2], d = q[3];
    return (((a.x + a.y) + (a.z + a.w)) + ((b.x + b.y) + (b.z + b.w))) + (((c.x + c.y) + (c.z + c.w)) + ((d.x + d.y) + (d.z + d.w)));
}

namespace pg8 {
struct RowScale { const float* p; int mode; };
__device__ __forceinline__ float row_scale(const RowScale& rs, int row) {
    if (rs.mode == 0) return 1.f;
    if (rs.mode == 2) return rs.p[row];
    return rsqrtf(ss16(rs.p + (size_t)row * 16) * (1.0f / 1024.0f) + EPS);
}
template <int ACT> struct EpiScale {
    static constexpr bool PERM = true;
    bf16_t* O; int ldc; RowScale rs;
    __device__ __forceinline__ bool operator()(f32x4 (&acc)[2][2][4][2], const Unit& u, int wr, int wc, int fr, int fq) const {
        const int row0 = u.pm * BM + wr * 64 + fr;
#pragma unroll
        for (int ai = 0; ai < 2; ++ai)
#pragma unroll
            for (int m = 0; m < 4; ++m) {
                const int row = row0 + ai * HALF + m * 16; const float sc = row_scale(rs, row);
                if (ACT == 2) {
                    bf16_t* rowp = O + (size_t)row * ldc + u.pn * HALF + wc * 32 + 8 * fq;
                    const f32x4 g0 = acc[ai][0][m][0] * sc, g1 = acc[ai][0][m][1] * sc, u0 = acc[ai][1][m][0] * sc, u1 = acc[ai][1][m][1] * sc;
                    u32x4 w; w.x = pkbf(fast_silu(g0[0]) * u0[0], fast_silu(g0[1]) * u0[1]); w.y = pkbf(fast_silu(g0[2]) * u0[2], fast_silu(g0[3]) * u0[3]);
                    w.z = pkbf(fast_silu(g1[0]) * u1[0], fast_silu(g1[1]) * u1[1]); w.w = pkbf(fast_silu(g1[2]) * u1[2], fast_silu(g1[3]) * u1[3]);
                    *(u32x4*)rowp = w;
                } else {
                    bf16_t* rowp = O + (size_t)row * ldc + u.pn * BM + wc * 32 + 8 * fq;
#pragma unroll
                    for (int bj = 0; bj < 2; ++bj) {
                        f32x4 v0 = acc[ai][bj][m][0] * sc, v1 = acc[ai][bj][m][1] * sc;
                        if (ACT == 1) {
#pragma unroll
                            for (int j = 0; j < 4; ++j) { v0[j] = fmaxf(fast_sigmoid(v0[j]), 8.6736174e-19f); v1[j] = fmaxf(fast_sigmoid(v1[j]), 8.6736174e-19f); }
                        }
                        u32x4 w; w.x = pkbf(v0[0], v0[1]); w.y = pkbf(v0[2], v0[3]); w.z = pkbf(v1[0], v1[1]); w.w = pkbf(v1[2], v1[3]);
                        *(u32x4*)(rowp + bj * HALF) = w;
                    }
                }
            }
        return false;
    }
};
struct EpiResidual {
    static constexpr bool PERM = false;
    const float* base; float* out; bf16_t* xb; float* ssp;
    __device__ __forceinline__ bool operator()(f32x4 (&acc)[2][2][4][2], const Unit& u, int wr, int wc, int fr, int fq) const {
        const int row0 = u.pm * BM + wr * 64 + fr, col0 = u.pn * BM + wc * 32 + 4 * fq;
#pragma unroll
        for (int ai = 0; ai < 2; ++ai)
#pragma unroll
            for (int m = 0; m < 4; ++m) {
                const int row = row0 + ai * HALF + m * 16; const size_t off = (size_t)row * DM + col0; float ss = 0.f;
#pragma unroll
                for (int bj = 0; bj < 2; ++bj)
#pragma unroll
                    for (int n = 0; n < 2; ++n) {
                        const size_t o2 = off + bj * HALF + n * 16;
                        const f32x4 b = *(const f32x4*)(base + o2); const f32x4 o = b + acc[ai][bj][m][n];
                        *(f32x4*)(out + o2) = o;
                        typedef unsigned u32x2v __attribute__((ext_vector_type(2)));
                        u32x2v w; w.x = pkbf(o[0], o[1]); w.y = pkbf(o[2], o[3]); *(u32x2v*)(xb + o2) = w;
                        ss += (o[0] * o[0] + o[1] * o[1]) + (o[2] * o[2] + o[3] * o[3]);
                    }
                ss += swz_xor<16>(ss); ss = half_sum(ss);
                if (fq == 0) ssp[(size_t)row * 16 + u.pn * 4 + wc] = ss;
            }
        return false;
    }
};
struct EpiMerge {
    static constexpr bool PERM = true;
    const bf16_t* SG; bf16_t* Y;
    __device__ __forceinline__ bool operator()(f32x4 (&acc)[2][2][4][2], const Unit& u, int wr, int wc, int fr, int fq) const {
        const int n = u.ak >> 8; const int row0 = u.pm * BM + wr * 64 + fr, col0 = u.pn * BM + wc * 32 + 8 * fq;
#pragma unroll
        for (int ai = 0; ai < 2; ++ai)
#pragma unroll
            for (int m = 0; m < 4; ++m) {
                const int row = row0 + ai * HALF + m * 16;
#pragma unroll
                for (int bj = 0; bj < 2; ++bj) {
                    const bf16_t* sp = SG + (size_t)row * 4096 + n * 1024 + col0 + bj * HALF;
                    const u32x4 a = *(const u32x4*)sp; float sa[8]; unpack8(a, sa);
                    if (n < 3) {
                        const u32x4 b = *(const u32x4*)(sp + 1024); float sb[8]; unpack8(b, sb);
#pragma unroll
                        for (int j = 0; j < 4; ++j) { acc[ai][bj][m][0][j] *= sa[j] * __builtin_amdgcn_rcpf(sb[j]); acc[ai][bj][m][1][j] *= sa[4 + j] * __builtin_amdgcn_rcpf(sb[4 + j]); }
                    } else {
                        float o[8];
#pragma unroll
                        for (int j = 0; j < 4; ++j) { o[j] = acc[ai][bj][m][0][j] * sa[j]; o[4 + j] = acc[ai][bj][m][1][j] * sa[4 + j]; }
                        *(u32x4*)(Y + (size_t)row * DM + col0 + bj * HALF) = pack8(o);
                    }
                }
            }
        return n < 3;
    }
};
struct MergeOrder {
    StaticOrder so;
    __device__ bool next(int i, Unit& u) const { if (!so.next(i >> 2, u)) return false; const int n = i & 3; u.pb = n * 4 + u.pn; u.ak = n * 256; return true; }
    __device__ __forceinline__ void a_ready(const Unit&) const {}
    __device__ __forceinline__ void done(const Unit&) const {}
};
struct MoeOrder {
    StaticOrder so; int nN; int ps[9];
    __device__ bool next(int i, Unit& u) const {
        if (!so.next(i, u)) return false; int e = 0;
#pragma unroll
        for (int k = 1; k < 8; ++k) e = (u.pm >= ps[k]) ? k : e;
        u.pb = e * nN + u.pn; u.ak = 0; return true; }
    __device__ __forceinline__ void a_ready(const Unit&) const {}
    __device__ __forceinline__ void done(const Unit&) const {}
};
}

__device__ __forceinline__ void tr_item(const float* __restrict__ W, int ldw, int k0, int n0, bf16* dst, int ldd, const float* __restrict__ gain, LAS float* scr, int lane) {
#pragma unroll 8
    for (int i = 0; i < 32; ++i) { const int kk = 2 * i + (lane >> 5); float v = W[(size_t)(k0 + kk) * ldw + n0 + (lane & 31)]; if (gain) v *= gain[k0 + kk]; scr[kk * 33 + (lane & 31)] = v; }
    LDS_WAIT(); asm volatile("" ::: "memory");
    const int c = lane & 7;
#pragma unroll
    for (int j = 0; j < 4; ++j) { const int n = (lane >> 3) + 8 * j; const LAS float* s = scr + (8 * c) * 33 + n;
        v4u o; o.x = pkbf(s[0 * 33], s[1 * 33]); o.y = pkbf(s[2 * 33], s[3 * 33]); o.z = pkbf(s[4 * 33], s[5 * 33]); o.w = pkbf(s[6 * 33], s[7 * 33]);
        *(v4u*)(dst + (size_t)n * ldd + 8 * c) = o; }
    LDS_WAIT(); asm volatile("" ::: "memory");
}
template <int MAP>
__device__ __forceinline__ void tr_mat(const float* __restrict__ W, int ldw, int Ktot, int ncols, int nsrc0, bf16* dst, int ldd, int drow0, const float* __restrict__ gain, LAS float* scr, int lane, int gw, int NGW) {
    const int nnb = ncols / 32, nit = (Ktot / 64) * nnb;
    for (int it = gw; it < nit; it += NGW) {
        const int kb = it / nnb, nb = it - kb * nnb, k0 = kb * 64, nl = nb * 32;
        const int drow = drow0 + (MAP == 1 ? ((nl >> 7) * 256 + (nl & 127)) : nl);
        tr_item(W, ldw, k0, nsrc0 + nl, dst + (size_t)drow * ldd + k0, ldd, gain, scr, lane);
    }
}

template <int DK, int DV, bool MOBA>
__device__ __forceinline__ void naive_attn_unit(LAS unsigned char* lds, const bf16* Q, int qp, int qhs, const bf16* K, int kp, int khs, const bf16* V, int vp, int vhs,
                                                bf16* O, int op, int b, int h, int qc, const int* sel, const int tid) {
    LAS float* Ks = (LAS float*)lds; LAS float* Vs = Ks + 64 * DK;
    const int qi = qc * 512 + tid;
    const size_t tok = (size_t)b * SEQ + qi;
    float q[DK];
    { const v4u* qsrc = (const v4u*)(Q + tok * qp + h * qhs);
#pragma unroll
      for (int c = 0; c < DK / 8; ++c) unpack8(qsrc[c], q + 8 * c); }
    float o[DV];
#pragma unroll
    for (int d = 0; d < DV; ++d) o[d] = 0.f;
    float m = -1e30f, l = 0.f;
    const int qblk = qi >> 8; unsigned mask = 0u;
    if (MOBA) { const int sv = sel[tok * 4 + h]; const int ns = (sv >> 12) & 3;
        if (ns > 0) mask |= 1u << (sv & 15); if (ns > 1) mask |= 1u << ((sv >> 4) & 15); if (ns > 2) mask |= 1u << ((sv >> 8) & 15); }
    const int ntile = qc * 8 + 8;
    const int wave_last = qc * 512 + (tid | 63);
    for (int kt = 0; kt < ntile; ++kt) {
        __syncthreads();
        const int k0 = kt * 64;
        for (int c = tid; c < 64 * (DK / 8); c += NTHR) { const int r = c / (DK / 8), ch = c - r * (DK / 8);
            const v4u w = *(const v4u*)(K + ((size_t)b * SEQ + k0 + r) * kp + h * khs + ch * 8); float f[8]; unpack8(w, f);
            LAS f32x4* d = (LAS f32x4*)(Ks + r * DK + ch * 8); d[0] = (f32x4){f[0], f[1], f[2], f[3]}; d[1] = (f32x4){f[4], f[5], f[6], f[7]}; }
        for (int c = tid; c < 64 * (DV / 8); c += NTHR) { const int r = c / (DV / 8), ch = c - r * (DV / 8);
            const v4u w = *(const v4u*)(V + ((size_t)b * SEQ + k0 + r) * vp + h * vhs + ch * 8); float f[8]; unpack8(w, f);
            LAS f32x4* d = (LAS f32x4*)(Vs + r * DV + ch * 8); d[0] = (f32x4){f[0], f[1], f[2], f[3]}; d[1] = (f32x4){f[4], f[5], f[6], f[7]}; }
        __syncthreads();
        if (k0 > wave_last) continue;
        const int nblk = k0 >> 8;
        bool tile_ok = true;
        if (MOBA) { tile_ok = (nblk == qblk) || ((mask >> nblk) & 1u); if (!__any(tile_ok)) continue; }
        for (int jj = 0; jj < 64; ++jj) {
            const int kj = k0 + jj;
            const bool ok = MOBA ? (tile_ok && (nblk != qblk || kj <= qi)) : (kj <= qi);
            if (ok) {
                const LAS f32x4* kr = (const LAS f32x4*)(Ks + jj * DK);
                float s0 = 0.f, s1 = 0.f;
#pragma unroll
                for (int c = 0; c < DK / 8; ++c) { const f32x4 a = kr[2 * c], bq = kr[2 * c + 1];
                    s0 += q[8 * c] * a[0]; s1 += q[8 * c + 1] * a[1]; s0 += q[8 * c + 2] * a[2]; s1 += q[8 * c + 3] * a[3];
                    s0 += q[8 * c + 4] * bq[0]; s1 += q[8 * c + 5] * bq[1]; s0 += q[8 * c + 6] * bq[2]; s1 += q[8 * c + 7] * bq[3]; }
                const float s = s0 + s1;
                if (s > m) { const float cf = __builtin_amdgcn_exp2f(m - s); l *= cf;
#pragma unroll
                    for (int d = 0; d < DV; ++d) o[d] *= cf;
                    m = s; }
                const float p = __builtin_amdgcn_exp2f(s - m); l += p;
                const LAS f32x4* vr = (const LAS f32x4*)(Vs + jj * DV);
#pragma unroll
                for (int c = 0; c < DV / 4; ++c) { const f32x4 a = vr[c]; o[4 * c] += p * a[0]; o[4 * c + 1] += p * a[1]; o[4 * c + 2] += p * a[2]; o[4 * c + 3] += p * a[3]; }
            }
        }
    }
    const float inv = 1.0f / l;
    v4u* od = (v4u*)(O + tok * op + h * DV);
#pragma unroll
    for (int c = 0; c < DV / 8; ++c) { float t8[8];
#pragma unroll
        for (int j = 0; j < 8; ++j) t8[j] = o[8 * c + j] * inv;
        od[c] = pack8(t8); }
    __syncthreads();
}

__device__ __forceinline__ void sgu_unit(LAS unsigned char* lds, const bf16* PROJ, bf16* O, const float* __restrict__ lng, const float* __restrict__ lnb, const float* __restrict__ ws, const float* __restrict__ bs, int unit, const int tid) {
    LAS float* vn = (LAS float*)lds;
    const int lane = tid & 63, wave = tid >> 6;
    const size_t t0 = (size_t)unit * 128;
    const f32x4 g4 = *(const f32x4*)(lng + lane * 4), b4 = *(const f32x4*)(lnb + lane * 4);
    for (int i = 0; i < 16; ++i) {
        const int s = wave * 16 + i;
        typedef unsigned u32x2v __attribute__((ext_vector_type(2)));
        const u32x2v w = *(const u32x2v*)(PROJ + (t0 + s) * PJ_LD + PJ_V + lane * 4);
        float x0 = bflo(w.x), x1 = bfhi(w.x), x2 = bflo(w.y), x3 = bfhi(w.y);
        const float mu = wave_sum((x0 + x1) + (x2 + x3)) * (1.0f / 256.0f);
        x0 -= mu; x1 -= mu; x2 -= mu; x3 -= mu;
        const float var = wave_sum((x0 * x0 + x1 * x1) + (x2 * x2 + x3 * x3)) * (1.0f / 256.0f);
        const float rstd = rsqrtf(var + EPS);
        *(LAS f32x4*)(vn + s * 256 + lane * 4) = (f32x4){x0 * rstd * g4[0] + b4[0], x1 * rstd * g4[1] + b4[1], x2 * rstd * g4[2] + b4[2], x3 * rstd * g4[3] + b4[3]};
    }
    __syncthreads();
    const int ch = tid & 255, th = tid >> 8, g = ch >> 6;
    for (int i = 0; i < 64; ++i) {
        const int t = 2 * i + th;
        const float* wrow = ws + ((size_t)g * 128 + t) * 128;
        float z = 0.f;
        for (int s = 0; s <= t; ++s) z += wrow[s] * vn[s * 256 + ch];
        z += bs[g * 128 + t];
        const float u = bf1(PROJ[(t0 + t) * PJ_LD + PJ_U + ch]);
        O[(t0 + t) * DM + ch] = (bf16)(pkbf(u * z, 0.f) & 0xffffu);
    }
    __syncthreads();
}

__device__ __forceinline__ void conv_unit(LAS unsigned char* lds, const bf16* PROJ, bf16* O, const float* __restrict__ cw, const float* __restrict__ cb, const float* __restrict__ lng, const float* __restrict__ lnb, int unit, const int tid) {
    LAS float* zc = (LAS float*)lds;
    LAS float* cv = (LAS float*)(lds + 65536);
    const int lane = tid & 63, wave = tid >> 6;
    const int b = unit >> 7, p0 = (unit & 127) * 32;
    const int ch = tid & 255, half = tid >> 8;
    for (int i = 0; i < 31; ++i) {
        const int r = half + 2 * i, p = p0 - 30 + r; float z = 0.f;
        if (p >= 0) { const bf16* row = PROJ + ((size_t)b * SEQ + p) * PJ_LD; const float a = bf1(row[PJ_DA + ch]), g = bf1(row[PJ_DG + ch]); z = a * (1.0f / (1.0f + __expf(-g))); }
        zc[r * 256 + ch] = z;
    }
    float w[31];
#pragma unroll
    for (int j = 0; j < 31; ++j) w[j] = cw[j * 256 + ch];
    const float bias = cb[ch];
    __syncthreads();
    for (int i = 0; i < 16; ++i) {
        const int tt = half * 16 + i; float a = bias;
#pragma unroll
        for (int j = 0; j < 31; ++j) a += w[j] * zc[(tt + j) * 256 + ch];
        cv[tt * 256 + ch] = a;
    }
    __syncthreads();
    const f32x4 g4 = *(const f32x4*)(lng + lane * 4), b4 = *(const f32x4*)(lnb + lane * 4);
    for (int i = 0; i < 4; ++i) {
        const int tt = wave * 4 + i;
        const f32x4 x = *(const LAS f32x4*)(cv + tt * 256 + lane * 4);
        float x0 = x[0], x1 = x[1], x2 = x[2], x3 = x[3];
        const float mu = wave_sum((x0 + x1) + (x2 + x3)) * (1.0f / 256.0f);
        x0 -= mu; x1 -= mu; x2 -= mu; x3 -= mu;
        const float var = wave_sum((x0 * x0 + x1 * x1) + (x2 * x2 + x3 * x3)) * (1.0f / 256.0f);
        const float rstd = rsqrtf(var + EPS);
        const float y0 = x0 * rstd * g4[0] + b4[0], y1 = x1 * rstd * g4[1] + b4[1], y2 = x2 * rstd * g4[2] + b4[2], y3 = x3 * rstd * g4[3] + b4[3];
        typedef unsigned u32x2v __attribute__((ext_vector_type(2)));
        u32x2v wv; wv.x = pkbf(y0 / (1.0f + __expf(-y0)), y1 / (1.0f + __expf(-y1))); wv.y = pkbf(y2 / (1.0f + __expf(-y2)), y3 / (1.0f + __expf(-y3)));
        *(u32x2v*)(O + ((size_t)b * SEQ + p0 + tt) * DM + 768 + lane * 4) = wv;
    }
    __syncthreads();
}

struct Args { const void* in[31]; float* out; unsigned char* ws; int ph_lo, ph_hi; };
constexpr int N_PHASES = 11 + 14 + 11 + 14;
typedef const __attribute__((address_space(4))) Args* KArgs;
__device__ __forceinline__ KArgs kargs() { KArgs p = (KArgs)__builtin_amdgcn_kernarg_segment_ptr(); asm volatile("" : "+s"(p)); return p; }
#define IN_F(i) ((const float*)A->in[i])
#define WSP(type, off) ((type*)(ws + (off)))
struct Ctx { int tid, lane, wave, G, bid, gw, NGW, gt, NGT; };
__device__ __forceinline__ Ctx mkctx(int wv) {
    Ctx c; unsigned m = ~0u; asm volatile("" : "+s"(m)); const int ln = (int)__builtin_amdgcn_mbcnt_hi(m, __builtin_amdgcn_mbcnt_lo(m, 0u));
    int b = blockIdx.x; asm volatile("" : "+s"(b)); int w = wv; asm volatile("" : "+s"(w));
    c.tid = w * 64 + ln; c.lane = ln; c.wave = w; c.G = gridDim.x; c.bid = b;
    c.gw = c.bid * NWAVES + c.wave; c.NGW = c.G * NWAVES; c.gt = c.bid * NTHR + c.tid; c.NGT = c.G * NTHR; return c; }

__device__ __forceinline__ void ph_weights(int wv, LAS unsigned char* lds, int l) {
    const Ctx c = mkctx(wv);
    KArgs A = kargs(); unsigned char* ws = A->ws;
    const bool moe = (l & 1) != 0; const int li = l >> 1;
    const int lane = c.lane, gw = c.gw, NGW = c.NGW, gt = c.gt, NGT = c.NGT;
    LAS float* scr = (LAS float*)(lds + RING_OFF + c.wave * 16384);
    bf16* WINR = WSP(bf16, W_INR); bf16* WUQ = WSP(bf16, W_UQ); bf16* WUKV = WSP(bf16, W_UKV);
    const float* an = IN_F(2) + l * DM; const float* fn = IN_F(3) + l * DM;
    const float* win = IN_F(4) + (size_t)l * DM * IN_COLS;
    tr_mat<0>(win, IN_COLS, DM, 1280, 4096, WINR, DM, 0, an, scr, lane, gw, NGW);
    tr_mat<0>(win, IN_COLS, DM, 512, 5728, WINR, DM, 1280, an, scr, lane, gw, NGW);
    tr_mat<0>(win, IN_COLS, DM, 352, 5376, WINR, DM, 1792, an, scr, lane, gw, NGW);
    tr_mat<0>(win, IN_COLS, DM, 4096, 0, WSP(bf16, W_G), DM, 0, an, scr, lane, gw, NGW);
    tr_mat<0>(IN_F(13) + (size_t)l * 192 * 384, 384, 192, 384, 0, WUQ, 256, 0, IN_F(11) + l * 192, scr, lane, gw, NGW);
    tr_mat<0>(IN_F(14) + (size_t)l * 128 * 512, 512, 128, 512, 0, WUKV, 256, 0, IN_F(12) + l * 128, scr, lane, gw, NGW);
    for (int n = 0; n < 4; ++n) tr_mat<0>(IN_F(21) + ((size_t)l * 4 + n) * 256 * DM, DM, 256, DM, 0, WSP(bf16, W_B), 256, n * 1024, nullptr, scr, lane, gw, NGW);
    tr_mat<0>(IN_F(22) + (size_t)l * DM * DM, DM, DM, DM, 0, WSP(bf16, W_OUT), DM, 0, nullptr, scr, lane, gw, NGW);
    if (!moe) {
        tr_mat<1>(IN_F(23) + (size_t)li * DM * FFN, FFN, DM, FFN, 0, WSP(bf16, W_F1), DM, 0, fn, scr, lane, gw, NGW);
        tr_mat<1>(IN_F(24) + (size_t)li * DM * FFN, FFN, DM, FFN, 0, WSP(bf16, W_F1), DM, 128, fn, scr, lane, gw, NGW);
        tr_mat<0>(IN_F(25) + (size_t)li * FFN * DM, DM, FFN, DM, 0, WSP(bf16, W_F2), FFN, 0, nullptr, scr, lane, gw, NGW);
    } else {
        for (int e = 0; e < NE; ++e) {
            tr_mat<1>(IN_F(28) + ((size_t)li * NE + e) * DM * EDIM, EDIM, DM, EDIM, 0, WSP(bf16, W_F1), DM, e * 2 * EDIM, fn, scr, lane, gw, NGW);
            tr_mat<1>(IN_F(29) + ((size_t)li * NE + e) * DM * EDIM, EDIM, DM, EDIM, 0, WSP(bf16, W_F1), DM, e * 2 * EDIM + 128, fn, scr, lane, gw, NGW);
            tr_mat<0>(IN_F(30) + ((size_t)li * NE + e) * EDIM * DM, DM, EDIM, DM, 0, WSP(bf16, W_F2), EDIM, e * DM, nullptr, scr, lane, gw, NGW);
        }
    }
    unsigned zz = 0u; asm volatile("" : "+v"(zz)); const v4u z4 = {zz, zz, zz, zz};
    for (int i = gt; i < 160 * DM / 8; i += NGT) ((v4u*)(WINR + (size_t)2144 * DM))[i] = z4;
    for (int i = gt; i < 128 * 256 / 8; i += NGT) ((v4u*)(WUQ + (size_t)384 * 256))[i] = z4;
    for (int i = gt; i < 384 * 8; i += NGT) ((v4u*)(WUQ + (size_t)(i >> 3) * 256 + 192))[i & 7] = z4;
    for (int i = gt; i < 512 * 16; i += NGT) ((v4u*)(WUKV + (size_t)(i >> 4) * 256 + 128))[i & 15] = z4;
    if (l == 0) {
        const float* x_in = IN_F(0); const int* positions = (const int*)A->in[1];
        bf16* XB = WSP(bf16, WS_XB); float* SSA = WSP(float, WS_SSA); float* ROPE = WSP(float, WS_ROPE);
        for (int mrow = gw; mrow < T; mrow += NGW) {
            const f32x4* xr = (const f32x4*)(x_in + (size_t)mrow * DM) + lane; float s = 0.f;
            typedef unsigned u32x2v __attribute__((ext_vector_type(2)));
            u32x2v* o8 = (u32x2v*)(XB + (size_t)mrow * DM) + lane;
#pragma unroll
            for (int j = 0; j < 4; ++j) { const f32x4 v = xr[64 * j]; s += (v[0] * v[0] + v[1] * v[1]) + (v[2] * v[2] + v[3] * v[3]); u32x2v w; w.x = pkbf(v[0], v[1]); w.y = pkbf(v[2], v[3]); o8[64 * j] = w; }
            s = wave_sum(s);
            if (lane < 16) SSA[(size_t)mrow * 16 + lane] = (lane == 0) ? s : 0.f;
        }
        for (int i = gt; i < T * 24; i += NGT) {
            const int tok = i / 24, a = i - tok * 24;
            const float inv = (a < 8) ? powf(500000.0f, -(float)a * 0.125f) : powf(500000.0f, -(float)(a - 8) * 0.0625f);
            const float ang = (float)positions[tok] * inv; float sn, cs; sincosf(ang, &sn, &cs);
            ROPE[(size_t)tok * 48 + 2 * a] = cs; ROPE[(size_t)tok * 48 + 2 * a + 1] = sn;
        }
    }
}
__device__ __forceinline__ void ph_inproj(int wv, LAS unsigned char* lds) {
    const Ctx c = mkctx(wv);
    KArgs A = kargs(); unsigned char* ws = A->ws;
    pg8::Gemm g{WSP(bf16, WS_XB), WSP(bf16, W_INR), DM, DM, DM}; pg8::StaticOrder S; S.init(T, PJ_LD, c.G, c.bid);
    pg8::EpiScale<0> E{WSP(bf16, B_PROJ), PJ_LD, pg8::RowScale{WSP(float, WS_SSA), 1}};
    pg8::gemm_phase<pg8::EpiScale<0>, pg8::StaticOrder, true, true>(lds + RING_OFF, g, S, E, c.tid);
}
__device__ __forceinline__ void ph_prep(int wv, LAS unsigned char* lds, int l) {
    const Ctx c = mkctx(wv);
    KArgs A = kargs(); unsigned char* ws = A->ws;
    bf16* PROJ = WSP(bf16, B_PROJ); bf16* OB = WSP(bf16, B_O);
    {
        const float* qn = IN_F(9) + l * 64; const float* kn = IN_F(10) + l * 64; const float* ROPE = WSP(float, WS_ROPE);
        float* RSCQ = WSP(float, MS_RSCQ); float* RSCKV = WSP(float, MS_RSCKV);
        for (int idx = c.gt; idx < T * 4; idx += c.NGT) {
            const int tok = idx >> 2, h = idx & 3;
            bf16* pr = PROJ + (size_t)tok * PJ_LD; const float* tab = ROPE + (size_t)tok * 48;
#pragma unroll
            for (int which = 0; which < 2; ++which) {
                bf16* p = pr + (which ? PJ_BK : PJ_BQ) + h * 64; const float* gn = which ? kn : qn;
                float v[64]; float ss = 0.f;
#pragma unroll
                for (int cc = 0; cc < 8; ++cc) unpack8(((const v4u*)p)[cc], v + 8 * cc);
#pragma unroll
                for (int d = 0; d < 64; ++d) ss += v[d] * v[d];
                const float rstd = rsqrtf(ss * (1.0f / 64.0f) + EPS);
#pragma unroll
                for (int d = 0; d < 64; ++d) v[d] = v[d] * rstd * gn[d];
#pragma unroll
                for (int i = 0; i < 8; ++i) { const float cs = tab[2 * i], sn = tab[2 * i + 1], x1 = v[i], x2 = v[8 + i]; v[i] = x1 * cs - x2 * sn; v[8 + i] = x2 * cs + x1 * sn; }
                if (!which) {
#pragma unroll
                    for (int d = 0; d < 64; ++d) v[d] *= QS_B;
                }
#pragma unroll
                for (int cc = 0; cc < 8; ++cc) ((v4u*)p)[cc] = pack8(v + 8 * cc);
            }
            if (h == 0) { float ss = 0.f;
#pragma unroll
                for (int cc = 0; cc < 24; ++cc) { float f[8]; unpack8(((const v4u*)(pr + PJ_CQ))[cc], f);
#pragma unroll
                    for (int j = 0; j < 8; ++j) ss += f[j] * f[j]; }
                RSCQ[tok] = rsqrtf(ss * (1.0f / 192.0f) + EPS); }
            if (h == 1) { float ss = 0.f;
#pragma unroll
                for (int cc = 0; cc < 16; ++cc) { float f[8]; unpack8(((const v4u*)(pr + PJ_CKV))[cc], f);
#pragma unroll
                    for (int j = 0; j < 8; ++j) ss += f[j] * f[j]; }
                RSCKV[tok] = rsqrtf(ss * (1.0f / 128.0f) + EPS); }
        }
    }
    __syncthreads();
    for (int u = c.bid; u < T / 128; u += c.G) sgu_unit(lds + RING_OFF, PROJ, OB, IN_F(5) + l * 256, IN_F(6) + l * 256, IN_F(7) + (size_t)l * 4 * 128 * 128, IN_F(8) + l * 4 * 128, u, c.tid);
    for (int u = c.bid; u < T / 32; u += c.G) conv_unit(lds + RING_OFF, PROJ, OB, IN_F(17) + (size_t)l * 31 * 256, IN_F(18) + l * 256, IN_F(19) + l * 256, IN_F(20) + l * 256, u, c.tid);
}
__device__ __forceinline__ void ph_mla_up(int wv, LAS unsigned char* lds) {
    const Ctx c = mkctx(wv);
    { KArgs A = kargs(); unsigned char* ws = A->ws;
      pg8::Gemm g{WSP(bf16, B_PROJ) + PJ_CQ, WSP(bf16, W_UQ), PJ_LD, 256, 256}; pg8::StaticOrder S; S.init(T, 512, c.G, c.bid);
      pg8::EpiScale<0> E{WSP(bf16, B_QPRE), 512, pg8::RowScale{WSP(float, MS_RSCQ), 2}};
      pg8::gemm_phase<pg8::EpiScale<0>, pg8::StaticOrder, true, true>(lds + RING_OFF, g, S, E, c.tid); }
    { KArgs A = kargs(); unsigned char* ws = A->ws;
      pg8::Gemm g{WSP(bf16, B_PROJ) + PJ_CKV, WSP(bf16, W_UKV), PJ_LD, 256, 256}; pg8::StaticOrder S; S.init(T, 512, c.G, c.bid);
      pg8::EpiScale<0> E{WSP(bf16, B_KVPRE), 512, pg8::RowScale{WSP(float, MS_RSCKV), 2}};
      pg8::gemm_phase<pg8::EpiScale<0>, pg8::StaticOrder, true, true>(lds + RING_OFF, g, S, E, c.tid); }
    { KArgs A = kargs(); unsigned char* ws = A->ws; const bf16* PROJ = WSP(bf16, B_PROJ); float* KMEAN = WSP(float, MS_KMEAN);
      for (int i = c.gt; i < NB * 4 * 16 * 64; i += c.NGT) {
          const int d = i & 63, blk = (i >> 6) & 15, h = (i >> 10) & 3, b = i >> 12;
          const bf16* kp = PROJ + ((size_t)b * SEQ + blk * 256) * PJ_LD + PJ_BK + h * 64 + d; float s = 0.f;
          for (int j = 0; j < 256; ++j) s += bf1(kp[(size_t)j * PJ_LD]);
          KMEAN[i] = s * (1.0f / 256.0f);
      } }
}
template <int WHICH>
__device__ __forceinline__ void mla_post_pass(const Ctx& c, int l) {
    KArgs A = kargs(); unsigned char* ws = A->ws;
    const float* gn = IN_F(WHICH ? 16 : 15) + l * 96;
    const bf16* PROJ = WSP(bf16, B_PROJ); const bf16* QPRE = WSP(bf16, B_QPRE); const bf16* KVPRE = WSP(bf16, B_KVPRE);
    bf16* DST = WHICH ? WSP(bf16, B_CK) : WSP(bf16, B_CQ); const float* ROPE = WSP(float, WS_ROPE);
    for (int idx = c.gt; idx < T * 4; idx += c.NGT) {
        const int tok = idx >> 2, h = idx & 3; const float* tab = ROPE + (size_t)tok * 48 + 16;
        float v[96]; float ss = 0.f;
        if (WHICH == 0) {
#pragma unroll
            for (int cc = 0; cc < 12; ++cc) unpack8(((const v4u*)(QPRE + (size_t)tok * 512 + h * 96))[cc], v + 8 * cc);
        } else {
#pragma unroll
            for (int cc = 0; cc < 8; ++cc) unpack8(((const v4u*)(KVPRE + (size_t)tok * 512 + h * 128))[cc], v + 8 * cc);
#pragma unroll
            for (int cc = 0; cc < 4; ++cc) unpack8(((const v4u*)(PROJ + (size_t)tok * PJ_LD + PJ_KR))[cc], v + 64 + 8 * cc);
        }
#pragma unroll
        for (int d = 0; d < 96; ++d) ss += v[d] * v[d];
        const float rstd = rsqrtf(ss * (1.0f / 96.0f) + EPS);
#pragma unroll
        for (int d = 0; d < 96; ++d) v[d] = v[d] * rstd * gn[d];
#pragma unroll
        for (int i = 0; i < 16; ++i) { const float cs = tab[2 * i], sn = tab[2 * i + 1], x1 = v[64 + i], x2 = v[80 + i]; v[64 + i] = x1 * cs - x2 * sn; v[80 + i] = x2 * cs + x1 * sn; }
        if (WHICH == 0) {
#pragma unroll
            for (int d = 0; d < 96; ++d) v[d] *= QS_C;
        }
        bf16* dst = DST + (size_t)tok * 384 + h * 96;
#pragma unroll
        for (int cc = 0; cc < 12; ++cc) ((v4u*)dst)[cc] = pack8(v + 8 * cc);
    }
}
__device__ __forceinline__ void ph_mla_post(int wv, int l) {
    { const Ctx c = mkctx(wv); mla_post_pass<0>(c, l); }
    { const Ctx c = mkctx(wv); mla_post_pass<1>(c, l); }
    const Ctx c = mkctx(wv);
    KArgs A = kargs(); unsigned char* ws = A->ws;
    const bf16* PROJ = WSP(bf16, B_PROJ); const float* KMEAN = WSP(float, MS_KMEAN); int* SEL = WSP(int, MS_SEL);
    for (int idx = c.gt; idx < T * 4; idx += c.NGT) {
        const int tok = idx >> 2, h = idx & 3;
        float q[64];
#pragma unroll
        for (int cc = 0; cc < 8; ++cc) unpack8(((const v4u*)(PROJ + (size_t)tok * PJ_LD + PJ_BQ + h * 64))[cc], q + 8 * cc);
        const int b = tok / SEQ, qblk = (tok % SEQ) >> 8;
        float s0 = -INFINITY, s1 = -INFINITY, s2 = -INFINITY; int i0 = 0, i1 = 0, i2 = 0;
        for (int n = 0; n < qblk; ++n) {
            const f32x4* km = (const f32x4*)(KMEAN + ((size_t)(b * 4 + h) * 16 + n) * 64); float sc = 0.f;
#pragma unroll
            for (int cc = 0; cc < 16; ++cc) { const f32x4 k4 = km[cc]; sc += q[4 * cc] * k4[0]; sc += q[4 * cc + 1] * k4[1]; sc += q[4 * cc + 2] * k4[2]; sc += q[4 * cc + 3] * k4[3]; }
            if (sc > s0) { s2 = s1; i2 = i1; s1 = s0; i1 = i0; s0 = sc; i0 = n; }
            else if (sc > s1) { s2 = s1; i2 = i1; s1 = sc; i1 = n; }
            else if (sc > s2) { s2 = sc; i2 = n; }
        }
        const int ns = qblk < 3 ? qblk : 3;
        SEL[idx] = i0 | (i1 << 4) | (i2 << 8) | (ns << 12);
    }
}
__device__ __forceinline__ void ph_attn(int wv, LAS unsigned char* lds) {
    const Ctx c = mkctx(wv);
    for (int u = c.bid; u < NB * 4 * 8; u += c.G) {
        const int qc = u & 7, h = (u >> 3) & 3, b = u >> 5;
        { KArgs A = kargs(); unsigned char* ws = A->ws;
          naive_attn_unit<96, 64, false>(lds + RING_OFF, WSP(bf16, B_CQ), 384, 96, WSP(bf16, B_CK), 384, 96, WSP(bf16, B_KVPRE) + 64, 512, 128, WSP(bf16, B_O) + 512, DM, b, h, qc, nullptr, c.tid); }
        { KArgs A = kargs(); unsigned char* ws = A->ws; bf16* PROJ = WSP(bf16, B_PROJ);
          naive_attn_unit<64, 64, true>(lds + RING_OFF, PROJ + PJ_BQ, PJ_LD, 64, PROJ + PJ_BK, PJ_LD, 64, PROJ + PJ_BV, PJ_LD, 64, WSP(bf16, B_O) + 256, DM, b, h, 7 - qc, WSP(int, MS_SEL), c.tid); }
    }
}
__device__ __forceinline__ void ph_gates(int wv, LAS unsigned char* lds) {
    const Ctx c = mkctx(wv);
    KArgs A = kargs(); unsigned char* ws = A->ws;
    pg8::Gemm g{WSP(bf16, WS_XB), WSP(bf16, W_G), DM, DM, DM}; pg8::StaticOrder S; S.init(T, 4096, c.G, c.bid);
    pg8::EpiScale<1> E{WSP(bf16, B_SG), 4096, pg8::RowScale{WSP(float, WS_SSA), 1}};
    pg8::gemm_phase<pg8::EpiScale<1>, pg8::StaticOrder, true, true>(lds + RING_OFF, g, S, E, c.tid);
}
__device__ __forceinline__ void ph_merge(int wv, LAS unsigned char* lds) {
    const Ctx c = mkctx(wv);
    KArgs A = kargs(); unsigned char* ws = A->ws;
    pg8::Gemm g{WSP(bf16, B_O), WSP(bf16, W_B), DM, 256, 256}; pg8::MergeOrder S; S.so.init(T, DM, c.G, c.bid);
    pg8::EpiMerge E{WSP(bf16, B_SG), WSP(bf16, B_Y)};
    pg8::gemm_phase<pg8::EpiMerge, pg8::MergeOrder, true, true>(lds + RING_OFF, g, S, E, c.tid);
}
__device__ __forceinline__ void ph_wout(int wv, LAS unsigned char* lds, int l) {
    const Ctx c = mkctx(wv);
    KArgs A = kargs(); unsigned char* ws = A->ws;
    pg8::Gemm g{WSP(bf16, B_Y), WSP(bf16, W_OUT), DM, DM, DM}; pg8::StaticOrder S; S.init(T, DM, c.G, c.bid);
    pg8::EpiResidual E{l == 0 ? IN_F(0) : (const float*)A->out, A->out, WSP(bf16, WS_XB), WSP(float, WS_SSB)};
    pg8::gemm_phase<pg8::EpiResidual, pg8::StaticOrder, true, true>(lds + RING_OFF, g, S, E, c.tid);
}
__device__ __forceinline__ void ph_ffn_up(int wv, LAS unsigned char* lds) {
    const Ctx c = mkctx(wv);
    KArgs A = kargs(); unsigned char* ws = A->ws;
    pg8::Gemm g{WSP(bf16, WS_XB), WSP(bf16, W_F1), DM, DM, DM}; pg8::StaticOrder S; S.init(T, 2 * FFN, c.G, c.bid);
    pg8::EpiScale<2> E{WSP(bf16, B_HID), FFN, pg8::RowScale{WSP(float, WS_SSB), 1}};
    pg8::gemm_phase<pg8::EpiScale<2>, pg8::StaticOrder, true, true>(lds + RING_OFF, g, S, E, c.tid);
}
__device__ __forceinline__ void ph_ffn_down(int wv, LAS unsigned char* lds) {
    const Ctx c = mkctx(wv);
    KArgs A = kargs(); unsigned char* ws = A->ws;
    pg8::Gemm g{WSP(bf16, B_HID), WSP(bf16, W_F2), FFN, FFN, FFN}; pg8::StaticOrder S; S.init(T, DM, c.G, c.bid);
    pg8::EpiResidual E{A->out, A->out, WSP(bf16, WS_XB), WSP(float, WS_SSA)};
    pg8::gemm_phase<pg8::EpiResidual, pg8::StaticOrder, true, true>(lds + RING_OFF, g, S, E, c.tid);
}
__device__ __forceinline__ void ph_router(int wv, int l) {
    const Ctx c = mkctx(wv);
    KArgs A = kargs(); unsigned char* ws = A->ws; const int li = l >> 1; const int lane = c.lane;
    gu32* mcnt = (gu32*)(ws + WS_CTL) + CW_MOE + 64 * li;
    const float* fn = IN_F(3) + l * DM; const float* wr_ = IN_F(26) + (size_t)li * DM * NE; const float* rb = IN_F(27) + li * NE;
    const float* xout = A->out; const float* SSB = WSP(float, WS_SSB); int* TOKE = WSP(int, MS_TOKE); float* TOKW = WSP(float, MS_TOKW);
    for (int tok = c.gw; tok < T; tok += c.NGW) {
        const float sp = (lane < 16) ? SSB[(size_t)tok * 16 + lane] : 0.f;
        const float rstd = rsqrtf(wave_sum(sp) * (1.0f / 1024.0f) + EPS);
        float pl[8];
#pragma unroll
        for (int e = 0; e < 8; ++e) pl[e] = 0.f;
#pragma unroll
        for (int j = 0; j < 4; ++j) {
            const int k0 = (64 * j + lane) * 4; const f32x4 xv = *(const f32x4*)(xout + (size_t)tok * DM + k0); const f32x4 gv = *(const f32x4*)(fn + k0);
#pragma unroll
            for (int q = 0; q < 4; ++q) { const float hv = xv[q] * rstd * gv[q]; const f32x4 w0 = *(const f32x4*)(wr_ + (size_t)(k0 + q) * 8), w1 = *(const f32x4*)(wr_ + (size_t)(k0 + q) * 8 + 4);
                pl[0] += hv * w0[0]; pl[1] += hv * w0[1]; pl[2] += hv * w0[2]; pl[3] += hv * w0[3]; pl[4] += hv * w1[0]; pl[5] += hv * w1[1]; pl[6] += hv * w1[2]; pl[7] += hv * w1[3]; }
        }
#pragma unroll
        for (int e = 0; e < 8; ++e) pl[e] = wave_sum(pl[e]) + rb[e];
        int e0 = 0; float l0 = pl[0];
#pragma unroll
        for (int e = 1; e < 8; ++e) if (pl[e] > l0) { l0 = pl[e]; e0 = e; }
        int e1 = -1; float l1 = -INFINITY;
#pragma unroll
        for (int e = 0; e < 8; ++e) if (e != e0 && pl[e] > l1) { l1 = pl[e]; e1 = e; }
        const float tt = expf(l1 - l0); const float w0 = 1.0f / (1.0f + tt), w1 = tt / (1.0f + tt);
        if (lane == 0) { TOKE[tok * 2] = e0; TOKE[tok * 2 + 1] = e1; TOKW[tok * 2] = w0; TOKW[tok * 2 + 1] = w1;
            __hip_atomic_fetch_add(mcnt + e0, 1u, RLX_AGENT); __hip_atomic_fetch_add(mcnt + e1, 1u, RLX_AGENT); }
    }
}
__device__ __forceinline__ void ph_assign(int wv, int l) {
    const Ctx c = mkctx(wv);
    KArgs A = kargs(); unsigned char* ws = A->ws; const int li = l >> 1; const int lane = c.lane;
    gu32* mcnt = (gu32*)(ws + WS_CTL) + CW_MOE + 64 * li; gu32* mcur = mcnt + 16;
    const float* SSB = WSP(float, WS_SSB); const int* TOKE = WSP(int, MS_TOKE); int* TOKS = WSP(int, MS_TOKS); float* RSSLOT = WSP(float, MS_RSSLOT);
    const bf16* XB = WSP(bf16, WS_XB); bf16* XS = WSP(bf16, B_XS);
    int ps[9]; { int acc = 0;
#pragma unroll
        for (int e = 0; e < 8; ++e) { ps[e] = acc; const int cn = (int)__hip_atomic_load(mcnt + e, RLX_AGENT); acc += (cn + 255) >> 8; } ps[8] = acc; }
    for (int tok = c.gw; tok < T; tok += c.NGW) {
        const float sp = (lane < 16) ? SSB[(size_t)tok * 16 + lane] : 0.f;
        const float rstd = rsqrtf(wave_sum(sp) * (1.0f / 1024.0f) + EPS);
        const int e0 = TOKE[tok * 2], e1 = TOKE[tok * 2 + 1];
        int s0 = 0, s1 = 0;
        if (lane == 0) {
            int b0 = 0, b1 = 0;
#pragma unroll
            for (int e = 0; e < 8; ++e) { b0 = (e == e0) ? ps[e] : b0; b1 = (e == e1) ? ps[e] : b1; }
            s0 = b0 * 256 + (int)__hip_atomic_fetch_add(mcur + e0, 1u, RLX_AGENT); s1 = b1 * 256 + (int)__hip_atomic_fetch_add(mcur + e1, 1u, RLX_AGENT);
            TOKS[tok * 2] = s0; TOKS[tok * 2 + 1] = s1; RSSLOT[s0] = rstd; RSSLOT[s1] = rstd;
        }
        s0 = __builtin_amdgcn_readfirstlane(s0); s1 = __builtin_amdgcn_readfirstlane(s1);
        const v4u* src = (const v4u*)(XB + (size_t)tok * DM) + lane; const v4u a = src[0], b = src[64];
        v4u* d0 = (v4u*)(XS + (size_t)s0 * DM) + lane; v4u* d1 = (v4u*)(XS + (size_t)s1 * DM) + lane;
        d0[0] = a; d0[64] = b; d1[0] = a; d1[64] = b;
    }
}
__device__ __forceinline__ void moe_panels(gu32* mcnt, int (&ps)[9]) { int acc = 0;
#pragma unroll
    for (int e = 0; e < 8; ++e) { ps[e] = acc; const int cn = (int)__hip_atomic_load(mcnt + e, RLX_AGENT); acc += (cn + 255) >> 8; } ps[8] = acc; }
__device__ __forceinline__ void ph_moe_up(int wv, LAS unsigned char* lds, int l) {
    const Ctx c = mkctx(wv);
    KArgs A = kargs(); unsigned char* ws = A->ws;
    pg8::MoeOrder S; S.nN = 11; moe_panels((gu32*)(ws + WS_CTL) + CW_MOE + 64 * (l >> 1), S.ps);
    S.so.init(S.ps[8] * 256, 2 * EDIM, c.G, c.bid);
    pg8::Gemm g{WSP(bf16, B_XS), WSP(bf16, W_F1), DM, DM, DM};
    pg8::EpiScale<2> E{WSP(bf16, B_HIDM), EDIM, pg8::RowScale{WSP(float, MS_RSSLOT), 2}};
    pg8::gemm_phase<pg8::EpiScale<2>, pg8::MoeOrder, true, true>(lds + RING_OFF, g, S, E, c.tid);
}
__device__ __forceinline__ void ph_moe_down(int wv, LAS unsigned char* lds, int l) {
    const Ctx c = mkctx(wv);
    KArgs A = kargs(); unsigned char* ws = A->ws;
    pg8::MoeOrder S; S.nN = 4; moe_panels((gu32*)(ws + WS_CTL) + CW_MOE + 64 * (l >> 1), S.ps);
    S.so.init(S.ps[8] * 256, DM, c.G, c.bid);
    pg8::Gemm g{WSP(bf16, B_HIDM), WSP(bf16, W_F2), EDIM, EDIM, EDIM};
    pg8::EpiScale<0> E{WSP(bf16, B_Y2), DM, pg8::RowScale{nullptr, 0}};
    pg8::gemm_phase<pg8::EpiScale<0>, pg8::MoeOrder, true, true>(lds + RING_OFF, g, S, E, c.tid);
}
__device__ __forceinline__ void ph_combine(int wv) {
    const Ctx c = mkctx(wv);
    KArgs A = kargs(); unsigned char* ws = A->ws; const int lane = c.lane;
    float* xout = A->out; const int* TOKS = WSP(int, MS_TOKS); const float* TOKW = WSP(float, MS_TOKW); const bf16* Y2 = WSP(bf16, B_Y2); bf16* XB = WSP(bf16, WS_XB); float* SSA = WSP(float, WS_SSA);
    for (int tok = c.gw; tok < T; tok += c.NGW) {
        const int s0 = TOKS[tok * 2], s1 = TOKS[tok * 2 + 1]; const float w0 = TOKW[tok * 2], w1 = TOKW[tok * 2 + 1];
        typedef unsigned u32x2v __attribute__((ext_vector_type(2)));
        float ss = 0.f;
#pragma unroll
        for (int j = 0; j < 4; ++j) {
            const int c4 = 64 * j + lane;
            f32x4 xv = *((const f32x4*)(xout + (size_t)tok * DM) + c4);
            const u32x2v ya = *((const u32x2v*)(Y2 + (size_t)s0 * DM) + c4), yb = *((const u32x2v*)(Y2 + (size_t)s1 * DM) + c4);
            xv[0] += w0 * bflo(ya.x) + w1 * bflo(yb.x); xv[1] += w0 * bfhi(ya.x) + w1 * bfhi(yb.x); xv[2] += w0 * bflo(ya.y) + w1 * bflo(yb.y); xv[3] += w0 * bfhi(ya.y) + w1 * bfhi(yb.y);
            *((f32x4*)(xout + (size_t)tok * DM) + c4) = xv;
            u32x2v w; w.x = pkbf(xv[0], xv[1]); w.y = pkbf(xv[2], xv[3]); *((u32x2v*)(XB + (size_t)tok * DM) + c4) = w;
            ss += (xv[0] * xv[0] + xv[1] * xv[1]) + (xv[2] * xv[2] + xv[3] * xv[3]);
        }
        ss = wave_sum(ss);
        if (lane < 16) SSA[(size_t)tok * 16 + lane] = (lane == 0) ? ss : 0.f;
    }
}

__global__ void __launch_bounds__(NTHR, 2) trunk_fwd(Args args) {
    extern __shared__ __attribute__((aligned(16))) unsigned char lds_raw[];
    LAS unsigned char* lds = (LAS unsigned char*)lds_raw;
    const int wv = __builtin_amdgcn_readfirstlane((int)threadIdx.x >> 6);
    for (int u = threadIdx.x; u < (LDS_BYTES - LDSCTL_OFF) / 4; u += NTHR) ((LAS unsigned*)(lds + LDSCTL_OFF))[u] = 0u;
    __syncthreads();
    volatile LAS unsigned* MISC = (volatile LAS unsigned*)(lds + MISC_OFF);
    XcdBarrier bar = xcd_barrier_post((unsigned*)((gu32*)(args.ws + WS_CTL) + CW_BAR), MISC + 8, (int)threadIdx.x);
    const int lo = args.ph_lo, hi = args.ph_hi;
    int pc = 0;
#define PH_BEGIN if (pc >= lo && pc < hi) {
#define PH_END if (pc + 1 < hi) xcd_barrier(bar, mkctx(wv).tid); } ++pc;
    for (int l = 0; l < DEPTH; ++l) {
        PH_BEGIN ph_weights(wv, lds, l); PH_END
        PH_BEGIN ph_inproj(wv, lds); PH_END
        PH_BEGIN ph_prep(wv, lds, l); PH_END
        PH_BEGIN ph_mla_up(wv, lds); PH_END
        PH_BEGIN ph_mla_post(wv, l); PH_END
        PH_BEGIN ph_attn(wv, lds); PH_END
        PH_BEGIN ph_gates(wv, lds); PH_END
        PH_BEGIN ph_merge(wv, lds); PH_END
        PH_BEGIN ph_wout(wv, lds, l); PH_END
        if (!(l & 1)) {
            PH_BEGIN ph_ffn_up(wv, lds); PH_END
            PH_BEGIN ph_ffn_down(wv, lds); PH_END
        } else {
            PH_BEGIN ph_router(wv, l); PH_END
            PH_BEGIN ph_assign(wv, l); PH_END
            PH_BEGIN ph_moe_up(wv, lds, l); PH_END
            PH_BEGIN ph_moe_down(wv, lds, l); PH_END
            PH_BEGIN ph_combine(wv); PH_END
        }
    }
#undef PH_BEGIN
#undef PH_END
}

#ifndef MK_MULTI
#define MK_MULTI 0
#endif
extern "C" void kernel_launch(void* const* d_in, const int* in_sizes, int n_in, void* d_out, int out_size, void* d_ws, size_t ws_size, hipStream_t stream) {
    static int grid = 0;
    if (grid == 0) {
        if (n_in != 31 || out_size != T * DM || ws_size < WS_END) { fprintf(stderr, "kernel_launch: unexpected problem: n_in %d out %d ws %zu (need %zu)\n", n_in, out_size, ws_size, (size_t)WS_END); grid = -1; return; }
        int dev = 0, cus = 0;
        if (hipGetDevice(&dev) != hipSuccess || hipDeviceGetAttribute(&cus, hipDeviceAttributeMultiprocessorCount, dev) != hipSuccess) { grid = -1; return; }
        if (hipFuncSetAttribute((const void*)trunk_fwd, hipFuncAttributeMaxDynamicSharedMemorySize, LDS_BYTES) != hipSuccess) { fprintf(stderr, "kernel_launch: hipFuncSetAttribute failed\n"); grid = -1; return; }
        int per_cu = 0;
        if (hipOccupancyMaxActiveBlocksPerMultiprocessor(&per_cu, (const void*)trunk_fwd, NTHR, LDS_BYTES) != hipSuccess || per_cu < 1) fprintf(stderr, "kernel_launch: occupancy query says %d\n", per_cu);
        (void)hipGetLastError();
        grid = cus;
    }
    if (grid < 0) return;
    (void)hipMemsetAsync((char*)d_ws + WS_CTL, 0, CTL_ZERO_BYTES, stream);
    Args a{};
    for (int i = 0; i < 31; ++i) a.in[i] = d_in[i];
    a.out = (float*)d_out; a.ws = (unsigned char*)d_ws;
#if MK_MULTI
    for (int p = 0; p < N_PHASES; ++p) { a.ph_lo = p; a.ph_hi = p + 1; hipLaunchKernelGGL(trunk_fwd, dim3(grid), dim3(NTHR), LDS_BYTES, stream, a); }
#else
    a.ph_lo = 0; a.ph_hi = N_PHASES;
    hipLaunchKernelGGL(trunk_fwd, dim3(grid), dim3(NTHR), LDS_BYTES, stream, a);
#endif
}
```

```cpp
#include <hip/hip_runtime.h>
#include <cstdio>
#include <cstdint>
#include <cmath>
namespace pg8 {
#define PG8_LAS __attribute__((address_space(3)))
typedef unsigned short bf16_t;
typedef short bf16x8 __attribute__((ext_vector_type(8)));
typedef float f32x4 __attribute__((ext_vector_type(4)));
typedef unsigned u32x4 __attribute__((ext_vector_type(4)));
constexpr int BM = 256, BK = 64, HALF = 128, HTB = HALF * BK * 2  , STAGE_BYTES = 8 * HTB, NXCD = 8, WGM = 8;

__host__ __device__ __forceinline__ int lds_byte(int r, int c) { const int st = (r >> 4) * 2 + (c >> 5), rr = r & 15, cc = c & 31, ob = rr * 64 + cc * 2; return st * 1024 + (ob ^ (((ob >> 9) & 1) << 5)); }
__host__ __device__ __forceinline__ void stage_rc(int b, int& R, int& C) { const int st = b / 1024, sb = b % 1024, swz = sb ^ (((sb >> 9) & 1) << 5); R = (st >> 1) * 16 + swz / 64; C = (st & 1) * 32 + (swz % 64) / 2; }
__host__ __device__ __forceinline__ int perm32(int rho) { const int n = rho >> 4, i = rho & 15; return 8 * (i >> 2) + 4 * n + (i & 3); }

struct Unit { int pm, pn, pb, ak; };
struct Gemm { const bf16_t* A; const bf16_t* Bt; int lda, ldb, K; };

struct StaticOrder {
    int nM, nN, nwg, G, c;
    __host__ __device__ void init(int M, int N, int G_, int c_) { nM = M / BM; nN = N / BM; nwg = nM * nN; G = G_; c = c_; }
    __host__ __device__ bool next(int i, Unit& u) const {
        const long L = (long)i * G + c; if (L >= nwg) return false;
        int wgid = (int)L; { const int q = nwg / NXCD, r = nwg % NXCD, xcd = wgid % NXCD, off = wgid / NXCD; wgid = (xcd < r ? xcd * (q + 1) : r * (q + 1) + (xcd - r) * q) + off; }
        const int nig = WGM * nN, gid = wgid / nig, fm = gid * WGM, gsz = (nM - fm) < WGM ? (nM - fm) : WGM;
        u.pm = fm + ((wgid % nig) % gsz); u.pn = (wgid % nig) / gsz; u.pb = u.pn; u.ak = 0; return true;
    }
    __device__ __forceinline__ void a_ready(const Unit&) const {}
    __device__ __forceinline__ void done(const Unit&) const {}
};

template <class Epi, class Sched, bool ALIGN_EPI = false, bool SP2 = false>
__device__ __forceinline__ void gemm_phase(PG8_LAS unsigned char* lds, const Gemm g, const Sched& S, const Epi& E, const int tid) {
    const int wid = __builtin_amdgcn_readfirstlane(tid >> 6), lane = tid & 63, wr = wid >> 2, wc = wid & 3, fr = lane & 15, fq = lane >> 4;
    const int K = g.K, nt = K / BK;
    unsigned voffA[2], voffB[2];
#pragma unroll
    for (int i = 0; i < 2; ++i) { int R, C; stage_rc(tid * 16 + i * 8192, R, C); const int Rb = Epi::PERM ? ((R & ~31) + perm32(R & 31)) : R;
        voffA[i] = (unsigned)(R * g.lda + C) * 2u; voffB[i] = (unsigned)(Rb * g.ldb + C) * 2u; }
    const size_t kstep = (size_t)(BK * 2);
    const size_t hstepA = (size_t)HALF * g.lda * 2, hstepB = (size_t)HALF * g.ldb * 2;
    const size_t tstepA = 2 * hstepA, tstepB = 2 * hstepB;
    const unsigned ldsw = (unsigned)wid * 1024u;
    const int aoff = lds_byte(wr * 64 + fr, fq * 8), boff = lds_byte(wc * 32 + fr, fq * 8);
#define PG8_SA(b, h) (((b) * 2 + (h)) * HTB)
#define PG8_SB(b, h) ((4 + (b) * 2 + (h)) * HTB)
#define PG8_STAGE(bufoff, gbase, voff) do { _Pragma("unroll") for (int _i = 0; _i < 2; ++_i) \
        __builtin_amdgcn_global_load_lds((const unsigned*)((const char*)(gbase) + (voff)[_i]), (PG8_LAS unsigned*)(lds + (bufoff) + ldsw + _i * 8192), 16, 0, 0); } while (0)
#define PG8_LDA(dst, b, h) do { _Pragma("unroll") for (int m = 0; m < 4; ++m) _Pragma("unroll") for (int k = 0; k < 2; ++k) dst[m][k] = *(const PG8_LAS bf16x8*)(lds + PG8_SA(b, h) + aoff + m * 2048 + k * 1024); } while (0)
#define PG8_LDB(dst, b, h) do { _Pragma("unroll") for (int n = 0; n < 2; ++n) _Pragma("unroll") for (int k = 0; k < 2; ++k) dst[n][k] = *(const PG8_LAS bf16x8*)(lds + PG8_SB(b, h) + boff + n * 2048 + k * 1024); } while (0)
#define PG8_MMA(ai, bj, At, Bt) do { __builtin_amdgcn_s_setprio(1); _Pragma("unroll") for (int m = 0; m < 4; ++m) _Pragma("unroll") for (int n = 0; n < 2; ++n) _Pragma("unroll") for (int k = 0; k < 2; ++k) \
        acc[ai][bj][m][n] = __builtin_amdgcn_mfma_f32_16x16x32_bf16(Bt[n][k], At[m][k], acc[ai][bj][m][n], 0, 0, 0); __builtin_amdgcn_s_setprio(0); } while (0)
#define PG8_WAIT_V(n) asm volatile("s_waitcnt vmcnt(" #n ")" ::: "memory")
#define PG8_WAIT_L(n) asm volatile("s_waitcnt lgkmcnt(" #n ")" ::: "memory")
#define PG8_BAR __builtin_amdgcn_s_barrier()
#define PG8_SCHED __builtin_amdgcn_sched_barrier(0)
    Unit cur, nxt; int ui = 0;
    if (!S.next(0, cur)) return;
    f32x4 acc[2][2][4][2];
#pragma unroll
    for (int a = 0; a < 2; ++a)
#pragma unroll
        for (int b = 0; b < 2; ++b)
#pragma unroll
            for (int m = 0; m < 4; ++m)
#pragma unroll
                for (int n = 0; n < 2; ++n) acc[a][b][m][n] = (f32x4){0.f, 0.f, 0.f, 0.f};
    bf16x8 At[4][2], B0[2][2], B1[2][2];
    const char* cA = (const char*)g.A + (size_t)cur.pm * tstepA + (size_t)cur.ak * 2; const char* cB = (const char*)g.Bt + (size_t)cur.pb * tstepB;
    S.a_ready(cur);
    if constexpr (SP2) {
        PG8_STAGE(PG8_SB(0, 0), cB, voffB); PG8_STAGE(PG8_SB(0, 1), cB + hstepB, voffB); PG8_STAGE(PG8_SA(0, 0), cA, voffA); PG8_STAGE(PG8_SA(0, 1), cA + hstepA, voffA);
        if (wr == 1) PG8_BAR;
        PG8_WAIT_V(2); PG8_BAR;
        PG8_STAGE(PG8_SB(1, 0), cB + kstep, voffB); PG8_STAGE(PG8_SA(1, 0), cA + kstep, voffA); PG8_STAGE(PG8_SB(1, 1), cB + hstepB + kstep, voffB);
        PG8_WAIT_V(6); PG8_BAR;
    } else {
        PG8_STAGE(PG8_SB(0, 0), cB, voffB); PG8_STAGE(PG8_SA(0, 0), cA, voffA); PG8_STAGE(PG8_SB(0, 1), cB + hstepB, voffB); PG8_STAGE(PG8_SA(0, 1), cA + hstepA, voffA);
        if (wr == 1) PG8_BAR;
        PG8_WAIT_V(4); PG8_BAR;
        PG8_STAGE(PG8_SB(1, 0), cB + kstep, voffB); PG8_STAGE(PG8_SA(1, 0), cA + kstep, voffA); PG8_STAGE(PG8_SB(1, 1), cB + hstepB + kstep, voffB);
        PG8_WAIT_V(6); PG8_BAR;
    }
    for (;;) {
        const bool has_next = S.next(ui + 1, nxt);
        const char* nA = has_next ? (const char*)g.A + (size_t)nxt.pm * tstepA + (size_t)nxt.ak * 2 : cA; const char* nB = has_next ? (const char*)g.Bt + (size_t)nxt.pb * tstepB : cB;
        for (int t = 0; t < nt; t += 2) {
            const bool last = (t == nt - 2);
            const char* a1 = cA + (size_t)(t + 1) * kstep;
            const char* a2 = last ? nA : cA + (size_t)(t + 2) * kstep; const char* b2 = last ? nB : cB + (size_t)(t + 2) * kstep;
            const char* a3 = a2 + kstep; const char* b3 = b2 + kstep;
            if (last && has_next) S.a_ready(nxt);
            if constexpr (SP2) {
            PG8_LDB(B0, 0, 0); PG8_LDB(B1, 0, 1); PG8_SCHED; PG8_LDA(At, 0, 0); PG8_STAGE(PG8_SA(1, 1), a1 + hstepA, voffA);
            PG8_WAIT_V(8); PG8_WAIT_L(0); PG8_BAR; PG8_MMA(0, 0, At, B0); PG8_MMA(0, 1, At, B1); PG8_BAR; PG8_SCHED;
            PG8_LDA(At, 0, 1); PG8_STAGE(PG8_SB(0, 0), b2, voffB); PG8_STAGE(PG8_SB(0, 1), b2 + hstepB, voffB); PG8_STAGE(PG8_SA(0, 0), a2, voffA);
            PG8_WAIT_V(8); PG8_WAIT_L(0); PG8_BAR; PG8_MMA(1, 0, At, B0); PG8_MMA(1, 1, At, B1); PG8_BAR; PG8_SCHED;
            PG8_LDB(B0, 1, 0); PG8_LDB(B1, 1, 1); PG8_SCHED; PG8_LDA(At, 1, 0); PG8_STAGE(PG8_SA(0, 1), a2 + hstepA, voffA);
            PG8_WAIT_V(8); PG8_WAIT_L(0); PG8_BAR; PG8_MMA(0, 0, At, B0); PG8_MMA(0, 1, At, B1); PG8_BAR; PG8_SCHED;
            PG8_LDA(At, 1, 1); PG8_STAGE(PG8_SB(1, 0), b3, voffB); PG8_STAGE(PG8_SB(1, 1), b3 + hstepB, voffB); PG8_STAGE(PG8_SA(1, 0), a3, voffA);
            PG8_WAIT_V(8); PG8_WAIT_L(0); PG8_BAR; PG8_MMA(1, 0, At, B0); PG8_MMA(1, 1, At, B1); PG8_BAR; PG8_SCHED;
            } else {
            PG8_LDB(B0, 0, 0); PG8_SCHED; PG8_LDA(At, 0, 0); PG8_STAGE(PG8_SA(1, 1), a1 + hstepA, voffA);
            PG8_WAIT_L(8); PG8_BAR; PG8_WAIT_L(0); PG8_MMA(0, 0, At, B0); PG8_BAR; PG8_SCHED;
            PG8_LDB(B1, 0, 1); PG8_STAGE(PG8_SB(0, 0), b2, voffB);
            PG8_BAR; PG8_WAIT_L(0); PG8_MMA(0, 1, At, B1); PG8_BAR;
            PG8_LDA(At, 0, 1); PG8_STAGE(PG8_SA(0, 0), a2, voffA);
            PG8_BAR; PG8_WAIT_L(0); PG8_MMA(1, 0, At, B0); PG8_BAR; PG8_SCHED;
            PG8_STAGE(PG8_SB(0, 1), b2 + hstepB, voffB);
            PG8_WAIT_V(6); PG8_BAR; PG8_MMA(1, 1, At, B1); PG8_BAR;
            PG8_LDB(B0, 1, 0); PG8_SCHED; PG8_LDA(At, 1, 0); PG8_STAGE(PG8_SA(0, 1), a2 + hstepA, voffA);
            PG8_WAIT_L(8); PG8_BAR; PG8_WAIT_L(0); PG8_MMA(0, 0, At, B0); PG8_BAR; PG8_SCHED;
            PG8_LDB(B1, 1, 1); PG8_STAGE(PG8_SB(1, 0), b3, voffB);
            PG8_BAR; PG8_WAIT_L(0); PG8_MMA(0, 1, At, B1); PG8_BAR;
            PG8_LDA(At, 1, 1); PG8_STAGE(PG8_SA(1, 0), a3, voffA);
            PG8_BAR; PG8_WAIT_L(0); PG8_MMA(1, 0, At, B0); PG8_BAR; PG8_SCHED;
            PG8_STAGE(PG8_SB(1, 1), b3 + hstepB, voffB);
            PG8_WAIT_V(6); PG8_BAR; PG8_MMA(1, 1, At, B1); PG8_BAR;
            }
        }
        if constexpr (ALIGN_EPI) { if (wr == 0) PG8_BAR; }
        const bool keep = E(acc, cur, wr, wc, fr, fq);
        if (!has_next) break;
        if (!keep) {
#pragma unroll
        for (int a = 0; a < 2; ++a)
#pragma unroll
            for (int b = 0; b < 2; ++b)
#pragma unroll
                for (int m = 0; m < 4; ++m)
#pragma unroll
                    for (int n = 0; n < 2; ++n) acc[a][b][m][n] = (f32x4){0.f, 0.f, 0.f, 0.f};
        }
        cur = nxt; cA = nA; cB = nB; ++ui;
        if constexpr (ALIGN_EPI) { if (wr == 1) PG8_BAR; }
    }
    PG8_WAIT_V(0);
    if constexpr (!ALIGN_EPI) { if (wr == 0) PG8_BAR; }
    PG8_BAR;
#undef PG8_SA
#undef PG8_SB
#undef PG8_STAGE
#undef PG8_LDA
#undef PG8_LDB
#undef PG8_MMA
#undef PG8_WAIT_V
#undef PG8_WAIT_L
#undef PG8_BAR
#undef PG8_SCHED
}
}
#define GAS __attribute__((address_space(1)))
#define LAS __attribute__((address_space(3)))
typedef unsigned short bf16;
typedef unsigned v4u __attribute__((ext_vector_type(4)));
typedef float f32x4 __attribute__((ext_vector_type(4)));
typedef short bf16x8 __attribute__((ext_vector_type(8)));
typedef GAS unsigned gu32;
typedef GAS unsigned long long gu64;
#define RLX_AGENT __ATOMIC_RELAXED, __HIP_MEMORY_SCOPE_AGENT
#define LDS_WAIT() asm volatile("s_waitcnt lgkmcnt(0)" ::: "memory")
#define VM_WAIT() asm volatile("s_waitcnt vmcnt(0)" ::: "memory")
__device__ __forceinline__ unsigned long long rt() { return __builtin_amdgcn_s_memrealtime(); }
__device__ __forceinline__ unsigned f2bf(float f) { unsigned u = __builtin_bit_cast(unsigned, f); return (u + 0x7fffu + ((u >> 16) & 1u)) >> 16; }
__device__ __forceinline__ unsigned pk2(float lo, float hi) { return f2bf(lo) | (f2bf(hi) << 16); }

#define XB_TMO      128
#define XB_XCNT(j)  (256  + 64 * (j))
#define XB_XSUB(j)  (1280 + 64 * (j))
#define XB_XGEN(j)  (2304 + 64 * (j))
#define XB_TOP      3328
#define XB_TOPGEN   3392
#define XCD_BAR_WORDS 3456
#define XB_SPIN_CAP (1u << 18)

__device__ __forceinline__ unsigned xb_ld(unsigned* p)              { return __hip_atomic_load(p, __ATOMIC_RELAXED, __HIP_MEMORY_SCOPE_AGENT); }
__device__ __forceinline__ unsigned xb_add(unsigned* p, unsigned v) { return __hip_atomic_fetch_add(p, v, __ATOMIC_RELAXED, __HIP_MEMORY_SCOPE_AGENT); }
__device__ __forceinline__ unsigned xb_xcc_id() { return (unsigned)__builtin_amdgcn_s_getreg((3 << 11) | 20) & 0xFu; }
#define XB_SPIN(cond, bar) do { unsigned _sp = 0; while (cond) { __builtin_amdgcn_s_sleep(1); \
    if ((++_sp & 255u) == 0u) { if (xb_ld(&(bar)[XB_TMO])) break; if (_sp > XB_SPIN_CAP) { atomicAdd(&(bar)[XB_TMO], 1u); break; } } } } while (0)

struct XcdBarrier {
    unsigned* bar; unsigned x;
    volatile LAS unsigned* st;
};

__device__ __forceinline__ XcdBarrier xcd_barrier_post(unsigned* bar, volatile LAS unsigned* st, const int tid) {
    XcdBarrier b; b.bar = bar; b.x = xb_xcc_id(); b.st = st;
    if (tid == 0) (void)xb_add(&bar[XB_XCNT(b.x)], 1u);
    return b;
}
__device__ __forceinline__ void xcd_barrier_complete(unsigned* bar, unsigned x, unsigned& nloc, unsigned& nx) {
    const unsigned G = gridDim.x * gridDim.y * gridDim.z;
    unsigned sum, cnt, mine, sp = 0u;
    for (;;) {
        sum = 0u; cnt = 0u; mine = 0u;
#pragma unroll
        for (unsigned j = 0; j < 16; ++j) { const unsigned c = xb_ld(&bar[XB_XCNT(j)]); sum += c; cnt += (c > 0u) ? 1u : 0u; mine = (j == x) ? c : mine; }
        if (sum == G) break;
        __builtin_amdgcn_s_sleep(1);
        if ((++sp & 255u) == 0u) { if (xb_ld(&bar[XB_TMO])) break; if (sp > XB_SPIN_CAP) { atomicAdd(&bar[XB_TMO], 1u); break; } }
    }
    nloc = mine > 0u ? mine : 1u; nx = cnt > 0u ? cnt : 1u;
}

__device__ __forceinline__ void xcd_barrier(const XcdBarrier& b, const int tid) {
    asm volatile("s_waitcnt vmcnt(0)" ::: "memory");
    __syncthreads();
    if (tid == 0) {
        unsigned* bar = b.bar; asm volatile("" : "+s"(bar));
        __builtin_amdgcn_s_waitcnt(0);
        unsigned nloc = b.st[0], nx = b.st[1];
        if (nloc == 0u) { unsigned xl_ = b.x; asm volatile("" : "+s"(xl_)); xcd_barrier_complete(bar, xl_, nloc, nx); b.st[0] = nloc; b.st[1] = nx; }
        const unsigned old = xb_add(&bar[XB_XSUB(b.x)], 1u);
        const unsigned gen = old / nloc;
        if (old + 1u == (gen + 1u) * nloc) {
            __builtin_amdgcn_fence(__ATOMIC_RELEASE, "agent");
            asm volatile("s_waitcnt vmcnt(0)" ::: "memory");
            const unsigned og = xb_add(&bar[XB_TOP], 1u);
            const unsigned tg = og / nx;
            if (og + 1u == (tg + 1u) * nx) xb_add(&bar[XB_TOPGEN], 1u);
            else XB_SPIN(xb_ld(&bar[XB_TOPGEN]) == tg, bar);
            __builtin_amdgcn_fence(__ATOMIC_ACQUIRE, "agent");
            xb_add(&bar[XB_XGEN(b.x)], 1u);
            asm volatile("s_waitcnt vmcnt(0)" ::: "memory");
        } else {
            XB_SPIN(xb_ld(&bar[XB_XGEN(b.x)]) == gen, bar);
            __builtin_amdgcn_fence(__ATOMIC_ACQUIRE, "agent");
            asm volatile("s_waitcnt vmcnt(0)" ::: "memory");
        }
    }
    __syncthreads();
}
constexpr int NB = 8, SEQ = 4096, DM = 1024, T = NB * SEQ, DEPTH = 4, IN_COLS = 6240;
constexpr int FFN = 2816, NE = 8, EDIM = 1408;
constexpr float EPS = 1e-6f, LOG2E = 1.4426950408889634f;
constexpr int PJ_LD = 2304, PJ_U = 0, PJ_V = 256, PJ_BQ = 512, PJ_BK = 768, PJ_BV = 1024, PJ_DA = 1280, PJ_DG = 1536, PJ_CQ = 1792, PJ_CKV = 1984, PJ_KR = 2112;
constexpr float QS_B = 0.125f * LOG2E;
constexpr float QS_C = 0.10206207261596577f * LOG2E;
constexpr int NWAVES = 8, NTHR = 512;

constexpr size_t MiB = 1u << 20;
constexpr size_t WS_CTL = 0, CTL_ZERO_BYTES = 1 * MiB;
constexpr size_t WS_SSA = 1 * MiB, WS_SSB = 3 * MiB;
constexpr size_t WS_ROPE = 5 * MiB;
constexpr size_t WS_MISC = 11 * MiB;
constexpr size_t MS_RSCQ = WS_MISC, MS_RSCKV = WS_MISC + 128 * 1024, MS_SEL = WS_MISC + 256 * 1024, MS_KMEAN = WS_MISC + 768 * 1024,
                 MS_TOKE = WS_MISC + 1024 * 1024, MS_TOKW = WS_MISC + 1280 * 1024, MS_TOKS = WS_MISC + 1536 * 1024, MS_RSSLOT = WS_MISC + 1792 * 1024,
                 MS_WCNT = WS_MISC + 2304 * 1024, MS_WGCNT = WS_MISC + 2560 * 1024, MS_MTOT = WS_MISC + 2816 * 1024, MS_WSGU = WS_MISC + 2880 * 1024;
constexpr size_t WS_W = 14 * MiB;
constexpr size_t W_INR = WS_W, W_G = WS_W + 4 * MiB + 512 * 1024, W_UQ = WS_W + 12 * MiB + 512 * 1024, W_UKV = W_UQ + 256 * 1024, W_B = WS_W + 13 * MiB, W_OUT = WS_W + 15 * MiB,
                 W_F1 = WS_W + 17 * MiB, W_F2 = WS_W + 61 * MiB;
constexpr size_t WS_SSC = 98 * MiB;
constexpr size_t WS_XB = 100 * MiB;
constexpr size_t WS_BIG = 164 * MiB;
constexpr size_t B_PROJ = WS_BIG, B_QPRE = WS_BIG + 144 * MiB, B_KVPRE = WS_BIG + 176 * MiB  , B_CQ = WS_BIG + 208 * MiB, B_CK = WS_BIG + 232 * MiB, B_O = WS_BIG + 256 * MiB;
constexpr size_t B_SG = WS_BIG, B_Y = WS_BIG + 320 * MiB;
constexpr size_t B_HID = WS_BIG;
constexpr size_t B_XS = WS_BIG, B_HIDM = WS_BIG + 132 * MiB, B_Y2 = WS_BIG;
constexpr size_t WS_END = WS_BIG + 384 * MiB;
constexpr int MOE_ROWS_MAX = 65536 + 8 * 256;
static_assert(B_HIDM + (size_t)MOE_ROWS_MAX * EDIM * 2 <= WS_END && (size_t)MOE_ROWS_MAX * 1024 * 2 <= 132 * MiB, "moe map");
constexpr int CW_TMO = 0, CW_BAR = 4096, CW_MOE = 8192, CW_KMX = 9216;

constexpr int RING_OFF = 0, RING_BYTES = 131072;
constexpr int LDSCTL_OFF = RING_BYTES, MISC_OFF = LDSCTL_OFF + 320;
constexpr int LDS_BYTES = 147456;
constexpr int EPI_RED_OFF = 132096;

typedef float f32x2 __attribute__((ext_vector_type(2)));
typedef __bf16 bf16x2_t __attribute__((ext_vector_type(2)));
__device__ __forceinline__ unsigned pkbf(float lo, float hi) { f32x2 v = {lo, hi}; bf16x2_t b = __builtin_convertvector(v, bf16x2_t); return __builtin_bit_cast(unsigned, b); }
__device__ __forceinline__ float bflo(unsigned w) { return __uint_as_float(w << 16); }
__device__ __forceinline__ float bfhi(unsigned w) { return __uint_as_float(w & 0xffff0000u); }
__device__ __forceinline__ float bf1(bf16 b) { return __uint_as_float((unsigned)b << 16); }
__device__ __forceinline__ void unpack8(const v4u w, float* o) { o[0] = bflo(w.x); o[1] = bfhi(w.x); o[2] = bflo(w.y); o[3] = bfhi(w.y); o[4] = bflo(w.z); o[5] = bfhi(w.z); o[6] = bflo(w.w); o[7] = bfhi(w.w); }
__device__ __forceinline__ v4u pack8(const float* o) { v4u w; w.x = pkbf(o[0], o[1]); w.y = pkbf(o[2], o[3]); w.z = pkbf(o[4], o[5]); w.w = pkbf(o[6], o[7]); return w; }
template <int X> __device__ __forceinline__ float swz_xor(float v) { return __int_as_float(__builtin_amdgcn_ds_swizzle(__float_as_int(v), (X << 10) | 0x1f)); }
__device__ __forceinline__ float half_sum(float v) { auto rr = __builtin_amdgcn_permlane32_swap(__float_as_uint(v), __float_as_uint(v), false, false); return __uint_as_float(rr[0]) + __uint_as_float(rr[1]); }
__device__ __forceinline__ float wave_sum(float v) {
    v += swz_xor<1>(v); v += swz_xor<2>(v); v += swz_xor<4>(v); v += swz_xor<8>(v); v += swz_xor<16>(v);
    return half_sum(v);
}
__device__ __forceinline__ float fast_sigmoid(float x) { return __builtin_amdgcn_rcpf(1.0f + __builtin_amdgcn_exp2f(-x * LOG2E)); }
__device__ __forceinline__ float fast_silu(float x) { return x * fast_sigmoid(x); }
namespace pg8 {
struct RowScale { const float* p; int mode; };
__device__ __forceinline__ float row_scale(const RowScale& rs, int row) {
    if (rs.mode == 0) return 1.f;
    if (rs.mode == 2) return rs.p[row];
    if (rs.mode == 3) { const f32x4 p = *(const f32x4*)(rs.p + (size_t)row * 12); return rsqrtf(((p[0] + p[1]) + (p[2] + p[3])) * (1.0f / 192.0f) + EPS); }
    if (rs.mode == 4) { const f32x4 p = *(const f32x4*)(rs.p + (size_t)row * 12 + 4); return rsqrtf(((p[0] + p[1]) + (p[2] + p[3])) * (1.0f / 128.0f) + EPS); }
    { const f32x4 p = *(const f32x4*)(rs.p + (size_t)row * 4); return rsqrtf(((p[0] + p[1]) + (p[2] + p[3])) * (1.0f / 1024.0f) + EPS); }
}
template <int ACT> struct EpiScale {
    static constexpr bool PERM = true;
    bf16_t* O; int ldc; RowScale rs; float* ssc;
    __device__ __forceinline__ bool operator()(f32x4 (&acc)[2][2][4][2], const Unit& u, int wr, int wc, int fr, int fq) const {
        const int row0 = u.pm * BM + wr * 64 + fr;
        float scv[2][4];
#pragma unroll
        for (int ai = 0; ai < 2; ++ai)
#pragma unroll
            for (int m = 0; m < 4; ++m) scv[ai][m] = row_scale(rs, row0 + ai * HALF + m * 16);
#pragma unroll
        for (int ai = 0; ai < 2; ++ai)
#pragma unroll
            for (int m = 0; m < 4; ++m) {
                const int row = row0 + ai * HALF + m * 16; const float sc = scv[ai][m];
                if (ACT == 2) {
                    bf16_t* rowp = O + (size_t)row * ldc + u.pn * HALF + wc * 32 + 8 * fq;
                    const f32x4 g0 = acc[ai][0][m][0] * sc, g1 = acc[ai][0][m][1] * sc, u0 = acc[ai][1][m][0] * sc, u1 = acc[ai][1][m][1] * sc;
                    u32x4 w; w.x = pkbf(fast_silu(g0[0]) * u0[0], fast_silu(g0[1]) * u0[1]); w.y = pkbf(fast_silu(g0[2]) * u0[2], fast_silu(g0[3]) * u0[3]);
                    w.z = pkbf(fast_silu(g1[0]) * u1[0], fast_silu(g1[1]) * u1[1]); w.w = pkbf(fast_silu(g1[2]) * u1[2], fast_silu(g1[3]) * u1[3]);
                    *(u32x4*)rowp = w;
                } else {
                    bf16_t* rowp = O + (size_t)row * ldc + u.pn * BM + wc * 32 + 8 * fq;
                    float sq[2] = {0.f, 0.f};
#pragma unroll
                    for (int bj = 0; bj < 2; ++bj) {
                        f32x4 v0 = acc[ai][bj][m][0] * sc, v1 = acc[ai][bj][m][1] * sc;
                        if (ACT == 0) sq[bj] = ((v0[0] * v0[0] + v0[1] * v0[1]) + (v0[2] * v0[2] + v0[3] * v0[3])) + ((v1[0] * v1[0] + v1[1] * v1[1]) + (v1[2] * v1[2] + v1[3] * v1[3]));
                        if (ACT == 1) {
#pragma unroll
                            for (int j = 0; j < 4; ++j) { v0[j] = fmaxf(fast_sigmoid(v0[j]), 8.6736174e-19f); v1[j] = fmaxf(fast_sigmoid(v1[j]), 8.6736174e-19f); }
                        }
                        u32x4 w; w.x = pkbf(v0[0], v0[1]); w.y = pkbf(v0[2], v0[3]); w.z = pkbf(v1[0], v1[1]); w.w = pkbf(v1[2], v1[3]);
                        *(u32x4*)(rowp + bj * HALF) = w;
                    }
                    if (ACT == 0 && ssc != nullptr && (u.pn == 7 || u.pn == 8)) {
                        float a = (u.pn == 7) ? (sq[0] + (wc < 2 ? sq[1] : 0.f)) : sq[0];
                        float c = sq[1];
                        a += swz_xor<16>(a); a = half_sum(a); c += swz_xor<16>(c); c = half_sum(c);
                        if (fq == 0) {
                            float* sp = ssc + (size_t)row * 12;
                            if (u.pn == 7) { sp[wc] = a; if (wc >= 2) sp[4 + wc] = c; }
                            else { if (wc < 2) sp[4 + wc] = a; if (wc == 2) sp[8] = a; }
                        }
                    }
                }
            }
        return false;
    }
};
struct EpiResidual {
    static constexpr bool PERM = false;
    const float* base; float* out; bf16_t* xb; float* ssp; PG8_LAS float* red;
    __device__ __forceinline__ bool operator()(f32x4 (&acc)[2][2][4][2], const Unit& u, int wr, int wc, int fr, int fq) const {
        typedef unsigned u32x2v __attribute__((ext_vector_type(2)));
        const int row0 = u.pm * BM + wr * 64 + fr, col0 = u.pn * BM + wc * 32 + 4 * fq;
#pragma unroll
        for (int ai = 0; ai < 2; ++ai)
#pragma unroll
            for (int mp = 0; mp < 2; ++mp) {
                f32x4 bv[2][2][2];
#pragma unroll
                for (int mm = 0; mm < 2; ++mm)
#pragma unroll
                    for (int bj = 0; bj < 2; ++bj)
#pragma unroll
                        for (int n = 0; n < 2; ++n) bv[mm][bj][n] = *(const f32x4*)(base + (size_t)(row0 + ai * HALF + (2 * mp + mm) * 16) * DM + col0 + bj * HALF + n * 16);
#pragma unroll
                for (int mm = 0; mm < 2; ++mm) {
                    const int m = 2 * mp + mm, row = row0 + ai * HALF + m * 16; const size_t off = (size_t)row * DM + col0; float ss = 0.f;
#pragma unroll
                    for (int bj = 0; bj < 2; ++bj)
#pragma unroll
                        for (int n = 0; n < 2; ++n) {
                            const size_t o2 = off + bj * HALF + n * 16; const f32x4 o = bv[mm][bj][n] + acc[ai][bj][m][n];
                            *(f32x4*)(out + o2) = o;
                            u32x2v w; w.x = pkbf(o[0], o[1]); w.y = pkbf(o[2], o[3]); *(u32x2v*)(xb + o2) = w;
                            ss += (o[0] * o[0] + o[1] * o[1]) + (o[2] * o[2] + o[3] * o[3]);
                        }
                    ss += swz_xor<16>(ss); ss = half_sum(ss);
                    if (fq == 0) red[(ai * HALF + wr * 64 + m * 16 + fr) * 4 + wc] = ss;
                }
            }
        asm volatile("s_waitcnt lgkmcnt(0)" ::: "memory"); __builtin_amdgcn_s_barrier(); asm volatile("" ::: "memory");
        const int t = (wr * 4 + wc) * 64 + fq * 16 + fr;
        if (t < 256) { const f32x4 p = *(const PG8_LAS f32x4*)(red + t * 4); ssp[(size_t)(u.pm * BM + t) * 4 + u.pn] = (p[0] + p[1]) + (p[2] + p[3]); }
        return false;
    }
};
struct EpiKV {
    static constexpr bool PERM = true;
    bf16_t* CK; bf16_t* VB; const bf16_t* PROJ; const float* ssc; const float* rope; const float* ckn; unsigned* kmx;
    __device__ __forceinline__ bool operator()(f32x4 (&acc)[2][2][4][2], const Unit& u, int wr, int wc, int fr, int fq) const {
        typedef unsigned u32x2v __attribute__((ext_vector_type(2)));
        { unsigned mk_ = ~0u; asm volatile("" : "+s"(mk_)); const int ln_ = (int)__builtin_amdgcn_mbcnt_hi(mk_, __builtin_amdgcn_mbcnt_lo(mk_, 0u)); fr = ln_ & 15; fq = ln_ >> 4; }
        const int hh = 2 * u.pn + (wc >> 1); const bool isv = (wc & 1) != 0; const int row0 = u.pm * BM + wr * 64 + fr;
        float k2max = 0.f;
#pragma unroll
        for (int ai = 0; ai < 2; ++ai)
#pragma unroll
            for (int m = 0; m < 4; ++m) {
                const int row = row0 + ai * HALF + m * 16;
                const float* sp = ssc + (size_t)row * 12; const f32x4 pp = *(const f32x4*)(sp + 4);
                const float rs = rsqrtf(((pp[0] + pp[1]) + (pp[2] + pp[3])) * (1.0f / 128.0f) + EPS);
                if (isv) {
#pragma unroll
                    for (int bj = 0; bj < 2; ++bj) { const f32x4 v0 = acc[ai][bj][m][0] * rs, v1 = acc[ai][bj][m][1] * rs;
                        u32x4 w; w.x = pkbf(v0[0], v0[1]); w.y = pkbf(v0[2], v0[3]); w.z = pkbf(v1[0], v1[1]); w.w = pkbf(v1[2], v1[3]);
                        *(u32x4*)(VB + (size_t)row * 256 + hh * 64 + 32 * bj + 8 * fq) = w; }
                } else {
                    float ss = 0.f;
#pragma unroll
                    for (int bj = 0; bj < 2; ++bj)
#pragma unroll
                        for (int n = 0; n < 2; ++n) { const f32x4 a = acc[ai][bj][m][n]; ss += (a[0] * a[0] + a[1] * a[1]) + (a[2] * a[2] + a[3] * a[3]); }
                    ss += swz_xor<16>(ss); ss = half_sum(ss); ss *= rs * rs;
                    const float rk = rsqrtf((ss + sp[8]) * (1.0f / 96.0f) + EPS); const float rr = rs * rk;
                    bf16_t* kd = CK + (size_t)row * 384 + hh * 96; float kn2 = 0.f;
#pragma unroll
                    for (int bj = 0; bj < 2; ++bj) { const f32x4 g0 = *(const f32x4*)(ckn + 32 * bj + 8 * fq), g1 = *(const f32x4*)(ckn + 32 * bj + 8 * fq + 4);
                        const f32x4 a = acc[ai][bj][m][0] * rr * g0, b = acc[ai][bj][m][1] * rr * g1;
                        kn2 += ((a[0] * a[0] + a[1] * a[1]) + (a[2] * a[2] + a[3] * a[3])) + ((b[0] * b[0] + b[1] * b[1]) + (b[2] * b[2] + b[3] * b[3]));
                        u32x4 w; w.x = pkbf(a[0], a[1]); w.y = pkbf(a[2], a[3]); w.z = pkbf(b[0], b[1]); w.w = pkbf(b[2], b[3]);
                        *(u32x4*)(kd + 32 * bj + 8 * fq) = w; }
                    const u32x2v k1 = *(const u32x2v*)(PROJ + (size_t)row * PJ_LD + PJ_KR + 4 * fq), k2 = *(const u32x2v*)(PROJ + (size_t)row * PJ_LD + PJ_KR + 16 + 4 * fq);
                    const f32x4 ga = *(const f32x4*)(ckn + 64 + 4 * fq), gb = *(const f32x4*)(ckn + 80 + 4 * fq);
                    const float* tb = rope + (size_t)row * 48 + 16 + 8 * fq; const f32x4 t0 = *(const f32x4*)tb, t1 = *(const f32x4*)(tb + 4);
                    const float x1[4] = {bflo(k1.x) * rk * ga[0], bfhi(k1.x) * rk * ga[1], bflo(k1.y) * rk * ga[2], bfhi(k1.y) * rk * ga[3]};
                    const float x2[4] = {bflo(k2.x) * rk * gb[0], bfhi(k2.x) * rk * gb[1], bflo(k2.y) * rk * gb[2], bfhi(k2.y) * rk * gb[3]};
                    const float cs[4] = {t0[0], t0[2], t1[0], t1[2]}, sn[4] = {t0[1], t0[3], t1[1], t1[3]};
                    u32x2v y1, y2;
                    y1.x = pkbf(x1[0] * cs[0] - x2[0] * sn[0], x1[1] * cs[1] - x2[1] * sn[1]); y1.y = pkbf(x1[2] * cs[2] - x2[2] * sn[2], x1[3] * cs[3] - x2[3] * sn[3]);
                    y2.x = pkbf(x2[0] * cs[0] + x1[0] * sn[0], x2[1] * cs[1] + x1[1] * sn[1]); y2.y = pkbf(x2[2] * cs[2] + x1[2] * sn[2], x2[3] * cs[3] + x1[3] * sn[3]);
                    *(u32x2v*)(kd + 64 + 4 * fq) = y1; *(u32x2v*)(kd + 80 + 4 * fq) = y2;
                    kn2 += ((x1[0] * x1[0] + x2[0] * x2[0]) + (x1[1] * x1[1] + x2[1] * x2[1])) + ((x1[2] * x1[2] + x2[2] * x2[2]) + (x1[3] * x1[3] + x2[3] * x2[3]));
                    kn2 += swz_xor<16>(kn2); kn2 = half_sum(kn2); k2max = fmaxf(k2max, kn2);
                }
                asm volatile("" ::: "memory");
            }
        if (!isv) {
            k2max = fmaxf(k2max, swz_xor<1>(k2max)); k2max = fmaxf(k2max, swz_xor<2>(k2max)); k2max = fmaxf(k2max, swz_xor<4>(k2max)); k2max = fmaxf(k2max, swz_xor<8>(k2max));
            if (fr == 0 && fq == 0) __hip_atomic_fetch_max(kmx + ((u.pm * BM) / SEQ) * 4 + hh, __float_as_uint(k2max), __ATOMIC_RELAXED, __HIP_MEMORY_SCOPE_AGENT);
        }
        return false;
    }
};
struct EpiMlaUp {
    static constexpr bool PERM = true;
    EpiScale<0> q; EpiKV kv;
    __device__ __forceinline__ bool operator()(f32x4 (&acc)[2][2][4][2], const Unit& u, int wr, int wc, int fr, int fq) const {
        { unsigned mk_ = ~0u; asm volatile("" : "+s"(mk_)); const int ln_ = (int)__builtin_amdgcn_mbcnt_hi(mk_, __builtin_amdgcn_mbcnt_lo(mk_, 0u)); fr = ln_ & 15; fq = ln_ >> 4; }
        if (u.pn < 2) return q(acc, u, wr, wc, fr, fq);
        Unit v = u; v.pn = u.pn - 2; return kv(acc, v, wr, wc, fr, fq);
    }
};
struct MlaUpOrder {
    StaticOrder so; int akq, akkv;
    __device__ bool next(int i, Unit& u) const { if (!so.next(i, u)) return false; u.pb = u.pn; u.ak = (u.pn < 2) ? akq : akkv; return true; }
    __device__ __forceinline__ void a_ready(const Unit&) const {}
    __device__ __forceinline__ void done(const Unit&) const {}
};
struct EpiGates {
    static constexpr bool PERM = true;
    bf16_t* RG; RowScale rs;
    __device__ __forceinline__ bool operator()(f32x4 (&acc)[2][2][4][2], const Unit& u, int wr, int wc, int fr, int fq) const {
        typedef unsigned u32x2v __attribute__((ext_vector_type(2)));
        const int row0 = u.pm * BM + wr * 64 + fr, oc = u.pn * 64 + wc * 16 + fq * 4;
        float scv[2][4];
#pragma unroll
        for (int ai = 0; ai < 2; ++ai)
#pragma unroll
            for (int m = 0; m < 4; ++m) scv[ai][m] = row_scale(rs, row0 + ai * HALF + m * 16);
#pragma unroll
        for (int ai = 0; ai < 2; ++ai)
#pragma unroll
            for (int m = 0; m < 4; ++m) {
                const int row = row0 + ai * HALF + m * 16; const float sc = scv[ai][m];
                f32x4 s[4];
#pragma unroll
                for (int b = 0; b < 4; ++b) { const f32x4 g = acc[ai][b >> 1][m][b & 1] * sc;
#pragma unroll
                    for (int j = 0; j < 4; ++j) s[b][j] = fmaxf(fast_sigmoid(g[j]), 8.6736174e-19f); }
                bf16_t* rp = RG + (size_t)row * 4096 + oc;
#pragma unroll
                for (int b = 0; b < 4; ++b) { f32x4 r = s[b];
                    if (b < 3) {
#pragma unroll
                        for (int j = 0; j < 4; ++j) r[j] = s[b][j] * __builtin_amdgcn_rcpf(s[b + 1][j]); }
                    u32x2v w; w.x = pkbf(r[0], r[1]); w.y = pkbf(r[2], r[3]); *(u32x2v*)(rp + b * 1024) = w; }
            }
        return false;
    }
};
struct EpiMerge {
    static constexpr bool PERM = true;
    const bf16_t* SG; bf16_t* Y;
    __device__ __forceinline__ bool operator()(f32x4 (&acc)[2][2][4][2], const Unit& u, int wr, int wc, int fr, int fq) const {
        const int n = u.ak >> 8; const int row0 = u.pm * BM + wr * 64 + fr, col0 = u.pn * BM + wc * 32 + 8 * fq;
#pragma unroll
        for (int ai = 0; ai < 2; ++ai)
#pragma unroll
            for (int mp = 0; mp < 2; ++mp) {
              u32x4 av[2][2];
#pragma unroll
              for (int mm = 0; mm < 2; ++mm)
#pragma unroll
                for (int bj = 0; bj < 2; ++bj) av[mm][bj] = *(const u32x4*)(SG + (size_t)(row0 + ai * HALF + (2 * mp + mm) * 16) * 4096 + n * 1024 + col0 + bj * HALF);
#pragma unroll
              for (int mm = 0; mm < 2; ++mm) {
                const int m = 2 * mp + mm, row = row0 + ai * HALF + m * 16;
#pragma unroll
                for (int bj = 0; bj < 2; ++bj) {
                    float sa[8]; unpack8(av[mm][bj], sa);
#pragma unroll
                    for (int j = 0; j < 4; ++j) { acc[ai][bj][m][0][j] *= sa[j]; acc[ai][bj][m][1][j] *= sa[4 + j]; }
                    if (n == 3) {
                        float o[8];
#pragma unroll
                        for (int j = 0; j < 4; ++j) { o[j] = acc[ai][bj][m][0][j]; o[4 + j] = acc[ai][bj][m][1][j]; }
                        *(u32x4*)(Y + (size_t)row * DM + col0 + bj * HALF) = pack8(o);
                    }
                }
              }
            }
        return n < 3;
    }
};
struct MergeOrder {
    StaticOrder so;
    __device__ bool next(int i, Unit& u) const { if (!so.next(i >> 2, u)) return false; const int n = i & 3; u.pb = n * 4 + u.pn; u.ak = n * 256; return true; }
    __device__ __forceinline__ void a_ready(const Unit&) const {}
    __device__ __forceinline__ void done(const Unit&) const {}
};
struct MoeOrder {
    StaticOrder so; int nN; int ps[9];
    __device__ bool next(int i, Unit& u) const {
        if (!so.next(i, u)) return false; int e = 0;
#pragma unroll
        for (int k = 1; k < 8; ++k) e = (u.pm >= ps[k]) ? k : e;
        u.pb = e * nN + u.pn; u.ak = 0; return true; }
    __device__ __forceinline__ void a_ready(const Unit&) const {}
    __device__ __forceinline__ void done(const Unit&) const {}
};
}

struct TrDesc { const float* src; bf16* dst; const float* gain; int ldw, ldd, nnb, nsrc0, drow0, map, cum, pad; };
constexpr int TR_TAB_OFF = 8448;
struct TrItem { const float* W; bf16* dst; const float* gain; int ldw, ldd, k0, n0, perm; };
__device__ __forceinline__ void tr_load(const TrItem& it, float (&v)[32], int lane) {
#pragma unroll
    for (int i = 0; i < 32; ++i) { const int kk = 2 * i + (lane >> 5); v[i] = it.W[(size_t)(it.k0 + kk) * it.ldw + it.n0 + (lane & 31)]; }
}
__device__ __forceinline__ void tr_finish(const TrItem& it, float (&v)[32], LAS float* scr, int lane) {
    if (it.gain) {
#pragma unroll
        for (int i = 0; i < 32; ++i) v[i] *= it.gain[it.k0 + 2 * i + (lane >> 5)];
    }
#pragma unroll
    for (int i = 0; i < 32; ++i) scr[(2 * i + (lane >> 5)) * 33 + (lane & 31)] = v[i];
    LDS_WAIT(); asm volatile("" ::: "memory");
    const int c = lane & 7;
#pragma unroll
    for (int j = 0; j < 4; ++j) { const int n = (lane >> 3) + 8 * j; const LAS float* s = scr + (8 * c) * 33 + n;
        v4u o; o.x = pkbf(s[0 * 33], s[1 * 33]); o.y = pkbf(s[2 * 33], s[3 * 33]); o.z = pkbf(s[4 * 33], s[5 * 33]); o.w = pkbf(s[6 * 33], s[7 * 33]);
        const int nr = it.perm ? (32 * (n >> 4) + 8 * ((n >> 2) & 3) + (n & 3)) : n;
        *(v4u*)(it.dst + (size_t)nr * it.ldd + 8 * c) = o; }
    LDS_WAIT(); asm volatile("" ::: "memory");
}
__device__ __forceinline__ void tr_add(LAS TrDesc* t, int& n, int& cum, const float* src, int ldw, int Ktot, int ncols, int nsrc0, bf16* dst, int ldd, int drow0, int map, const float* gain) {
    int z = 0; asm volatile("" : "+s"(z));
    asm volatile("" : "+s"(gain));
    t[n].src = src; t[n].dst = dst; t[n].gain = gain; t[n].ldw = ldw + z; t[n].ldd = ldd + z; t[n].nnb = ncols / 32 + z; t[n].nsrc0 = nsrc0 + z; t[n].drow0 = drow0 + z; t[n].map = map + z; t[n].cum = cum + z;
    cum += (Ktot / 64) * (ncols / 32); ++n;
}
__device__ __forceinline__ TrItem tr_lookup(const LAS TrDesc* t, int& d, int it) {
    while (it >= t[d + 1].cum) ++d;
    const int local = it - t[d].cum, nnb = t[d].nnb, kb = local / nnb, nb = local - kb * nnb, k0 = kb * 64, nl = nb * 32;
    const int mp = t[d].map;
    const int drow = t[d].drow0 + (mp == 1 ? ((nl >> 7) * 256 + (nl & 127)) : mp == 2 ? (256 * (nl >> 8) + 128 * ((nl >> 5) & 1) + 32 * ((((nl >> 7) & 1) << 1) + ((nl >> 6) & 1)))
                                 : mp == 3 ? (256 * ((nl & 1023) >> 6) + 128 * (nl >> 11) + 32 * (((nl & 1023) >> 4) & 3) + 4 * ((nl >> 10) & 1)) : nl); const int ldd = t[d].ldd;
    TrItem r; r.W = t[d].src; r.dst = t[d].dst + (size_t)drow * ldd + k0; r.gain = t[d].gain; r.ldw = t[d].ldw; r.ldd = ldd; r.k0 = k0; r.n0 = t[d].nsrc0 + nl; r.perm = (mp == 3) ? 1 : 0; return r;
}
__device__ __forceinline__ void tr_run(const LAS TrDesc* t, int total, LAS float* scr, int lane, int gw, int NGW) {
    const int per = (total + NGW - 1) / NGW, lo = gw * per, hi = (lo + per < total) ? lo + per : total;
    if (lo >= hi) return;
    int d = 0; TrItem cur = tr_lookup(t, d, lo); float va[32], vb[32];
    tr_load(cur, va, lane);
    for (int it = lo; it < hi; it += 2) {
        TrItem nx = cur; const bool h1 = it + 1 < hi;
        if (h1) { nx = tr_lookup(t, d, it + 1); tr_load(nx, vb, lane); }
        tr_finish(cur, va, scr, lane);
        if (!h1) break;
        const bool h2 = it + 2 < hi;
        if (h2) { cur = tr_lookup(t, d, it + 2); tr_load(cur, va, lane); }
        tr_finish(nx, vb, scr, lane);
    }
}

template <int DK, int DV, bool MOBA>
__device__ __forceinline__ void naive_attn_unit(LAS unsigned char* lds, const bf16* Q, int qp, int qhs, const bf16* K, int kp, int khs, const bf16* V, int vp, int vhs,
                                                bf16* O, int op, int b, int h, int qc, const int* sel, const int tid) {
    LAS float* Ks = (LAS float*)lds; LAS float* Vs = Ks + 64 * DK;
    const int qi = qc * 512 + tid;
    const size_t tok = (size_t)b * SEQ + qi;
    float q[DK];
    { const v4u* qsrc = (const v4u*)(Q + tok * qp + h * qhs);
#pragma unroll
      for (int c = 0; c < DK / 8; ++c) unpack8(qsrc[c], q + 8 * c); }
    float o[DV];
#pragma unroll
    for (int d = 0; d < DV; ++d) o[d] = 0.f;
    float m = -1e30f, l = 0.f;
    const int qblk = qi >> 8; unsigned mask = 0u;
    if (MOBA) { const int sv = sel[tok * 4 + h]; const int ns = (sv >> 12) & 3;
        if (ns > 0) mask |= 1u << (sv & 15); if (ns > 1) mask |= 1u << ((sv >> 4) & 15); if (ns > 2) mask |= 1u << ((sv >> 8) & 15); }
    const int ntile = qc * 8 + 8;
    const int wave_last = qc * 512 + (tid | 63);
    for (int kt = 0; kt < ntile; ++kt) {
        __syncthreads();
        const int k0 = kt * 64;
        for (int c = tid; c < 64 * (DK / 8); c += NTHR) { const int r = c / (DK / 8), ch = c - r * (DK / 8);
            const v4u w = *(const v4u*)(K + ((size_t)b * SEQ + k0 + r) * kp + h * khs + ch * 8); float f[8]; unpack8(w, f);
            LAS f32x4* d = (LAS f32x4*)(Ks + r * DK + ch * 8); d[0] = (f32x4){f[0], f[1], f[2], f[3]}; d[1] = (f32x4){f[4], f[5], f[6], f[7]}; }
        for (int c = tid; c < 64 * (DV / 8); c += NTHR) { const int r = c / (DV / 8), ch = c - r * (DV / 8);
            const v4u w = *(const v4u*)(V + ((size_t)b * SEQ + k0 + r) * vp + h * vhs + ch * 8); float f[8]; unpack8(w, f);
            LAS f32x4* d = (LAS f32x4*)(Vs + r * DV + ch * 8); d[0] = (f32x4){f[0], f[1], f[2], f[3]}; d[1] = (f32x4){f[4], f[5], f[6], f[7]}; }
        __syncthreads();
        if (k0 > wave_last) continue;
        const int nblk = k0 >> 8;
        bool tile_ok = true;
        if (MOBA) { tile_ok = (nblk == qblk) || ((mask >> nblk) & 1u); if (!__any(tile_ok)) continue; }
        for (int jj = 0; jj < 64; ++jj) {
            const int kj = k0 + jj;
            const bool ok = MOBA ? (tile_ok && (nblk != qblk || kj <= qi)) : (kj <= qi);
            if (ok) {
                const LAS f32x4* kr = (const LAS f32x4*)(Ks + jj * DK);
                float s0 = 0.f, s1 = 0.f;
#pragma unroll
                for (int c = 0; c < DK / 8; ++c) { const f32x4 a = kr[2 * c], bq = kr[2 * c + 1];
                    s0 += q[8 * c] * a[0]; s1 += q[8 * c + 1] * a[1]; s0 += q[8 * c + 2] * a[2]; s1 += q[8 * c + 3] * a[3];
                    s0 += q[8 * c + 4] * bq[0]; s1 += q[8 * c + 5] * bq[1]; s0 += q[8 * c + 6] * bq[2]; s1 += q[8 * c + 7] * bq[3]; }
                const float s = s0 + s1;
                if (s > m) { const float cf = __builtin_amdgcn_exp2f(m - s); l *= cf;
#pragma unroll
                    for (int d = 0; d < DV; ++d) o[d] *= cf;
                    m = s; }
                const float p = __builtin_amdgcn_exp2f(s - m); l += p;
                const LAS f32x4* vr = (const LAS f32x4*)(Vs + jj * DV);
#pragma unroll
                for (int c = 0; c < DV / 4; ++c) { const f32x4 a = vr[c]; o[4 * c] += p * a[0]; o[4 * c + 1] += p * a[1]; o[4 * c + 2] += p * a[2]; o[4 * c + 3] += p * a[3]; }
            }
        }
    }
    const float inv = 1.0f / l;
    v4u* od = (v4u*)(O + tok * op + h * DV);
#pragma unroll
    for (int c = 0; c < DV / 8; ++c) { float t8[8];
#pragma unroll
        for (int j = 0; j < 8; ++j) t8[j] = o[8 * c + j] * inv;
        od[c] = pack8(t8); }
    __syncthreads();
}

constexpr int SGU_P = 136;
__device__ __forceinline__ void sgu_unit(LAS unsigned char* lds, const bf16* PROJ, bf16* O, const float* __restrict__ lng, const float* __restrict__ lnb, const bf16* __restrict__ WM, const float* __restrict__ bs, int unit, const int tid) {
    LAS bf16* vnT = (LAS bf16*)lds;
    const int lane = tid & 63, wave = __builtin_amdgcn_readfirstlane(tid >> 6), r32 = lane & 31, hi = lane >> 5;
    const size_t t0 = (size_t)unit * 128;
    float g4[4], b4[4];
#pragma unroll
    for (int j = 0; j < 4; ++j) { g4[j] = lng[lane + 64 * j]; b4[j] = lnb[lane + 64 * j]; }
    bf16x8 wf[20];
    { const int g_ = wave >> 1; const bf16* wb = WM + ((size_t)(g_ * 128 + r32) * 128 + 8 * hi);
#pragma unroll
      for (int nt = 0; nt < 4; ++nt)
#pragma unroll
          for (int ks = 0; ks < 2 * nt + 2; ++ks) wf[nt * (nt + 1) + ks] = *(const bf16x8*)(wb + (size_t)(32 * nt) * 128 + 16 * ks); }
    for (int i4 = 0; i4 < 4; ++i4) {
        float x[4][4];
#pragma unroll
        for (int u = 0; u < 4; ++u) { const bf16* vp = PROJ + (t0 + wave * 16 + i4 * 4 + u) * PJ_LD + PJ_V + lane;
            x[u][0] = bf1(vp[0]); x[u][1] = bf1(vp[64]); x[u][2] = bf1(vp[128]); x[u][3] = bf1(vp[192]); }
        float mu[4], var[4];
#pragma unroll
        for (int u = 0; u < 4; ++u) mu[u] = (x[u][0] + x[u][1]) + (x[u][2] + x[u][3]);
#pragma unroll
        for (int u = 0; u < 4; ++u) mu[u] = wave_sum(mu[u]) * (1.0f / 256.0f);
#pragma unroll
        for (int u = 0; u < 4; ++u) { x[u][0] -= mu[u]; x[u][1] -= mu[u]; x[u][2] -= mu[u]; x[u][3] -= mu[u]; var[u] = (x[u][0] * x[u][0] + x[u][1] * x[u][1]) + (x[u][2] * x[u][2] + x[u][3] * x[u][3]); }
#pragma unroll
        for (int u = 0; u < 4; ++u) var[u] = wave_sum(var[u]) * (1.0f / 256.0f);
#pragma unroll
        for (int u = 0; u < 4; ++u) { const int s = wave * 16 + i4 * 4 + u; const float rstd = rsqrtf(var[u] + EPS);
            const unsigned w01 = pkbf(x[u][0] * rstd * g4[0] + b4[0], x[u][1] * rstd * g4[1] + b4[1]), w23 = pkbf(x[u][2] * rstd * g4[2] + b4[2], x[u][3] * rstd * g4[3] + b4[3]);
            vnT[(lane) * SGU_P + s] = (bf16)(w01 & 0xffffu); vnT[(lane + 64) * SGU_P + s] = (bf16)(w01 >> 16);
            vnT[(lane + 128) * SGU_P + s] = (bf16)(w23 & 0xffffu); vnT[(lane + 192) * SGU_P + s] = (bf16)(w23 >> 16); }
    }
    __syncthreads();
    const int g = wave >> 1, dt = wave & 1;
    bf16x8 af[8];
#pragma unroll
    for (int ks = 0; ks < 8; ++ks) af[ks] = *(const LAS bf16x8*)(vnT + (g * 64 + dt * 32 + r32) * SGU_P + 16 * ks + 8 * hi);
    typedef float f32x16s __attribute__((ext_vector_type(16)));
    f32x16s acc[4];
#pragma unroll
    for (int nt = 0; nt < 4; ++nt) {
#pragma unroll
        for (int r = 0; r < 16; ++r) acc[nt][r] = 0.f;
#pragma unroll
        for (int ks = 0; ks < 2 * nt + 2; ++ks) {
            acc[nt] = __builtin_amdgcn_mfma_f32_32x32x16_bf16(af[ks], wf[nt * (nt + 1) + ks], acc[nt], 0, 0, 0);
        }
    }
    typedef unsigned u32x2v __attribute__((ext_vector_type(2)));
    u32x2v uva[4][4]; float biasv[4];
#pragma unroll
    for (int nt = 0; nt < 4; ++nt) { const int t = 32 * nt + r32; biasv[nt] = bs[g * 128 + t]; const bf16* up = PROJ + (t0 + t) * PJ_LD + PJ_U + g * 64 + dt * 32 + 4 * hi;
#pragma unroll
        for (int j = 0; j < 4; ++j) uva[nt][j] = *(const u32x2v*)(up + 8 * j); }
#pragma unroll
    for (int nt = 0; nt < 4; ++nt) {
        const int t = 32 * nt + r32; const float bias = biasv[nt];
        bf16* op = O + (t0 + t) * DM + g * 64 + dt * 32 + 4 * hi;
#pragma unroll
        for (int j = 0; j < 4; ++j) {
            const u32x2v uu = uva[nt][j];
            u32x2v w; w.x = pkbf(bflo(uu.x) * (acc[nt][4 * j] + bias), bfhi(uu.x) * (acc[nt][4 * j + 1] + bias)); w.y = pkbf(bflo(uu.y) * (acc[nt][4 * j + 2] + bias), bfhi(uu.y) * (acc[nt][4 * j + 3] + bias));
            *(u32x2v*)(op + 8 * j) = w;
        }
    }
    __syncthreads();
}

__device__ __forceinline__ void prep_block(LAS unsigned char* lds, bf16* PROJ, const float* __restrict__ ROPE, const float* __restrict__ qn, const float* __restrict__ kn, float* KMEAN, unsigned* kmx_out, int item, const int tid) {
    const int b = item >> 5, blk = (item >> 1) & 15, hf = item & 1;
    const int sub = tid & 7;
    const size_t tok0 = (size_t)b * SEQ + blk * 256 + hf * 128;
    float kmx = 0.f;
    f32x4 gq0 = *(const f32x4*)(qn + 8 * sub), gq1 = *(const f32x4*)(qn + 8 * sub + 4), gk0 = *(const f32x4*)(kn + 8 * sub), gk1 = *(const f32x4*)(kn + 8 * sub + 4);
#pragma unroll 1
    for (int pass = 0; pass < 16; pass += 4) {
        v4u raw[4];
#pragma unroll
        for (int u = 0; u < 4; ++u) { const int row = (pass + u) * 64 + (tid >> 3);
            const int tk = row >> 3, which = (row >> 2) & 1, hd = row & 3;
            raw[u] = *(const v4u*)(PROJ + (tok0 + tk) * PJ_LD + (which ? PJ_BK : PJ_BQ) + hd * 64 + 8 * sub); }
#pragma unroll
        for (int u = 0; u < 4; ++u) { const int row = (pass + u) * 64 + (tid >> 3);
            const int tk = row >> 3, which = (row >> 2) & 1, hd = row & 3;
            float v[8]; unpack8(raw[u], v);
            float ss = ((v[0] * v[0] + v[1] * v[1]) + (v[2] * v[2] + v[3] * v[3])) + ((v[4] * v[4] + v[5] * v[5]) + (v[6] * v[6] + v[7] * v[7]));
            ss += swz_xor<1>(ss); ss += swz_xor<2>(ss); ss += swz_xor<4>(ss);
            const float rstd = rsqrtf(ss * (1.0f / 64.0f) + EPS);
            const f32x4 g0 = which ? gk0 : gq0, g1 = which ? gk1 : gq1;
#pragma unroll
            for (int j = 0; j < 4; ++j) { v[j] *= rstd * g0[j]; v[4 + j] *= rstd * g1[j]; }
            const float* tab = ROPE + (tok0 + tk) * 48;
#pragma unroll
            for (int j = 0; j < 8; ++j) { const float other = swz_xor<1>(v[j]);
                if (sub < 2) { const float cs = tab[2 * j], sn = tab[2 * j + 1]; v[j] = (sub == 0) ? (v[j] * cs - other * sn) : (v[j] * cs + other * sn); } }
            if (!which) {
#pragma unroll
                for (int j = 0; j < 8; ++j) v[j] *= QS_B;
            } else {
                float s2 = ((v[0] * v[0] + v[1] * v[1]) + (v[2] * v[2] + v[3] * v[3])) + ((v[4] * v[4] + v[5] * v[5]) + (v[6] * v[6] + v[7] * v[7]));
                s2 += swz_xor<1>(s2); s2 += swz_xor<2>(s2); s2 += swz_xor<4>(s2); kmx = fmaxf(kmx, s2);
            }
            *(v4u*)(PROJ + (tok0 + tk) * PJ_LD + (which ? PJ_BK : PJ_BQ) + hd * 64 + 8 * sub) = pack8(v);
        }
    }
    {
        LAS float* kl = (LAS float*)lds; kl[tid] = kmx;
        __syncthreads();
        if (tid < 4) { float mx = 0.f; for (int i = 0; i < NTHR; ++i) { const bool mine = (((i >> 5) & 1) == 1) && (((i >> 3) & 3) == tid); mx = mine ? fmaxf(mx, kl[i]) : mx; }
            __hip_atomic_fetch_max(kmx_out + b * 4 + tid, __float_as_uint(mx), __ATOMIC_RELAXED, __HIP_MEMORY_SCOPE_AGENT); }
    }
    __syncthreads();
    {
        const int h = tid >> 7, d = (tid >> 1) & 63, half = tid & 1;
        const bf16* kp = PROJ + (tok0 + half * 64) * PJ_LD + PJ_BK + h * 64 + d;
#define KLD(p) __hip_atomic_load((const unsigned short*)(p), __ATOMIC_RELAXED, __HIP_MEMORY_SCOPE_AGENT)
        float s0 = 0.f, s1 = 0.f, s2 = 0.f, s3 = 0.f;
#pragma unroll 8
        for (int j = 0; j < 16; ++j) { s0 += bf1(KLD(kp + (size_t)(4 * j) * PJ_LD)); s1 += bf1(KLD(kp + (size_t)(4 * j + 1) * PJ_LD)); s2 += bf1(KLD(kp + (size_t)(4 * j + 2) * PJ_LD)); s3 += bf1(KLD(kp + (size_t)(4 * j + 3) * PJ_LD)); }
        float s = (s0 + s1) + (s2 + s3);
        s += swz_xor<1>(s);
        if (half == 0) KMEAN[(((size_t)(b * 4 + h) * 16 + blk) * 2 + hf) * 64 + d] = s;
#undef KLD
    }
    __syncthreads();
}

__device__ __forceinline__ void conv_unit(LAS unsigned char* lds, const bf16* PROJ, bf16* O, const float* __restrict__ cw, const float* __restrict__ cb, const float* __restrict__ lng, const float* __restrict__ lnb, int unit, const int tid) {
    LAS float* zc = (LAS float*)lds;
    const int lane = tid & 63, wave = __builtin_amdgcn_readfirstlane(tid >> 6);
    const int b = unit >> 6, p0 = (unit & 63) * 64;
    const int ch = tid & 255, half = tid >> 8;
#pragma unroll 1
    for (int i0 = 0; i0 < 47; i0 += 24) {
        float av[24], gv[24];
#pragma unroll
        for (int u = 0; u < 24; ++u) { const int i = i0 + u, r = half + 2 * i, p = p0 - 30 + r; av[u] = 0.f; gv[u] = 0.f;
            if (i < 47 && p >= 0) { const bf16* row = PROJ + ((size_t)b * SEQ + p) * PJ_LD; av[u] = bf1(row[PJ_DA + ch]); gv[u] = bf1(row[PJ_DG + ch]); } }
#pragma unroll
        for (int u = 0; u < 24; ++u) { const int i = i0 + u, r = half + 2 * i; if (i < 47) zc[r * 256 + ch] = av[u] * fast_sigmoid(gv[u]); }
    }
    float w[31];
#pragma unroll
    for (int j = 0; j < 31; ++j) w[j] = cw[j * 256 + ch];
    const float bias = cb[ch];
    __syncthreads();
    float acc[32];
    {
        float z[62];
#pragma unroll
        for (int j = 0; j < 62; ++j) z[j] = zc[(half * 32 + j) * 256 + ch];
#pragma unroll
        for (int t = 0; t < 32; ++t) { float a = bias;
#pragma unroll
            for (int j = 0; j < 31; ++j) a += w[j] * z[t + j];
            acc[t] = a; }
    }
    __syncthreads();
#pragma unroll
    for (int t = 0; t < 32; ++t) zc[(half * 32 + t) * 256 + ch] = acc[t];
    __syncthreads();
    const f32x4 g4 = *(const f32x4*)(lng + lane * 4), b4 = *(const f32x4*)(lnb + lane * 4);
    for (int i4 = 0; i4 < 2; ++i4) {
        f32x4 x[4]; float mu[4], var[4];
#pragma unroll
        for (int u = 0; u < 4; ++u) { x[u] = *(const LAS f32x4*)(zc + (wave * 8 + i4 * 4 + u) * 256 + lane * 4); mu[u] = (x[u][0] + x[u][1]) + (x[u][2] + x[u][3]); }
#pragma unroll
        for (int u = 0; u < 4; ++u) mu[u] = wave_sum(mu[u]) * (1.0f / 256.0f);
#pragma unroll
        for (int u = 0; u < 4; ++u) { x[u] = x[u] - mu[u]; var[u] = (x[u][0] * x[u][0] + x[u][1] * x[u][1]) + (x[u][2] * x[u][2] + x[u][3] * x[u][3]); }
#pragma unroll
        for (int u = 0; u < 4; ++u) var[u] = wave_sum(var[u]) * (1.0f / 256.0f);
#pragma unroll
        for (int u = 0; u < 4; ++u) { const float rstd = rsqrtf(var[u] + EPS);
            const float y0 = x[u][0] * rstd * g4[0] + b4[0], y1 = x[u][1] * rstd * g4[1] + b4[1], y2 = x[u][2] * rstd * g4[2] + b4[2], y3 = x[u][3] * rstd * g4[3] + b4[3];
            typedef unsigned u32x2v __attribute__((ext_vector_type(2)));
            u32x2v wv; wv.x = pkbf(fast_silu(y0), fast_silu(y1)); wv.y = pkbf(fast_silu(y2), fast_silu(y3));
            *(u32x2v*)(O + ((size_t)b * SEQ + p0 + wave * 8 + i4 * 4 + u) * DM + 768 + lane * 4) = wv; }
    }
    __syncthreads();
}

typedef float f32x16 __attribute__((ext_vector_type(16)));
template <int DK> struct AttnLds { static constexpr int KBYTES = 64 * DK * 2  , VP = 68, VBYTES = 64 * VP * 2, K0 = 0, K1 = KBYTES, V0 = 2 * KBYTES, V1 = 2 * KBYTES + VBYTES, UM = 2 * KBYTES + 2 * VBYTES; };
__device__ __forceinline__ float half_max(float v) { auto rr = __builtin_amdgcn_permlane32_swap(__float_as_uint(v), __float_as_uint(v), false, false); return fmaxf(__uint_as_float(rr[0]), __uint_as_float(rr[1])); }
#define ATT_FAST_BOUND 30.0f
__device__ __forceinline__ void softmax_fast(f32x16& s, float& l, bf16x8 (&p)[2], const bool diag, const bool blocked, const int qi, const int kbase) {
    if (diag) {
#pragma unroll
        for (int r = 0; r < 16; ++r) { const int key = kbase + (r & 3) + 8 * (r >> 2); if (key > qi) s[r] = -INFINITY; }
    }
    float sum = 0.f;
#pragma unroll
    for (int r = 0; r < 16; ++r) { const float e = __builtin_amdgcn_exp2f(s[r]); s[r] = e; sum += e; }
    v4u w0, w1;
    w0.x = pkbf(s[0], s[1]); w0.y = pkbf(s[2], s[3]); w0.z = pkbf(s[4], s[5]); w0.w = pkbf(s[6], s[7]);
    w1.x = pkbf(s[8], s[9]); w1.y = pkbf(s[10], s[11]); w1.z = pkbf(s[12], s[13]); w1.w = pkbf(s[14], s[15]);
    if (blocked) { sum = 0.f; w0 = (v4u){0u, 0u, 0u, 0u}; w1 = (v4u){0u, 0u, 0u, 0u}; }
    l += sum;
    p[0] = __builtin_bit_cast(bf16x8, w0); p[1] = __builtin_bit_cast(bf16x8, w1);
}
__device__ __forceinline__ void softmax_group(f32x16& s, f32x16 (&o)[2], float& m, float& l, bf16x8 (&p)[2], const bool diag, const bool blocked, const int qi, const int kbase) {
    if (diag) {
#pragma unroll
        for (int r = 0; r < 16; ++r) { const int key = kbase + (r & 3) + 8 * (r >> 2); if (key > qi) s[r] = -INFINITY; }
    }
    float mx = fmaxf(s[0], s[1]);
#pragma unroll
    for (int r = 2; r < 16; ++r) mx = fmaxf(mx, s[r]);
    mx = half_max(mx);
    if (blocked) mx = -INFINITY;
    const float mn = fmaxf(m, mx);
    const float ms = (mn == -INFINITY) ? 0.f : mn;
    const float alpha = __builtin_amdgcn_exp2f(m - ms);
    const float mse = blocked ? INFINITY : ms;
    float sum = 0.f;
#pragma unroll
    for (int r = 0; r < 16; ++r) { const float e = __builtin_amdgcn_exp2f(s[r] - mse); s[r] = e; sum += e; }
    l = l * alpha + sum; m = mn;
    if (__any(alpha != 1.f)) {
#pragma unroll
        for (int dt = 0; dt < 2; ++dt)
#pragma unroll
            for (int r = 0; r < 16; ++r) o[dt][r] *= alpha;
    }
#pragma unroll
    for (int st = 0; st < 2; ++st) { const int bs = 8 * st;
        v4u w; w.x = pkbf(s[bs], s[bs + 1]); w.y = pkbf(s[bs + 2], s[bs + 3]); w.z = pkbf(s[bs + 4], s[bs + 5]); w.w = pkbf(s[bs + 6], s[bs + 7]);
        p[st] = __builtin_bit_cast(bf16x8, w); }
}
template <int NKS, int DK>
__device__ __forceinline__ float qpost(bf16x8 (&qf)[NKS], const float* __restrict__ qgain, const float* __restrict__ tabrow, const int hi) {
    float qv[8 * NKS]; float ss = 0.f;
#pragma unroll
    for (int ks = 0; ks < NKS; ++ks) unpack8(__builtin_bit_cast(v4u, qf[ks]), qv + 8 * ks);
#pragma unroll
    for (int i = 0; i < 8 * NKS; ++i) ss += qv[i] * qv[i];
    const float rstd = rsqrtf(half_sum(ss) * (1.0f / (float)DK) + EPS);
#pragma unroll
    for (int ks = 0; ks < NKS; ++ks) { const f32x4 ga = *(const f32x4*)(qgain + 16 * ks + 8 * hi), gb = *(const f32x4*)(qgain + 16 * ks + 8 * hi + 4);
#pragma unroll
        for (int j = 0; j < 4; ++j) { qv[8 * ks + j] *= rstd * ga[j]; qv[8 * ks + 4 + j] *= rstd * gb[j]; } }
    const float* tb = tabrow + 16 + 16 * hi;
#pragma unroll
    for (int j = 0; j < 8; ++j) { const float cs = tb[2 * j], sn = tb[2 * j + 1], x1 = qv[32 + j], x2 = qv[40 + j]; qv[32 + j] = x1 * cs - x2 * sn; qv[40 + j] = x2 * cs + x1 * sn; }
    float q2 = 0.f;
#pragma unroll
    for (int i = 0; i < 8 * NKS; ++i) { qv[i] *= QS_C; q2 += qv[i] * qv[i]; }
#pragma unroll
    for (int ks = 0; ks < NKS; ++ks) qf[ks] = __builtin_bit_cast(bf16x8, pack8(qv + 8 * ks));
    return half_sum(q2);
}
template <int DK, bool MOBA, bool QPOST, int qp, int qhs, int kp, int khs, int vp, int vhs, int op>
__device__ __forceinline__ void attn_unit(LAS unsigned char* lds, const bf16* __restrict__ Q, const bf16* __restrict__ K,
                                          const bf16* __restrict__ V, bf16* O, const int b, const int h, const int qc, const float* __restrict__ kmean, const float* __restrict__ qgain, const float* __restrict__ rope, const unsigned* __restrict__ kmx, const int tid) {
    using L = AttnLds<DK>;
    constexpr int NKS = DK / 16, KCH = DK / 8;
    const int lane = tid & 63, w = __builtin_amdgcn_readfirstlane(tid >> 6), r32 = lane & 31, hi = lane >> 5;
    const int q0 = qc * 512;
    const size_t tokbase = (size_t)b * SEQ;
    const int g0 = w, g1 = 15 - w;
    const int qi0 = q0 + 32 * g0 + r32, qi1 = q0 + 32 * g1 + r32;
    const int tl0 = (q0 + 32 * g0 + 31) >> 6, tl1 = (q0 + 32 * g1 + 31) >> 6;
    const int ob0 = (q0 + 32 * g0) >> 8, ob1 = (q0 + 32 * g1) >> 8;
    bf16x8 qf0[NKS], qf1[NKS];
    { const bf16* p0 = Q + (tokbase + qi0) * qp + h * qhs + 8 * hi;
#pragma unroll
      for (int ks = 0; ks < NKS; ++ks) qf0[ks] = *(const bf16x8*)(p0 + 16 * ks); }
    float q2a = 0.f, q2b = 0.f;
    if (QPOST) { q2a = qpost<NKS, DK>(qf0, qgain, rope + (tokbase + qi0) * 48, hi); asm volatile("" ::: "memory"); }
    { const bf16* p1 = Q + (tokbase + qi1) * qp + h * qhs + 8 * hi;
#pragma unroll
      for (int ks = 0; ks < NKS; ++ks) qf1[ks] = *(const bf16x8*)(p1 + 16 * ks); }
    if (QPOST) { q2b = qpost<NKS, DK>(qf1, qgain, rope + (tokbase + qi1) * 48, hi); asm volatile("" ::: "memory"); }
    unsigned mk0 = 0u, mk1 = 0u, umask = 0xffffffffu;
    if (MOBA) {
        LAS float* kml = (LAS float*)(lds + L::UM + 16);
        { const float* kmg = kmean + (size_t)(b * 4 + h) * 16 * 128;
          for (int i = tid; i < 1024; i += NTHR) { const int n = i >> 6, d = i & 63; kml[i] = (kmg[n * 128 + d] + kmg[n * 128 + 64 + d]) * (1.0f / 256.0f); } }
        __syncthreads();
        const LAS float* km = kml + 8 * hi;
#pragma unroll
        for (int g = 0; g < 2; ++g) {
            float qv[8 * NKS];
#pragma unroll
            for (int ks = 0; ks < NKS; ++ks) unpack8(__builtin_bit_cast(v4u, g ? qf1[ks] : qf0[ks]), qv + 8 * ks);
            { float q2 = 0.f;
#pragma unroll
              for (int i = 0; i < 8 * NKS; ++i) q2 += qv[i] * qv[i];
              q2 = half_sum(q2); if (g) q2b = q2; else q2a = q2; }
            const int ob = g ? ob1 : ob0;
            float s0 = -INFINITY, s1 = -INFINITY, s2 = -INFINITY; int i0 = 0, i1 = 0, i2 = 0;
            for (int n = 0; n < ob; ++n) {
                const LAS float* kmp = km + n * 64; float sc = 0.f;
#pragma unroll
                for (int ks = 0; ks < NKS; ++ks) { const f32x4 ka = *(const LAS f32x4*)(kmp + 16 * ks), kb2 = *(const LAS f32x4*)(kmp + 16 * ks + 4);
                    sc += qv[8 * ks] * ka[0]; sc += qv[8 * ks + 1] * ka[1]; sc += qv[8 * ks + 2] * ka[2]; sc += qv[8 * ks + 3] * ka[3];
                    sc += qv[8 * ks + 4] * kb2[0]; sc += qv[8 * ks + 5] * kb2[1]; sc += qv[8 * ks + 6] * kb2[2]; sc += qv[8 * ks + 7] * kb2[3]; }
                sc = half_sum(sc);
                if (sc > s0) { s2 = s1; i2 = i1; s1 = s0; i1 = i0; s0 = sc; i0 = n; }
                else if (sc > s1) { s2 = s1; i2 = i1; s1 = sc; i1 = n; }
                else if (sc > s2) { s2 = sc; i2 = n; }
            }
            unsigned mk = 0u; if (ob > 0) mk |= 1u << i0; if (ob > 1) mk |= 1u << i1; if (ob > 2) mk |= 1u << i2;
            if (g) mk1 = mk; else mk0 = mk;
        }
        LAS unsigned* um = (LAS unsigned*)(lds + L::UM);
        if (tid == 0) *um = 0u;
        __syncthreads();
        __hip_atomic_fetch_or(um, mk0 | mk1, __ATOMIC_RELAXED, __HIP_MEMORY_SCOPE_WORKGROUP);
        __syncthreads();
        umask = *um;
    }
    const float k2m = __uint_as_float(__hip_atomic_load(kmx + b * 4 + h, __ATOMIC_RELAXED, __HIP_MEMORY_SCOPE_AGENT));
    const bool fast = __all(fmaxf(q2a, q2b) * k2m <= ATT_FAST_BOUND * ATT_FAST_BOUND);
    const int ntile = qc * 8 + 8;
    v4u vreg = {0u, 0u, 0u, 0u};
#define ATT_NEEDED(t) (!MOBA || ((t) >> 2) >= 2 * qc || ((umask >> ((t) >> 2)) & 1u))
#define ATT_LOADK(t, buf) do { const bf16* kt_ = K + (tokbase + (size_t)(t) * 64) * kp + h * khs; int ln_ = lane; asm volatile("" : "+v"(ln_)); \
        LAS unsigned char* kd_ = lds + ((buf) ? L::K1 : L::K0) + w * 1024; \
        __builtin_amdgcn_global_load_lds((const unsigned*)(kt_ + ln_ * kp + w * 8), (LAS unsigned*)kd_, 16, 0, 0); \
        if (DK == 96 && w < 4) __builtin_amdgcn_global_load_lds((const unsigned*)(kt_ + ln_ * kp + (8 + w) * 8), (LAS unsigned*)(kd_ + 8192), 16, 0, 0); } while (0)
#define ATT_LOADV(t) do { int t2_ = tid; asm volatile("" : "+v"(t2_)); const int vkey = t2_ >> 3, vch = t2_ & 7; \
        vreg = *(const v4u*)(V + (tokbase + (size_t)(t) * 64) * vp + (vkey * vp + h * vhs + vch * 8)); } while (0)
    unsigned krd_lane = (unsigned)(hi * 1024 + r32 * 16), vrd_lane = (unsigned)((r32 * L::VP + 4 * hi) * 2);
    asm volatile("" : "+v"(krd_lane), "+v"(vrd_lane));
#define ATT_STOREV(buf) do { int t2_ = tid; asm volatile("" : "+v"(t2_)); const int vkey = t2_ >> 3, vch = t2_ & 7; \
        LAS unsigned char* vtb_ = lds + ((buf) ? L::V1 : L::V0) + ((vch * 8) * L::VP + vkey) * 2; asm volatile("" : "+v"(vtb_)); LAS bf16* vt_ = (LAS bf16*)vtb_; \
        vt_[0 * L::VP] = (bf16)(vreg.x & 0xffffu); vt_[1 * L::VP] = (bf16)(vreg.x >> 16); vt_[2 * L::VP] = (bf16)(vreg.y & 0xffffu); vt_[3 * L::VP] = (bf16)(vreg.y >> 16); \
        vt_[4 * L::VP] = (bf16)(vreg.z & 0xffffu); vt_[5 * L::VP] = (bf16)(vreg.z >> 16); vt_[6 * L::VP] = (bf16)(vreg.w & 0xffffu); vt_[7 * L::VP] = (bf16)(vreg.w >> 16); } while (0)
    int t = 0; while (t < ntile && !ATT_NEEDED(t)) t += 4;
    ATT_LOADK(t, 0); ATT_LOADV(t); ATT_STOREV(0);
    asm volatile("s_waitcnt vmcnt(0)" ::: "memory");
    __syncthreads();
    f32x16 o0[2], o1[2];
#pragma unroll
    for (int dt = 0; dt < 2; ++dt)
#pragma unroll
        for (int r = 0; r < 16; ++r) { o0[dt][r] = 0.f; o1[dt][r] = 0.f; }
    float m0 = -INFINITY, m1 = -INFINITY, l0 = 0.f, l1 = 0.f;
    int cur = 0;
#define ATT_LOOP(FASTP) do { \
    while (t < ntile) { \
        int tn = t + 1; while (tn < ntile && (tn & 3) == 0 && !ATT_NEEDED(tn)) tn += 4; \
        if (tn < ntile) { ATT_LOADK(tn, cur ^ 1); ATT_LOADV(tn); }    \
        const int nblk = t >> 2; \
        bool a0 = (t <= tl0), a1 = (t <= tl1); \
        bool bl0 = false, bl1 = false; \
        if (MOBA) { \
            bl0 = (nblk != ob0) && !((mk0 >> nblk) & 1u); bl1 = (nblk != ob1) && !((mk1 >> nblk) & 1u); \
            a0 = a0 && __any(!bl0); a1 = a1 && __any(!bl1); \
        } \
        if (a0 || a1) { \
            const LAS unsigned char* kb = lds + (cur ? L::K1 : L::K0) + krd_lane; const LAS unsigned char* vb = lds + (cur ? L::V1 : L::V0) + vrd_lane; \
            asm volatile("" : "+v"(kb), "+v"(vb)); \
_Pragma("unroll") \
            for (int kt = 0; kt < 2; ++kt) { \
                f32x16 s0, s1; \
_Pragma("unroll") \
                for (int r = 0; r < 16; ++r) { s0[r] = 0.f; s1[r] = 0.f; } \
_Pragma("unroll") \
                for (int ks = 0; ks < NKS; ++ks) { \
                    const bf16x8 kf = *(const LAS bf16x8*)(kb + (2 * ks * 1024 + 32 * kt * 16)); \
                    if (a0) s0 = __builtin_amdgcn_mfma_f32_32x32x16_bf16(kf, qf0[ks], s0, 0, 0, 0); \
                    if (a1) s1 = __builtin_amdgcn_mfma_f32_32x32x16_bf16(kf, qf1[ks], s1, 0, 0, 0); \
                } \
                bf16x8 p0[2], p1[2]; \
                const int kbase = 64 * t + 32 * kt + 4 * hi; \
                if (a0) { if (FASTP) softmax_fast(s0, l0, p0, t == tl0, bl0, qi0, kbase); else softmax_group(s0, o0, m0, l0, p0, t == tl0, bl0, qi0, kbase); } \
                __builtin_amdgcn_sched_barrier(0);    \
                if (a1) { if (FASTP) softmax_fast(s1, l1, p1, t == tl1, bl1, qi1, kbase); else softmax_group(s1, o1, m1, l1, p1, t == tl1, bl1, qi1, kbase); } \
                __builtin_amdgcn_sched_barrier(0); \
_Pragma("unroll") \
                for (int st = 0; st < 2; ++st) \
_Pragma("unroll") \
                    for (int dt = 0; dt < 2; ++dt) { \
                        typedef unsigned u32x2v __attribute__((ext_vector_type(2))); \
                        const LAS unsigned char* vp_ = vb + (32 * dt * L::VP + 32 * kt + 16 * st) * 2; \
                        const u32x2v va = *(const LAS u32x2v*)vp_, vc = *(const LAS u32x2v*)(vp_ + 16); \
                        const v4u vv = {va.x, va.y, vc.x, vc.y}; const bf16x8 vf = __builtin_bit_cast(bf16x8, vv); \
                        if (a0) o0[dt] = __builtin_amdgcn_mfma_f32_32x32x16_bf16(vf, p0[st], o0[dt], 0, 0, 0); \
                        if (a1) o1[dt] = __builtin_amdgcn_mfma_f32_32x32x16_bf16(vf, p1[st], o1[dt], 0, 0, 0); \
                    } \
            } \
        } \
        if (tn < ntile) ATT_STOREV(cur ^ 1); \
        asm volatile("s_waitcnt vmcnt(0)" ::: "memory"); \
        __syncthreads(); \
        t = tn; cur ^= 1; \
    } \
    } while (0)
    if (fast) ATT_LOOP(true); else ATT_LOOP(false);
#undef ATT_LOOP
#undef ATT_NEEDED
#undef ATT_LOADK
#undef ATT_LOADV
#undef ATT_STOREV
    {
        typedef unsigned u32x2v __attribute__((ext_vector_type(2)));
        const float i0 = 1.0f / half_sum(l0), i1 = 1.0f / half_sum(l1);
        bf16* d0 = O + (tokbase + qi0) * op + h * 64 + 4 * hi; bf16* d1 = O + (tokbase + qi1) * op + h * 64 + 4 * hi;
#pragma unroll
        for (int dt = 0; dt < 2; ++dt)
#pragma unroll
            for (int j = 0; j < 4; ++j) {
                u32x2v wa; wa.x = pkbf(o0[dt][4 * j] * i0, o0[dt][4 * j + 1] * i0); wa.y = pkbf(o0[dt][4 * j + 2] * i0, o0[dt][4 * j + 3] * i0); *(u32x2v*)(d0 + 32 * dt + 8 * j) = wa;
                u32x2v wb; wb.x = pkbf(o1[dt][4 * j] * i1, o1[dt][4 * j + 1] * i1); wb.y = pkbf(o1[dt][4 * j + 2] * i1, o1[dt][4 * j + 3] * i1); *(u32x2v*)(d1 + 32 * dt + 8 * j) = wb;
            }
    }
}
struct Args { const void* in[31]; float* out; unsigned char* ws; int ph_lo, ph_hi; };
constexpr int N_PHASES = 1 + 8 + 11 + 8 + 11;
typedef const __attribute__((address_space(4))) Args* KArgs;
__device__ __forceinline__ KArgs kargs() { KArgs p = (KArgs)__builtin_amdgcn_kernarg_segment_ptr(); asm volatile("" : "+s"(p)); return p; }
#define IN_F(i) ((const float*)A->in[i])
#define WSP(type, off) ((type*)(ws + (off)))
#ifndef TPROBE
#define TPROBE 0
#endif
#define TP_BID 203
#define TP_ACC(lds) ((LAS unsigned long long*)((lds) + MISC_OFF + 64))
#define TP_BEGIN(id) unsigned long long tp0_##id = 0ull; if (TPROBE == (id)) { __syncthreads(); tp0_##id = __builtin_amdgcn_s_memrealtime(); }
#define TP_END(id, lds) if (TPROBE == (id)) { __syncthreads(); if (blockIdx.x == TP_BID && threadIdx.x == 0) *TP_ACC(lds) += __builtin_amdgcn_s_memrealtime() - tp0_##id; }
struct Ctx { int tid, lane, wave, G, bid, gw, NGW, gt, NGT; };
__device__ __forceinline__ Ctx mkctx(int wv) {
    Ctx c; unsigned m = ~0u; asm volatile("" : "+s"(m)); const int ln = (int)__builtin_amdgcn_mbcnt_hi(m, __builtin_amdgcn_mbcnt_lo(m, 0u));
    int b = blockIdx.x; asm volatile("" : "+s"(b)); int w = wv; asm volatile("" : "+s"(w));
    c.tid = w * 64 + ln; c.lane = ln; c.wave = w; c.G = gridDim.x; c.bid = b;
    c.gw = c.bid * NWAVES + c.wave; c.NGW = c.G * NWAVES; c.gt = c.bid * NTHR + c.tid; c.NGT = c.G * NTHR; return c; }

__device__ __forceinline__ void conv_mixer_weights(int wv, LAS unsigned char* lds, int l) {
    const Ctx c = mkctx(wv);
    KArgs A = kargs(); unsigned char* ws = A->ws;
    const int lane = c.lane, gw = c.gw, NGW = c.NGW, gt = c.gt, NGT = c.NGT;
    LAS float* scr = (LAS float*)(lds + RING_OFF + c.wave * 16384); LAS TrDesc* tab = (LAS TrDesc*)(lds + RING_OFF + TR_TAB_OFF); asm volatile("" : "+v"(tab));
    bf16* WINR = WSP(bf16, W_INR); bf16* WUQ = WSP(bf16, W_UQ); bf16* WUKV = WSP(bf16, W_UKV);
    int total = 0;
    if (c.tid == 0) {
        int n = 0, cum = 0;
        const float* an = IN_F(2) + l * DM; const float* win = IN_F(4) + (size_t)l * DM * IN_COLS;
        tr_add(tab, n, cum, win, IN_COLS, DM, 4096, 0, WSP(bf16, W_G), DM, 0, 3, an);
        tr_add(tab, n, cum, win, IN_COLS, DM, 1280, 4096, WINR, DM, 0, 0, an);
        tr_add(tab, n, cum, win, IN_COLS, DM, 512, 5728, WINR, DM, 1280, 0, an);
        tr_add(tab, n, cum, win, IN_COLS, DM, 352, 5376, WINR, DM, 1792, 0, an);
        tr_add(tab, n, cum, IN_F(13) + (size_t)l * 192 * 384, 384, 192, 384, 0, WUQ, 256, 0, 0, IN_F(11) + l * 192);
        tr_add(tab, n, cum, IN_F(14) + (size_t)l * 128 * 512, 512, 128, 512, 0, WUKV, 256, 0, 2, IN_F(12) + l * 128);
        for (int nb = 0; nb < 4; ++nb) tr_add(tab, n, cum, IN_F(21) + ((size_t)l * 4 + nb) * 256 * DM, DM, 256, DM, 0, WSP(bf16, W_B), 256, nb * 1024, 0, nullptr);
        tr_add(tab, n, cum, IN_F(22) + (size_t)l * DM * DM, DM, DM, DM, 0, WSP(bf16, W_OUT), DM, 0, 0, nullptr);
        tab[n].cum = cum; tab[31].cum = cum;
    }
    __syncthreads();
    total = tab[31].cum;
    tr_run(tab, total, scr, lane, gw, NGW);
    unsigned zz = 0u; asm volatile("" : "+v"(zz)); const v4u z4 = {zz, zz, zz, zz};
    for (int i = gt; i < 160 * DM / 8; i += NGT) ((v4u*)(WINR + (size_t)2144 * DM))[i] = z4;
    for (int i = gt; i < 128 * 256 / 8; i += NGT) ((v4u*)(WUQ + (size_t)384 * 256))[i] = z4;
    for (int i = gt; i < 384 * 8; i += NGT) ((v4u*)(WUQ + (size_t)(i >> 3) * 256 + 192))[i & 7] = z4;
    for (int i = gt; i < 512 * 16; i += NGT) ((v4u*)(WUKV + (size_t)(i >> 4) * 256 + 128))[i & 15] = z4;
    {
        const float* wsrc = IN_F(7) + (size_t)l * 4 * 128 * 128; bf16* wm = WSP(bf16, MS_WSGU);
        for (int i = gt; i < 4 * 128 * 128 / 8; i += NGT) {
            const int t = (i >> 4) & 127, s0 = (i & 15) * 8; const f32x4 a = *(const f32x4*)(wsrc + (size_t)i * 8), b = *(const f32x4*)(wsrc + (size_t)i * 8 + 4);
            float f[8] = {a[0], a[1], a[2], a[3], b[0], b[1], b[2], b[3]};
#pragma unroll
            for (int j = 0; j < 8; ++j) f[j] = (s0 + j <= t) ? f[j] : 0.f;
            *(v4u*)(wm + (size_t)i * 8) = pack8(f);
        }
    }
    __syncthreads();
}
__device__ __forceinline__ void conv_ffn_weights(int wv, LAS unsigned char* lds, int l) {
    const Ctx c = mkctx(wv);
    KArgs A = kargs(); unsigned char* ws = A->ws;
    LAS float* scr = (LAS float*)(lds + RING_OFF + c.wave * 16384); LAS TrDesc* tab = (LAS TrDesc*)(lds + RING_OFF + TR_TAB_OFF); asm volatile("" : "+v"(tab));
    if (c.tid == 0) {
        int n = 0, cum = 0; const bool moe = (l & 1) != 0; const int li = l >> 1; const float* fn = IN_F(3) + l * DM;
        if (!moe) {
            tr_add(tab, n, cum, IN_F(23) + (size_t)li * DM * FFN, FFN, DM, FFN, 0, WSP(bf16, W_F1), DM, 0, 1, fn);
            tr_add(tab, n, cum, IN_F(24) + (size_t)li * DM * FFN, FFN, DM, FFN, 0, WSP(bf16, W_F1), DM, 128, 1, fn);
            tr_add(tab, n, cum, IN_F(25) + (size_t)li * FFN * DM, DM, FFN, DM, 0, WSP(bf16, W_F2), FFN, 0, 0, nullptr);
        } else {
            for (int e = 0; e < NE; ++e) {
                tr_add(tab, n, cum, IN_F(28) + ((size_t)li * NE + e) * DM * EDIM, EDIM, DM, EDIM, 0, WSP(bf16, W_F1), DM, e * 2 * EDIM, 1, fn);
                tr_add(tab, n, cum, IN_F(29) + ((size_t)li * NE + e) * DM * EDIM, EDIM, DM, EDIM, 0, WSP(bf16, W_F1), DM, e * 2 * EDIM + 128, 1, fn);
                tr_add(tab, n, cum, IN_F(30) + ((size_t)li * NE + e) * EDIM * DM, DM, EDIM, DM, 0, WSP(bf16, W_F2), EDIM, e * DM, 0, nullptr);
            }
        }
        tab[n].cum = cum; tab[31].cum = cum;
    }
    __syncthreads();
    tr_run(tab, tab[31].cum, scr, c.lane, c.gw, c.NGW);
    __syncthreads();
}
__device__ __forceinline__ void ph_prologue(int wv, LAS unsigned char* lds) {
    conv_mixer_weights(wv, lds, 0);
    const Ctx c = mkctx(wv);
    KArgs A = kargs(); unsigned char* ws = A->ws;
    const int lane = c.lane, gw = c.gw, NGW = c.NGW, gt = c.gt, NGT = c.NGT;
    {
        const float* x_in = IN_F(0); const int* positions = (const int*)A->in[1];
        bf16* XB = WSP(bf16, WS_XB); float* SSA = WSP(float, WS_SSA); float* ROPE = WSP(float, WS_ROPE);
        for (int mrow0 = gw; mrow0 < T; mrow0 += 4 * NGW) {
            typedef unsigned u32x2v __attribute__((ext_vector_type(2)));
            f32x4 v[4][4]; bool ok[4];
#pragma unroll
            for (int u = 0; u < 4; ++u) { const int mrow = mrow0 + u * NGW; ok[u] = mrow < T; const f32x4* xr = (const f32x4*)(x_in + (size_t)(ok[u] ? mrow : mrow0) * DM) + lane;
#pragma unroll
                for (int j = 0; j < 4; ++j) v[u][j] = xr[64 * j]; }
            asm volatile("" ::: "memory");
#pragma unroll
            for (int u = 0; u < 4; ++u) if (ok[u]) { const int mrow = mrow0 + u * NGW; float s = 0.f;
                u32x2v* o8 = (u32x2v*)(XB + (size_t)mrow * DM) + lane;
#pragma unroll
                for (int j = 0; j < 4; ++j) { const f32x4 x = v[u][j]; s += (x[0] * x[0] + x[1] * x[1]) + (x[2] * x[2] + x[3] * x[3]); u32x2v w; w.x = pkbf(x[0], x[1]); w.y = pkbf(x[2], x[3]); o8[64 * j] = w; }
                s = wave_sum(s);
                if (lane < 4) SSA[(size_t)mrow * 4 + lane] = (lane == 0) ? s : 0.f; }
        }
        for (int i = gt; i < T * 24; i += NGT) {
            const int tok = i / 24, a = i - tok * 24;
            const float inv = (a < 8) ? powf(500000.0f, -(float)a * 0.125f) : powf(500000.0f, -(float)(a - 8) * 0.0625f);
            const float ang = (float)positions[tok] * inv; float sn, cs; sincosf(ang, &sn, &cs);
            ROPE[(size_t)tok * 48 + 2 * a] = cs; ROPE[(size_t)tok * 48 + 2 * a + 1] = sn;
        }
    }
}
__device__ __forceinline__ void ph_inproj(int wv, LAS unsigned char* lds) {
    const Ctx c = mkctx(wv);
    KArgs A = kargs(); unsigned char* ws = A->ws;
    pg8::Gemm g{WSP(bf16, WS_XB), WSP(bf16, W_INR), DM, DM, DM}; pg8::StaticOrder S; S.init(T, PJ_LD, c.G, c.bid);
    pg8::EpiScale<0> E{WSP(bf16, B_PROJ), PJ_LD, pg8::RowScale{WSP(float, WS_SSA), 1}, WSP(float, WS_SSC)};
    pg8::gemm_phase<pg8::EpiScale<0>, pg8::StaticOrder, true, true>(lds + RING_OFF, g, S, E, c.tid);
}
__device__ __forceinline__ void mla_up_gemms(int wv, LAS unsigned char* lds, int l) {
    const Ctx c = mkctx(wv);
    KArgs A = kargs(); unsigned char* ws = A->ws;
    static_assert(W_UKV == W_UQ + 512 * 256 * 2, "the two MLA up-projection weight copies form one [1024][256] matrix");
    pg8::Gemm g{WSP(bf16, B_PROJ), WSP(bf16, W_UQ), PJ_LD, 256, 256}; pg8::MlaUpOrder S; S.so.init(T, 1024, c.G, c.bid); S.akq = PJ_CQ; S.akkv = PJ_CKV;
    pg8::EpiMlaUp E{pg8::EpiScale<0>{WSP(bf16, B_QPRE), 512, pg8::RowScale{WSP(float, WS_SSC), 3}, nullptr},
                    pg8::EpiKV{WSP(bf16, B_CK), WSP(bf16, B_KVPRE), WSP(bf16, B_PROJ), WSP(float, WS_SSC), WSP(float, WS_ROPE), IN_F(16) + l * 96, (unsigned*)(ws + WS_CTL) + CW_KMX + (l * 2 + 1) * 32}};
    pg8::gemm_phase<pg8::EpiMlaUp, pg8::MlaUpOrder, true, false>(lds + RING_OFF, g, S, E, c.tid);
}
__device__ __forceinline__ void ph_prep(int wv, LAS unsigned char* lds, int l) {
    TP_BEGIN(4) mla_up_gemms(wv, lds, l); TP_END(4, lds)
    {
        const Ctx c = mkctx(wv);
        KArgs A = kargs(); unsigned char* ws = A->ws;
        bf16* PROJ = WSP(bf16, B_PROJ); bf16* OB = WSP(bf16, B_O);
        TP_BEGIN(5) for (int it = c.bid; it < NB * 32; it += c.G) prep_block(lds + RING_OFF, PROJ, WSP(float, WS_ROPE), IN_F(9) + l * 64, IN_F(10) + l * 64, WSP(float, MS_KMEAN), (unsigned*)(ws + WS_CTL) + CW_KMX + (l * 2 + 0) * 32, it, c.tid); TP_END(5, lds)
        TP_BEGIN(6) for (int u = c.bid; u < T / 128; u += c.G) sgu_unit(lds + RING_OFF, PROJ, OB, IN_F(5) + l * 256, IN_F(6) + l * 256, WSP(bf16, MS_WSGU), IN_F(8) + l * 4 * 128, u, c.tid); TP_END(6, lds)
        TP_BEGIN(7) for (int u = c.bid; u < T / 64; u += c.G) conv_unit(lds + RING_OFF, PROJ, OB, IN_F(17) + (size_t)l * 31 * 256, IN_F(18) + l * 256, IN_F(19) + l * 256, IN_F(20) + l * 256, u, c.tid); TP_END(7, lds)
        __syncthreads();
    }
    TP_BEGIN(8) conv_ffn_weights(wv, lds, l); TP_END(8, lds)
}
template <int WHICH>
__device__ __forceinline__ void mla_post_pass(const Ctx& c, int l) {
    KArgs A = kargs(); unsigned char* ws = A->ws;
    const float* gn = IN_F(WHICH ? 16 : 15) + l * 96;
    const bf16* PROJ = WSP(bf16, B_PROJ); const bf16* QPRE = WSP(bf16, B_QPRE); const bf16* KVPRE = WSP(bf16, B_KVPRE);
    bf16* DST = WHICH ? WSP(bf16, B_CK) : WSP(bf16, B_CQ); const float* ROPE = WSP(float, WS_ROPE);
    for (int idx = c.gt; idx < T * 4; idx += c.NGT) {
        const int tok = idx >> 2, h = idx & 3; const float* tab = ROPE + (size_t)tok * 48 + 16;
        float v[96]; float ss = 0.f;
        if (WHICH == 0) {
#pragma unroll
            for (int cc = 0; cc < 12; ++cc) unpack8(((const v4u*)(QPRE + (size_t)tok * 512 + h * 96))[cc], v + 8 * cc);
        } else {
#pragma unroll
            for (int cc = 0; cc < 8; ++cc) unpack8(((const v4u*)(KVPRE + (size_t)tok * 512 + h * 128))[cc], v + 8 * cc);
#pragma unroll
            for (int cc = 0; cc < 4; ++cc) unpack8(((const v4u*)(PROJ + (size_t)tok * PJ_LD + PJ_KR))[cc], v + 64 + 8 * cc);
        }
#pragma unroll
        for (int d = 0; d < 96; ++d) ss += v[d] * v[d];
        const float rstd = rsqrtf(ss * (1.0f / 96.0f) + EPS);
#pragma unroll
        for (int d = 0; d < 96; ++d) v[d] = v[d] * rstd * gn[d];
#pragma unroll
        for (int i = 0; i < 16; ++i) { const float cs = tab[2 * i], sn = tab[2 * i + 1], x1 = v[64 + i], x2 = v[80 + i]; v[64 + i] = x1 * cs - x2 * sn; v[80 + i] = x2 * cs + x1 * sn; }
        if (WHICH == 0) {
#pragma unroll
            for (int d = 0; d < 96; ++d) v[d] *= QS_C;
        }
        bf16* dst = DST + (size_t)tok * 384 + h * 96;
#pragma unroll
        for (int cc = 0; cc < 12; ++cc) ((v4u*)dst)[cc] = pack8(v + 8 * cc);
    }
}
__device__ __forceinline__ void ph_mla_post(int wv, int l) {
    { const Ctx c = mkctx(wv); mla_post_pass<0>(c, l); }
    { const Ctx c = mkctx(wv); mla_post_pass<1>(c, l); }
}
__device__ __forceinline__ void ph_attn(int wv, LAS unsigned char* lds, int l) {
    const Ctx c = mkctx(wv);
    for (int u = c.bid; u < NB * 4 * 8; u += c.G) {
        const int qc = u & 7, h = (u >> 3) & 3, b = u >> 5;
        TP_BEGIN(1) { KArgs A = kargs(); unsigned char* ws = A->ws;
          attn_unit<96, false, true, 512, 96, 384, 96, 256, 64, DM>(lds + RING_OFF, WSP(bf16, B_QPRE), WSP(bf16, B_CK), WSP(bf16, B_KVPRE), WSP(bf16, B_O) + 512, b, h, qc, nullptr, IN_F(15) + l * 96, WSP(float, WS_ROPE), (const unsigned*)(ws + WS_CTL) + CW_KMX + (l * 2 + 1) * 32, c.tid); } TP_END(1, lds)
        TP_BEGIN(2) { KArgs A = kargs(); unsigned char* ws = A->ws; bf16* PROJ = WSP(bf16, B_PROJ);
          attn_unit<64, true, false, PJ_LD, 64, PJ_LD, 64, PJ_LD, 64, DM>(lds + RING_OFF, PROJ + PJ_BQ, PROJ + PJ_BK, PROJ + PJ_BV, WSP(bf16, B_O) + 256, b, h, 7 - qc, WSP(float, MS_KMEAN), nullptr, nullptr, (const unsigned*)(ws + WS_CTL) + CW_KMX + (l * 2 + 0) * 32, c.tid); } TP_END(2, lds)
    }
}
__device__ __forceinline__ void ph_gates(int wv, LAS unsigned char* lds) {
    const Ctx c = mkctx(wv);
    KArgs A = kargs(); unsigned char* ws = A->ws;
    pg8::Gemm g{WSP(bf16, WS_XB), WSP(bf16, W_G), DM, DM, DM}; pg8::StaticOrder S; S.init(T, 4096, c.G, c.bid);
    pg8::EpiGates E{WSP(bf16, B_SG), pg8::RowScale{WSP(float, WS_SSA), 1}};
    pg8::gemm_phase<pg8::EpiGates, pg8::StaticOrder, true, true>(lds + RING_OFF, g, S, E, c.tid);
}
__device__ __forceinline__ void ph_merge(int wv, LAS unsigned char* lds) {
    const Ctx c = mkctx(wv);
    KArgs A = kargs(); unsigned char* ws = A->ws;
    pg8::Gemm g{WSP(bf16, B_O), WSP(bf16, W_B), DM, 256, 256}; pg8::MergeOrder S; S.so.init(T, DM, c.G, c.bid);
    pg8::EpiMerge E{WSP(bf16, B_SG), WSP(bf16, B_Y)};
    pg8::gemm_phase<pg8::EpiMerge, pg8::MergeOrder, true, true>(lds + RING_OFF, g, S, E, c.tid);
}
__device__ __forceinline__ void ph_wout(int wv, LAS unsigned char* lds, int l) {
    const Ctx c = mkctx(wv);
    KArgs A = kargs(); unsigned char* ws = A->ws;
    pg8::Gemm g{WSP(bf16, B_Y), WSP(bf16, W_OUT), DM, DM, DM}; pg8::StaticOrder S; S.init(T, DM, c.G, c.bid);
    pg8::EpiResidual E{l == 0 ? IN_F(0) : (const float*)A->out, A->out, WSP(bf16, WS_XB), WSP(float, WS_SSB), (LAS float*)(lds + EPI_RED_OFF)};
    pg8::gemm_phase<pg8::EpiResidual, pg8::StaticOrder, true, true>(lds + RING_OFF, g, S, E, c.tid);
}
__device__ __forceinline__ void ph_ffn_up(int wv, LAS unsigned char* lds) {
    const Ctx c = mkctx(wv);
    KArgs A = kargs(); unsigned char* ws = A->ws;
    pg8::Gemm g{WSP(bf16, WS_XB), WSP(bf16, W_F1), DM, DM, DM}; pg8::StaticOrder S; S.init(T, 2 * FFN, c.G, c.bid);
    pg8::EpiScale<2> E{WSP(bf16, B_HID), FFN, pg8::RowScale{WSP(float, WS_SSB), 1}, nullptr};
    pg8::gemm_phase<pg8::EpiScale<2>, pg8::StaticOrder, true, true>(lds + RING_OFF, g, S, E, c.tid);
}
__device__ __forceinline__ void ph_ffn_down(int wv, LAS unsigned char* lds, int l) {
    const Ctx c = mkctx(wv);
    KArgs A = kargs(); unsigned char* ws = A->ws;
    pg8::Gemm g{WSP(bf16, B_HID), WSP(bf16, W_F2), FFN, FFN, FFN}; pg8::StaticOrder S; S.init(T, DM, c.G, c.bid);
    pg8::EpiResidual E{A->out, A->out, WSP(bf16, WS_XB), WSP(float, WS_SSA), (LAS float*)(lds + EPI_RED_OFF)};
    pg8::gemm_phase<pg8::EpiResidual, pg8::StaticOrder, true, true>(lds + RING_OFF, g, S, E, c.tid);
    TP_BEGIN(9) if (l < DEPTH - 1) conv_mixer_weights(wv, lds, l + 1); TP_END(9, lds)
}
__device__ __forceinline__ int wave_sum_i(int v) {
    v += __builtin_amdgcn_ds_swizzle(v, (1 << 10) | 0x1f); v += __builtin_amdgcn_ds_swizzle(v, (2 << 10) | 0x1f); v += __builtin_amdgcn_ds_swizzle(v, (4 << 10) | 0x1f);
    v += __builtin_amdgcn_ds_swizzle(v, (8 << 10) | 0x1f); v += __builtin_amdgcn_ds_swizzle(v, (16 << 10) | 0x1f);
    auto rr = __builtin_amdgcn_permlane32_swap((unsigned)v, (unsigned)v, false, false); return (int)rr[0] + (int)rr[1];
}
__device__ __forceinline__ void ph_router(int wv, LAS unsigned char* lds, int l) {
    const Ctx c = mkctx(wv);
    KArgs A = kargs(); unsigned char* ws = A->ws; const int li = l >> 1; const int lane = c.lane;
    const float* fn = IN_F(3) + l * DM; const float* wr_ = IN_F(26) + (size_t)li * DM * NE; const float* rb = IN_F(27) + li * NE;
    const float* xout = A->out; const float* SSB = WSP(float, WS_SSB); int* TOKE = WSP(int, MS_TOKE); float* TOKW = WSP(float, MS_TOKW);
    int* WCNT = WSP(int, MS_WCNT); int* WGCNT = WSP(int, MS_WGCNT);
    int cnt[8];
#pragma unroll
    for (int e = 0; e < 8; ++e) cnt[e] = 0;
    float wq[16][8];
#pragma unroll
    for (int j = 0; j < 4; ++j) { const int k0 = (64 * j + lane) * 4; const f32x4 gv = *(const f32x4*)(fn + k0);
#pragma unroll
        for (int q = 0; q < 4; ++q) { const f32x4 w0 = *(const f32x4*)(wr_ + (size_t)(k0 + q) * 8), w1 = *(const f32x4*)(wr_ + (size_t)(k0 + q) * 8 + 4);
#pragma unroll
            for (int e = 0; e < 4; ++e) { wq[4 * j + q][e] = gv[q] * w0[e]; wq[4 * j + q][4 + e] = gv[q] * w1[e]; } } }
    float rbv[8];
#pragma unroll
    for (int e = 0; e < 8; ++e) rbv[e] = rb[e];
    for (int tok0 = c.gw; tok0 < T; tok0 += 2 * c.NGW) {
        f32x4 sp[2], xv[2][4]; bool ok[2];
#pragma unroll
        for (int u = 0; u < 2; ++u) { const int tok = tok0 + u * c.NGW; ok[u] = tok < T; const int tk = ok[u] ? tok : tok0;
            sp[u] = *(const f32x4*)(SSB + (size_t)tk * 4);
#pragma unroll
            for (int j = 0; j < 4; ++j) xv[u][j] = *(const f32x4*)(xout + (size_t)tk * DM + (64 * j + lane) * 4); }
        float pl[2][8];
#pragma unroll
        for (int u = 0; u < 2; ++u) { const float rstd = rsqrtf(((sp[u][0] + sp[u][1]) + (sp[u][2] + sp[u][3])) * (1.0f / 1024.0f) + EPS);
#pragma unroll
            for (int e = 0; e < 8; ++e) pl[u][e] = 0.f;
#pragma unroll
            for (int j = 0; j < 4; ++j)
#pragma unroll
                for (int q = 0; q < 4; ++q) { const float hv = xv[u][j][q] * rstd;
#pragma unroll
                    for (int e = 0; e < 8; ++e) pl[u][e] += hv * wq[4 * j + q][e]; } }
#pragma unroll
        for (int e = 0; e < 8; ++e) { pl[0][e] = wave_sum(pl[0][e]) + rbv[e]; pl[1][e] = wave_sum(pl[1][e]) + rbv[e]; }
#pragma unroll
        for (int u = 0; u < 2; ++u) {
            int e0 = 0; float l0 = pl[u][0];
#pragma unroll
            for (int e = 1; e < 8; ++e) if (pl[u][e] > l0) { l0 = pl[u][e]; e0 = e; }
            int e1 = -1; float l1 = -INFINITY;
#pragma unroll
            for (int e = 0; e < 8; ++e) if (e != e0 && pl[u][e] > l1) { l1 = pl[u][e]; e1 = e; }
            const float tt = expf(l1 - l0); const float w0 = 1.0f / (1.0f + tt), w1 = tt / (1.0f + tt);
            if (ok[u]) {
#pragma unroll
                for (int e = 0; e < 8; ++e) cnt[e] += (e == e0 ? 1 : 0) + (e == e1 ? 1 : 0);
                const int tok = tok0 + u * c.NGW;
                if (lane == 0) { TOKE[tok * 2] = e0; TOKE[tok * 2 + 1] = e1; TOKW[tok * 2] = w0; TOKW[tok * 2 + 1] = w1; }
            }
        }
    }
    LAS int* red = (LAS int*)(lds + RING_OFF);
    int mine = 0;
#pragma unroll
    for (int e = 0; e < 8; ++e) mine = (lane == e) ? cnt[e] : mine;
    if (lane < 8) { WCNT[c.gw * 8 + lane] = mine; red[c.wave * 8 + lane] = mine; }
    __syncthreads();
    if (c.tid < 8) { int s = 0;
#pragma unroll
        for (int w = 0; w < NWAVES; ++w) s += red[w * 8 + c.tid];
        WGCNT[c.bid * 8 + c.tid] = s; }
    __syncthreads();
}
__device__ __forceinline__ void ph_assign(int wv, LAS unsigned char* lds, int l) {
    const Ctx c = mkctx(wv);
    KArgs A = kargs(); unsigned char* ws = A->ws; const int lane = c.lane;
    const float* SSB = WSP(float, WS_SSB); const int* TOKE = WSP(int, MS_TOKE); int* TOKS = WSP(int, MS_TOKS); float* RSSLOT = WSP(float, MS_RSSLOT);
    const int* WCNT = WSP(int, MS_WCNT); const int* WGCNT = WSP(int, MS_WGCNT); int* MTOT = WSP(int, MS_MTOT);
    const bf16* XB = WSP(bf16, WS_XB); bf16* XS = WSP(bf16, B_XS);
    int tot[8], bas[8];
#pragma unroll
    for (int e = 0; e < 8; ++e) { tot[e] = 0; bas[e] = 0; }
    for (int t = c.tid; t < c.G; t += NTHR) {
        typedef int i32x4 __attribute__((ext_vector_type(4)));
        const i32x4 a = *(const i32x4*)(WGCNT + t * 8), b = *(const i32x4*)(WGCNT + t * 8 + 4); const int lt = (t < c.bid) ? 1 : 0;
        tot[0] += a[0]; tot[1] += a[1]; tot[2] += a[2]; tot[3] += a[3]; tot[4] += b[0]; tot[5] += b[1]; tot[6] += b[2]; tot[7] += b[3];
        bas[0] += lt * a[0]; bas[1] += lt * a[1]; bas[2] += lt * a[2]; bas[3] += lt * a[3]; bas[4] += lt * b[0]; bas[5] += lt * b[1]; bas[6] += lt * b[2]; bas[7] += lt * b[3];
    }
    LAS int* red = (LAS int*)(lds + RING_OFF);
#pragma unroll
    for (int e = 0; e < 8; ++e) { tot[e] = wave_sum_i(tot[e]); bas[e] = wave_sum_i(bas[e]); }
    if (lane == 0) {
#pragma unroll
        for (int e = 0; e < 8; ++e) { red[c.wave * 16 + e] = tot[e]; red[c.wave * 16 + 8 + e] = bas[e]; } }
    __syncthreads();
#pragma unroll
    for (int e = 0; e < 8; ++e) { int st = 0, sb = 0;
#pragma unroll
        for (int w = 0; w < NWAVES; ++w) { st += red[w * 16 + e]; sb += red[w * 16 + 8 + e]; }
        tot[e] = st; bas[e] = sb; }
    int run[8]; { int acc = 0;
#pragma unroll
        for (int e = 0; e < 8; ++e) { run[e] = acc * 256 + bas[e]; acc += (tot[e] + 255) >> 8; } }
    if (c.bid == 0 && c.tid < 8) { int v = 0;
#pragma unroll
        for (int e = 0; e < 8; ++e) v = (c.tid == e) ? tot[e] : v;
        MTOT[c.tid] = v; }
    for (int w = 0; w < c.wave; ++w) {
        typedef int i32x4 __attribute__((ext_vector_type(4)));
        const i32x4 a = *(const i32x4*)(WCNT + (c.bid * NWAVES + w) * 8), b = *(const i32x4*)(WCNT + (c.bid * NWAVES + w) * 8 + 4);
        run[0] += a[0]; run[1] += a[1]; run[2] += a[2]; run[3] += a[3]; run[4] += b[0]; run[5] += b[1]; run[6] += b[2]; run[7] += b[3];
    }
    for (int tok0 = c.gw; tok0 < T; tok0 += 4 * c.NGW) {
        f32x4 sp[4]; int ee[4][2]; v4u ra[4], rb2[4]; bool ok[4];
#pragma unroll
        for (int u = 0; u < 4; ++u) { const int tok = tok0 + u * c.NGW; ok[u] = tok < T; const int tk = ok[u] ? tok : tok0;
            sp[u] = *(const f32x4*)(SSB + (size_t)tk * 4); ee[u][0] = TOKE[tk * 2]; ee[u][1] = TOKE[tk * 2 + 1];
            const v4u* src = (const v4u*)(XB + (size_t)tk * DM) + lane; ra[u] = src[0]; rb2[u] = src[64]; }
#pragma unroll
        for (int u = 0; u < 4; ++u) if (ok[u]) {
            const int tok = tok0 + u * c.NGW;
            const float rstd = rsqrtf(((sp[u][0] + sp[u][1]) + (sp[u][2] + sp[u][3])) * (1.0f / 1024.0f) + EPS);
            int s0 = 0, s1 = 0;
#pragma unroll
            for (int e = 0; e < 8; ++e) { if (e == ee[u][0]) { s0 = run[e]; run[e] += 1; } }
#pragma unroll
            for (int e = 0; e < 8; ++e) { if (e == ee[u][1]) { s1 = run[e]; run[e] += 1; } }
            if (lane == 0) { TOKS[tok * 2] = s0; TOKS[tok * 2 + 1] = s1; RSSLOT[s0] = rstd; RSSLOT[s1] = rstd; }
            v4u* d0 = (v4u*)(XS + (size_t)s0 * DM) + lane; v4u* d1 = (v4u*)(XS + (size_t)s1 * DM) + lane;
            d0[0] = ra[u]; d0[64] = rb2[u]; d1[0] = ra[u]; d1[64] = rb2[u];
        }
    }
    __syncthreads();
}
__device__ __forceinline__ void moe_panels(const int* mtot, int (&ps)[9]) { int acc = 0;
#pragma unroll
    for (int e = 0; e < 8; ++e) { ps[e] = acc; const int cn = __hip_atomic_load(mtot + e, RLX_AGENT); acc += (cn + 255) >> 8; } ps[8] = acc; }
__device__ __forceinline__ void ph_moe_up(int wv, LAS unsigned char* lds, int l) {
    const Ctx c = mkctx(wv);
    KArgs A = kargs(); unsigned char* ws = A->ws;
    pg8::MoeOrder S; S.nN = 11; moe_panels(WSP(int, MS_MTOT), S.ps);
    S.so.init(S.ps[8] * 256, 2 * EDIM, c.G, c.bid);
    pg8::Gemm g{WSP(bf16, B_XS), WSP(bf16, W_F1), DM, DM, DM};
    pg8::EpiScale<2> E{WSP(bf16, B_HIDM), EDIM, pg8::RowScale{WSP(float, MS_RSSLOT), 2}, nullptr};
    pg8::gemm_phase<pg8::EpiScale<2>, pg8::MoeOrder, true, true>(lds + RING_OFF, g, S, E, c.tid);
}
__device__ __forceinline__ void ph_moe_down(int wv, LAS unsigned char* lds, int l) {
    const Ctx c = mkctx(wv);
    KArgs A = kargs(); unsigned char* ws = A->ws;
    pg8::MoeOrder S; S.nN = 4; moe_panels(WSP(int, MS_MTOT), S.ps);
    S.so.init(S.ps[8] * 256, DM, c.G, c.bid);
    pg8::Gemm g{WSP(bf16, B_HIDM), WSP(bf16, W_F2), EDIM, EDIM, EDIM};
    pg8::EpiScale<0> E{WSP(bf16, B_Y2), DM, pg8::RowScale{nullptr, 0}, nullptr};
    pg8::gemm_phase<pg8::EpiScale<0>, pg8::MoeOrder, true, true>(lds + RING_OFF, g, S, E, c.tid);
}
__device__ __forceinline__ void ph_combine(int wv, LAS unsigned char* lds, int l) {
    const Ctx c = mkctx(wv);
    KArgs A = kargs(); unsigned char* ws = A->ws; const int lane = c.lane;
    float* xout = A->out; const int* TOKS = WSP(int, MS_TOKS); const float* TOKW = WSP(float, MS_TOKW); const bf16* Y2 = WSP(bf16, B_Y2); bf16* XB = WSP(bf16, WS_XB); float* SSA = WSP(float, WS_SSA);
    for (int tok0 = c.gw; tok0 < T; tok0 += 2 * c.NGW) {
        typedef unsigned u32x2v __attribute__((ext_vector_type(2)));
        int ss_[2][2]; float ww[2][2]; f32x4 xv[2][4]; bool ok[2];
#pragma unroll
        for (int u = 0; u < 2; ++u) { const int tok = tok0 + u * c.NGW; ok[u] = tok < T; const int tk = ok[u] ? tok : tok0;
            ss_[u][0] = TOKS[tk * 2]; ss_[u][1] = TOKS[tk * 2 + 1]; ww[u][0] = TOKW[tk * 2]; ww[u][1] = TOKW[tk * 2 + 1];
#pragma unroll
            for (int j = 0; j < 4; ++j) xv[u][j] = *((const f32x4*)(xout + (size_t)tk * DM) + 64 * j + lane); }
        u32x2v ya[2][4], yb[2][4];
#pragma unroll
        for (int u = 0; u < 2; ++u)
#pragma unroll
            for (int j = 0; j < 4; ++j) { ya[u][j] = *((const u32x2v*)(Y2 + (size_t)ss_[u][0] * DM) + 64 * j + lane); yb[u][j] = *((const u32x2v*)(Y2 + (size_t)ss_[u][1] * DM) + 64 * j + lane); }
#pragma unroll
        for (int u = 0; u < 2; ++u) if (ok[u]) {
            const int tok = tok0 + u * c.NGW; const float w0 = ww[u][0], w1 = ww[u][1]; float ss = 0.f;
#pragma unroll
            for (int j = 0; j < 4; ++j) {
                const int c4 = 64 * j + lane; f32x4 x = xv[u][j]; const u32x2v a = ya[u][j], b = yb[u][j];
                x[0] += w0 * bflo(a.x) + w1 * bflo(b.x); x[1] += w0 * bfhi(a.x) + w1 * bfhi(b.x); x[2] += w0 * bflo(a.y) + w1 * bflo(b.y); x[3] += w0 * bfhi(a.y) + w1 * bfhi(b.y);
                *((f32x4*)(xout + (size_t)tok * DM) + c4) = x;
                u32x2v w; w.x = pkbf(x[0], x[1]); w.y = pkbf(x[2], x[3]); *((u32x2v*)(XB + (size_t)tok * DM) + c4) = w;
                ss += (x[0] * x[0] + x[1] * x[1]) + (x[2] * x[2] + x[3] * x[3]);
            }
            ss = wave_sum(ss);
            if (lane < 4) SSA[(size_t)tok * 4 + lane] = (lane == 0) ? ss : 0.f;
        }
    }
    if (l < DEPTH - 1) { __syncthreads(); conv_mixer_weights(wv, lds, l + 1); }
}

__global__ void __launch_bounds__(NTHR, 2) trunk_fwd(Args args) {
    extern __shared__ __attribute__((aligned(16))) unsigned char lds_raw[];
    LAS unsigned char* lds = (LAS unsigned char*)lds_raw;
    const int wv = __builtin_amdgcn_readfirstlane((int)threadIdx.x >> 6);
    for (int u = threadIdx.x; u < (LDS_BYTES - LDSCTL_OFF) / 4; u += NTHR) ((LAS unsigned*)(lds + LDSCTL_OFF))[u] = 0u;
    __syncthreads();
    volatile LAS unsigned* MISC = (volatile LAS unsigned*)(lds + MISC_OFF);
    XcdBarrier bar = xcd_barrier_post((unsigned*)((gu32*)(args.ws + WS_CTL) + CW_BAR), MISC + 8, (int)threadIdx.x);
    const int lo = args.ph_lo, hi = args.ph_hi;
    int pc = 0;
#define PH_BEGIN if (pc >= lo && pc < hi) {
#define PH_END if (pc + 1 < hi) xcd_barrier(bar, mkctx(wv).tid); } ++pc;
    PH_BEGIN ph_prologue(wv, lds); PH_END
    for (int l = 0; l < DEPTH; ++l) {
        PH_BEGIN ph_inproj(wv, lds); PH_END
        PH_BEGIN ph_prep(wv, lds, l); PH_END
        PH_BEGIN ph_attn(wv, lds, l); PH_END
        PH_BEGIN ph_gates(wv, lds); PH_END
        PH_BEGIN ph_merge(wv, lds); PH_END
        PH_BEGIN ph_wout(wv, lds, l); PH_END
        if (!(l & 1)) {
            PH_BEGIN ph_ffn_up(wv, lds); PH_END
            PH_BEGIN ph_ffn_down(wv, lds, l); PH_END
        } else {
            PH_BEGIN ph_router(wv, lds, l); PH_END
            PH_BEGIN ph_assign(wv, lds, l); PH_END
            PH_BEGIN ph_moe_up(wv, lds, l); PH_END
            PH_BEGIN ph_moe_down(wv, lds, l); PH_END
            PH_BEGIN ph_combine(wv, lds, l); PH_END
        }
    }
    if (TPROBE != 0 && blockIdx.x == TP_BID && threadIdx.x == 0) { const unsigned long long tt_ = *TP_ACC(lds), te_ = __builtin_amdgcn_s_memrealtime(); while (__builtin_amdgcn_s_memrealtime() - te_ < 7ull * tt_) __builtin_amdgcn_s_sleep(32); }
#undef PH_BEGIN
#undef PH_END
}

#ifndef MK_MULTI
#define MK_MULTI 0
#endif
extern "C" void kernel_launch(void* const* d_in, const int* in_sizes, int n_in, void* d_out, int out_size, void* d_ws, size_t ws_size, hipStream_t stream) {
    static int grid = 0;
    if (grid == 0) {
        if (n_in != 31 || out_size != T * DM || ws_size < WS_END) { fprintf(stderr, "kernel_launch: unexpected problem: n_in %d out %d ws %zu (need %zu)\n", n_in, out_size, ws_size, (size_t)WS_END); grid = -1; return; }
        int dev = 0, cus = 0;
        if (hipGetDevice(&dev) != hipSuccess || hipDeviceGetAttribute(&cus, hipDeviceAttributeMultiprocessorCount, dev) != hipSuccess) { grid = -1; return; }
        if (hipFuncSetAttribute((const void*)trunk_fwd, hipFuncAttributeMaxDynamicSharedMemorySize, LDS_BYTES) != hipSuccess) { fprintf(stderr, "kernel_launch: hipFuncSetAttribute failed\n"); grid = -1; return; }
        int per_cu = 0;
        if (hipOccupancyMaxActiveBlocksPerMultiprocessor(&per_cu, (const void*)trunk_fwd, NTHR, LDS_BYTES) != hipSuccess || per_cu < 1) fprintf(stderr, "kernel_launch: occupancy query says %d\n", per_cu);
        (void)hipGetLastError();
        grid = cus;
    }
    if (grid < 0) return;
    (void)hipMemsetAsync((char*)d_ws + WS_CTL, 0, CTL_ZERO_BYTES, stream);
    Args a{};
    for (int i = 0; i < 31; ++i) a.in[i] = d_in[i];
    a.out = (float*)d_out; a.ws = (unsigned char*)d_ws;
#if MK_MULTI
    for (int p = 0; p < N_PHASES; ++p) { a.ph_lo = p; a.ph_hi = p + 1; hipLaunchKernelGGL(trunk_fwd, dim3(grid), dim3(NTHR), LDS_BYTES, stream, a); }
#else
    a.ph_lo = 0; a.ph_hi = N_PHASES;
    hipLaunchKernelGGL(trunk_fwd, dim3(grid), dim3(NTHR), LDS_BYTES, stream, a);
#endif
}
```

```cpp
#include <hip/hip_runtime.h>
#include <cstdio>
#include <cstdint>
#include <cmath>
namespace pg8 {
#define PG8_LAS __attribute__((address_space(3)))
typedef unsigned short bf16_t;
typedef short bf16x8 __attribute__((ext_vector_type(8)));
typedef float f32x4 __attribute__((ext_vector_type(4)));
typedef unsigned u32x4 __attribute__((ext_vector_type(4)));
constexpr int BM = 256, BK = 64, HALF = 128, HTB = HALF * BK * 2  , STAGE_BYTES = 8 * HTB, NXCD = 8, WGM = 8;

__host__ __device__ __forceinline__ int lds_byte(int r, int c) { const int st = (r >> 4) * 2 + (c >> 5), rr = r & 15, cc = c & 31, ob = rr * 64 + cc * 2; return st * 1024 + (ob ^ (((ob >> 9) & 1) << 5)); }
__host__ __device__ __forceinline__ void stage_rc(int b, int& R, int& C) { const int st = b / 1024, sb = b % 1024, swz = sb ^ (((sb >> 9) & 1) << 5); R = (st >> 1) * 16 + swz / 64; C = (st & 1) * 32 + (swz % 64) / 2; }
__host__ __device__ __forceinline__ int perm32(int rho) { const int n = rho >> 4, i = rho & 15; return 8 * (i >> 2) + 4 * n + (i & 3); }

struct Unit { int pm, pn, pb, ak; };
struct Gemm { const bf16_t* A; const bf16_t* Bt; int lda, ldb, K; };

struct StaticOrder {
    int nM, nN, nwg, G, c;
    __host__ __device__ void init(int M, int N, int G_, int c_) { nM = M / BM; nN = N / BM; nwg = nM * nN; G = G_; c = c_; }
    __host__ __device__ bool next(int i, Unit& u) const {
        const long L = (long)i * G + c; if (L >= nwg) return false;
        int wgid = (int)L; { const int q = nwg / NXCD, r = nwg % NXCD, xcd = wgid % NXCD, off = wgid / NXCD; wgid = (xcd < r ? xcd * (q + 1) : r * (q + 1) + (xcd - r) * q) + off; }
        const int nig = WGM * nN, gid = wgid / nig, fm = gid * WGM, gsz = (nM - fm) < WGM ? (nM - fm) : WGM;
        u.pm = fm + ((wgid % nig) % gsz); u.pn = (wgid % nig) / gsz; u.pb = u.pn; u.ak = 0; return true;
    }
    __device__ __forceinline__ void a_ready(const Unit&) const {}
    __device__ __forceinline__ void done(const Unit&) const {}
};

template <class Epi, class Sched, bool ALIGN_EPI = false, bool SP2 = false>
__device__ __forceinline__ void gemm_phase(PG8_LAS unsigned char* lds, const Gemm g, const Sched& S, const Epi& E, const int tid) {
    const int wid = __builtin_amdgcn_readfirstlane(tid >> 6), lane = tid & 63, wr = wid >> 2, wc = wid & 3, fr = lane & 15, fq = lane >> 4;
    const int K = g.K, nt = K / BK;
    unsigned voffA[2], voffB[2];
#pragma unroll
    for (int i = 0; i < 2; ++i) { int R, C; stage_rc(tid * 16 + i * 8192, R, C); const int Rb = Epi::PERM ? ((R & ~31) + perm32(R & 31)) : R;
        voffA[i] = (unsigned)(R * g.lda + C) * 2u; voffB[i] = (unsigned)(Rb * g.ldb + C) * 2u; }
    const size_t kstep = (size_t)(BK * 2);
    const size_t hstepA = (size_t)HALF * g.lda * 2, hstepB = (size_t)HALF * g.ldb * 2;
    const size_t tstepA = 2 * hstepA, tstepB = 2 * hstepB;
    const unsigned ldsw = (unsigned)wid * 1024u;
    const int aoff = lds_byte(wr * 64 + fr, fq * 8), boff = lds_byte(wc * 32 + fr, fq * 8);
#define PG8_SA(b, h) (((b) * 2 + (h)) * HTB)
#define PG8_SB(b, h) ((4 + (b) * 2 + (h)) * HTB)
#define PG8_STAGE(bufoff, gbase, voff) do { _Pragma("unroll") for (int _i = 0; _i < 2; ++_i) \
        __builtin_amdgcn_global_load_lds((const unsigned*)((const char*)(gbase) + (voff)[_i]), (PG8_LAS unsigned*)(lds + (bufoff) + ldsw + _i * 8192), 16, 0, 0); } while (0)
#define PG8_LDA(dst, b, h) do { _Pragma("unroll") for (int m = 0; m < 4; ++m) _Pragma("unroll") for (int k = 0; k < 2; ++k) dst[m][k] = *(const PG8_LAS bf16x8*)(lds + PG8_SA(b, h) + aoff + m * 2048 + k * 1024); } while (0)
#define PG8_LDB(dst, b, h) do { _Pragma("unroll") for (int n = 0; n < 2; ++n) _Pragma("unroll") for (int k = 0; k < 2; ++k) dst[n][k] = *(const PG8_LAS bf16x8*)(lds + PG8_SB(b, h) + boff + n * 2048 + k * 1024); } while (0)
#define PG8_MMA(ai, bj, At, Bt) do { __builtin_amdgcn_s_setprio(1); _Pragma("unroll") for (int m = 0; m < 4; ++m) _Pragma("unroll") for (int n = 0; n < 2; ++n) _Pragma("unroll") for (int k = 0; k < 2; ++k) \
        acc[ai][bj][m][n] = __builtin_amdgcn_mfma_f32_16x16x32_bf16(Bt[n][k], At[m][k], acc[ai][bj][m][n], 0, 0, 0); __builtin_amdgcn_s_setprio(0); } while (0)
#define PG8_WAIT_V(n) asm volatile("s_waitcnt vmcnt(" #n ")" ::: "memory")
#define PG8_WAIT_L(n) asm volatile("s_waitcnt lgkmcnt(" #n ")" ::: "memory")
#define PG8_BAR __builtin_amdgcn_s_barrier()
#define PG8_SCHED __builtin_amdgcn_sched_barrier(0)
    Unit cur, nxt; int ui = 0;
    if (!S.next(0, cur)) return;
    f32x4 acc[2][2][4][2];
#pragma unroll
    for (int a = 0; a < 2; ++a)
#pragma unroll
        for (int b = 0; b < 2; ++b)
#pragma unroll
            for (int m = 0; m < 4; ++m)
#pragma unroll
                for (int n = 0; n < 2; ++n) acc[a][b][m][n] = (f32x4){0.f, 0.f, 0.f, 0.f};
    bf16x8 At[4][2], B0[2][2], B1[2][2];
    const char* cA = (const char*)g.A + (size_t)cur.pm * tstepA + (size_t)cur.ak * 2; const char* cB = (const char*)g.Bt + (size_t)cur.pb * tstepB;
    S.a_ready(cur);
    if constexpr (SP2) {
        PG8_STAGE(PG8_SB(0, 0), cB, voffB); PG8_STAGE(PG8_SB(0, 1), cB + hstepB, voffB); PG8_STAGE(PG8_SA(0, 0), cA, voffA); PG8_STAGE(PG8_SA(0, 1), cA + hstepA, voffA);
        if (wr == 1) PG8_BAR;
        PG8_WAIT_V(2); PG8_BAR;
        PG8_STAGE(PG8_SB(1, 0), cB + kstep, voffB); PG8_STAGE(PG8_SA(1, 0), cA + kstep, voffA); PG8_STAGE(PG8_SB(1, 1), cB + hstepB + kstep, voffB);
        PG8_WAIT_V(6); PG8_BAR;
    } else {
        PG8_STAGE(PG8_SB(0, 0), cB, voffB); PG8_STAGE(PG8_SA(0, 0), cA, voffA); PG8_STAGE(PG8_SB(0, 1), cB + hstepB, voffB); PG8_STAGE(PG8_SA(0, 1), cA + hstepA, voffA);
        if (wr == 1) PG8_BAR;
        PG8_WAIT_V(4); PG8_BAR;
        PG8_STAGE(PG8_SB(1, 0), cB + kstep, voffB); PG8_STAGE(PG8_SA(1, 0), cA + kstep, voffA); PG8_STAGE(PG8_SB(1, 1), cB + hstepB + kstep, voffB);
        PG8_WAIT_V(6); PG8_BAR;
    }
    for (;;) {
        const bool has_next = S.next(ui + 1, nxt);
        const char* nA = has_next ? (const char*)g.A + (size_t)nxt.pm * tstepA + (size_t)nxt.ak * 2 : cA; const char* nB = has_next ? (const char*)g.Bt + (size_t)nxt.pb * tstepB : cB;
        for (int t = 0; t < nt; t += 2) {
            const bool last = (t == nt - 2);
            const char* a1 = cA + (size_t)(t + 1) * kstep;
            const char* a2 = last ? nA : cA + (size_t)(t + 2) * kstep; const char* b2 = last ? nB : cB + (size_t)(t + 2) * kstep;
            const char* a3 = a2 + kstep; const char* b3 = b2 + kstep;
            if (last && has_next) S.a_ready(nxt);
            if constexpr (SP2) {
            PG8_LDB(B0, 0, 0); PG8_LDB(B1, 0, 1); PG8_SCHED; PG8_LDA(At, 0, 0); PG8_STAGE(PG8_SA(1, 1), a1 + hstepA, voffA);
            PG8_WAIT_V(8); PG8_WAIT_L(0); PG8_BAR; PG8_MMA(0, 0, At, B0); PG8_MMA(0, 1, At, B1); PG8_BAR; PG8_SCHED;
            PG8_LDA(At, 0, 1); PG8_STAGE(PG8_SB(0, 0), b2, voffB); PG8_STAGE(PG8_SB(0, 1), b2 + hstepB, voffB); PG8_STAGE(PG8_SA(0, 0), a2, voffA);
            PG8_WAIT_V(8); PG8_WAIT_L(0); PG8_BAR; PG8_MMA(1, 0, At, B0); PG8_MMA(1, 1, At, B1); PG8_BAR; PG8_SCHED;
            PG8_LDB(B0, 1, 0); PG8_LDB(B1, 1, 1); PG8_SCHED; PG8_LDA(At, 1, 0); PG8_STAGE(PG8_SA(0, 1), a2 + hstepA, voffA);
            PG8_WAIT_V(8); PG8_WAIT_L(0); PG8_BAR; PG8_MMA(0, 0, At, B0); PG8_MMA(0, 1, At, B1); PG8_BAR; PG8_SCHED;
            PG8_LDA(At, 1, 1); PG8_STAGE(PG8_SB(1, 0), b3, voffB); PG8_STAGE(PG8_SB(1, 1), b3 + hstepB, voffB); PG8_STAGE(PG8_SA(1, 0), a3, voffA);
            PG8_WAIT_V(8); PG8_WAIT_L(0); PG8_BAR; PG8_MMA(1, 0, At, B0); PG8_MMA(1, 1, At, B1); PG8_BAR; PG8_SCHED;
            } else {
            PG8_LDB(B0, 0, 0); PG8_SCHED; PG8_LDA(At, 0, 0); PG8_STAGE(PG8_SA(1, 1), a1 + hstepA, voffA);
            PG8_WAIT_L(8); PG8_BAR; PG8_WAIT_L(0); PG8_MMA(0, 0, At, B0); PG8_BAR; PG8_SCHED;
            PG8_LDB(B1, 0, 1); PG8_STAGE(PG8_SB(0, 0), b2, voffB);
            PG8_BAR; PG8_WAIT_L(0); PG8_MMA(0, 1, At, B1); PG8_BAR;
            PG8_LDA(At, 0, 1); PG8_STAGE(PG8_SA(0, 0), a2, voffA);
            PG8_BAR; PG8_WAIT_L(0); PG8_MMA(1, 0, At, B0); PG8_BAR; PG8_SCHED;
            PG8_STAGE(PG8_SB(0, 1), b2 + hstepB, voffB);
            PG8_WAIT_V(6); PG8_BAR; PG8_MMA(1, 1, At, B1); PG8_BAR;
            PG8_LDB(B0, 1, 0); PG8_SCHED; PG8_LDA(At, 1, 0); PG8_STAGE(PG8_SA(0, 1), a2 + hstepA, voffA);
            PG8_WAIT_L(8); PG8_BAR; PG8_WAIT_L(0); PG8_MMA(0, 0, At, B0); PG8_BAR; PG8_SCHED;
            PG8_LDB(B1, 1, 1); PG8_STAGE(PG8_SB(1, 0), b3, voffB);
            PG8_BAR; PG8_WAIT_L(0); PG8_MMA(0, 1, At, B1); PG8_BAR;
            PG8_LDA(At, 1, 1); PG8_STAGE(PG8_SA(1, 0), a3, voffA);
            PG8_BAR; PG8_WAIT_L(0); PG8_MMA(1, 0, At, B0); PG8_BAR; PG8_SCHED;
            PG8_STAGE(PG8_SB(1, 1), b3 + hstepB, voffB);
            PG8_WAIT_V(6); PG8_BAR; PG8_MMA(1, 1, At, B1); PG8_BAR;
            }
        }
        if constexpr (ALIGN_EPI) { if (wr == 0) PG8_BAR; }
        const bool keep = E(acc, cur, wr, wc, fr, fq);
        if (!has_next) break;
        if (!keep) {
#pragma unroll
        for (int a = 0; a < 2; ++a)
#pragma unroll
            for (int b = 0; b < 2; ++b)
#pragma unroll
                for (int m = 0; m < 4; ++m)
#pragma unroll
                    for (int n = 0; n < 2; ++n) acc[a][b][m][n] = (f32x4){0.f, 0.f, 0.f, 0.f};
        }
        cur = nxt; cA = nA; cB = nB; ++ui;
        if constexpr (ALIGN_EPI) { if (wr == 1) PG8_BAR; }
    }
    PG8_WAIT_V(0);
    if constexpr (!ALIGN_EPI) { if (wr == 0) PG8_BAR; }
    PG8_BAR;
#undef PG8_SA
#undef PG8_SB
#undef PG8_STAGE
#undef PG8_LDA
#undef PG8_LDB
#undef PG8_MMA
#undef PG8_WAIT_V
#undef PG8_WAIT_L
#undef PG8_BAR
#undef PG8_SCHED
}
}
#define GAS __attribute__((address_space(1)))
#define LAS __attribute__((address_space(3)))
typedef unsigned short bf16;
typedef unsigned v4u __attribute__((ext_vector_type(4)));
typedef float f32x4 __attribute__((ext_vector_type(4)));
typedef short bf16x8 __attribute__((ext_vector_type(8)));
typedef GAS unsigned gu32;
typedef GAS unsigned long long gu64;
#define RLX_AGENT __ATOMIC_RELAXED, __HIP_MEMORY_SCOPE_AGENT
#define LDS_WAIT() asm volatile("s_waitcnt lgkmcnt(0)" ::: "memory")
#define VM_WAIT() asm volatile("s_waitcnt vmcnt(0)" ::: "memory")
__device__ __forceinline__ unsigned long long rt() { return __builtin_amdgcn_s_memrealtime(); }
__device__ __forceinline__ unsigned f2bf(float f) { unsigned u = __builtin_bit_cast(unsigned, f); return (u + 0x7fffu + ((u >> 16) & 1u)) >> 16; }
__device__ __forceinline__ unsigned pk2(float lo, float hi) { return f2bf(lo) | (f2bf(hi) << 16); }

#define XB_TMO      128
#define XB_XCNT(j)  (256  + 64 * (j))
#define XB_XSUB(j)  (1280 + 64 * (j))
#define XB_XGEN(j)  (2304 + 64 * (j))
#define XB_TOP      3328
#define XB_TOPGEN   3392
#define XCD_BAR_WORDS 3456
#define XB_SPIN_CAP (1u << 18)

__device__ __forceinline__ unsigned xb_ld(unsigned* p)              { return __hip_atomic_load(p, __ATOMIC_RELAXED, __HIP_MEMORY_SCOPE_AGENT); }
__device__ __forceinline__ unsigned xb_add(unsigned* p, unsigned v) { return __hip_atomic_fetch_add(p, v, __ATOMIC_RELAXED, __HIP_MEMORY_SCOPE_AGENT); }
__device__ __forceinline__ unsigned xb_xcc_id() { return (unsigned)__builtin_amdgcn_s_getreg((3 << 11) | 20) & 0xFu; }
#define XB_SPIN(cond, bar) do { unsigned _sp = 0; while (cond) { __builtin_amdgcn_s_sleep(1); \
    if ((++_sp & 255u) == 0u) { if (xb_ld(&(bar)[XB_TMO])) break; if (_sp > XB_SPIN_CAP) { atomicAdd(&(bar)[XB_TMO], 1u); break; } } } } while (0)

struct XcdBarrier {
    unsigned* bar; unsigned x;
    volatile LAS unsigned* st;
};

__device__ __forceinline__ XcdBarrier xcd_barrier_post(unsigned* bar, volatile LAS unsigned* st, const int tid) {
    XcdBarrier b; b.bar = bar; b.x = xb_xcc_id(); b.st = st;
    if (tid == 0) (void)xb_add(&bar[XB_XCNT(b.x)], 1u);
    return b;
}
__device__ __forceinline__ void xcd_barrier_complete(unsigned* bar, unsigned x, unsigned& nloc, unsigned& nx) {
    const unsigned G = gridDim.x * gridDim.y * gridDim.z;
    unsigned sum, cnt, mine, sp = 0u;
    for (;;) {
        sum = 0u; cnt = 0u; mine = 0u;
#pragma unroll
        for (unsigned j = 0; j < 16; ++j) { const unsigned c = xb_ld(&bar[XB_XCNT(j)]); sum += c; cnt += (c > 0u) ? 1u : 0u; mine = (j == x) ? c : mine; }
        if (sum == G) break;
        __builtin_amdgcn_s_sleep(1);
        if ((++sp & 255u) == 0u) { if (xb_ld(&bar[XB_TMO])) break; if (sp > XB_SPIN_CAP) { atomicAdd(&bar[XB_TMO], 1u); break; } }
    }
    nloc = mine > 0u ? mine : 1u; nx = cnt > 0u ? cnt : 1u;
}

__device__ __forceinline__ void xcd_barrier(const XcdBarrier& b, const int tid) {
    asm volatile("s_waitcnt vmcnt(0)" ::: "memory");
    __syncthreads();
    if (tid == 0) {
        unsigned* bar = b.bar; asm volatile("" : "+s"(bar));
        __builtin_amdgcn_s_waitcnt(0);
        unsigned nloc = b.st[0], nx = b.st[1];
        if (nloc == 0u) { unsigned xl_ = b.x; asm volatile("" : "+s"(xl_)); xcd_barrier_complete(bar, xl_, nloc, nx); b.st[0] = nloc; b.st[1] = nx; }
        const unsigned old = xb_add(&bar[XB_XSUB(b.x)], 1u);
        const unsigned gen = old / nloc;
        if (old + 1u == (gen + 1u) * nloc) {
            __builtin_amdgcn_fence(__ATOMIC_RELEASE, "agent");
            asm volatile("s_waitcnt vmcnt(0)" ::: "memory");
            const unsigned og = xb_add(&bar[XB_TOP], 1u);
            const unsigned tg = og / nx;
            if (og + 1u == (tg + 1u) * nx) xb_add(&bar[XB_TOPGEN], 1u);
            else XB_SPIN(xb_ld(&bar[XB_TOPGEN]) == tg, bar);
            __builtin_amdgcn_fence(__ATOMIC_ACQUIRE, "agent");
            xb_add(&bar[XB_XGEN(b.x)], 1u);
            asm volatile("s_waitcnt vmcnt(0)" ::: "memory");
        } else {
            XB_SPIN(xb_ld(&bar[XB_XGEN(b.x)]) == gen, bar);
            __builtin_amdgcn_fence(__ATOMIC_ACQUIRE, "agent");
            asm volatile("s_waitcnt vmcnt(0)" ::: "memory");
        }
    }
    __syncthreads();
}
constexpr int NB = 8, SEQ = 4096, DM = 1024, T = NB * SEQ, DEPTH = 4, IN_COLS = 6240;
constexpr int FFN = 2816, NE = 8, EDIM = 1408;
constexpr float EPS = 1e-6f, LOG2E = 1.4426950408889634f;
constexpr int PJ_LD = 2304, PJ_U = 0, PJ_V = 256, PJ_BQ = 512, PJ_BK = 768, PJ_BV = 1024, PJ_DA = 1280, PJ_DG = 1536, PJ_CQ = 1792, PJ_CKV = 1984, PJ_KR = 2112;
constexpr float QS_B = 0.125f * LOG2E;
constexpr float QS_C = 0.10206207261596577f * LOG2E;
constexpr int NWAVES = 8, NTHR = 512;

constexpr size_t MiB = 1u << 20;
constexpr size_t WS_CTL = 0, CTL_ZERO_BYTES = 1 * MiB;
constexpr size_t WS_SSA = 1 * MiB, WS_SSB = 3 * MiB;
constexpr size_t WS_ROPE = 5 * MiB;
constexpr size_t WS_MISC = 11 * MiB;
constexpr size_t MS_RSCQ = WS_MISC, MS_RSCKV = WS_MISC + 128 * 1024, MS_SEL = WS_MISC + 256 * 1024, MS_KMEAN = WS_MISC + 768 * 1024,
                 MS_TOKE = WS_MISC + 1024 * 1024, MS_TOKW = WS_MISC + 1280 * 1024, MS_TOKS = WS_MISC + 1536 * 1024, MS_RSSLOT = WS_MISC + 1792 * 1024,
                 MS_WCNT = WS_MISC + 2304 * 1024, MS_WGCNT = WS_MISC + 2560 * 1024, MS_MTOT = WS_MISC + 2816 * 1024, MS_WSGU = WS_MISC + 2880 * 1024;
constexpr size_t WS_W = 14 * MiB;
constexpr size_t W_INR = WS_W, W_G = WS_W + 4 * MiB + 512 * 1024, W_UQ = WS_W + 12 * MiB + 512 * 1024, W_UKV = W_UQ + 256 * 1024, W_B = WS_W + 13 * MiB, W_OUT = WS_W + 15 * MiB,
                 W_F1 = WS_W + 17 * MiB, W_F2 = WS_W + 61 * MiB;
constexpr size_t WS_SSC = 98 * MiB;
constexpr size_t WS_XB = 100 * MiB;
constexpr size_t WS_BIG = 164 * MiB;
constexpr size_t B_PROJ = WS_BIG, B_QPRE = WS_BIG + 144 * MiB, B_KVPRE = WS_BIG + 176 * MiB  , B_CQ = WS_BIG + 208 * MiB, B_CK = WS_BIG + 232 * MiB, B_O = WS_BIG + 256 * MiB;
constexpr size_t B_SG = WS_BIG, B_Y = WS_BIG + 320 * MiB;
constexpr size_t B_HID = WS_BIG;
constexpr size_t B_XS = WS_BIG, B_HIDM = WS_BIG + 132 * MiB, B_Y2 = WS_BIG;
constexpr size_t WS_END = WS_BIG + 384 * MiB;
constexpr int MOE_ROWS_MAX = 65536 + 8 * 256;
static_assert(B_HIDM + (size_t)MOE_ROWS_MAX * EDIM * 2 <= WS_END && (size_t)MOE_ROWS_MAX * 1024 * 2 <= 132 * MiB, "moe map");
constexpr int CW_TMO = 0, CW_BAR = 4096, CW_MOE = 8192, CW_KMX = 9216;

constexpr int RING_OFF = 0, RING_BYTES = 131072;
constexpr int LDSCTL_OFF = RING_BYTES, MISC_OFF = LDSCTL_OFF + 320;
constexpr int LDS_BYTES = 147456;
constexpr int EPI_RED_OFF = 132096;

typedef float f32x2 __attribute__((ext_vector_type(2)));
typedef __bf16 bf16x2_t __attribute__((ext_vector_type(2)));
__device__ __forceinline__ unsigned pkbf(float lo, float hi) { f32x2 v = {lo, hi}; bf16x2_t b = __builtin_convertvector(v, bf16x2_t); return __builtin_bit_cast(unsigned, b); }
__device__ __forceinline__ float bflo(unsigned w) { return __uint_as_float(w << 16); }
__device__ __forceinline__ float bfhi(unsigned w) { return __uint_as_float(w & 0xffff0000u); }
__device__ __forceinline__ float bf1(bf16 b) { return __uint_as_float((unsigned)b << 16); }
__device__ __forceinline__ void unpack8(const v4u w, float* o) { o[0] = bflo(w.x); o[1] = bfhi(w.x); o[2] = bflo(w.y); o[3] = bfhi(w.y); o[4] = bflo(w.z); o[5] = bfhi(w.z); o[6] = bflo(w.w); o[7] = bfhi(w.w); }
__device__ __forceinline__ v4u pack8(const float* o) { v4u w; w.x = pkbf(o[0], o[1]); w.y = pkbf(o[2], o[3]); w.z = pkbf(o[4], o[5]); w.w = pkbf(o[6], o[7]); return w; }
template <int X> __device__ __forceinline__ float swz_xor(float v) { return __int_as_float(__builtin_amdgcn_ds_swizzle(__float_as_int(v), (X << 10) | 0x1f)); }
__device__ __forceinline__ float half_sum(float v) { auto rr = __builtin_amdgcn_permlane32_swap(__float_as_uint(v), __float_as_uint(v), false, false); return __uint_as_float(rr[0]) + __uint_as_float(rr[1]); }
__device__ __forceinline__ float wave_sum(float v) {
    v += swz_xor<1>(v); v += swz_xor<2>(v); v += swz_xor<4>(v); v += swz_xor<8>(v); v += swz_xor<16>(v);
    return half_sum(v);
}
__device__ __forceinline__ float fast_sigmoid(float x) { return __builtin_amdgcn_rcpf(1.0f + __builtin_amdgcn_exp2f(-x * LOG2E)); }
__device__ __forceinline__ float fast_silu(float x) { return x * fast_sigmoid(x); }
namespace pg8 {
struct RowScale { const float* p; int mode; };
__device__ __forceinline__ float row_scale(const RowScale& rs, int row) {
    if (rs.mode == 0) return 1.f;
    if (rs.mode == 2) return rs.p[row];
    if (rs.mode == 3) { const f32x4 p = *(const f32x4*)(rs.p + (size_t)row * 12); return rsqrtf(((p[0] + p[1]) + (p[2] + p[3])) * (1.0f / 192.0f) + EPS); }
    if (rs.mode == 4) { const f32x4 p = *(const f32x4*)(rs.p + (size_t)row * 12 + 4); return rsqrtf(((p[0] + p[1]) + (p[2] + p[3])) * (1.0f / 128.0f) + EPS); }
    { const f32x4 p = *(const f32x4*)(rs.p + (size_t)row * 4); return rsqrtf(((p[0] + p[1]) + (p[2] + p[3])) * (1.0f / 1024.0f) + EPS); }
}
template <int ACT> struct EpiScale {
    static constexpr bool PERM = true;
    bf16_t* O; int ldc; RowScale rs; float* ssc;
    __device__ __forceinline__ bool operator()(f32x4 (&acc)[2][2][4][2], const Unit& u, int wr, int wc, int fr, int fq) const {
        const int row0 = u.pm * BM + wr * 64 + fr;
        float scv[2][4];
#pragma unroll
        for (int ai = 0; ai < 2; ++ai)
#pragma unroll
            for (int m = 0; m < 4; ++m) scv[ai][m] = row_scale(rs, row0 + ai * HALF + m * 16);
#pragma unroll
        for (int ai = 0; ai < 2; ++ai)
#pragma unroll
            for (int m = 0; m < 4; ++m) {
                const int row = row0 + ai * HALF + m * 16; const float sc = scv[ai][m];
                if (ACT == 2) {
                    bf16_t* rowp = O + (size_t)row * ldc + u.pn * HALF + wc * 32 + 8 * fq;
                    const f32x4 g0 = acc[ai][0][m][0] * sc, g1 = acc[ai][0][m][1] * sc, u0 = acc[ai][1][m][0] * sc, u1 = acc[ai][1][m][1] * sc;
                    u32x4 w; w.x = pkbf(fast_silu(g0[0]) * u0[0], fast_silu(g0[1]) * u0[1]); w.y = pkbf(fast_silu(g0[2]) * u0[2], fast_silu(g0[3]) * u0[3]);
                    w.z = pkbf(fast_silu(g1[0]) * u1[0], fast_silu(g1[1]) * u1[1]); w.w = pkbf(fast_silu(g1[2]) * u1[2], fast_silu(g1[3]) * u1[3]);
                    *(u32x4*)rowp = w;
                } else {
                    bf16_t* rowp = O + (size_t)row * ldc + u.pn * BM + wc * 32 + 8 * fq;
                    float sq[2] = {0.f, 0.f};
#pragma unroll
                    for (int bj = 0; bj < 2; ++bj) {
                        f32x4 v0 = acc[ai][bj][m][0] * sc, v1 = acc[ai][bj][m][1] * sc;
                        if (ACT == 0) sq[bj] = ((v0[0] * v0[0] + v0[1] * v0[1]) + (v0[2] * v0[2] + v0[3] * v0[3])) + ((v1[0] * v1[0] + v1[1] * v1[1]) + (v1[2] * v1[2] + v1[3] * v1[3]));
                        if (ACT == 1) {
#pragma unroll
                            for (int j = 0; j < 4; ++j) { v0[j] = fmaxf(fast_sigmoid(v0[j]), 8.6736174e-19f); v1[j] = fmaxf(fast_sigmoid(v1[j]), 8.6736174e-19f); }
                        }
                        u32x4 w; w.x = pkbf(v0[0], v0[1]); w.y = pkbf(v0[2], v0[3]); w.z = pkbf(v1[0], v1[1]); w.w = pkbf(v1[2], v1[3]);
                        *(u32x4*)(rowp + bj * HALF) = w;
                    }
                    if (ACT == 0 && ssc != nullptr && (u.pn == 7 || u.pn == 8)) {
                        float a = (u.pn == 7) ? (sq[0] + (wc < 2 ? sq[1] : 0.f)) : sq[0];
                        float c = sq[1];
                        a += swz_xor<16>(a); a = half_sum(a); c += swz_xor<16>(c); c = half_sum(c);
                        if (fq == 0) {
                            float* sp = ssc + (size_t)row * 12;
                            if (u.pn == 7) { sp[wc] = a; if (wc >= 2) sp[4 + wc] = c; }
                            else { if (wc < 2) sp[4 + wc] = a; if (wc == 2) sp[8] = a; }
                        }
                    }
                }
            }
        return false;
    }
};
struct EpiResidual {
    static constexpr bool PERM = false;
    const float* base; float* out; bf16_t* xb; float* ssp; PG8_LAS float* red;
    __device__ __forceinline__ bool operator()(f32x4 (&acc)[2][2][4][2], const Unit& u, int wr, int wc, int fr, int fq) const {
        typedef unsigned u32x2v __attribute__((ext_vector_type(2)));
        const int row0 = u.pm * BM + wr * 64 + fr, col0 = u.pn * BM + wc * 32 + 4 * fq;
#pragma unroll
        for (int ai = 0; ai < 2; ++ai)
#pragma unroll
            for (int mp = 0; mp < 2; ++mp) {
                f32x4 bv[2][2][2];
#pragma unroll
                for (int mm = 0; mm < 2; ++mm)
#pragma unroll
                    for (int bj = 0; bj < 2; ++bj)
#pragma unroll
                        for (int n = 0; n < 2; ++n) bv[mm][bj][n] = *(const f32x4*)(base + (size_t)(row0 + ai * HALF + (2 * mp + mm) * 16) * DM + col0 + bj * HALF + n * 16);
#pragma unroll
                for (int mm = 0; mm < 2; ++mm) {
                    const int m = 2 * mp + mm, row = row0 + ai * HALF + m * 16; const size_t off = (size_t)row * DM + col0; float ss = 0.f;
#pragma unroll
                    for (int bj = 0; bj < 2; ++bj)
#pragma unroll
                        for (int n = 0; n < 2; ++n) {
                            const size_t o2 = off + bj * HALF + n * 16; const f32x4 o = bv[mm][bj][n] + acc[ai][bj][m][n];
                            *(f32x4*)(out + o2) = o;
                            u32x2v w; w.x = pkbf(o[0], o[1]); w.y = pkbf(o[2], o[3]); *(u32x2v*)(xb + o2) = w;
                            ss += (o[0] * o[0] + o[1] * o[1]) + (o[2] * o[2] + o[3] * o[3]);
                        }
                    ss += swz_xor<16>(ss); ss = half_sum(ss);
                    if (fq == 0) red[(ai * HALF + wr * 64 + m * 16 + fr) * 4 + wc] = ss;
                }
            }
        asm volatile("s_waitcnt lgkmcnt(0)" ::: "memory"); __builtin_amdgcn_s_barrier(); asm volatile("" ::: "memory");
        const int t = (wr * 4 + wc) * 64 + fq * 16 + fr;
        if (t < 256) { const f32x4 p = *(const PG8_LAS f32x4*)(red + t * 4); ssp[(size_t)(u.pm * BM + t) * 4 + u.pn] = (p[0] + p[1]) + (p[2] + p[3]); }
        return false;
    }
};
struct EpiKV {
    static constexpr bool PERM = true;
    bf16_t* CK; bf16_t* VB; const bf16_t* PROJ; const float* ssc; const float* rope; const float* ckn; unsigned* kmx;
    __device__ __forceinline__ bool operator()(f32x4 (&acc)[2][2][4][2], const Unit& u, int wr, int wc, int fr, int fq) const {
        typedef unsigned u32x2v __attribute__((ext_vector_type(2)));
        { unsigned mk_ = ~0u; asm volatile("" : "+s"(mk_)); const int ln_ = (int)__builtin_amdgcn_mbcnt_hi(mk_, __builtin_amdgcn_mbcnt_lo(mk_, 0u)); fr = ln_ & 15; fq = ln_ >> 4; }
        const int hh = 2 * u.pn + (wc >> 1); const bool isv = (wc & 1) != 0; const int row0 = u.pm * BM + wr * 64 + fr;
        float k2max = 0.f;
#pragma unroll
        for (int ai = 0; ai < 2; ++ai)
#pragma unroll
            for (int m = 0; m < 4; ++m) {
                const int row = row0 + ai * HALF + m * 16;
                const float* sp = ssc + (size_t)row * 12; const f32x4 pp = *(const f32x4*)(sp + 4);
                const float rs = rsqrtf(((pp[0] + pp[1]) + (pp[2] + pp[3])) * (1.0f / 128.0f) + EPS);
                if (isv) {
#pragma unroll
                    for (int bj = 0; bj < 2; ++bj) { const f32x4 v0 = acc[ai][bj][m][0] * rs, v1 = acc[ai][bj][m][1] * rs;
                        u32x4 w; w.x = pkbf(v0[0], v0[1]); w.y = pkbf(v0[2], v0[3]); w.z = pkbf(v1[0], v1[1]); w.w = pkbf(v1[2], v1[3]);
                        *(u32x4*)(VB + (size_t)row * 256 + hh * 64 + 32 * bj + 8 * fq) = w; }
                } else {
                    float ss = 0.f;
#pragma unroll
                    for (int bj = 0; bj < 2; ++bj)
#pragma unroll
                        for (int n = 0; n < 2; ++n) { const f32x4 a = acc[ai][bj][m][n]; ss += (a[0] * a[0] + a[1] * a[1]) + (a[2] * a[2] + a[3] * a[3]); }
                    ss += swz_xor<16>(ss); ss = half_sum(ss); ss *= rs * rs;
                    const float rk = rsqrtf((ss + sp[8]) * (1.0f / 96.0f) + EPS); const float rr = rs * rk;
                    bf16_t* kd = CK + (size_t)row * 384 + hh * 96; float kn2 = 0.f;
#pragma unroll
                    for (int bj = 0; bj < 2; ++bj) { const f32x4 g0 = *(const f32x4*)(ckn + 32 * bj + 8 * fq), g1 = *(const f32x4*)(ckn + 32 * bj + 8 * fq + 4);
                        const f32x4 a = acc[ai][bj][m][0] * rr * g0, b = acc[ai][bj][m][1] * rr * g1;
                        kn2 += ((a[0] * a[0] + a[1] * a[1]) + (a[2] * a[2] + a[3] * a[3])) + ((b[0] * b[0] + b[1] * b[1]) + (b[2] * b[2] + b[3] * b[3]));
                        u32x4 w; w.x = pkbf(a[0], a[1]); w.y = pkbf(a[2], a[3]); w.z = pkbf(b[0], b[1]); w.w = pkbf(b[2], b[3]);
                        *(u32x4*)(kd + 32 * bj + 8 * fq) = w; }
                    const u32x2v k1 = *(const u32x2v*)(PROJ + (size_t)row * PJ_LD + PJ_KR + 4 * fq), k2 = *(const u32x2v*)(PROJ + (size_t)row * PJ_LD + PJ_KR + 16 + 4 * fq);
                    const f32x4 ga = *(const f32x4*)(ckn + 64 + 4 * fq), gb = *(const f32x4*)(ckn + 80 + 4 * fq);
                    const float* tb = rope + (size_t)row * 48 + 16 + 8 * fq; const f32x4 t0 = *(const f32x4*)tb, t1 = *(const f32x4*)(tb + 4);
                    const float x1[4] = {bflo(k1.x) * rk * ga[0], bfhi(k1.x) * rk * ga[1], bflo(k1.y) * rk * ga[2], bfhi(k1.y) * rk * ga[3]};
                    const float x2[4] = {bflo(k2.x) * rk * gb[0], bfhi(k2.x) * rk * gb[1], bflo(k2.y) * rk * gb[2], bfhi(k2.y) * rk * gb[3]};
                    const float cs[4] = {t0[0], t0[2], t1[0], t1[2]}, sn[4] = {t0[1], t0[3], t1[1], t1[3]};
                    u32x2v y1, y2;
                    y1.x = pkbf(x1[0] * cs[0] - x2[0] * sn[0], x1[1] * cs[1] - x2[1] * sn[1]); y1.y = pkbf(x1[2] * cs[2] - x2[2] * sn[2], x1[3] * cs[3] - x2[3] * sn[3]);
                    y2.x = pkbf(x2[0] * cs[0] + x1[0] * sn[0], x2[1] * cs[1] + x1[1] * sn[1]); y2.y = pkbf(x2[2] * cs[2] + x1[2] * sn[2], x2[3] * cs[3] + x1[3] * sn[3]);
                    *(u32x2v*)(kd + 64 + 4 * fq) = y1; *(u32x2v*)(kd + 80 + 4 * fq) = y2;
                    kn2 += ((x1[0] * x1[0] + x2[0] * x2[0]) + (x1[1] * x1[1] + x2[1] * x2[1])) + ((x1[2] * x1[2] + x2[2] * x2[2]) + (x1[3] * x1[3] + x2[3] * x2[3]));
                    kn2 += swz_xor<16>(kn2); kn2 = half_sum(kn2); k2max = fmaxf(k2max, kn2);
                }
                asm volatile("" ::: "memory");
            }
        if (!isv) {
            k2max = fmaxf(k2max, swz_xor<1>(k2max)); k2max = fmaxf(k2max, swz_xor<2>(k2max)); k2max = fmaxf(k2max, swz_xor<4>(k2max)); k2max = fmaxf(k2max, swz_xor<8>(k2max));
            if (fr == 0 && fq == 0) __hip_atomic_fetch_max(kmx + ((u.pm * BM) / SEQ) * 4 + hh, __float_as_uint(k2max), __ATOMIC_RELAXED, __HIP_MEMORY_SCOPE_AGENT);
        }
        return false;
    }
};
struct EpiGates {
    static constexpr bool PERM = true;
    bf16_t* RG; RowScale rs;
    __device__ __forceinline__ bool operator()(f32x4 (&acc)[2][2][4][2], const Unit& u, int wr, int wc, int fr, int fq) const {
        typedef unsigned u32x2v __attribute__((ext_vector_type(2)));
        const int row0 = u.pm * BM + wr * 64 + fr, oc = u.pn * 64 + wc * 16 + fq * 4;
        float scv[2][4];
#pragma unroll
        for (int ai = 0; ai < 2; ++ai)
#pragma unroll
            for (int m = 0; m < 4; ++m) scv[ai][m] = row_scale(rs, row0 + ai * HALF + m * 16);
#pragma unroll
        for (int ai = 0; ai < 2; ++ai)
#pragma unroll
            for (int m = 0; m < 4; ++m) {
                const int row = row0 + ai * HALF + m * 16; const float sc = scv[ai][m];
                f32x4 s[4];
#pragma unroll
                for (int b = 0; b < 4; ++b) { const f32x4 g = acc[ai][b >> 1][m][b & 1] * sc;
#pragma unroll
                    for (int j = 0; j < 4; ++j) s[b][j] = fmaxf(fast_sigmoid(g[j]), 8.6736174e-19f); }
                bf16_t* rp = RG + (size_t)row * 4096 + oc;
#pragma unroll
                for (int b = 0; b < 4; ++b) { f32x4 r = s[b];
                    if (b < 3) {
#pragma unroll
                        for (int j = 0; j < 4; ++j) r[j] = s[b][j] * __builtin_amdgcn_rcpf(s[b + 1][j]); }
                    u32x2v w; w.x = pkbf(r[0], r[1]); w.y = pkbf(r[2], r[3]); *(u32x2v*)(rp + b * 1024) = w; }
            }
        return false;
    }
};
struct EpiMerge {
    static constexpr bool PERM = true;
    const bf16_t* SG; bf16_t* Y;
    __device__ __forceinline__ bool operator()(f32x4 (&acc)[2][2][4][2], const Unit& u, int wr, int wc, int fr, int fq) const {
        const int n = u.ak >> 8; const int row0 = u.pm * BM + wr * 64 + fr, col0 = u.pn * BM + wc * 32 + 8 * fq;
#pragma unroll
        for (int ai = 0; ai < 2; ++ai)
#pragma unroll
            for (int mp = 0; mp < 2; ++mp) {
              u32x4 av[2][2];
#pragma unroll
              for (int mm = 0; mm < 2; ++mm)
#pragma unroll
                for (int bj = 0; bj < 2; ++bj) av[mm][bj] = *(const u32x4*)(SG + (size_t)(row0 + ai * HALF + (2 * mp + mm) * 16) * 4096 + n * 1024 + col0 + bj * HALF);
#pragma unroll
              for (int mm = 0; mm < 2; ++mm) {
                const int m = 2 * mp + mm, row = row0 + ai * HALF + m * 16;
#pragma unroll
                for (int bj = 0; bj < 2; ++bj) {
                    float sa[8]; unpack8(av[mm][bj], sa);
#pragma unroll
                    for (int j = 0; j < 4; ++j) { acc[ai][bj][m][0][j] *= sa[j]; acc[ai][bj][m][1][j] *= sa[4 + j]; }
                    if (n == 3) {
                        float o[8];
#pragma unroll
                        for (int j = 0; j < 4; ++j) { o[j] = acc[ai][bj][m][0][j]; o[4 + j] = acc[ai][bj][m][1][j]; }
                        *(u32x4*)(Y + (size_t)row * DM + col0 + bj * HALF) = pack8(o);
                    }
                }
              }
            }
        return n < 3;
    }
};
struct MergeOrder {
    StaticOrder so;
    __device__ bool next(int i, Unit& u) const { if (!so.next(i >> 2, u)) return false; const int n = i & 3; u.pb = n * 4 + u.pn; u.ak = n * 256; return true; }
    __device__ __forceinline__ void a_ready(const Unit&) const {}
    __device__ __forceinline__ void done(const Unit&) const {}
};
struct MoeOrder {
    StaticOrder so; int nN; int ps[9];
    __device__ bool next(int i, Unit& u) const {
        if (!so.next(i, u)) return false; int e = 0;
#pragma unroll
        for (int k = 1; k < 8; ++k) e = (u.pm >= ps[k]) ? k : e;
        u.pb = e * nN + u.pn; u.ak = 0; return true; }
    __device__ __forceinline__ void a_ready(const Unit&) const {}
    __device__ __forceinline__ void done(const Unit&) const {}
};
}

struct TrDesc { const float* src; bf16* dst; const float* gain; int ldw, ldd, nnb, nsrc0, drow0, map, cum, pad; };
constexpr int TR_TAB_OFF = 8448;
struct TrItem { const float* W; bf16* dst; const float* gain; int ldw, ldd, k0, n0, perm; };
__device__ __forceinline__ void tr_load(const TrItem& it, float (&v)[32], int lane) {
#pragma unroll
    for (int i = 0; i < 32; ++i) { const int kk = 2 * i + (lane >> 5); v[i] = it.W[(size_t)(it.k0 + kk) * it.ldw + it.n0 + (lane & 31)]; }
}
__device__ __forceinline__ void tr_finish(const TrItem& it, float (&v)[32], LAS float* scr, int lane) {
    if (it.gain) {
#pragma unroll
        for (int i = 0; i < 32; ++i) v[i] *= it.gain[it.k0 + 2 * i + (lane >> 5)];
    }
#pragma unroll
    for (int i = 0; i < 32; ++i) scr[(2 * i + (lane >> 5)) * 33 + (lane & 31)] = v[i];
    LDS_WAIT(); asm volatile("" ::: "memory");
    const int c = lane & 7;
#pragma unroll
    for (int j = 0; j < 4; ++j) { const int n = (lane >> 3) + 8 * j; const LAS float* s = scr + (8 * c) * 33 + n;
        v4u o; o.x = pkbf(s[0 * 33], s[1 * 33]); o.y = pkbf(s[2 * 33], s[3 * 33]); o.z = pkbf(s[4 * 33], s[5 * 33]); o.w = pkbf(s[6 * 33], s[7 * 33]);
        const int nr = it.perm ? (32 * (n >> 4) + 8 * ((n >> 2) & 3) + (n & 3)) : n;
        *(v4u*)(it.dst + (size_t)nr * it.ldd + 8 * c) = o; }
    LDS_WAIT(); asm volatile("" ::: "memory");
}
__device__ __forceinline__ void tr_add(LAS TrDesc* t, int& n, int& cum, const float* src, int ldw, int Ktot, int ncols, int nsrc0, bf16* dst, int ldd, int drow0, int map, const float* gain) {
    int z = 0; asm volatile("" : "+s"(z));
    asm volatile("" : "+s"(gain));
    t[n].src = src; t[n].dst = dst; t[n].gain = gain; t[n].ldw = ldw + z; t[n].ldd = ldd + z; t[n].nnb = ncols / 32 + z; t[n].nsrc0 = nsrc0 + z; t[n].drow0 = drow0 + z; t[n].map = map + z; t[n].cum = cum + z;
    cum += (Ktot / 64) * (ncols / 32); ++n;
}
__device__ __forceinline__ TrItem tr_lookup(const LAS TrDesc* t, int& d, int it) {
    while (it >= t[d + 1].cum) ++d;
    const int local = it - t[d].cum, nnb = t[d].nnb, kb = local / nnb, nb = local - kb * nnb, k0 = kb * 64, nl = nb * 32;
    const int mp = t[d].map;
    const int drow = t[d].drow0 + (mp == 1 ? ((nl >> 7) * 256 + (nl & 127)) : mp == 2 ? (256 * (nl >> 8) + 128 * ((nl >> 5) & 1) + 32 * ((((nl >> 7) & 1) << 1) + ((nl >> 6) & 1)))
                                 : mp == 3 ? (256 * ((nl & 1023) >> 6) + 128 * (nl >> 11) + 32 * (((nl & 1023) >> 4) & 3) + 4 * ((nl >> 10) & 1)) : nl); const int ldd = t[d].ldd;
    TrItem r; r.W = t[d].src; r.dst = t[d].dst + (size_t)drow * ldd + k0; r.gain = t[d].gain; r.ldw = t[d].ldw; r.ldd = ldd; r.k0 = k0; r.n0 = t[d].nsrc0 + nl; r.perm = (mp == 3) ? 1 : 0; return r;
}
__device__ __forceinline__ void tr_run(const LAS TrDesc* t, int total, LAS float* scr, int lane, int gw, int NGW) {
    const int per = (total + NGW - 1) / NGW, lo = gw * per, hi = (lo + per < total) ? lo + per : total;
    if (lo >= hi) return;
    int d = 0; TrItem cur = tr_lookup(t, d, lo); float va[32], vb[32];
    tr_load(cur, va, lane);
    for (int it = lo; it < hi; it += 2) {
        TrItem nx = cur; const bool h1 = it + 1 < hi;
        if (h1) { nx = tr_lookup(t, d, it + 1); tr_load(nx, vb, lane); }
        tr_finish(cur, va, scr, lane);
        if (!h1) break;
        const bool h2 = it + 2 < hi;
        if (h2) { cur = tr_lookup(t, d, it + 2); tr_load(cur, va, lane); }
        tr_finish(nx, vb, scr, lane);
    }
}

template <int DK, int DV, bool MOBA>
__device__ __forceinline__ void naive_attn_unit(LAS unsigned char* lds, const bf16* Q, int qp, int qhs, const bf16* K, int kp, int khs, const bf16* V, int vp, int vhs,
                                                bf16* O, int op, int b, int h, int qc, const int* sel, const int tid) {
    LAS float* Ks = (LAS float*)lds; LAS float* Vs = Ks + 64 * DK;
    const int qi = qc * 512 + tid;
    const size_t tok = (size_t)b * SEQ + qi;
    float q[DK];
    { const v4u* qsrc = (const v4u*)(Q + tok * qp + h * qhs);
#pragma unroll
      for (int c = 0; c < DK / 8; ++c) unpack8(qsrc[c], q + 8 * c); }
    float o[DV];
#pragma unroll
    for (int d = 0; d < DV; ++d) o[d] = 0.f;
    float m = -1e30f, l = 0.f;
    const int qblk = qi >> 8; unsigned mask = 0u;
    if (MOBA) { const int sv = sel[tok * 4 + h]; const int ns = (sv >> 12) & 3;
        if (ns > 0) mask |= 1u << (sv & 15); if (ns > 1) mask |= 1u << ((sv >> 4) & 15); if (ns > 2) mask |= 1u << ((sv >> 8) & 15); }
    const int ntile = qc * 8 + 8;
    const int wave_last = qc * 512 + (tid | 63);
    for (int kt = 0; kt < ntile; ++kt) {
        __syncthreads();
        const int k0 = kt * 64;
        for (int c = tid; c < 64 * (DK / 8); c += NTHR) { const int r = c / (DK / 8), ch = c - r * (DK / 8);
            const v4u w = *(const v4u*)(K + ((size_t)b * SEQ + k0 + r) * kp + h * khs + ch * 8); float f[8]; unpack8(w, f);
            LAS f32x4* d = (LAS f32x4*)(Ks + r * DK + ch * 8); d[0] = (f32x4){f[0], f[1], f[2], f[3]}; d[1] = (f32x4){f[4], f[5], f[6], f[7]}; }
        for (int c = tid; c < 64 * (DV / 8); c += NTHR) { const int r = c / (DV / 8), ch = c - r * (DV / 8);
            const v4u w = *(const v4u*)(V + ((size_t)b * SEQ + k0 + r) * vp + h * vhs + ch * 8); float f[8]; unpack8(w, f);
            LAS f32x4* d = (LAS f32x4*)(Vs + r * DV + ch * 8); d[0] = (f32x4){f[0], f[1], f[2], f[3]}; d[1] = (f32x4){f[4], f[5], f[6], f[7]}; }
        __syncthreads();
        if (k0 > wave_last) continue;
        const int nblk = k0 >> 8;
        bool tile_ok = true;
        if (MOBA) { tile_ok = (nblk == qblk) || ((mask >> nblk) & 1u); if (!__any(tile_ok)) continue; }
        for (int jj = 0; jj < 64; ++jj) {
            const int kj = k0 + jj;
            const bool ok = MOBA ? (tile_ok && (nblk != qblk || kj <= qi)) : (kj <= qi);
            if (ok) {
                const LAS f32x4* kr = (const LAS f32x4*)(Ks + jj * DK);
                float s0 = 0.f, s1 = 0.f;
#pragma unroll
                for (int c = 0; c < DK / 8; ++c) { const f32x4 a = kr[2 * c], bq = kr[2 * c + 1];
                    s0 += q[8 * c] * a[0]; s1 += q[8 * c + 1] * a[1]; s0 += q[8 * c + 2] * a[2]; s1 += q[8 * c + 3] * a[3];
                    s0 += q[8 * c + 4] * bq[0]; s1 += q[8 * c + 5] * bq[1]; s0 += q[8 * c + 6] * bq[2]; s1 += q[8 * c + 7] * bq[3]; }
                const float s = s0 + s1;
                if (s > m) { const float cf = __builtin_amdgcn_exp2f(m - s); l *= cf;
#pragma unroll
                    for (int d = 0; d < DV; ++d) o[d] *= cf;
                    m = s; }
                const float p = __builtin_amdgcn_exp2f(s - m); l += p;
                const LAS f32x4* vr = (const LAS f32x4*)(Vs + jj * DV);
#pragma unroll
                for (int c = 0; c < DV / 4; ++c) { const f32x4 a = vr[c]; o[4 * c] += p * a[0]; o[4 * c + 1] += p * a[1]; o[4 * c + 2] += p * a[2]; o[4 * c + 3] += p * a[3]; }
            }
        }
    }
    const float inv = 1.0f / l;
    v4u* od = (v4u*)(O + tok * op + h * DV);
#pragma unroll
    for (int c = 0; c < DV / 8; ++c) { float t8[8];
#pragma unroll
        for (int j = 0; j < 8; ++j) t8[j] = o[8 * c + j] * inv;
        od[c] = pack8(t8); }
    __syncthreads();
}

constexpr int SGU_P = 136;
__device__ __forceinline__ void sgu_unit(LAS unsigned char* lds, const bf16* PROJ, bf16* O, const float* __restrict__ lng, const float* __restrict__ lnb, const bf16* __restrict__ WM, const float* __restrict__ bs, int unit, const int tid) {
    LAS bf16* vnT = (LAS bf16*)lds;
    const int lane = tid & 63, wave = __builtin_amdgcn_readfirstlane(tid >> 6), r32 = lane & 31, hi = lane >> 5;
    const size_t t0 = (size_t)unit * 128;
    float g4[4], b4[4];
#pragma unroll
    for (int j = 0; j < 4; ++j) { g4[j] = lng[lane + 64 * j]; b4[j] = lnb[lane + 64 * j]; }
    bf16x8 wf[20];
    { const int g_ = wave >> 1; const bf16* wb = WM + ((size_t)(g_ * 128 + r32) * 128 + 8 * hi);
#pragma unroll
      for (int nt = 0; nt < 4; ++nt)
#pragma unroll
          for (int ks = 0; ks < 2 * nt + 2; ++ks) wf[nt * (nt + 1) + ks] = *(const bf16x8*)(wb + (size_t)(32 * nt) * 128 + 16 * ks); }
    for (int i4 = 0; i4 < 4; ++i4) {
        float x[4][4];
#pragma unroll
        for (int u = 0; u < 4; ++u) { const bf16* vp = PROJ + (t0 + wave * 16 + i4 * 4 + u) * PJ_LD + PJ_V + lane;
            x[u][0] = bf1(vp[0]); x[u][1] = bf1(vp[64]); x[u][2] = bf1(vp[128]); x[u][3] = bf1(vp[192]); }
        float mu[4], var[4];
#pragma unroll
        for (int u = 0; u < 4; ++u) mu[u] = (x[u][0] + x[u][1]) + (x[u][2] + x[u][3]);
#pragma unroll
        for (int u = 0; u < 4; ++u) mu[u] = wave_sum(mu[u]) * (1.0f / 256.0f);
#pragma unroll
        for (int u = 0; u < 4; ++u) { x[u][0] -= mu[u]; x[u][1] -= mu[u]; x[u][2] -= mu[u]; x[u][3] -= mu[u]; var[u] = (x[u][0] * x[u][0] + x[u][1] * x[u][1]) + (x[u][2] * x[u][2] + x[u][3] * x[u][3]); }
#pragma unroll
        for (int u = 0; u < 4; ++u) var[u] = wave_sum(var[u]) * (1.0f / 256.0f);
#pragma unroll
        for (int u = 0; u < 4; ++u) { const int s = wave * 16 + i4 * 4 + u; const float rstd = rsqrtf(var[u] + EPS);
            const unsigned w01 = pkbf(x[u][0] * rstd * g4[0] + b4[0], x[u][1] * rstd * g4[1] + b4[1]), w23 = pkbf(x[u][2] * rstd * g4[2] + b4[2], x[u][3] * rstd * g4[3] + b4[3]);
            vnT[(lane) * SGU_P + s] = (bf16)(w01 & 0xffffu); vnT[(lane + 64) * SGU_P + s] = (bf16)(w01 >> 16);
            vnT[(lane + 128) * SGU_P + s] = (bf16)(w23 & 0xffffu); vnT[(lane + 192) * SGU_P + s] = (bf16)(w23 >> 16); }
    }
    __syncthreads();
    const int g = wave >> 1, dt = wave & 1;
    bf16x8 af[8];
#pragma unroll
    for (int ks = 0; ks < 8; ++ks) af[ks] = *(const LAS bf16x8*)(vnT + (g * 64 + dt * 32 + r32) * SGU_P + 16 * ks + 8 * hi);
    typedef float f32x16s __attribute__((ext_vector_type(16)));
    f32x16s acc[4];
#pragma unroll
    for (int nt = 0; nt < 4; ++nt) {
#pragma unroll
        for (int r = 0; r < 16; ++r) acc[nt][r] = 0.f;
#pragma unroll
        for (int ks = 0; ks < 2 * nt + 2; ++ks) {
            acc[nt] = __builtin_amdgcn_mfma_f32_32x32x16_bf16(af[ks], wf[nt * (nt + 1) + ks], acc[nt], 0, 0, 0);
        }
    }
    typedef unsigned u32x2v __attribute__((ext_vector_type(2)));
    u32x2v uva[4][4]; float biasv[4];
#pragma unroll
    for (int nt = 0; nt < 4; ++nt) { const int t = 32 * nt + r32; biasv[nt] = bs[g * 128 + t]; const bf16* up = PROJ + (t0 + t) * PJ_LD + PJ_U + g * 64 + dt * 32 + 4 * hi;
#pragma unroll
        for (int j = 0; j < 4; ++j) uva[nt][j] = *(const u32x2v*)(up + 8 * j); }
#pragma unroll
    for (int nt = 0; nt < 4; ++nt) {
        const int t = 32 * nt + r32; const float bias = biasv[nt];
        bf16* op = O + (t0 + t) * DM + g * 64 + dt * 32 + 4 * hi;
#pragma unroll
        for (int j = 0; j < 4; ++j) {
            const u32x2v uu = uva[nt][j];
            u32x2v w; w.x = pkbf(bflo(uu.x) * (acc[nt][4 * j] + bias), bfhi(uu.x) * (acc[nt][4 * j + 1] + bias)); w.y = pkbf(bflo(uu.y) * (acc[nt][4 * j + 2] + bias), bfhi(uu.y) * (acc[nt][4 * j + 3] + bias));
            *(u32x2v*)(op + 8 * j) = w;
        }
    }
    __syncthreads();
}

__device__ __forceinline__ void prep_block(LAS unsigned char* lds, bf16* PROJ, const float* __restrict__ ROPE, const float* __restrict__ qn, const float* __restrict__ kn, float* KMEAN, unsigned* kmx_out, int item, const int tid) {
    const int b = item >> 5, blk = (item >> 1) & 15, hf = item & 1;
    const int sub = tid & 7;
    const size_t tok0 = (size_t)b * SEQ + blk * 256 + hf * 128;
    float kmx = 0.f;
    f32x4 gq0 = *(const f32x4*)(qn + 8 * sub), gq1 = *(const f32x4*)(qn + 8 * sub + 4), gk0 = *(const f32x4*)(kn + 8 * sub), gk1 = *(const f32x4*)(kn + 8 * sub + 4);
#pragma unroll 1
    for (int pass = 0; pass < 16; pass += 4) {
        v4u raw[4];
#pragma unroll
        for (int u = 0; u < 4; ++u) { const int row = (pass + u) * 64 + (tid >> 3);
            const int tk = row >> 3, which = (row >> 2) & 1, hd = row & 3;
            raw[u] = *(const v4u*)(PROJ + (tok0 + tk) * PJ_LD + (which ? PJ_BK : PJ_BQ) + hd * 64 + 8 * sub); }
#pragma unroll
        for (int u = 0; u < 4; ++u) { const int row = (pass + u) * 64 + (tid >> 3);
            const int tk = row >> 3, which = (row >> 2) & 1, hd = row & 3;
            float v[8]; unpack8(raw[u], v);
            float ss = ((v[0] * v[0] + v[1] * v[1]) + (v[2] * v[2] + v[3] * v[3])) + ((v[4] * v[4] + v[5] * v[5]) + (v[6] * v[6] + v[7] * v[7]));
            ss += swz_xor<1>(ss); ss += swz_xor<2>(ss); ss += swz_xor<4>(ss);
            const float rstd = rsqrtf(ss * (1.0f / 64.0f) + EPS);
            const f32x4 g0 = which ? gk0 : gq0, g1 = which ? gk1 : gq1;
#pragma unroll
            for (int j = 0; j < 4; ++j) { v[j] *= rstd * g0[j]; v[4 + j] *= rstd * g1[j]; }
            const float* tab = ROPE + (tok0 + tk) * 48;
#pragma unroll
            for (int j = 0; j < 8; ++j) { const float other = swz_xor<1>(v[j]);
                if (sub < 2) { const float cs = tab[2 * j], sn = tab[2 * j + 1]; v[j] = (sub == 0) ? (v[j] * cs - other * sn) : (v[j] * cs + other * sn); } }
            if (!which) {
#pragma unroll
                for (int j = 0; j < 8; ++j) v[j] *= QS_B;
            } else {
                float s2 = ((v[0] * v[0] + v[1] * v[1]) + (v[2] * v[2] + v[3] * v[3])) + ((v[4] * v[4] + v[5] * v[5]) + (v[6] * v[6] + v[7] * v[7]));
                s2 += swz_xor<1>(s2); s2 += swz_xor<2>(s2); s2 += swz_xor<4>(s2); kmx = fmaxf(kmx, s2);
            }
            *(v4u*)(PROJ + (tok0 + tk) * PJ_LD + (which ? PJ_BK : PJ_BQ) + hd * 64 + 8 * sub) = pack8(v);
        }
    }
    {
        LAS float* kl = (LAS float*)lds; kl[tid] = kmx;
        __syncthreads();
        if (tid < 4) { float mx = 0.f; for (int i = 0; i < NTHR; ++i) { const bool mine = (((i >> 5) & 1) == 1) && (((i >> 3) & 3) == tid); mx = mine ? fmaxf(mx, kl[i]) : mx; }
            __hip_atomic_fetch_max(kmx_out + b * 4 + tid, __float_as_uint(mx), __ATOMIC_RELAXED, __HIP_MEMORY_SCOPE_AGENT); }
    }
    __syncthreads();
    {
        const int h = tid >> 7, d = (tid >> 1) & 63, half = tid & 1;
        const bf16* kp = PROJ + (tok0 + half * 64) * PJ_LD + PJ_BK + h * 64 + d;
#define KLD(p) __hip_atomic_load((const unsigned short*)(p), __ATOMIC_RELAXED, __HIP_MEMORY_SCOPE_AGENT)
        float s0 = 0.f, s1 = 0.f, s2 = 0.f, s3 = 0.f;
#pragma unroll 8
        for (int j = 0; j < 16; ++j) { s0 += bf1(KLD(kp + (size_t)(4 * j) * PJ_LD)); s1 += bf1(KLD(kp + (size_t)(4 * j + 1) * PJ_LD)); s2 += bf1(KLD(kp + (size_t)(4 * j + 2) * PJ_LD)); s3 += bf1(KLD(kp + (size_t)(4 * j + 3) * PJ_LD)); }
        float s = (s0 + s1) + (s2 + s3);
        s += swz_xor<1>(s);
        if (half == 0) KMEAN[(((size_t)(b * 4 + h) * 16 + blk) * 2 + hf) * 64 + d] = s;
#undef KLD
    }
    __syncthreads();
}

__device__ __forceinline__ void conv_unit(LAS unsigned char* lds, const bf16* PROJ, bf16* O, const float* __restrict__ cw, const float* __restrict__ cb, const float* __restrict__ lng, const float* __restrict__ lnb, int unit, const int tid) {
    LAS float* zc = (LAS float*)lds;
    const int lane = tid & 63, wave = __builtin_amdgcn_readfirstlane(tid >> 6);
    const int b = unit >> 6, p0 = (unit & 63) * 64;
    const int ch = tid & 255, half = tid >> 8;
    {
        typedef unsigned u32x2v __attribute__((ext_vector_type(2)));
        u32x2v av[12], gv[12];
#pragma unroll
        for (int i = 0; i < 12; ++i) { const int r = wave + 8 * i, p = p0 - 30 + r; av[i] = (u32x2v){0u, 0u}; gv[i] = (u32x2v){0u, 0u};
            if (r < 94 && p >= 0) { const bf16* row = PROJ + ((size_t)b * SEQ + p) * PJ_LD; av[i] = *(const u32x2v*)(row + PJ_DA + 4 * lane); gv[i] = *(const u32x2v*)(row + PJ_DG + 4 * lane); } }
#pragma unroll
        for (int i = 0; i < 12; ++i) { const int r = wave + 8 * i;
            if (r < 94) *(LAS f32x4*)(zc + r * 256 + 4 * lane) = (f32x4){bflo(av[i].x) * fast_sigmoid(bflo(gv[i].x)), bfhi(av[i].x) * fast_sigmoid(bfhi(gv[i].x)), bflo(av[i].y) * fast_sigmoid(bflo(gv[i].y)), bfhi(av[i].y) * fast_sigmoid(bfhi(gv[i].y))}; }
    }
    float w[31];
#pragma unroll
    for (int j = 0; j < 31; ++j) w[j] = cw[j * 256 + ch];
    const float bias = cb[ch];
    __syncthreads();
    float acc[32];
    {
        float z[62];
#pragma unroll
        for (int j = 0; j < 62; ++j) z[j] = zc[(half * 32 + j) * 256 + ch];
#pragma unroll
        for (int t = 0; t < 32; ++t) { float a = bias;
#pragma unroll
            for (int j = 0; j < 31; ++j) a += w[j] * z[t + j];
            acc[t] = a; }
    }
    __syncthreads();
#pragma unroll
    for (int t = 0; t < 32; ++t) zc[(half * 32 + t) * 256 + ch] = acc[t];
    __syncthreads();
    const f32x4 g4 = *(const f32x4*)(lng + lane * 4), b4 = *(const f32x4*)(lnb + lane * 4);
    for (int i4 = 0; i4 < 2; ++i4) {
        f32x4 x[4]; float mu[4], var[4];
#pragma unroll
        for (int u = 0; u < 4; ++u) { x[u] = *(const LAS f32x4*)(zc + (wave * 8 + i4 * 4 + u) * 256 + lane * 4); mu[u] = (x[u][0] + x[u][1]) + (x[u][2] + x[u][3]); }
#pragma unroll
        for (int u = 0; u < 4; ++u) mu[u] = wave_sum(mu[u]) * (1.0f / 256.0f);
#pragma unroll
        for (int u = 0; u < 4; ++u) { x[u] = x[u] - mu[u]; var[u] = (x[u][0] * x[u][0] + x[u][1] * x[u][1]) + (x[u][2] * x[u][2] + x[u][3] * x[u][3]); }
#pragma unroll
        for (int u = 0; u < 4; ++u) var[u] = wave_sum(var[u]) * (1.0f / 256.0f);
#pragma unroll
        for (int u = 0; u < 4; ++u) { const float rstd = rsqrtf(var[u] + EPS);
            const float y0 = x[u][0] * rstd * g4[0] + b4[0], y1 = x[u][1] * rstd * g4[1] + b4[1], y2 = x[u][2] * rstd * g4[2] + b4[2], y3 = x[u][3] * rstd * g4[3] + b4[3];
            typedef unsigned u32x2v __attribute__((ext_vector_type(2)));
            u32x2v wv; wv.x = pkbf(fast_silu(y0), fast_silu(y1)); wv.y = pkbf(fast_silu(y2), fast_silu(y3));
            *(u32x2v*)(O + ((size_t)b * SEQ + p0 + wave * 8 + i4 * 4 + u) * DM + 768 + lane * 4) = wv; }
    }
    __syncthreads();
}

typedef float f32x16 __attribute__((ext_vector_type(16)));
template <int DK> struct AttnLds { static constexpr int KBYTES = 64 * DK * 2  , VP = 68, VBYTES = 64 * VP * 2, K0 = 0, K1 = KBYTES, V0 = 2 * KBYTES, V1 = 2 * KBYTES + VBYTES, UM = 2 * KBYTES + 2 * VBYTES; };
__device__ __forceinline__ float half_max(float v) { auto rr = __builtin_amdgcn_permlane32_swap(__float_as_uint(v), __float_as_uint(v), false, false); return fmaxf(__uint_as_float(rr[0]), __uint_as_float(rr[1])); }
#define ATT_FAST_BOUND 30.0f
__device__ __forceinline__ void softmax_fast(f32x16& s, float& l, bf16x8 (&p)[2], const bool diag, const bool blocked, const int qi, const int kbase) {
    if (diag) {
#pragma unroll
        for (int r = 0; r < 16; ++r) { const int key = kbase + (r & 3) + 8 * (r >> 2); if (key > qi) s[r] = -INFINITY; }
    }
    float sum = 0.f;
#pragma unroll
    for (int r = 0; r < 16; ++r) { const float e = __builtin_amdgcn_exp2f(s[r]); s[r] = e; sum += e; }
    v4u w0, w1;
    w0.x = pkbf(s[0], s[1]); w0.y = pkbf(s[2], s[3]); w0.z = pkbf(s[4], s[5]); w0.w = pkbf(s[6], s[7]);
    w1.x = pkbf(s[8], s[9]); w1.y = pkbf(s[10], s[11]); w1.z = pkbf(s[12], s[13]); w1.w = pkbf(s[14], s[15]);
    if (blocked) { sum = 0.f; w0 = (v4u){0u, 0u, 0u, 0u}; w1 = (v4u){0u, 0u, 0u, 0u}; }
    l += sum;
    p[0] = __builtin_bit_cast(bf16x8, w0); p[1] = __builtin_bit_cast(bf16x8, w1);
}
__device__ __forceinline__ void softmax_group(f32x16& s, f32x16 (&o)[2], float& m, float& l, bf16x8 (&p)[2], const bool diag, const bool blocked, const int qi, const int kbase) {
    if (diag) {
#pragma unroll
        for (int r = 0; r < 16; ++r) { const int key = kbase + (r & 3) + 8 * (r >> 2); if (key > qi) s[r] = -INFINITY; }
    }
    float mx = fmaxf(s[0], s[1]);
#pragma unroll
    for (int r = 2; r < 16; ++r) mx = fmaxf(mx, s[r]);
    mx = half_max(mx);
    if (blocked) mx = -INFINITY;
    const float mn = fmaxf(m, mx);
    const float ms = (mn == -INFINITY) ? 0.f : mn;
    const float alpha = __builtin_amdgcn_exp2f(m - ms);
    const float mse = blocked ? INFINITY : ms;
    float sum = 0.f;
#pragma unroll
    for (int r = 0; r < 16; ++r) { const float e = __builtin_amdgcn_exp2f(s[r] - mse); s[r] = e; sum += e; }
    l = l * alpha + sum; m = mn;
    if (__any(alpha != 1.f)) {
#pragma unroll
        for (int dt = 0; dt < 2; ++dt)
#pragma unroll
            for (int r = 0; r < 16; ++r) o[dt][r] *= alpha;
    }
#pragma unroll
    for (int st = 0; st < 2; ++st) { const int bs = 8 * st;
        v4u w; w.x = pkbf(s[bs], s[bs + 1]); w.y = pkbf(s[bs + 2], s[bs + 3]); w.z = pkbf(s[bs + 4], s[bs + 5]); w.w = pkbf(s[bs + 6], s[bs + 7]);
        p[st] = __builtin_bit_cast(bf16x8, w); }
}
template <int NKS, int DK>
__device__ __forceinline__ float qpost(bf16x8 (&qf)[NKS], const float* __restrict__ qgain, const float* __restrict__ tabrow, const int hi) {
    float qv[8 * NKS]; float ss = 0.f;
#pragma unroll
    for (int ks = 0; ks < NKS; ++ks) unpack8(__builtin_bit_cast(v4u, qf[ks]), qv + 8 * ks);
#pragma unroll
    for (int i = 0; i < 8 * NKS; ++i) ss += qv[i] * qv[i];
    const float rstd = rsqrtf(half_sum(ss) * (1.0f / (float)DK) + EPS);
#pragma unroll
    for (int ks = 0; ks < NKS; ++ks) { const f32x4 ga = *(const f32x4*)(qgain + 16 * ks + 8 * hi), gb = *(const f32x4*)(qgain + 16 * ks + 8 * hi + 4);
#pragma unroll
        for (int j = 0; j < 4; ++j) { qv[8 * ks + j] *= rstd * ga[j]; qv[8 * ks + 4 + j] *= rstd * gb[j]; } }
    const float* tb = tabrow + 16 + 16 * hi;
#pragma unroll
    for (int j = 0; j < 8; ++j) { const float cs = tb[2 * j], sn = tb[2 * j + 1], x1 = qv[32 + j], x2 = qv[40 + j]; qv[32 + j] = x1 * cs - x2 * sn; qv[40 + j] = x2 * cs + x1 * sn; }
    float q2 = 0.f;
#pragma unroll
    for (int i = 0; i < 8 * NKS; ++i) { qv[i] *= QS_C; q2 += qv[i] * qv[i]; }
#pragma unroll
    for (int ks = 0; ks < NKS; ++ks) qf[ks] = __builtin_bit_cast(bf16x8, pack8(qv + 8 * ks));
    return half_sum(q2);
}
template <int DK, bool MOBA, bool QPOST, int qp, int qhs, int kp, int khs, int vp, int vhs, int op>
__device__ __forceinline__ void attn_unit(LAS unsigned char* lds, const bf16* __restrict__ Q, const bf16* __restrict__ K,
                                          const bf16* __restrict__ V, bf16* O, const int b, const int h, const int qc, const float* __restrict__ kmean, const float* __restrict__ qgain, const float* __restrict__ rope, const unsigned* __restrict__ kmx, const int tid) {
    using L = AttnLds<DK>;
    constexpr int NKS = DK / 16, KCH = DK / 8;
    const int lane = tid & 63, w = __builtin_amdgcn_readfirstlane(tid >> 6), r32 = lane & 31, hi = lane >> 5;
    const int q0 = qc * 512;
    const size_t tokbase = (size_t)b * SEQ;
    const int g0 = w, g1 = 15 - w;
    const int qi0 = q0 + 32 * g0 + r32, qi1 = q0 + 32 * g1 + r32;
    const int tl0 = (q0 + 32 * g0 + 31) >> 6, tl1 = (q0 + 32 * g1 + 31) >> 6;
    const int ob0 = (q0 + 32 * g0) >> 8, ob1 = (q0 + 32 * g1) >> 8;
    bf16x8 qf0[NKS], qf1[NKS];
    { const bf16* p0 = Q + (tokbase + qi0) * qp + h * qhs + 8 * hi;
#pragma unroll
      for (int ks = 0; ks < NKS; ++ks) qf0[ks] = *(const bf16x8*)(p0 + 16 * ks); }
    float q2a = 0.f, q2b = 0.f;
    if (QPOST) { q2a = qpost<NKS, DK>(qf0, qgain, rope + (tokbase + qi0) * 48, hi); asm volatile("" ::: "memory"); }
    { const bf16* p1 = Q + (tokbase + qi1) * qp + h * qhs + 8 * hi;
#pragma unroll
      for (int ks = 0; ks < NKS; ++ks) qf1[ks] = *(const bf16x8*)(p1 + 16 * ks); }
    if (QPOST) { q2b = qpost<NKS, DK>(qf1, qgain, rope + (tokbase + qi1) * 48, hi); asm volatile("" ::: "memory"); }
    unsigned mk0 = 0u, mk1 = 0u, umask = 0xffffffffu;
    if (MOBA) {
        LAS float* kml = (LAS float*)(lds + L::UM + 16);
        { const float* kmg = kmean + (size_t)(b * 4 + h) * 16 * 128;
          for (int i = tid; i < 1024; i += NTHR) { const int n = i >> 6, d = i & 63; kml[i] = (kmg[n * 128 + d] + kmg[n * 128 + 64 + d]) * (1.0f / 256.0f); } }
        __syncthreads();
        const LAS float* km = kml + 8 * hi;
#pragma unroll
        for (int g = 0; g < 2; ++g) {
            float qv[8 * NKS];
#pragma unroll
            for (int ks = 0; ks < NKS; ++ks) unpack8(__builtin_bit_cast(v4u, g ? qf1[ks] : qf0[ks]), qv + 8 * ks);
            { float q2 = 0.f;
#pragma unroll
              for (int i = 0; i < 8 * NKS; ++i) q2 += qv[i] * qv[i];
              q2 = half_sum(q2); if (g) q2b = q2; else q2a = q2; }
            const int ob = g ? ob1 : ob0;
            float s0 = -INFINITY, s1 = -INFINITY, s2 = -INFINITY; int i0 = 0, i1 = 0, i2 = 0;
            for (int n = 0; n < ob; ++n) {
                const LAS float* kmp = km + n * 64; float sc = 0.f;
#pragma unroll
                for (int ks = 0; ks < NKS; ++ks) { const f32x4 ka = *(const LAS f32x4*)(kmp + 16 * ks), kb2 = *(const LAS f32x4*)(kmp + 16 * ks + 4);
                    sc += qv[8 * ks] * ka[0]; sc += qv[8 * ks + 1] * ka[1]; sc += qv[8 * ks + 2] * ka[2]; sc += qv[8 * ks + 3] * ka[3];
                    sc += qv[8 * ks + 4] * kb2[0]; sc += qv[8 * ks + 5] * kb2[1]; sc += qv[8 * ks + 6] * kb2[2]; sc += qv[8 * ks + 7] * kb2[3]; }
                sc = half_sum(sc);
                if (sc > s0) { s2 = s1; i2 = i1; s1 = s0; i1 = i0; s0 = sc; i0 = n; }
                else if (sc > s1) { s2 = s1; i2 = i1; s1 = sc; i1 = n; }
                else if (sc > s2) { s2 = sc; i2 = n; }
            }
            unsigned mk = 0u; if (ob > 0) mk |= 1u << i0; if (ob > 1) mk |= 1u << i1; if (ob > 2) mk |= 1u << i2;
            if (g) mk1 = mk; else mk0 = mk;
        }
        LAS unsigned* um = (LAS unsigned*)(lds + L::UM);
        if (tid == 0) *um = 0u;
        __syncthreads();
        __hip_atomic_fetch_or(um, mk0 | mk1, __ATOMIC_RELAXED, __HIP_MEMORY_SCOPE_WORKGROUP);
        __syncthreads();
        umask = *um;
    }
    const float k2m = __uint_as_float(__hip_atomic_load(kmx + b * 4 + h, __ATOMIC_RELAXED, __HIP_MEMORY_SCOPE_AGENT));
    const bool fast = __all(fmaxf(q2a, q2b) * k2m <= ATT_FAST_BOUND * ATT_FAST_BOUND);
    const int ntile = qc * 8 + 8;
    v4u vreg = {0u, 0u, 0u, 0u};
#define ATT_NEEDED(t) (!MOBA || ((t) >> 2) >= 2 * qc || ((umask >> ((t) >> 2)) & 1u))
#define ATT_LOADK(t, buf) do { const bf16* kt_ = K + (tokbase + (size_t)(t) * 64) * kp + h * khs; int ln_ = lane; asm volatile("" : "+v"(ln_)); \
        LAS unsigned char* kd_ = lds + ((buf) ? L::K1 : L::K0) + w * 1024; \
        __builtin_amdgcn_global_load_lds((const unsigned*)(kt_ + ln_ * kp + w * 8), (LAS unsigned*)kd_, 16, 0, 0); \
        if (DK == 96 && w < 4) __builtin_amdgcn_global_load_lds((const unsigned*)(kt_ + ln_ * kp + (8 + w) * 8), (LAS unsigned*)(kd_ + 8192), 16, 0, 0); } while (0)
#define ATT_LOADV(t) do { int t2_ = tid; asm volatile("" : "+v"(t2_)); const int vkey = t2_ >> 3, vch = t2_ & 7; \
        vreg = *(const v4u*)(V + (tokbase + (size_t)(t) * 64) * vp + (vkey * vp + h * vhs + vch * 8)); } while (0)
    unsigned krd_lane = (unsigned)(hi * 1024 + r32 * 16), vrd_lane = (unsigned)((r32 * L::VP + 4 * hi) * 2);
    asm volatile("" : "+v"(krd_lane), "+v"(vrd_lane));
#define ATT_STOREV(buf) do { int t2_ = tid; asm volatile("" : "+v"(t2_)); const int vkey = t2_ >> 3, vch = t2_ & 7; \
        LAS unsigned char* vtb_ = lds + ((buf) ? L::V1 : L::V0) + ((vch * 8) * L::VP + vkey) * 2; asm volatile("" : "+v"(vtb_)); LAS bf16* vt_ = (LAS bf16*)vtb_; \
        vt_[0 * L::VP] = (bf16)(vreg.x & 0xffffu); vt_[1 * L::VP] = (bf16)(vreg.x >> 16); vt_[2 * L::VP] = (bf16)(vreg.y & 0xffffu); vt_[3 * L::VP] = (bf16)(vreg.y >> 16); \
        vt_[4 * L::VP] = (bf16)(vreg.z & 0xffffu); vt_[5 * L::VP] = (bf16)(vreg.z >> 16); vt_[6 * L::VP] = (bf16)(vreg.w & 0xffffu); vt_[7 * L::VP] = (bf16)(vreg.w >> 16); } while (0)
    int t = 0; while (t < ntile && !ATT_NEEDED(t)) t += 4;
    ATT_LOADK(t, 0); ATT_LOADV(t); ATT_STOREV(0);
    asm volatile("s_waitcnt vmcnt(0)" ::: "memory");
    __syncthreads();
    f32x16 o0[2], o1[2];
#pragma unroll
    for (int dt = 0; dt < 2; ++dt)
#pragma unroll
        for (int r = 0; r < 16; ++r) { o0[dt][r] = 0.f; o1[dt][r] = 0.f; }
    float m0 = -INFINITY, m1 = -INFINITY, l0 = 0.f, l1 = 0.f;
    int cur = 0;
#define ATT_LOOP(FASTP) do { \
    while (t < ntile) { \
        int tn = t + 1; while (tn < ntile && (tn & 3) == 0 && !ATT_NEEDED(tn)) tn += 4; \
        if (tn < ntile) { ATT_LOADK(tn, cur ^ 1); ATT_LOADV(tn); }    \
        const int nblk = t >> 2; \
        bool a0 = (t <= tl0), a1 = (t <= tl1); \
        bool bl0 = false, bl1 = false; \
        if (MOBA) { \
            bl0 = (nblk != ob0) && !((mk0 >> nblk) & 1u); bl1 = (nblk != ob1) && !((mk1 >> nblk) & 1u); \
            a0 = a0 && __any(!bl0); a1 = a1 && __any(!bl1); \
        } \
        if (a0 || a1) { \
            const LAS unsigned char* kb = lds + (cur ? L::K1 : L::K0) + krd_lane; const LAS unsigned char* vb = lds + (cur ? L::V1 : L::V0) + vrd_lane; \
            asm volatile("" : "+v"(kb), "+v"(vb)); \
_Pragma("unroll") \
            for (int kt = 0; kt < 2; ++kt) { \
                f32x16 s0, s1; \
_Pragma("unroll") \
                for (int r = 0; r < 16; ++r) { s0[r] = 0.f; s1[r] = 0.f; } \
_Pragma("unroll") \
                for (int ks = 0; ks < NKS; ++ks) { \
                    const bf16x8 kf = *(const LAS bf16x8*)(kb + (2 * ks * 1024 + 32 * kt * 16)); \
                    if (a0) s0 = __builtin_amdgcn_mfma_f32_32x32x16_bf16(kf, qf0[ks], s0, 0, 0, 0); \
                    if (a1) s1 = __builtin_amdgcn_mfma_f32_32x32x16_bf16(kf, qf1[ks], s1, 0, 0, 0); \
                } \
                bf16x8 p0[2], p1[2]; \
                const int kbase = 64 * t + 32 * kt + 4 * hi; \
                if (a0) { if (FASTP) softmax_fast(s0, l0, p0, t == tl0, bl0, qi0, kbase); else softmax_group(s0, o0, m0, l0, p0, t == tl0, bl0, qi0, kbase); } \
                __builtin_amdgcn_sched_barrier(0);    \
                if (a1) { if (FASTP) softmax_fast(s1, l1, p1, t == tl1, bl1, qi1, kbase); else softmax_group(s1, o1, m1, l1, p1, t == tl1, bl1, qi1, kbase); } \
                __builtin_amdgcn_sched_barrier(0); \
_Pragma("unroll") \
                for (int st = 0; st < 2; ++st) \
_Pragma("unroll") \
                    for (int dt = 0; dt < 2; ++dt) { \
                        typedef unsigned u32x2v __attribute__((ext_vector_type(2))); \
                        const LAS unsigned char* vp_ = vb + (32 * dt * L::VP + 32 * kt + 16 * st) * 2; \
                        const u32x2v va = *(const LAS u32x2v*)vp_, vc = *(const LAS u32x2v*)(vp_ + 16); \
                        const v4u vv = {va.x, va.y, vc.x, vc.y}; const bf16x8 vf = __builtin_bit_cast(bf16x8, vv); \
                        if (a0) o0[dt] = __builtin_amdgcn_mfma_f32_32x32x16_bf16(vf, p0[st], o0[dt], 0, 0, 0); \
                        if (a1) o1[dt] = __builtin_amdgcn_mfma_f32_32x32x16_bf16(vf, p1[st], o1[dt], 0, 0, 0); \
                    } \
            } \
        } \
        if (tn < ntile) ATT_STOREV(cur ^ 1); \
        asm volatile("s_waitcnt vmcnt(0)" ::: "memory"); \
        __syncthreads(); \
        t = tn; cur ^= 1; \
    } \
    } while (0)
    if (fast) ATT_LOOP(true); else ATT_LOOP(false);
#undef ATT_LOOP
#undef ATT_NEEDED
#undef ATT_LOADK
#undef ATT_LOADV
#undef ATT_STOREV
    {
        typedef unsigned u32x2v __attribute__((ext_vector_type(2)));
        const float i0 = 1.0f / half_sum(l0), i1 = 1.0f / half_sum(l1);
        bf16* d0 = O + (tokbase + qi0) * op + h * 64 + 4 * hi; bf16* d1 = O + (tokbase + qi1) * op + h * 64 + 4 * hi;
#pragma unroll
        for (int dt = 0; dt < 2; ++dt)
#pragma unroll
            for (int j = 0; j < 4; ++j) {
                u32x2v wa; wa.x = pkbf(o0[dt][4 * j] * i0, o0[dt][4 * j + 1] * i0); wa.y = pkbf(o0[dt][4 * j + 2] * i0, o0[dt][4 * j + 3] * i0); *(u32x2v*)(d0 + 32 * dt + 8 * j) = wa;
                u32x2v wb; wb.x = pkbf(o1[dt][4 * j] * i1, o1[dt][4 * j + 1] * i1); wb.y = pkbf(o1[dt][4 * j + 2] * i1, o1[dt][4 * j + 3] * i1); *(u32x2v*)(d1 + 32 * dt + 8 * j) = wb;
            }
    }
}
struct Args { const void* in[31]; float* out; unsigned char* ws; int ph_lo, ph_hi; };
constexpr int N_PHASES = 1 + 8 + 11 + 8 + 11;
typedef const __attribute__((address_space(4))) Args* KArgs;
__device__ __forceinline__ KArgs kargs() { KArgs p = (KArgs)__builtin_amdgcn_kernarg_segment_ptr(); asm volatile("" : "+s"(p)); return p; }
#define IN_F(i) ((const float*)A->in[i])
#define WSP(type, off) ((type*)(ws + (off)))
#ifndef TPROBE
#define TPROBE 0
#endif
#define TP_BID 203
#define TP_ACC(lds) ((LAS unsigned long long*)((lds) + MISC_OFF + 64))
#define TP_BEGIN(id) unsigned long long tp0_##id = 0ull; if (TPROBE == (id)) { __syncthreads(); tp0_##id = __builtin_amdgcn_s_memrealtime(); }
#define TP_END(id, lds) if (TPROBE == (id)) { __syncthreads(); if (blockIdx.x == TP_BID && threadIdx.x == 0) *TP_ACC(lds) += __builtin_amdgcn_s_memrealtime() - tp0_##id; }
struct Ctx { int tid, lane, wave, G, bid, gw, NGW, gt, NGT; };
__device__ __forceinline__ Ctx mkctx(int wv) {
    Ctx c; unsigned m = ~0u; asm volatile("" : "+s"(m)); const int ln = (int)__builtin_amdgcn_mbcnt_hi(m, __builtin_amdgcn_mbcnt_lo(m, 0u));
    int b = blockIdx.x; asm volatile("" : "+s"(b)); int w = wv; asm volatile("" : "+s"(w));
    c.tid = w * 64 + ln; c.lane = ln; c.wave = w; c.G = gridDim.x; c.bid = b;
    c.gw = c.bid * NWAVES + c.wave; c.NGW = c.G * NWAVES; c.gt = c.bid * NTHR + c.tid; c.NGT = c.G * NTHR; return c; }

__device__ __forceinline__ void conv_mixer_weights(int wv, LAS unsigned char* lds, int l) {
    const Ctx c = mkctx(wv);
    KArgs A = kargs(); unsigned char* ws = A->ws;
    const int lane = c.lane, gw = c.gw, NGW = c.NGW, gt = c.gt, NGT = c.NGT;
    LAS float* scr = (LAS float*)(lds + RING_OFF + c.wave * 16384); LAS TrDesc* tab = (LAS TrDesc*)(lds + RING_OFF + TR_TAB_OFF); asm volatile("" : "+v"(tab));
    bf16* WINR = WSP(bf16, W_INR); bf16* WUQ = WSP(bf16, W_UQ); bf16* WUKV = WSP(bf16, W_UKV);
    int total = 0;
    if (c.tid == 0) {
        int n = 0, cum = 0;
        const float* an = IN_F(2) + l * DM; const float* win = IN_F(4) + (size_t)l * DM * IN_COLS;
        tr_add(tab, n, cum, win, IN_COLS, DM, 4096, 0, WSP(bf16, W_G), DM, 0, 3, an);
        tr_add(tab, n, cum, win, IN_COLS, DM, 1280, 4096, WINR, DM, 0, 0, an);
        tr_add(tab, n, cum, win, IN_COLS, DM, 512, 5728, WINR, DM, 1280, 0, an);
        tr_add(tab, n, cum, win, IN_COLS, DM, 352, 5376, WINR, DM, 1792, 0, an);
        tr_add(tab, n, cum, IN_F(13) + (size_t)l * 192 * 384, 384, 192, 384, 0, WUQ, 256, 0, 0, IN_F(11) + l * 192);
        tr_add(tab, n, cum, IN_F(14) + (size_t)l * 128 * 512, 512, 128, 512, 0, WUKV, 256, 0, 2, IN_F(12) + l * 128);
        for (int nb = 0; nb < 4; ++nb) tr_add(tab, n, cum, IN_F(21) + ((size_t)l * 4 + nb) * 256 * DM, DM, 256, DM, 0, WSP(bf16, W_B), 256, nb * 1024, 0, nullptr);
        tr_add(tab, n, cum, IN_F(22) + (size_t)l * DM * DM, DM, DM, DM, 0, WSP(bf16, W_OUT), DM, 0, 0, nullptr);
        tab[n].cum = cum; tab[31].cum = cum;
    }
    __syncthreads();
    total = tab[31].cum;
    tr_run(tab, total, scr, lane, gw, NGW);
    unsigned zz = 0u; asm volatile("" : "+v"(zz)); const v4u z4 = {zz, zz, zz, zz};
    for (int i = gt; i < 160 * DM / 8; i += NGT) ((v4u*)(WINR + (size_t)2144 * DM))[i] = z4;
    for (int i = gt; i < 128 * 256 / 8; i += NGT) ((v4u*)(WUQ + (size_t)384 * 256))[i] = z4;
    for (int i = gt; i < 384 * 8; i += NGT) ((v4u*)(WUQ + (size_t)(i >> 3) * 256 + 192))[i & 7] = z4;
    for (int i = gt; i < 512 * 16; i += NGT) ((v4u*)(WUKV + (size_t)(i >> 4) * 256 + 128))[i & 15] = z4;
    {
        const float* wsrc = IN_F(7) + (size_t)l * 4 * 128 * 128; bf16* wm = WSP(bf16, MS_WSGU);
        for (int i = gt; i < 4 * 128 * 128 / 8; i += NGT) {
            const int t = (i >> 4) & 127, s0 = (i & 15) * 8; const f32x4 a = *(const f32x4*)(wsrc + (size_t)i * 8), b = *(const f32x4*)(wsrc + (size_t)i * 8 + 4);
            float f[8] = {a[0], a[1], a[2], a[3], b[0], b[1], b[2], b[3]};
#pragma unroll
            for (int j = 0; j < 8; ++j) f[j] = (s0 + j <= t) ? f[j] : 0.f;
            *(v4u*)(wm + (size_t)i * 8) = pack8(f);
        }
    }
    __syncthreads();
}
__device__ __forceinline__ void conv_ffn_weights(int wv, LAS unsigned char* lds, int l) {
    const Ctx c = mkctx(wv);
    KArgs A = kargs(); unsigned char* ws = A->ws;
    LAS float* scr = (LAS float*)(lds + RING_OFF + c.wave * 16384); LAS TrDesc* tab = (LAS TrDesc*)(lds + RING_OFF + TR_TAB_OFF); asm volatile("" : "+v"(tab));
    if (c.tid == 0) {
        int n = 0, cum = 0; const bool moe = (l & 1) != 0; const int li = l >> 1; const float* fn = IN_F(3) + l * DM;
        if (!moe) {
            tr_add(tab, n, cum, IN_F(23) + (size_t)li * DM * FFN, FFN, DM, FFN, 0, WSP(bf16, W_F1), DM, 0, 1, fn);
            tr_add(tab, n, cum, IN_F(24) + (size_t)li * DM * FFN, FFN, DM, FFN, 0, WSP(bf16, W_F1), DM, 128, 1, fn);
            tr_add(tab, n, cum, IN_F(25) + (size_t)li * FFN * DM, DM, FFN, DM, 0, WSP(bf16, W_F2), FFN, 0, 0, nullptr);
        } else {
            for (int e = 0; e < NE; ++e) {
                tr_add(tab, n, cum, IN_F(28) + ((size_t)li * NE + e) * DM * EDIM, EDIM, DM, EDIM, 0, WSP(bf16, W_F1), DM, e * 2 * EDIM, 1, fn);
                tr_add(tab, n, cum, IN_F(29) + ((size_t)li * NE + e) * DM * EDIM, EDIM, DM, EDIM, 0, WSP(bf16, W_F1), DM, e * 2 * EDIM + 128, 1, fn);
                tr_add(tab, n, cum, IN_F(30) + ((size_t)li * NE + e) * EDIM * DM, DM, EDIM, DM, 0, WSP(bf16, W_F2), EDIM, e * DM, 0, nullptr);
            }
        }
        tab[n].cum = cum; tab[31].cum = cum;
    }
    __syncthreads();
    tr_run(tab, tab[31].cum, scr, c.lane, c.gw, c.NGW);
    __syncthreads();
}
__device__ __forceinline__ void ph_prologue(int wv, LAS unsigned char* lds) {
    conv_mixer_weights(wv, lds, 0);
    const Ctx c = mkctx(wv);
    KArgs A = kargs(); unsigned char* ws = A->ws;
    const int lane = c.lane, gw = c.gw, NGW = c.NGW, gt = c.gt, NGT = c.NGT;
    {
        const float* x_in = IN_F(0); const int* positions = (const int*)A->in[1];
        bf16* XB = WSP(bf16, WS_XB); float* SSA = WSP(float, WS_SSA); float* ROPE = WSP(float, WS_ROPE);
        for (int mrow = gw; mrow < T; mrow += NGW) {
            const f32x4* xr = (const f32x4*)(x_in + (size_t)mrow * DM) + lane; float s = 0.f;
            typedef unsigned u32x2v __attribute__((ext_vector_type(2)));
            u32x2v* o8 = (u32x2v*)(XB + (size_t)mrow * DM) + lane;
#pragma unroll
            for (int j = 0; j < 4; ++j) { const f32x4 v = xr[64 * j]; s += (v[0] * v[0] + v[1] * v[1]) + (v[2] * v[2] + v[3] * v[3]); u32x2v w; w.x = pkbf(v[0], v[1]); w.y = pkbf(v[2], v[3]); o8[64 * j] = w; }
            s = wave_sum(s);
            if (lane < 4) SSA[(size_t)mrow * 4 + lane] = (lane == 0) ? s : 0.f;
        }
        for (int i = gt; i < T * 24; i += NGT) {
            const int tok = i / 24, a = i - tok * 24;
            const float inv = (a < 8) ? powf(500000.0f, -(float)a * 0.125f) : powf(500000.0f, -(float)(a - 8) * 0.0625f);
            const float ang = (float)positions[tok] * inv; float sn, cs; sincosf(ang, &sn, &cs);
            ROPE[(size_t)tok * 48 + 2 * a] = cs; ROPE[(size_t)tok * 48 + 2 * a + 1] = sn;
        }
    }
}
__device__ __forceinline__ void ph_inproj(int wv, LAS unsigned char* lds) {
    const Ctx c = mkctx(wv);
    KArgs A = kargs(); unsigned char* ws = A->ws;
    pg8::Gemm g{WSP(bf16, WS_XB), WSP(bf16, W_INR), DM, DM, DM}; pg8::StaticOrder S; S.init(T, PJ_LD, c.G, c.bid);
    pg8::EpiScale<0> E{WSP(bf16, B_PROJ), PJ_LD, pg8::RowScale{WSP(float, WS_SSA), 1}, WSP(float, WS_SSC)};
    pg8::gemm_phase<pg8::EpiScale<0>, pg8::StaticOrder, true, true>(lds + RING_OFF, g, S, E, c.tid);
}
__device__ __forceinline__ void mla_up_gemms(int wv, LAS unsigned char* lds, int l) {
    const Ctx c = mkctx(wv);
    { KArgs A = kargs(); unsigned char* ws = A->ws;
      pg8::Gemm g{WSP(bf16, B_PROJ) + PJ_CQ, WSP(bf16, W_UQ), PJ_LD, 256, 256}; pg8::StaticOrder S; S.init(T, 512, c.G, c.bid);
      pg8::EpiScale<0> E{WSP(bf16, B_QPRE), 512, pg8::RowScale{WSP(float, WS_SSC), 3}, nullptr};
      pg8::gemm_phase<pg8::EpiScale<0>, pg8::StaticOrder, true, true>(lds + RING_OFF, g, S, E, c.tid); }
    { KArgs A = kargs(); unsigned char* ws = A->ws;
      pg8::Gemm g{WSP(bf16, B_PROJ) + PJ_CKV, WSP(bf16, W_UKV), PJ_LD, 256, 256}; pg8::StaticOrder S; S.init(T, 512, c.G, c.bid);
      pg8::EpiKV E{WSP(bf16, B_CK), WSP(bf16, B_KVPRE), WSP(bf16, B_PROJ), WSP(float, WS_SSC), WSP(float, WS_ROPE), IN_F(16) + l * 96, (unsigned*)(ws + WS_CTL) + CW_KMX + (l * 2 + 1) * 32};
      pg8::gemm_phase<pg8::EpiKV, pg8::StaticOrder, true, true>(lds + RING_OFF, g, S, E, c.tid); }
}
__device__ __forceinline__ void ph_prep(int wv, LAS unsigned char* lds, int l) {
    TP_BEGIN(4) mla_up_gemms(wv, lds, l); TP_END(4, lds)
    {
        const Ctx c = mkctx(wv);
        KArgs A = kargs(); unsigned char* ws = A->ws;
        bf16* PROJ = WSP(bf16, B_PROJ); bf16* OB = WSP(bf16, B_O);
        TP_BEGIN(5) for (int it = c.bid; it < NB * 32; it += c.G) prep_block(lds + RING_OFF, PROJ, WSP(float, WS_ROPE), IN_F(9) + l * 64, IN_F(10) + l * 64, WSP(float, MS_KMEAN), (unsigned*)(ws + WS_CTL) + CW_KMX + (l * 2 + 0) * 32, it, c.tid); TP_END(5, lds)
        TP_BEGIN(6) for (int u = c.bid; u < T / 128; u += c.G) sgu_unit(lds + RING_OFF, PROJ, OB, IN_F(5) + l * 256, IN_F(6) + l * 256, WSP(bf16, MS_WSGU), IN_F(8) + l * 4 * 128, u, c.tid); TP_END(6, lds)
        TP_BEGIN(7) for (int u = c.bid; u < T / 64; u += c.G) conv_unit(lds + RING_OFF, PROJ, OB, IN_F(17) + (size_t)l * 31 * 256, IN_F(18) + l * 256, IN_F(19) + l * 256, IN_F(20) + l * 256, u, c.tid); TP_END(7, lds)
        __syncthreads();
    }
    TP_BEGIN(8) conv_ffn_weights(wv, lds, l); TP_END(8, lds)
}
template <int WHICH>
__device__ __forceinline__ void mla_post_pass(const Ctx& c, int l) {
    KArgs A = kargs(); unsigned char* ws = A->ws;
    const float* gn = IN_F(WHICH ? 16 : 15) + l * 96;
    const bf16* PROJ = WSP(bf16, B_PROJ); const bf16* QPRE = WSP(bf16, B_QPRE); const bf16* KVPRE = WSP(bf16, B_KVPRE);
    bf16* DST = WHICH ? WSP(bf16, B_CK) : WSP(bf16, B_CQ); const float* ROPE = WSP(float, WS_ROPE);
    for (int idx = c.gt; idx < T * 4; idx += c.NGT) {
        const int tok = idx >> 2, h = idx & 3; const float* tab = ROPE + (size_t)tok * 48 + 16;
        float v[96]; float ss = 0.f;
        if (WHICH == 0) {
#pragma unroll
            for (int cc = 0; cc < 12; ++cc) unpack8(((const v4u*)(QPRE + (size_t)tok * 512 + h * 96))[cc], v + 8 * cc);
        } else {
#pragma unroll
            for (int cc = 0; cc < 8; ++cc) unpack8(((const v4u*)(KVPRE + (size_t)tok * 512 + h * 128))[cc], v + 8 * cc);
#pragma unroll
            for (int cc = 0; cc < 4; ++cc) unpack8(((const v4u*)(PROJ + (size_t)tok * PJ_LD + PJ_KR))[cc], v + 64 + 8 * cc);
        }
#pragma unroll
        for (int d = 0; d < 96; ++d) ss += v[d] * v[d];
        const float rstd = rsqrtf(ss * (1.0f / 96.0f) + EPS);
#pragma unroll
        for (int d = 0; d < 96; ++d) v[d] = v[d] * rstd * gn[d];
#pragma unroll
        for (int i = 0; i < 16; ++i) { const float cs = tab[2 * i], sn = tab[2 * i + 1], x1 = v[64 + i], x2 = v[80 + i]; v[64 + i] = x1 * cs - x2 * sn; v[80 + i] = x2 * cs + x1 * sn; }
        if (WHICH == 0) {
#pragma unroll
            for (int d = 0; d < 96; ++d) v[d] *= QS_C;
        }
        bf16* dst = DST + (size_t)tok * 384 + h * 96;
#pragma unroll
        for (int cc = 0; cc < 12; ++cc) ((v4u*)dst)[cc] = pack8(v + 8 * cc);
    }
}
__device__ __forceinline__ void ph_mla_post(int wv, int l) {
    { const Ctx c = mkctx(wv); mla_post_pass<0>(c, l); }
    { const Ctx c = mkctx(wv); mla_post_pass<1>(c, l); }
}
__device__ __forceinline__ void ph_attn(int wv, LAS unsigned char* lds, int l) {
    const Ctx c = mkctx(wv);
    for (int u = c.bid; u < NB * 4 * 8; u += c.G) {
        const int qc = u & 7, h = (u >> 3) & 3, b = u >> 5;
        TP_BEGIN(1) { KArgs A = kargs(); unsigned char* ws = A->ws;
          attn_unit<96, false, true, 512, 96, 384, 96, 256, 64, DM>(lds + RING_OFF, WSP(bf16, B_QPRE), WSP(bf16, B_CK), WSP(bf16, B_KVPRE), WSP(bf16, B_O) + 512, b, h, qc, nullptr, IN_F(15) + l * 96, WSP(float, WS_ROPE), (const unsigned*)(ws + WS_CTL) + CW_KMX + (l * 2 + 1) * 32, c.tid); } TP_END(1, lds)
        TP_BEGIN(2) { KArgs A = kargs(); unsigned char* ws = A->ws; bf16* PROJ = WSP(bf16, B_PROJ);
          attn_unit<64, true, false, PJ_LD, 64, PJ_LD, 64, PJ_LD, 64, DM>(lds + RING_OFF, PROJ + PJ_BQ, PROJ + PJ_BK, PROJ + PJ_BV, WSP(bf16, B_O) + 256, b, h, 7 - qc, WSP(float, MS_KMEAN), nullptr, nullptr, (const unsigned*)(ws + WS_CTL) + CW_KMX + (l * 2 + 0) * 32, c.tid); } TP_END(2, lds)
    }
}
__device__ __forceinline__ void ph_gates(int wv, LAS unsigned char* lds) {
    const Ctx c = mkctx(wv);
    KArgs A = kargs(); unsigned char* ws = A->ws;
    pg8::Gemm g{WSP(bf16, WS_XB), WSP(bf16, W_G), DM, DM, DM}; pg8::StaticOrder S; S.init(T, 4096, c.G, c.bid);
    pg8::EpiGates E{WSP(bf16, B_SG), pg8::RowScale{WSP(float, WS_SSA), 1}};
    pg8::gemm_phase<pg8::EpiGates, pg8::StaticOrder, true, true>(lds + RING_OFF, g, S, E, c.tid);
}
__device__ __forceinline__ void ph_merge(int wv, LAS unsigned char* lds) {
    const Ctx c = mkctx(wv);
    KArgs A = kargs(); unsigned char* ws = A->ws;
    pg8::Gemm g{WSP(bf16, B_O), WSP(bf16, W_B), DM, 256, 256}; pg8::MergeOrder S; S.so.init(T, DM, c.G, c.bid);
    pg8::EpiMerge E{WSP(bf16, B_SG), WSP(bf16, B_Y)};
    pg8::gemm_phase<pg8::EpiMerge, pg8::MergeOrder, true, true>(lds + RING_OFF, g, S, E, c.tid);
}
__device__ __forceinline__ void ph_wout(int wv, LAS unsigned char* lds, int l) {
    const Ctx c = mkctx(wv);
    KArgs A = kargs(); unsigned char* ws = A->ws;
    pg8::Gemm g{WSP(bf16, B_Y), WSP(bf16, W_OUT), DM, DM, DM}; pg8::StaticOrder S; S.init(T, DM, c.G, c.bid);
    pg8::EpiResidual E{l == 0 ? IN_F(0) : (const float*)A->out, A->out, WSP(bf16, WS_XB), WSP(float, WS_SSB), (LAS float*)(lds + EPI_RED_OFF)};
    pg8::gemm_phase<pg8::EpiResidual, pg8::StaticOrder, true, true>(lds + RING_OFF, g, S, E, c.tid);
}
__device__ __forceinline__ void ph_ffn_up(int wv, LAS unsigned char* lds) {
    const Ctx c = mkctx(wv);
    KArgs A = kargs(); unsigned char* ws = A->ws;
    pg8::Gemm g{WSP(bf16, WS_XB), WSP(bf16, W_F1), DM, DM, DM}; pg8::StaticOrder S; S.init(T, 2 * FFN, c.G, c.bid);
    pg8::EpiScale<2> E{WSP(bf16, B_HID), FFN, pg8::RowScale{WSP(float, WS_SSB), 1}, nullptr};
    pg8::gemm_phase<pg8::EpiScale<2>, pg8::StaticOrder, true, true>(lds + RING_OFF, g, S, E, c.tid);
}
__device__ __forceinline__ void ph_ffn_down(int wv, LAS unsigned char* lds, int l) {
    const Ctx c = mkctx(wv);
    KArgs A = kargs(); unsigned char* ws = A->ws;
    pg8::Gemm g{WSP(bf16, B_HID), WSP(bf16, W_F2), FFN, FFN, FFN}; pg8::StaticOrder S; S.init(T, DM, c.G, c.bid);
    pg8::EpiResidual E{A->out, A->out, WSP(bf16, WS_XB), WSP(float, WS_SSA), (LAS float*)(lds + EPI_RED_OFF)};
    pg8::gemm_phase<pg8::EpiResidual, pg8::StaticOrder, true, true>(lds + RING_OFF, g, S, E, c.tid);
    TP_BEGIN(9) if (l < DEPTH - 1) conv_mixer_weights(wv, lds, l + 1); TP_END(9, lds)
}
__device__ __forceinline__ int wave_sum_i(int v) {
    v += __builtin_amdgcn_ds_swizzle(v, (1 << 10) | 0x1f); v += __builtin_amdgcn_ds_swizzle(v, (2 << 10) | 0x1f); v += __builtin_amdgcn_ds_swizzle(v, (4 << 10) | 0x1f);
    v += __builtin_amdgcn_ds_swizzle(v, (8 << 10) | 0x1f); v += __builtin_amdgcn_ds_swizzle(v, (16 << 10) | 0x1f);
    auto rr = __builtin_amdgcn_permlane32_swap((unsigned)v, (unsigned)v, false, false); return (int)rr[0] + (int)rr[1];
}
__device__ __forceinline__ void ph_router(int wv, LAS unsigned char* lds, int l) {
    const Ctx c = mkctx(wv);
    KArgs A = kargs(); unsigned char* ws = A->ws; const int li = l >> 1; const int lane = c.lane;
    const float* fn = IN_F(3) + l * DM; const float* wr_ = IN_F(26) + (size_t)li * DM * NE; const float* rb = IN_F(27) + li * NE;
    const float* xout = A->out; const float* SSB = WSP(float, WS_SSB); int* TOKE = WSP(int, MS_TOKE); float* TOKW = WSP(float, MS_TOKW);
    int* WCNT = WSP(int, MS_WCNT); int* WGCNT = WSP(int, MS_WGCNT);
    int cnt[8];
#pragma unroll
    for (int e = 0; e < 8; ++e) cnt[e] = 0;
    float wq[16][8];
#pragma unroll
    for (int j = 0; j < 4; ++j) { const int k0 = (64 * j + lane) * 4; const f32x4 gv = *(const f32x4*)(fn + k0);
#pragma unroll
        for (int q = 0; q < 4; ++q) { const f32x4 w0 = *(const f32x4*)(wr_ + (size_t)(k0 + q) * 8), w1 = *(const f32x4*)(wr_ + (size_t)(k0 + q) * 8 + 4);
#pragma unroll
            for (int e = 0; e < 4; ++e) { wq[4 * j + q][e] = gv[q] * w0[e]; wq[4 * j + q][4 + e] = gv[q] * w1[e]; } } }
    float rbv[8];
#pragma unroll
    for (int e = 0; e < 8; ++e) rbv[e] = rb[e];
    for (int tok0 = c.gw; tok0 < T; tok0 += 2 * c.NGW) {
        f32x4 sp[2], xv[2][4]; bool ok[2];
#pragma unroll
        for (int u = 0; u < 2; ++u) { const int tok = tok0 + u * c.NGW; ok[u] = tok < T; const int tk = ok[u] ? tok : tok0;
            sp[u] = *(const f32x4*)(SSB + (size_t)tk * 4);
#pragma unroll
            for (int j = 0; j < 4; ++j) xv[u][j] = *(const f32x4*)(xout + (size_t)tk * DM + (64 * j + lane) * 4); }
        float pl[2][8];
#pragma unroll
        for (int u = 0; u < 2; ++u) { const float rstd = rsqrtf(((sp[u][0] + sp[u][1]) + (sp[u][2] + sp[u][3])) * (1.0f / 1024.0f) + EPS);
#pragma unroll
            for (int e = 0; e < 8; ++e) pl[u][e] = 0.f;
#pragma unroll
            for (int j = 0; j < 4; ++j)
#pragma unroll
                for (int q = 0; q < 4; ++q) { const float hv = xv[u][j][q] * rstd;
#pragma unroll
                    for (int e = 0; e < 8; ++e) pl[u][e] += hv * wq[4 * j + q][e]; } }
#pragma unroll
        for (int e = 0; e < 8; ++e) { pl[0][e] = wave_sum(pl[0][e]) + rbv[e]; pl[1][e] = wave_sum(pl[1][e]) + rbv[e]; }
#pragma unroll
        for (int u = 0; u < 2; ++u) {
            int e0 = 0; float l0 = pl[u][0];
#pragma unroll
            for (int e = 1; e < 8; ++e) if (pl[u][e] > l0) { l0 = pl[u][e]; e0 = e; }
            int e1 = -1; float l1 = -INFINITY;
#pragma unroll
            for (int e = 0; e < 8; ++e) if (e != e0 && pl[u][e] > l1) { l1 = pl[u][e]; e1 = e; }
            const float tt = expf(l1 - l0); const float w0 = 1.0f / (1.0f + tt), w1 = tt / (1.0f + tt);
            if (ok[u]) {
#pragma unroll
                for (int e = 0; e < 8; ++e) cnt[e] += (e == e0 ? 1 : 0) + (e == e1 ? 1 : 0);
                const int tok = tok0 + u * c.NGW;
                if (lane == 0) { TOKE[tok * 2] = e0; TOKE[tok * 2 + 1] = e1; TOKW[tok * 2] = w0; TOKW[tok * 2 + 1] = w1; }
            }
        }
    }
    LAS int* red = (LAS int*)(lds + RING_OFF);
    int mine = 0;
#pragma unroll
    for (int e = 0; e < 8; ++e) mine = (lane == e) ? cnt[e] : mine;
    if (lane < 8) { WCNT[c.gw * 8 + lane] = mine; red[c.wave * 8 + lane] = mine; }
    __syncthreads();
    if (c.tid < 8) { int s = 0;
#pragma unroll
        for (int w = 0; w < NWAVES; ++w) s += red[w * 8 + c.tid];
        WGCNT[c.bid * 8 + c.tid] = s; }
    __syncthreads();
}
__device__ __forceinline__ void ph_assign(int wv, LAS unsigned char* lds, int l) {
    const Ctx c = mkctx(wv);
    KArgs A = kargs(); unsigned char* ws = A->ws; const int lane = c.lane;
    const float* SSB = WSP(float, WS_SSB); const int* TOKE = WSP(int, MS_TOKE); int* TOKS = WSP(int, MS_TOKS); float* RSSLOT = WSP(float, MS_RSSLOT);
    const int* WCNT = WSP(int, MS_WCNT); const int* WGCNT = WSP(int, MS_WGCNT); int* MTOT = WSP(int, MS_MTOT);
    const bf16* XB = WSP(bf16, WS_XB); bf16* XS = WSP(bf16, B_XS);
    int tot[8], bas[8];
#pragma unroll
    for (int e = 0; e < 8; ++e) { tot[e] = 0; bas[e] = 0; }
    for (int t = c.tid; t < c.G; t += NTHR) {
        typedef int i32x4 __attribute__((ext_vector_type(4)));
        const i32x4 a = *(const i32x4*)(WGCNT + t * 8), b = *(const i32x4*)(WGCNT + t * 8 + 4); const int lt = (t < c.bid) ? 1 : 0;
        tot[0] += a[0]; tot[1] += a[1]; tot[2] += a[2]; tot[3] += a[3]; tot[4] += b[0]; tot[5] += b[1]; tot[6] += b[2]; tot[7] += b[3];
        bas[0] += lt * a[0]; bas[1] += lt * a[1]; bas[2] += lt * a[2]; bas[3] += lt * a[3]; bas[4] += lt * b[0]; bas[5] += lt * b[1]; bas[6] += lt * b[2]; bas[7] += lt * b[3];
    }
    LAS int* red = (LAS int*)(lds + RING_OFF);
#pragma unroll
    for (int e = 0; e < 8; ++e) { tot[e] = wave_sum_i(tot[e]); bas[e] = wave_sum_i(bas[e]); }
    if (lane == 0) {
#pragma unroll
        for (int e = 0; e < 8; ++e) { red[c.wave * 16 + e] = tot[e]; red[c.wave * 16 + 8 + e] = bas[e]; } }
    __syncthreads();
#pragma unroll
    for (int e = 0; e < 8; ++e) { int st = 0, sb = 0;
#pragma unroll
        for (int w = 0; w < NWAVES; ++w) { st += red[w * 16 + e]; sb += red[w * 16 + 8 + e]; }
        tot[e] = st; bas[e] = sb; }
    int run[8]; { int acc = 0;
#pragma unroll
        for (int e = 0; e < 8; ++e) { run[e] = acc * 256 + bas[e]; acc += (tot[e] + 255) >> 8; } }
    if (c.bid == 0 && c.tid < 8) { int v = 0;
#pragma unroll
        for (int e = 0; e < 8; ++e) v = (c.tid == e) ? tot[e] : v;
        MTOT[c.tid] = v; }
    for (int w = 0; w < c.wave; ++w) {
        typedef int i32x4 __attribute__((ext_vector_type(4)));
        const i32x4 a = *(const i32x4*)(WCNT + (c.bid * NWAVES + w) * 8), b = *(const i32x4*)(WCNT + (c.bid * NWAVES + w) * 8 + 4);
        run[0] += a[0]; run[1] += a[1]; run[2] += a[2]; run[3] += a[3]; run[4] += b[0]; run[5] += b[1]; run[6] += b[2]; run[7] += b[3];
    }
    for (int tok0 = c.gw; tok0 < T; tok0 += 4 * c.NGW) {
        f32x4 sp[4]; int ee[4][2]; v4u ra[4], rb2[4]; bool ok[4];
#pragma unroll
        for (int u = 0; u < 4; ++u) { const int tok = tok0 + u * c.NGW; ok[u] = tok < T; const int tk = ok[u] ? tok : tok0;
            sp[u] = *(const f32x4*)(SSB + (size_t)tk * 4); ee[u][0] = TOKE[tk * 2]; ee[u][1] = TOKE[tk * 2 + 1];
            const v4u* src = (const v4u*)(XB + (size_t)tk * DM) + lane; ra[u] = src[0]; rb2[u] = src[64]; }
#pragma unroll
        for (int u = 0; u < 4; ++u) if (ok[u]) {
            const int tok = tok0 + u * c.NGW;
            const float rstd = rsqrtf(((sp[u][0] + sp[u][1]) + (sp[u][2] + sp[u][3])) * (1.0f / 1024.0f) + EPS);
            int s0 = 0, s1 = 0;
#pragma unroll
            for (int e = 0; e < 8; ++e) { if (e == ee[u][0]) { s0 = run[e]; run[e] += 1; } }
#pragma unroll
            for (int e = 0; e < 8; ++e) { if (e == ee[u][1]) { s1 = run[e]; run[e] += 1; } }
            if (lane == 0) { TOKS[tok * 2] = s0; TOKS[tok * 2 + 1] = s1; RSSLOT[s0] = rstd; RSSLOT[s1] = rstd; }
            v4u* d0 = (v4u*)(XS + (size_t)s0 * DM) + lane; v4u* d1 = (v4u*)(XS + (size_t)s1 * DM) + lane;
            d0[0] = ra[u]; d0[64] = rb2[u]; d1[0] = ra[u]; d1[64] = rb2[u];
        }
    }
    __syncthreads();
}
__device__ __forceinline__ void moe_panels(const int* mtot, int (&ps)[9]) { int acc = 0;
#pragma unroll
    for (int e = 0; e < 8; ++e) { ps[e] = acc; const int cn = __hip_atomic_load(mtot + e, RLX_AGENT); acc += (cn + 255) >> 8; } ps[8] = acc; }
__device__ __forceinline__ void ph_moe_up(int wv, LAS unsigned char* lds, int l) {
    const Ctx c = mkctx(wv);
    KArgs A = kargs(); unsigned char* ws = A->ws;
    pg8::MoeOrder S; S.nN = 11; moe_panels(WSP(int, MS_MTOT), S.ps);
    S.so.init(S.ps[8] * 256, 2 * EDIM, c.G, c.bid);
    pg8::Gemm g{WSP(bf16, B_XS), WSP(bf16, W_F1), DM, DM, DM};
    pg8::EpiScale<2> E{WSP(bf16, B_HIDM), EDIM, pg8::RowScale{WSP(float, MS_RSSLOT), 2}, nullptr};
    pg8::gemm_phase<pg8::EpiScale<2>, pg8::MoeOrder, true, true>(lds + RING_OFF, g, S, E, c.tid);
}
__device__ __forceinline__ void ph_moe_down(int wv, LAS unsigned char* lds, int l) {
    const Ctx c = mkctx(wv);
    KArgs A = kargs(); unsigned char* ws = A->ws;
    pg8::MoeOrder S; S.nN = 4; moe_panels(WSP(int, MS_MTOT), S.ps);
    S.so.init(S.ps[8] * 256, DM, c.G, c.bid);
    pg8::Gemm g{WSP(bf16, B_HIDM), WSP(bf16, W_F2), EDIM, EDIM, EDIM};
    pg8::EpiScale<0> E{WSP(bf16, B_Y2), DM, pg8::RowScale{nullptr, 0}, nullptr};
    pg8::gemm_phase<pg8::EpiScale<0>, pg8::MoeOrder, true, true>(lds + RING_OFF, g, S, E, c.tid);
}
__device__ __forceinline__ void ph_combine(int wv, LAS unsigned char* lds, int l) {
    const Ctx c = mkctx(wv);
    KArgs A = kargs(); unsigned char* ws = A->ws; const int lane = c.lane;
    float* xout = A->out; const int* TOKS = WSP(int, MS_TOKS); const float* TOKW = WSP(float, MS_TOKW); const bf16* Y2 = WSP(bf16, B_Y2); bf16* XB = WSP(bf16, WS_XB); float* SSA = WSP(float, WS_SSA);
    for (int tok0 = c.gw; tok0 < T; tok0 += 2 * c.NGW) {
        typedef unsigned u32x2v __attribute__((ext_vector_type(2)));
        int ss_[2][2]; float ww[2][2]; f32x4 xv[2][4]; bool ok[2];
#pragma unroll
        for (int u = 0; u < 2; ++u) { const int tok = tok0 + u * c.NGW; ok[u] = tok < T; const int tk = ok[u] ? tok : tok0;
            ss_[u][0] = TOKS[tk * 2]; ss_[u][1] = TOKS[tk * 2 + 1]; ww[u][0] = TOKW[tk * 2]; ww[u][1] = TOKW[tk * 2 + 1];
#pragma unroll
            for (int j = 0; j < 4; ++j) xv[u][j] = *((const f32x4*)(xout + (size_t)tk * DM) + 64 * j + lane); }
        u32x2v ya[2][4], yb[2][4];
#pragma unroll
        for (int u = 0; u < 2; ++u)
#pragma unroll
            for (int j = 0; j < 4; ++j) { ya[u][j] = *((const u32x2v*)(Y2 + (size_t)ss_[u][0] * DM) + 64 * j + lane); yb[u][j] = *((const u32x2v*)(Y2 + (size_t)ss_[u][1] * DM) + 64 * j + lane); }
#pragma unroll
        for (int u = 0; u < 2; ++u) if (ok[u]) {
            const int tok = tok0 + u * c.NGW; const float w0 = ww[u][0], w1 = ww[u][1]; float ss = 0.f;
#pragma unroll
            for (int j = 0; j < 4; ++j) {
                const int c4 = 64 * j + lane; f32x4 x = xv[u][j]; const u32x2v a = ya[u][j], b = yb[u][j];
                x[0] += w0 * bflo(a.x) + w1 * bflo(b.x); x[1] += w0 * bfhi(a.x) + w1 * bfhi(b.x); x[2] += w0 * bflo(a.y) + w1 * bflo(b.y); x[3] += w0 * bfhi(a.y) + w1 * bfhi(b.y);
                *((f32x4*)(xout + (size_t)tok * DM) + c4) = x;
                u32x2v w; w.x = pkbf(x[0], x[1]); w.y = pkbf(x[2], x[3]); *((u32x2v*)(XB + (size_t)tok * DM) + c4) = w;
                ss += (x[0] * x[0] + x[1] * x[1]) + (x[2] * x[2] + x[3] * x[3]);
            }
            ss = wave_sum(ss);
            if (lane < 4) SSA[(size_t)tok * 4 + lane] = (lane == 0) ? ss : 0.f;
        }
    }
    if (l < DEPTH - 1) { __syncthreads(); conv_mixer_weights(wv, lds, l + 1); }
}

__global__ void __launch_bounds__(NTHR, 2) trunk_fwd(Args args) {
    extern __shared__ __attribute__((aligned(16))) unsigned char lds_raw[];
    LAS unsigned char* lds = (LAS unsigned char*)lds_raw;
    const int wv = __builtin_amdgcn_readfirstlane((int)threadIdx.x >> 6);
    for (int u = threadIdx.x; u < (LDS_BYTES - LDSCTL_OFF) / 4; u += NTHR) ((LAS unsigned*)(lds + LDSCTL_OFF))[u] = 0u;
    __syncthreads();
    volatile LAS unsigned* MISC = (volatile LAS unsigned*)(lds + MISC_OFF);
    XcdBarrier bar = xcd_barrier_post((unsigned*)((gu32*)(args.ws + WS_CTL) + CW_BAR), MISC + 8, (int)threadIdx.x);
    const int lo = args.ph_lo, hi = args.ph_hi;
    int pc = 0;
#define PH_BEGIN if (pc >= lo && pc < hi) {
#define PH_END if (pc + 1 < hi) xcd_barrier(bar, mkctx(wv).tid); } ++pc;
    PH_BEGIN ph_prologue(wv, lds); PH_END
    for (int l = 0; l < DEPTH; ++l) {
        PH_BEGIN ph_inproj(wv, lds); PH_END
        PH_BEGIN ph_prep(wv, lds, l); PH_END
        PH_BEGIN ph_attn(wv, lds, l); PH_END
        PH_BEGIN ph_gates(wv, lds); PH_END
        PH_BEGIN ph_merge(wv, lds); PH_END
        PH_BEGIN ph_wout(wv, lds, l); PH_END
        if (!(l & 1)) {
            PH_BEGIN ph_ffn_up(wv, lds); PH_END
            PH_BEGIN ph_ffn_down(wv, lds, l); PH_END
        } else {
            PH_BEGIN ph_router(wv, lds, l); PH_END
            PH_BEGIN ph_assign(wv, lds, l); PH_END
            PH_BEGIN ph_moe_up(wv, lds, l); PH_END
            PH_BEGIN ph_moe_down(wv, lds, l); PH_END
            PH_BEGIN ph_combine(wv, lds, l); PH_END
        }
    }
    if (TPROBE != 0 && blockIdx.x == TP_BID && threadIdx.x == 0) { const unsigned long long tt_ = *TP_ACC(lds), te_ = __builtin_amdgcn_s_memrealtime(); while (__builtin_amdgcn_s_memrealtime() - te_ < 7ull * tt_) __builtin_amdgcn_s_sleep(32); }
#undef PH_BEGIN
#undef PH_END
}

#ifndef MK_MULTI
#define MK_MULTI 0
#endif
extern "C" void kernel_launch(void* const* d_in, const int* in_sizes, int n_in, void* d_out, int out_size, void* d_ws, size_t ws_size, hipStream_t stream) {
    static int grid = 0;
    if (grid == 0) {
        if (n_in != 31 || out_size != T * DM || ws_size < WS_END) { fprintf(stderr, "kernel_launch: unexpected problem: n_in %d out %d ws %zu (need %zu)\n", n_in, out_size, ws_size, (size_t)WS_END); grid = -1; return; }
        int dev = 0, cus = 0;
        if (hipGetDevice(&dev) != hipSuccess || hipDeviceGetAttribute(&cus, hipDeviceAttributeMultiprocessorCount, dev) != hipSuccess) { grid = -1; return; }
        if (hipFuncSetAttribute((const void*)trunk_fwd, hipFuncAttributeMaxDynamicSharedMemorySize, LDS_BYTES) != hipSuccess) { fprintf(stderr, "kernel_launch: hipFuncSetAttribute failed\n"); grid = -1; return; }
        int per_cu = 0;
        if (hipOccupancyMaxActiveBlocksPerMultiprocessor(&per_cu, (const void*)trunk_fwd, NTHR, LDS_BYTES) != hipSuccess || per_cu < 1) fprintf(stderr, "kernel_launch: occupancy query says %d\n", per_cu);
        (void)hipGetLastError();
        grid = cus;
    }
    if (grid < 0) return;
    (void)hipMemsetAsync((char*)d_ws + WS_CTL, 0, CTL_ZERO_BYTES, stream);
    Args a{};
    for (int i = 0; i < 31; ++i) a.in[i] = d_in[i];
    a.out = (float*)d_out; a.ws = (unsigned char*)d_ws;
#if MK_MULTI
    for (int p = 0; p < N_PHASES; ++p) { a.ph_lo = p; a.ph_hi = p + 1; hipLaunchKernelGGL(trunk_fwd, dim3(grid), dim3(NTHR), LDS_BYTES, stream, a); }
#else
    a.ph_lo = 0; a.ph_hi = N_PHASES;
    hipLaunchKernelGGL(trunk_fwd, dim3(grid), dim3(NTHR), LDS_BYTES, stream, a);
#endif
}
```

```cpp
#include <hip/hip_runtime.h>
#include <cstdio>
#include <cstdint>
#include <cmath>
namespace pg8 {
#define PG8_LAS __attribute__((address_space(3)))
typedef unsigned short bf16_t;
typedef short bf16x8 __attribute__((ext_vector_type(8)));
typedef float f32x4 __attribute__((ext_vector_type(4)));
typedef unsigned u32x4 __attribute__((ext_vector_type(4)));
constexpr int BM = 256, BK = 64, HALF = 128, HTB = HALF * BK * 2  , STAGE_BYTES = 8 * HTB, NXCD = 8, WGM = 8;

__host__ __device__ __forceinline__ int lds_byte(int r, int c) { const int st = (r >> 4) * 2 + (c >> 5), rr = r & 15, cc = c & 31, ob = rr * 64 + cc * 2; return st * 1024 + (ob ^ (((ob >> 9) & 1) << 5)); }
__host__ __device__ __forceinline__ void stage_rc(int b, int& R, int& C) { const int st = b / 1024, sb = b % 1024, swz = sb ^ (((sb >> 9) & 1) << 5); R = (st >> 1) * 16 + swz / 64; C = (st & 1) * 32 + (swz % 64) / 2; }
__host__ __device__ __forceinline__ int perm32(int rho) { const int n = rho >> 4, i = rho & 15; return 8 * (i >> 2) + 4 * n + (i & 3); }

struct Unit { int pm, pn, pb, ak; };
struct Gemm { const bf16_t* A; const bf16_t* Bt; int lda, ldb, K; };

struct StaticOrder {
    int nM, nN, nwg, G, c;
    __host__ __device__ void init(int M, int N, int G_, int c_) { nM = M / BM; nN = N / BM; nwg = nM * nN; G = G_; c = c_; }
    __host__ __device__ bool next(int i, Unit& u) const {
        const long L = (long)i * G + c; if (L >= nwg) return false;
        int wgid = (int)L; { const int q = nwg / NXCD, r = nwg % NXCD, xcd = wgid % NXCD, off = wgid / NXCD; wgid = (xcd < r ? xcd * (q + 1) : r * (q + 1) + (xcd - r) * q) + off; }
        const int nig = WGM * nN, gid = wgid / nig, fm = gid * WGM, gsz = (nM - fm) < WGM ? (nM - fm) : WGM;
        u.pm = fm + ((wgid % nig) % gsz); u.pn = (wgid % nig) / gsz; u.pb = u.pn; u.ak = 0; return true;
    }
    __device__ __forceinline__ void a_ready(const Unit&) const {}
    __device__ __forceinline__ void done(const Unit&) const {}
};

template <class Epi, class Sched, bool ALIGN_EPI = false, bool SP2 = false>
__device__ __forceinline__ void gemm_phase(PG8_LAS unsigned char* lds, const Gemm g, const Sched& S, const Epi& E, const int tid) {
    const int wid = __builtin_amdgcn_readfirstlane(tid >> 6), lane = tid & 63, wr = wid >> 2, wc = wid & 3, fr = lane & 15, fq = lane >> 4;
    const int K = g.K, nt = K / BK;
    unsigned voffA[2], voffB[2];
#pragma unroll
    for (int i = 0; i < 2; ++i) { int R, C; stage_rc(tid * 16 + i * 8192, R, C); const int Rb = Epi::PERM ? ((R & ~31) + perm32(R & 31)) : R;
        voffA[i] = (unsigned)(R * g.lda + C) * 2u; voffB[i] = (unsigned)(Rb * g.ldb + C) * 2u; }
    const size_t kstep = (size_t)(BK * 2);
    const size_t hstepA = (size_t)HALF * g.lda * 2, hstepB = (size_t)HALF * g.ldb * 2;
    const size_t tstepA = 2 * hstepA, tstepB = 2 * hstepB;
    const unsigned ldsw = (unsigned)wid * 1024u;
    const int aoff = lds_byte(wr * 64 + fr, fq * 8), boff = lds_byte(wc * 32 + fr, fq * 8);
#define PG8_SA(b, h) (((b) * 2 + (h)) * HTB)
#define PG8_SB(b, h) ((4 + (b) * 2 + (h)) * HTB)
#define PG8_STAGE(bufoff, gbase, voff) do { _Pragma("unroll") for (int _i = 0; _i < 2; ++_i) \
        __builtin_amdgcn_global_load_lds((const unsigned*)((const char*)(gbase) + (voff)[_i]), (PG8_LAS unsigned*)(lds + (bufoff) + ldsw + _i * 8192), 16, 0, 0); } while (0)
#define PG8_LDA(dst, b, h) do { _Pragma("unroll") for (int m = 0; m < 4; ++m) _Pragma("unroll") for (int k = 0; k < 2; ++k) dst[m][k] = *(const PG8_LAS bf16x8*)(lds + PG8_SA(b, h) + aoff + m * 2048 + k * 1024); } while (0)
#define PG8_LDB(dst, b, h) do { _Pragma("unroll") for (int n = 0; n < 2; ++n) _Pragma("unroll") for (int k = 0; k < 2; ++k) dst[n][k] = *(const PG8_LAS bf16x8*)(lds + PG8_SB(b, h) + boff + n * 2048 + k * 1024); } while (0)
#define PG8_MMA(ai, bj, At, Bt) do { __builtin_amdgcn_s_setprio(1); _Pragma("unroll") for (int m = 0; m < 4; ++m) _Pragma("unroll") for (int n = 0; n < 2; ++n) _Pragma("unroll") for (int k = 0; k < 2; ++k) \
        acc[ai][bj][m][n] = __builtin_amdgcn_mfma_f32_16x16x32_bf16(Bt[n][k], At[m][k], acc[ai][bj][m][n], 0, 0, 0); __builtin_amdgcn_s_setprio(0); } while (0)
#define PG8_WAIT_V(n) asm volatile("s_waitcnt vmcnt(" #n ")" ::: "memory")
#define PG8_WAIT_L(n) asm volatile("s_waitcnt lgkmcnt(" #n ")" ::: "memory")
#define PG8_BAR __builtin_amdgcn_s_barrier()
#define PG8_SCHED __builtin_amdgcn_sched_barrier(0)
    Unit cur, nxt; int ui = 0;
    if (!S.next(0, cur)) return;
    f32x4 acc[2][2][4][2];
#pragma unroll
    for (int a = 0; a < 2; ++a)
#pragma unroll
        for (int b = 0; b < 2; ++b)
#pragma unroll
            for (int m = 0; m < 4; ++m)
#pragma unroll
                for (int n = 0; n < 2; ++n) acc[a][b][m][n] = (f32x4){0.f, 0.f, 0.f, 0.f};
    bf16x8 At[4][2], B0[2][2], B1[2][2];
    const char* cA = (const char*)g.A + (size_t)cur.pm * tstepA + (size_t)cur.ak * 2; const char* cB = (const char*)g.Bt + (size_t)cur.pb * tstepB;
    S.a_ready(cur);
    if constexpr (SP2) {
        PG8_STAGE(PG8_SB(0, 0), cB, voffB); PG8_STAGE(PG8_SB(0, 1), cB + hstepB, voffB); PG8_STAGE(PG8_SA(0, 0), cA, voffA); PG8_STAGE(PG8_SA(0, 1), cA + hstepA, voffA);
        if (wr == 1) PG8_BAR;
        PG8_WAIT_V(2); PG8_BAR;
        PG8_STAGE(PG8_SB(1, 0), cB + kstep, voffB); PG8_STAGE(PG8_SA(1, 0), cA + kstep, voffA); PG8_STAGE(PG8_SB(1, 1), cB + hstepB + kstep, voffB);
        PG8_WAIT_V(6); PG8_BAR;
    } else {
        PG8_STAGE(PG8_SB(0, 0), cB, voffB); PG8_STAGE(PG8_SA(0, 0), cA, voffA); PG8_STAGE(PG8_SB(0, 1), cB + hstepB, voffB); PG8_STAGE(PG8_SA(0, 1), cA + hstepA, voffA);
        if (wr == 1) PG8_BAR;
        PG8_WAIT_V(4); PG8_BAR;
        PG8_STAGE(PG8_SB(1, 0), cB + kstep, voffB); PG8_STAGE(PG8_SA(1, 0), cA + kstep, voffA); PG8_STAGE(PG8_SB(1, 1), cB + hstepB + kstep, voffB);
        PG8_WAIT_V(6); PG8_BAR;
    }
    for (;;) {
        const bool has_next = S.next(ui + 1, nxt);
        const char* nA = has_next ? (const char*)g.A + (size_t)nxt.pm * tstepA + (size_t)nxt.ak * 2 : cA; const char* nB = has_next ? (const char*)g.Bt + (size_t)nxt.pb * tstepB : cB;
        for (int t = 0; t < nt; t += 2) {
            const bool last = (t == nt - 2);
            const char* a1 = cA + (size_t)(t + 1) * kstep;
            const char* a2 = last ? nA : cA + (size_t)(t + 2) * kstep; const char* b2 = last ? nB : cB + (size_t)(t + 2) * kstep;
            const char* a3 = a2 + kstep; const char* b3 = b2 + kstep;
            if (last && has_next) S.a_ready(nxt);
            if constexpr (SP2) {
            PG8_LDB(B0, 0, 0); PG8_LDB(B1, 0, 1); PG8_SCHED; PG8_LDA(At, 0, 0); PG8_STAGE(PG8_SA(1, 1), a1 + hstepA, voffA);
            PG8_WAIT_V(8); PG8_WAIT_L(0); PG8_BAR; PG8_MMA(0, 0, At, B0); PG8_MMA(0, 1, At, B1); PG8_BAR; PG8_SCHED;
            PG8_LDA(At, 0, 1); PG8_STAGE(PG8_SB(0, 0), b2, voffB); PG8_STAGE(PG8_SB(0, 1), b2 + hstepB, voffB); PG8_STAGE(PG8_SA(0, 0), a2, voffA);
            PG8_WAIT_V(8); PG8_WAIT_L(0); PG8_BAR; PG8_MMA(1, 0, At, B0); PG8_MMA(1, 1, At, B1); PG8_BAR; PG8_SCHED;
            PG8_LDB(B0, 1, 0); PG8_LDB(B1, 1, 1); PG8_SCHED; PG8_LDA(At, 1, 0); PG8_STAGE(PG8_SA(0, 1), a2 + hstepA, voffA);
            PG8_WAIT_V(8); PG8_WAIT_L(0); PG8_BAR; PG8_MMA(0, 0, At, B0); PG8_MMA(0, 1, At, B1); PG8_BAR; PG8_SCHED;
            PG8_LDA(At, 1, 1); PG8_STAGE(PG8_SB(1, 0), b3, voffB); PG8_STAGE(PG8_SB(1, 1), b3 + hstepB, voffB); PG8_STAGE(PG8_SA(1, 0), a3, voffA);
            PG8_WAIT_V(8); PG8_WAIT_L(0); PG8_BAR; PG8_MMA(1, 0, At, B0); PG8_MMA(1, 1, At, B1); PG8_BAR; PG8_SCHED;
            } else {
            PG8_LDB(B0, 0, 0); PG8_SCHED; PG8_LDA(At, 0, 0); PG8_STAGE(PG8_SA(1, 1), a1 + hstepA, voffA);
            PG8_WAIT_L(8); PG8_BAR; PG8_WAIT_L(0); PG8_MMA(0, 0, At, B0); PG8_BAR; PG8_SCHED;
            PG8_LDB(B1, 0, 1); PG8_STAGE(PG8_SB(0, 0), b2, voffB);
            PG8_BAR; PG8_WAIT_L(0); PG8_MMA(0, 1, At, B1); PG8_BAR;
            PG8_LDA(At, 0, 1); PG8_STAGE(PG8_SA(0, 0), a2, voffA);
            PG8_BAR; PG8_WAIT_L(0); PG8_MMA(1, 0, At, B0); PG8_BAR; PG8_SCHED;
            PG8_STAGE(PG8_SB(0, 1), b2 + hstepB, voffB);
            PG8_WAIT_V(6); PG8_BAR; PG8_MMA(1, 1, At, B1); PG8_BAR;
            PG8_LDB(B0, 1, 0); PG8_SCHED; PG8_LDA(At, 1, 0); PG8_STAGE(PG8_SA(0, 1), a2 + hstepA, voffA);
            PG8_WAIT_L(8); PG8_BAR; PG8_WAIT_L(0); PG8_MMA(0, 0, At, B0); PG8_BAR; PG8_SCHED;
            PG8_LDB(B1, 1, 1); PG8_STAGE(PG8_SB(1, 0), b3, voffB);
            PG8_BAR; PG8_WAIT_L(0); PG8_MMA(0, 1, At, B1); PG8_BAR;
            PG8_LDA(At, 1, 1); PG8_STAGE(PG8_SA(1, 0), a3, voffA);
            PG8_BAR; PG8_WAIT_L(0); PG8_MMA(1, 0, At, B0); PG8_BAR; PG8_SCHED;
            PG8_STAGE(PG8_SB(1, 1), b3 + hstepB, voffB);
            PG8_WAIT_V(6); PG8_BAR; PG8_MMA(1, 1, At, B1); PG8_BAR;
            }
        }
        if constexpr (ALIGN_EPI) { if (wr == 0) PG8_BAR; }
        const bool keep = E(acc, cur, wr, wc, fr, fq);
        if (!has_next) break;
        if (!keep) {
#pragma unroll
        for (int a = 0; a < 2; ++a)
#pragma unroll
            for (int b = 0; b < 2; ++b)
#pragma unroll
                for (int m = 0; m < 4; ++m)
#pragma unroll
                    for (int n = 0; n < 2; ++n) acc[a][b][m][n] = (f32x4){0.f, 0.f, 0.f, 0.f};
        }
        cur = nxt; cA = nA; cB = nB; ++ui;
        if constexpr (ALIGN_EPI) { if (wr == 1) PG8_BAR; }
    }
    PG8_WAIT_V(0);
    if constexpr (!ALIGN_EPI) { if (wr == 0) PG8_BAR; }
    PG8_BAR;
#undef PG8_SA
#undef PG8_SB
#undef PG8_STAGE
#undef PG8_LDA
#undef PG8_LDB
#undef PG8_MMA
#undef PG8_WAIT_V
#undef PG8_WAIT_L
#undef PG8_BAR
#undef PG8_SCHED
}
}
#define GAS __attribute__((address_space(1)))
#define LAS __attribute__((address_space(3)))
typedef unsigned short bf16;
typedef unsigned v4u __attribute__((ext_vector_type(4)));
typedef float f32x4 __attribute__((ext_vector_type(4)));
typedef short bf16x8 __attribute__((ext_vector_type(8)));
typedef GAS unsigned gu32;
typedef GAS unsigned long long gu64;
#define RLX_AGENT __ATOMIC_RELAXED, __HIP_MEMORY_SCOPE_AGENT
#define LDS_WAIT() asm volatile("s_waitcnt lgkmcnt(0)" ::: "memory")
#define VM_WAIT() asm volatile("s_waitcnt vmcnt(0)" ::: "memory")
__device__ __forceinline__ unsigned long long rt() { return __builtin_amdgcn_s_memrealtime(); }
__device__ __forceinline__ unsigned f2bf(float f) { unsigned u = __builtin_bit_cast(unsigned, f); return (u + 0x7fffu + ((u >> 16) & 1u)) >> 16; }
__device__ __forceinline__ unsigned pk2(float lo, float hi) { return f2bf(lo) | (f2bf(hi) << 16); }

#define XB_TMO      128
#define XB_XCNT(j)  (256  + 64 * (j))
#define XB_XSUB(j)  (1280 + 64 * (j))
#define XB_XGEN(j)  (2304 + 64 * (j))
#define XB_TOP      3328
#define XB_TOPGEN   3392
#define XCD_BAR_WORDS 3456
#define XB_SPIN_CAP (1u << 18)

__device__ __forceinline__ unsigned xb_ld(unsigned* p)              { return __hip_atomic_load(p, __ATOMIC_RELAXED, __HIP_MEMORY_SCOPE_AGENT); }
__device__ __forceinline__ unsigned xb_add(unsigned* p, unsigned v) { return __hip_atomic_fetch_add(p, v, __ATOMIC_RELAXED, __HIP_MEMORY_SCOPE_AGENT); }
__device__ __forceinline__ unsigned xb_xcc_id() { return (unsigned)__builtin_amdgcn_s_getreg((3 << 11) | 20) & 0xFu; }
#define XB_SPIN(cond, bar) do { unsigned _sp = 0; while (cond) { __builtin_amdgcn_s_sleep(1); \
    if ((++_sp & 255u) == 0u) { if (xb_ld(&(bar)[XB_TMO])) break; if (_sp > XB_SPIN_CAP) { atomicAdd(&(bar)[XB_TMO], 1u); break; } } } } while (0)

struct XcdBarrier {
    unsigned* bar; unsigned x;
    volatile LAS unsigned* st;
};

__device__ __forceinline__ XcdBarrier xcd_barrier_post(unsigned* bar, volatile LAS unsigned* st, const int tid) {
    XcdBarrier b; b.bar = bar; b.x = xb_xcc_id(); b.st = st;
    if (tid == 0) (void)xb_add(&bar[XB_XCNT(b.x)], 1u);
    return b;
}
__device__ __forceinline__ void xcd_barrier_complete(unsigned* bar, unsigned x, unsigned& nloc, unsigned& nx) {
    const unsigned G = gridDim.x * gridDim.y * gridDim.z;
    unsigned sum, cnt, mine, sp = 0u;
    for (;;) {
        sum = 0u; cnt = 0u; mine = 0u;
#pragma unroll
        for (unsigned j = 0; j < 16; ++j) { const unsigned c = xb_ld(&bar[XB_XCNT(j)]); sum += c; cnt += (c > 0u) ? 1u : 0u; mine = (j == x) ? c : mine; }
        if (sum == G) break;
        __builtin_amdgcn_s_sleep(1);
        if ((++sp & 255u) == 0u) { if (xb_ld(&bar[XB_TMO])) break; if (sp > XB_SPIN_CAP) { atomicAdd(&bar[XB_TMO], 1u); break; } }
    }
    nloc = mine > 0u ? mine : 1u; nx = cnt > 0u ? cnt : 1u;
}

__device__ __forceinline__ void xcd_barrier(const XcdBarrier& b, const int tid) {
    asm volatile("s_waitcnt vmcnt(0)" ::: "memory");
    __syncthreads();
    if (tid == 0) {
        unsigned* bar = b.bar; asm volatile("" : "+s"(bar));
        __builtin_amdgcn_s_waitcnt(0);
        unsigned nloc = b.st[0], nx = b.st[1];
        if (nloc == 0u) { unsigned xl_ = b.x; asm volatile("" : "+s"(xl_)); xcd_barrier_complete(bar, xl_, nloc, nx); b.st[0] = nloc; b.st[1] = nx; }
        const unsigned old = xb_add(&bar[XB_XSUB(b.x)], 1u);
        const unsigned gen = old / nloc;
        if (old + 1u == (gen + 1u) * nloc) {
            __builtin_amdgcn_fence(__ATOMIC_RELEASE, "agent");
            asm volatile("s_waitcnt vmcnt(0)" ::: "memory");
            const unsigned og = xb_add(&bar[XB_TOP], 1u);
            const unsigned tg = og / nx;
            if (og + 1u == (tg + 1u) * nx) xb_add(&bar[XB_TOPGEN], 1u);
            else XB_SPIN(xb_ld(&bar[XB_TOPGEN]) == tg, bar);
            __builtin_amdgcn_fence(__ATOMIC_ACQUIRE, "agent");
            xb_add(&bar[XB_XGEN(b.x)], 1u);
            asm volatile("s_waitcnt vmcnt(0)" ::: "memory");
        } else {
            XB_SPIN(xb_ld(&bar[XB_XGEN(b.x)]) == gen, bar);
            __builtin_amdgcn_fence(__ATOMIC_ACQUIRE, "agent");
            asm volatile("s_waitcnt vmcnt(0)" ::: "memory");
        }
    }
    __syncthreads();
}
constexpr int NB = 8, SEQ = 4096, DM = 1024, T = NB * SEQ, DEPTH = 4, IN_COLS = 6240;
constexpr int FFN = 2816, NE = 8, EDIM = 1408;
constexpr float EPS = 1e-6f, LOG2E = 1.4426950408889634f;
constexpr int PJ_LD = 2304, PJ_U = 0, PJ_V = 256, PJ_BQ = 512, PJ_BK = 768, PJ_BV = 1024, PJ_DA = 1280, PJ_DG = 1536, PJ_CQ = 1792, PJ_CKV = 1984, PJ_KR = 2112;
constexpr float QS_B = 0.125f * LOG2E;
constexpr float QS_C = 0.10206207261596577f * LOG2E;
constexpr int NWAVES = 8, NTHR = 512;

constexpr size_t MiB = 1u << 20;
constexpr size_t WS_CTL = 0, CTL_ZERO_BYTES = 1 * MiB;
constexpr size_t WS_SSA = 1 * MiB, WS_SSB = 3 * MiB;
constexpr size_t WS_ROPE = 5 * MiB;
constexpr size_t WS_MISC = 11 * MiB;
constexpr size_t MS_RSCQ = WS_MISC, MS_RSCKV = WS_MISC + 128 * 1024, MS_SEL = WS_MISC + 256 * 1024, MS_KMEAN = WS_MISC + 768 * 1024,
                 MS_TOKE = WS_MISC + 1024 * 1024, MS_TOKW = WS_MISC + 1280 * 1024, MS_TOKS = WS_MISC + 1536 * 1024, MS_RSSLOT = WS_MISC + 1792 * 1024,
                 MS_WCNT = WS_MISC + 2304 * 1024, MS_WGCNT = WS_MISC + 2560 * 1024, MS_MTOT = WS_MISC + 2816 * 1024, MS_WSGU = WS_MISC + 2880 * 1024;
constexpr size_t WS_W = 14 * MiB;
constexpr size_t W_INR = WS_W, W_G = WS_W + 4 * MiB + 512 * 1024, W_UQ = WS_W + 12 * MiB + 512 * 1024, W_UKV = W_UQ + 256 * 1024, W_B = WS_W + 13 * MiB, W_OUT = WS_W + 15 * MiB,
                 W_F1 = WS_W + 17 * MiB, W_F2 = WS_W + 61 * MiB;
constexpr size_t WS_SSC = 98 * MiB;
constexpr size_t WS_XB = 100 * MiB;
constexpr size_t WS_BIG = 164 * MiB;
constexpr size_t B_PROJ = WS_BIG, B_QPRE = WS_BIG + 144 * MiB, B_KVPRE = WS_BIG + 176 * MiB  , B_CQ = WS_BIG + 208 * MiB, B_CK = WS_BIG + 232 * MiB, B_O = WS_BIG + 256 * MiB;
constexpr size_t B_SG = WS_BIG, B_Y = WS_BIG + 320 * MiB;
constexpr size_t B_HID = WS_BIG;
constexpr size_t B_XS = WS_BIG, B_HIDM = WS_BIG + 132 * MiB, B_Y2 = WS_BIG;
constexpr size_t WS_END = WS_BIG + 384 * MiB;
constexpr int MOE_ROWS_MAX = 65536 + 8 * 256;
static_assert(B_HIDM + (size_t)MOE_ROWS_MAX * EDIM * 2 <= WS_END && (size_t)MOE_ROWS_MAX * 1024 * 2 <= 132 * MiB, "moe map");
constexpr int CW_TMO = 0, CW_BAR = 4096, CW_MOE = 8192, CW_KMX = 9216;

constexpr int RING_OFF = 0, RING_BYTES = 131072;
constexpr int LDSCTL_OFF = RING_BYTES, MISC_OFF = LDSCTL_OFF + 320;
constexpr int LDS_BYTES = 147456;
constexpr int EPI_RED_OFF = 132096;

typedef float f32x2 __attribute__((ext_vector_type(2)));
typedef __bf16 bf16x2_t __attribute__((ext_vector_type(2)));
__device__ __forceinline__ unsigned pkbf(float lo, float hi) { f32x2 v = {lo, hi}; bf16x2_t b = __builtin_convertvector(v, bf16x2_t); return __builtin_bit_cast(unsigned, b); }
__device__ __forceinline__ float bflo(unsigned w) { return __uint_as_float(w << 16); }
__device__ __forceinline__ float bfhi(unsigned w) { return __uint_as_float(w & 0xffff0000u); }
__device__ __forceinline__ float bf1(bf16 b) { return __uint_as_float((unsigned)b << 16); }
__device__ __forceinline__ void unpack8(const v4u w, float* o) { o[0] = bflo(w.x); o[1] = bfhi(w.x); o[2] = bflo(w.y); o[3] = bfhi(w.y); o[4] = bflo(w.z); o[5] = bfhi(w.z); o[6] = bflo(w.w); o[7] = bfhi(w.w); }
__device__ __forceinline__ v4u pack8(const float* o) { v4u w; w.x = pkbf(o[0], o[1]); w.y = pkbf(o[2], o[3]); w.z = pkbf(o[4], o[5]); w.w = pkbf(o[6], o[7]); return w; }
template <int X> __device__ __forceinline__ float swz_xor(float v) { return __int_as_float(__builtin_amdgcn_ds_swizzle(__float_as_int(v), (X << 10) | 0x1f)); }
__device__ __forceinline__ float half_sum(float v) { auto rr = __builtin_amdgcn_permlane32_swap(__float_as_uint(v), __float_as_uint(v), false, false); return __uint_as_float(rr[0]) + __uint_as_float(rr[1]); }
__device__ __forceinline__ float wave_sum(float v) {
    v += swz_xor<1>(v); v += swz_xor<2>(v); v += swz_xor<4>(v); v += swz_xor<8>(v); v += swz_xor<16>(v);
    return half_sum(v);
}
__device__ __forceinline__ float fast_sigmoid(float x) { return __builtin_amdgcn_rcpf(1.0f + __builtin_amdgcn_exp2f(-x * LOG2E)); }
__device__ __forceinline__ float fast_silu(float x) { return x * fast_sigmoid(x); }
namespace pg8 {
struct RowScale { const float* p; int mode; };
__device__ __forceinline__ float row_scale(const RowScale& rs, int row) {
    if (rs.mode == 0) return 1.f;
    if (rs.mode == 2) return rs.p[row];
    if (rs.mode == 3) { const f32x4 p = *(const f32x4*)(rs.p + (size_t)row * 12); return rsqrtf(((p[0] + p[1]) + (p[2] + p[3])) * (1.0f / 192.0f) + EPS); }
    if (rs.mode == 4) { const f32x4 p = *(const f32x4*)(rs.p + (size_t)row * 12 + 4); return rsqrtf(((p[0] + p[1]) + (p[2] + p[3])) * (1.0f / 128.0f) + EPS); }
    { const f32x4 p = *(const f32x4*)(rs.p + (size_t)row * 4); return rsqrtf(((p[0] + p[1]) + (p[2] + p[3])) * (1.0f / 1024.0f) + EPS); }
}
template <int ACT> struct EpiScale {
    static constexpr bool PERM = true;
    bf16_t* O; int ldc; RowScale rs; float* ssc;
    __device__ __forceinline__ bool operator()(f32x4 (&acc)[2][2][4][2], const Unit& u, int wr, int wc, int fr, int fq) const {
        const int row0 = u.pm * BM + wr * 64 + fr;
        float scv[2][4];
#pragma unroll
        for (int ai = 0; ai < 2; ++ai)
#pragma unroll
            for (int m = 0; m < 4; ++m) scv[ai][m] = row_scale(rs, row0 + ai * HALF + m * 16);
#pragma unroll
        for (int ai = 0; ai < 2; ++ai)
#pragma unroll
            for (int m = 0; m < 4; ++m) {
                const int row = row0 + ai * HALF + m * 16; const float sc = scv[ai][m];
                if (ACT == 2) {
                    bf16_t* rowp = O + (size_t)row * ldc + u.pn * HALF + wc * 32 + 8 * fq;
                    const f32x4 g0 = acc[ai][0][m][0] * sc, g1 = acc[ai][0][m][1] * sc, u0 = acc[ai][1][m][0] * sc, u1 = acc[ai][1][m][1] * sc;
                    u32x4 w; w.x = pkbf(fast_silu(g0[0]) * u0[0], fast_silu(g0[1]) * u0[1]); w.y = pkbf(fast_silu(g0[2]) * u0[2], fast_silu(g0[3]) * u0[3]);
                    w.z = pkbf(fast_silu(g1[0]) * u1[0], fast_silu(g1[1]) * u1[1]); w.w = pkbf(fast_silu(g1[2]) * u1[2], fast_silu(g1[3]) * u1[3]);
                    *(u32x4*)rowp = w;
                } else {
                    bf16_t* rowp = O + (size_t)row * ldc + u.pn * BM + wc * 32 + 8 * fq;
                    float sq[2] = {0.f, 0.f};
#pragma unroll
                    for (int bj = 0; bj < 2; ++bj) {
                        f32x4 v0 = acc[ai][bj][m][0] * sc, v1 = acc[ai][bj][m][1] * sc;
                        if (ACT == 0) sq[bj] = ((v0[0] * v0[0] + v0[1] * v0[1]) + (v0[2] * v0[2] + v0[3] * v0[3])) + ((v1[0] * v1[0] + v1[1] * v1[1]) + (v1[2] * v1[2] + v1[3] * v1[3]));
                        if (ACT == 1) {
#pragma unroll
                            for (int j = 0; j < 4; ++j) { v0[j] = fmaxf(fast_sigmoid(v0[j]), 8.6736174e-19f); v1[j] = fmaxf(fast_sigmoid(v1[j]), 8.6736174e-19f); }
                        }
                        u32x4 w; w.x = pkbf(v0[0], v0[1]); w.y = pkbf(v0[2], v0[3]); w.z = pkbf(v1[0], v1[1]); w.w = pkbf(v1[2], v1[3]);
                        *(u32x4*)(rowp + bj * HALF) = w;
                    }
                    if (ACT == 0 && ssc != nullptr && (u.pn == 7 || u.pn == 8)) {
                        float a = (u.pn == 7) ? (sq[0] + (wc < 2 ? sq[1] : 0.f)) : sq[0];
                        float c = sq[1];
                        a += swz_xor<16>(a); a = half_sum(a); c += swz_xor<16>(c); c = half_sum(c);
                        if (fq == 0) {
                            float* sp = ssc + (size_t)row * 12;
                            if (u.pn == 7) { sp[wc] = a; if (wc >= 2) sp[4 + wc] = c; }
                            else { if (wc < 2) sp[4 + wc] = a; if (wc == 2) sp[8] = a; }
                        }
                    }
                }
            }
        return false;
    }
};
struct EpiResidual {
    static constexpr bool PERM = false;
    const float* base; float* out; bf16_t* xb; float* ssp; PG8_LAS float* red;
    __device__ __forceinline__ bool operator()(f32x4 (&acc)[2][2][4][2], const Unit& u, int wr, int wc, int fr, int fq) const {
        typedef unsigned u32x2v __attribute__((ext_vector_type(2)));
        const int row0 = u.pm * BM + wr * 64 + fr, col0 = u.pn * BM + wc * 32 + 4 * fq;
#pragma unroll
        for (int ai = 0; ai < 2; ++ai)
#pragma unroll
            for (int mp = 0; mp < 2; ++mp) {
                f32x4 bv[2][2][2];
#pragma unroll
                for (int mm = 0; mm < 2; ++mm)
#pragma unroll
                    for (int bj = 0; bj < 2; ++bj)
#pragma unroll
                        for (int n = 0; n < 2; ++n) bv[mm][bj][n] = *(const f32x4*)(base + (size_t)(row0 + ai * HALF + (2 * mp + mm) * 16) * DM + col0 + bj * HALF + n * 16);
#pragma unroll
                for (int mm = 0; mm < 2; ++mm) {
                    const int m = 2 * mp + mm, row = row0 + ai * HALF + m * 16; const size_t off = (size_t)row * DM + col0; float ss = 0.f;
#pragma unroll
                    for (int bj = 0; bj < 2; ++bj)
#pragma unroll
                        for (int n = 0; n < 2; ++n) {
                            const size_t o2 = off + bj * HALF + n * 16; const f32x4 o = bv[mm][bj][n] + acc[ai][bj][m][n];
                            *(f32x4*)(out + o2) = o;
                            u32x2v w; w.x = pkbf(o[0], o[1]); w.y = pkbf(o[2], o[3]); *(u32x2v*)(xb + o2) = w;
                            ss += (o[0] * o[0] + o[1] * o[1]) + (o[2] * o[2] + o[3] * o[3]);
                        }
                    ss += swz_xor<16>(ss); ss = half_sum(ss);
                    if (fq == 0) red[(ai * HALF + wr * 64 + m * 16 + fr) * 4 + wc] = ss;
                }
            }
        asm volatile("s_waitcnt lgkmcnt(0)" ::: "memory"); __builtin_amdgcn_s_barrier(); asm volatile("" ::: "memory");
        const int t = (wr * 4 + wc) * 64 + fq * 16 + fr;
        if (t < 256) { const f32x4 p = *(const PG8_LAS f32x4*)(red + t * 4); ssp[(size_t)(u.pm * BM + t) * 4 + u.pn] = (p[0] + p[1]) + (p[2] + p[3]); }
        return false;
    }
};
struct EpiKV {
    static constexpr bool PERM = true;
    bf16_t* CK; bf16_t* VB; const bf16_t* PROJ; const float* ssc; const float* rope; const float* ckn; unsigned* kmx;
    __device__ __forceinline__ bool operator()(f32x4 (&acc)[2][2][4][2], const Unit& u, int wr, int wc, int fr, int fq) const {
        typedef unsigned u32x2v __attribute__((ext_vector_type(2)));
        { unsigned mk_ = ~0u; asm volatile("" : "+s"(mk_)); const int ln_ = (int)__builtin_amdgcn_mbcnt_hi(mk_, __builtin_amdgcn_mbcnt_lo(mk_, 0u)); fr = ln_ & 15; fq = ln_ >> 4; }
        const int hh = 2 * u.pn + (wc >> 1); const bool isv = (wc & 1) != 0; const int row0 = u.pm * BM + wr * 64 + fr;
        float k2max = 0.f;
#pragma unroll
        for (int ai = 0; ai < 2; ++ai)
#pragma unroll
            for (int m = 0; m < 4; ++m) {
                const int row = row0 + ai * HALF + m * 16;
                const float* sp = ssc + (size_t)row * 12; const f32x4 pp = *(const f32x4*)(sp + 4);
                const float rs = rsqrtf(((pp[0] + pp[1]) + (pp[2] + pp[3])) * (1.0f / 128.0f) + EPS);
                if (isv) {
#pragma unroll
                    for (int bj = 0; bj < 2; ++bj) { const f32x4 v0 = acc[ai][bj][m][0] * rs, v1 = acc[ai][bj][m][1] * rs;
                        u32x4 w; w.x = pkbf(v0[0], v0[1]); w.y = pkbf(v0[2], v0[3]); w.z = pkbf(v1[0], v1[1]); w.w = pkbf(v1[2], v1[3]);
                        *(u32x4*)(VB + (size_t)row * 256 + hh * 64 + 32 * bj + 8 * fq) = w; }
                } else {
                    float ss = 0.f;
#pragma unroll
                    for (int bj = 0; bj < 2; ++bj)
#pragma unroll
                        for (int n = 0; n < 2; ++n) { const f32x4 a = acc[ai][bj][m][n]; ss += (a[0] * a[0] + a[1] * a[1]) + (a[2] * a[2] + a[3] * a[3]); }
                    ss += swz_xor<16>(ss); ss = half_sum(ss); ss *= rs * rs;
                    const float rk = rsqrtf((ss + sp[8]) * (1.0f / 96.0f) + EPS); const float rr = rs * rk;
                    bf16_t* kd = CK + (size_t)row * 384 + hh * 96; float kn2 = 0.f;
#pragma unroll
                    for (int bj = 0; bj < 2; ++bj) { const f32x4 g0 = *(const f32x4*)(ckn + 32 * bj + 8 * fq), g1 = *(const f32x4*)(ckn + 32 * bj + 8 * fq + 4);
                        const f32x4 a = acc[ai][bj][m][0] * rr * g0, b = acc[ai][bj][m][1] * rr * g1;
                        kn2 += ((a[0] * a[0] + a[1] * a[1]) + (a[2] * a[2] + a[3] * a[3])) + ((b[0] * b[0] + b[1] * b[1]) + (b[2] * b[2] + b[3] * b[3]));
                        u32x4 w; w.x = pkbf(a[0], a[1]); w.y = pkbf(a[2], a[3]); w.z = pkbf(b[0], b[1]); w.w = pkbf(b[2], b[3]);
                        *(u32x4*)(kd + 32 * bj + 8 * fq) = w; }
                    const u32x2v k1 = *(const u32x2v*)(PROJ + (size_t)row * PJ_LD + PJ_KR + 4 * fq), k2 = *(const u32x2v*)(PROJ + (size_t)row * PJ_LD + PJ_KR + 16 + 4 * fq);
                    const f32x4 ga = *(const f32x4*)(ckn + 64 + 4 * fq), gb = *(const f32x4*)(ckn + 80 + 4 * fq);
                    const float* tb = rope + (size_t)row * 48 + 16 + 8 * fq; const f32x4 t0 = *(const f32x4*)tb, t1 = *(const f32x4*)(tb + 4);
                    const float x1[4] = {bflo(k1.x) * rk * ga[0], bfhi(k1.x) * rk * ga[1], bflo(k1.y) * rk * ga[2], bfhi(k1.y) * rk * ga[3]};
                    const float x2[4] = {bflo(k2.x) * rk * gb[0], bfhi(k2.x) * rk * gb[1], bflo(k2.y) * rk * gb[2], bfhi(k2.y) * rk * gb[3]};
                    const float cs[4] = {t0[0], t0[2], t1[0], t1[2]}, sn[4] = {t0[1], t0[3], t1[1], t1[3]};
                    u32x2v y1, y2;
                    y1.x = pkbf(x1[0] * cs[0] - x2[0] * sn[0], x1[1] * cs[1] - x2[1] * sn[1]); y1.y = pkbf(x1[2] * cs[2] - x2[2] * sn[2], x1[3] * cs[3] - x2[3] * sn[3]);
                    y2.x = pkbf(x2[0] * cs[0] + x1[0] * sn[0], x2[1] * cs[1] + x1[1] * sn[1]); y2.y = pkbf(x2[2] * cs[2] + x1[2] * sn[2], x2[3] * cs[3] + x1[3] * sn[3]);
                    *(u32x2v*)(kd + 64 + 4 * fq) = y1; *(u32x2v*)(kd + 80 + 4 * fq) = y2;
                    kn2 += ((x1[0] * x1[0] + x2[0] * x2[0]) + (x1[1] * x1[1] + x2[1] * x2[1])) + ((x1[2] * x1[2] + x2[2] * x2[2]) + (x1[3] * x1[3] + x2[3] * x2[3]));
                    kn2 += swz_xor<16>(kn2); kn2 = half_sum(kn2); k2max = fmaxf(k2max, kn2);
                }
                asm volatile("" ::: "memory");
            }
        if (!isv) {
            k2max = fmaxf(k2max, swz_xor<1>(k2max)); k2max = fmaxf(k2max, swz_xor<2>(k2max)); k2max = fmaxf(k2max, swz_xor<4>(k2max)); k2max = fmaxf(k2max, swz_xor<8>(k2max));
            if (fr == 0 && fq == 0) __hip_atomic_fetch_max(kmx + ((u.pm * BM) / SEQ) * 4 + hh, __float_as_uint(k2max), __ATOMIC_RELAXED, __HIP_MEMORY_SCOPE_AGENT);
        }
        return false;
    }
};
struct EpiGates {
    static constexpr bool PERM = true;
    bf16_t* RG; RowScale rs;
    __device__ __forceinline__ bool operator()(f32x4 (&acc)[2][2][4][2], const Unit& u, int wr, int wc, int fr, int fq) const {
        typedef unsigned u32x2v __attribute__((ext_vector_type(2)));
        const int row0 = u.pm * BM + wr * 64 + fr, oc = u.pn * 64 + wc * 16 + fq * 4;
        float scv[2][4];
#pragma unroll
        for (int ai = 0; ai < 2; ++ai)
#pragma unroll
            for (int m = 0; m < 4; ++m) scv[ai][m] = row_scale(rs, row0 + ai * HALF + m * 16);
#pragma unroll
        for (int ai = 0; ai < 2; ++ai)
#pragma unroll
            for (int m = 0; m < 4; ++m) {
                const int row = row0 + ai * HALF + m * 16; const float sc = scv[ai][m];
                f32x4 s[4];
#pragma unroll
                for (int b = 0; b < 4; ++b) { const f32x4 g = acc[ai][b >> 1][m][b & 1] * sc;
#pragma unroll
                    for (int j = 0; j < 4; ++j) s[b][j] = fmaxf(fast_sigmoid(g[j]), 8.6736174e-19f); }
                bf16_t* rp = RG + (size_t)row * 4096 + oc;
#pragma unroll
                for (int b = 0; b < 4; ++b) { f32x4 r = s[b];
                    if (b < 3) {
#pragma unroll
                        for (int j = 0; j < 4; ++j) r[j] = s[b][j] * __builtin_amdgcn_rcpf(s[b + 1][j]); }
                    u32x2v w; w.x = pkbf(r[0], r[1]); w.y = pkbf(r[2], r[3]); *(u32x2v*)(rp + b * 1024) = w; }
            }
        return false;
    }
};
struct EpiMerge {
    static constexpr bool PERM = true;
    const bf16_t* SG; bf16_t* Y;
    __device__ __forceinline__ bool operator()(f32x4 (&acc)[2][2][4][2], const Unit& u, int wr, int wc, int fr, int fq) const {
        const int n = u.ak >> 8; const int row0 = u.pm * BM + wr * 64 + fr, col0 = u.pn * BM + wc * 32 + 8 * fq;
#pragma unroll
        for (int ai = 0; ai < 2; ++ai)
#pragma unroll
            for (int mp = 0; mp < 2; ++mp) {
              u32x4 av[2][2];
#pragma unroll
              for (int mm = 0; mm < 2; ++mm)
#pragma unroll
                for (int bj = 0; bj < 2; ++bj) av[mm][bj] = *(const u32x4*)(SG + (size_t)(row0 + ai * HALF + (2 * mp + mm) * 16) * 4096 + n * 1024 + col0 + bj * HALF);
#pragma unroll
              for (int mm = 0; mm < 2; ++mm) {
                const int m = 2 * mp + mm, row = row0 + ai * HALF + m * 16;
#pragma unroll
                for (int bj = 0; bj < 2; ++bj) {
                    float sa[8]; unpack8(av[mm][bj], sa);
#pragma unroll
                    for (int j = 0; j < 4; ++j) { acc[ai][bj][m][0][j] *= sa[j]; acc[ai][bj][m][1][j] *= sa[4 + j]; }
                    if (n == 3) {
                        float o[8];
#pragma unroll
                        for (int j = 0; j < 4; ++j) { o[j] = acc[ai][bj][m][0][j]; o[4 + j] = acc[ai][bj][m][1][j]; }
                        *(u32x4*)(Y + (size_t)row * DM + col0 + bj * HALF) = pack8(o);
                    }
                }
              }
            }
        return n < 3;
    }
};
struct MergeOrder {
    StaticOrder so;
    __device__ bool next(int i, Unit& u) const { if (!so.next(i >> 2, u)) return false; const int n = i & 3; u.pb = n * 4 + u.pn; u.ak = n * 256; return true; }
    __device__ __forceinline__ void a_ready(const Unit&) const {}
    __device__ __forceinline__ void done(const Unit&) const {}
};
struct MoeOrder {
    StaticOrder so; int nN; int ps[9];
    __device__ bool next(int i, Unit& u) const {
        if (!so.next(i, u)) return false; int e = 0;
#pragma unroll
        for (int k = 1; k < 8; ++k) e = (u.pm >= ps[k]) ? k : e;
        u.pb = e * nN + u.pn; u.ak = 0; return true; }
    __device__ __forceinline__ void a_ready(const Unit&) const {}
    __device__ __forceinline__ void done(const Unit&) const {}
};
}

struct TrDesc { const float* src; bf16* dst; const float* gain; int ldw, ldd, nnb, nsrc0, drow0, map, cum, pad; };
constexpr int TR_TAB_OFF = 8448;
struct TrItem { const float* W; bf16* dst; const float* gain; int ldw, ldd, k0, n0, perm; };
__device__ __forceinline__ void tr_load(const TrItem& it, float (&v)[32], int lane) {
#pragma unroll
    for (int i = 0; i < 32; ++i) { const int kk = 2 * i + (lane >> 5); v[i] = it.W[(size_t)(it.k0 + kk) * it.ldw + it.n0 + (lane & 31)]; }
}
__device__ __forceinline__ void tr_finish(const TrItem& it, float (&v)[32], LAS float* scr, int lane) {
    if (it.gain) {
#pragma unroll
        for (int i = 0; i < 32; ++i) v[i] *= it.gain[it.k0 + 2 * i + (lane >> 5)];
    }
#pragma unroll
    for (int i = 0; i < 32; ++i) scr[(2 * i + (lane >> 5)) * 33 + (lane & 31)] = v[i];
    LDS_WAIT(); asm volatile("" ::: "memory");
    const int c = lane & 7;
#pragma unroll
    for (int j = 0; j < 4; ++j) { const int n = (lane >> 3) + 8 * j; const LAS float* s = scr + (8 * c) * 33 + n;
        v4u o; o.x = pkbf(s[0 * 33], s[1 * 33]); o.y = pkbf(s[2 * 33], s[3 * 33]); o.z = pkbf(s[4 * 33], s[5 * 33]); o.w = pkbf(s[6 * 33], s[7 * 33]);
        const int nr = it.perm ? (32 * (n >> 4) + 8 * ((n >> 2) & 3) + (n & 3)) : n;
        *(v4u*)(it.dst + (size_t)nr * it.ldd + 8 * c) = o; }
    LDS_WAIT(); asm volatile("" ::: "memory");
}
__device__ __forceinline__ void tr_add(LAS TrDesc* t, int& n, int& cum, const float* src, int ldw, int Ktot, int ncols, int nsrc0, bf16* dst, int ldd, int drow0, int map, const float* gain) {
    int z = 0; asm volatile("" : "+s"(z));
    asm volatile("" : "+s"(gain));
    t[n].src = src; t[n].dst = dst; t[n].gain = gain; t[n].ldw = ldw + z; t[n].ldd = ldd + z; t[n].nnb = ncols / 32 + z; t[n].nsrc0 = nsrc0 + z; t[n].drow0 = drow0 + z; t[n].map = map + z; t[n].cum = cum + z;
    cum += (Ktot / 64) * (ncols / 32); ++n;
}
__device__ __forceinline__ TrItem tr_lookup(const LAS TrDesc* t, int& d, int it) {
    while (it >= t[d + 1].cum) ++d;
    const int local = it - t[d].cum, nnb = t[d].nnb, kb = local / nnb, nb = local - kb * nnb, k0 = kb * 64, nl = nb * 32;
    const int mp = t[d].map;
    const int drow = t[d].drow0 + (mp == 1 ? ((nl >> 7) * 256 + (nl & 127)) : mp == 2 ? (256 * (nl >> 8) + 128 * ((nl >> 5) & 1) + 32 * ((((nl >> 7) & 1) << 1) + ((nl >> 6) & 1)))
                                 : mp == 3 ? (256 * ((nl & 1023) >> 6) + 128 * (nl >> 11) + 32 * (((nl & 1023) >> 4) & 3) + 4 * ((nl >> 10) & 1)) : nl); const int ldd = t[d].ldd;
    TrItem r; r.W = t[d].src; r.dst = t[d].dst + (size_t)drow * ldd + k0; r.gain = t[d].gain; r.ldw = t[d].ldw; r.ldd = ldd; r.k0 = k0; r.n0 = t[d].nsrc0 + nl; r.perm = (mp == 3) ? 1 : 0; return r;
}
__device__ __forceinline__ void tr_run(const LAS TrDesc* t, int total, LAS float* scr, int lane, int gw, int NGW) {
    const int per = (total + NGW - 1) / NGW, lo = gw * per, hi = (lo + per < total) ? lo + per : total;
    if (lo >= hi) return;
    int d = 0; TrItem cur = tr_lookup(t, d, lo); float va[32], vb[32];
    tr_load(cur, va, lane);
    for (int it = lo; it < hi; it += 2) {
        TrItem nx = cur; const bool h1 = it + 1 < hi;
        if (h1) { nx = tr_lookup(t, d, it + 1); tr_load(nx, vb, lane); }
        tr_finish(cur, va, scr, lane);
        if (!h1) break;
        const bool h2 = it + 2 < hi;
        if (h2) { cur = tr_lookup(t, d, it + 2); tr_load(cur, va, lane); }
        tr_finish(nx, vb, scr, lane);
    }
}

template <int DK, int DV, bool MOBA>
__device__ __forceinline__ void naive_attn_unit(LAS unsigned char* lds, const bf16* Q, int qp, int qhs, const bf16* K, int kp, int khs, const bf16* V, int vp, int vhs,
                                                bf16* O, int op, int b, int h, int qc, const int* sel, const int tid) {
    LAS float* Ks = (LAS float*)lds; LAS float* Vs = Ks + 64 * DK;
    const int qi = qc * 512 + tid;
    const size_t tok = (size_t)b * SEQ + qi;
    float q[DK];
    { const v4u* qsrc = (const v4u*)(Q + tok * qp + h * qhs);
#pragma unroll
      for (int c = 0; c < DK / 8; ++c) unpack8(qsrc[c], q + 8 * c); }
    float o[DV];
#pragma unroll
    for (int d = 0; d < DV; ++d) o[d] = 0.f;
    float m = -1e30f, l = 0.f;
    const int qblk = qi >> 8; unsigned mask = 0u;
    if (MOBA) { const int sv = sel[tok * 4 + h]; const int ns = (sv >> 12) & 3;
        if (ns > 0) mask |= 1u << (sv & 15); if (ns > 1) mask |= 1u << ((sv >> 4) & 15); if (ns > 2) mask |= 1u << ((sv >> 8) & 15); }
    const int ntile = qc * 8 + 8;
    const int wave_last = qc * 512 + (tid | 63);
    for (int kt = 0; kt < ntile; ++kt) {
        __syncthreads();
        const int k0 = kt * 64;
        for (int c = tid; c < 64 * (DK / 8); c += NTHR) { const int r = c / (DK / 8), ch = c - r * (DK / 8);
            const v4u w = *(const v4u*)(K + ((size_t)b * SEQ + k0 + r) * kp + h * khs + ch * 8); float f[8]; unpack8(w, f);
            LAS f32x4* d = (LAS f32x4*)(Ks + r * DK + ch * 8); d[0] = (f32x4){f[0], f[1], f[2], f[3]}; d[1] = (f32x4){f[4], f[5], f[6], f[7]}; }
        for (int c = tid; c < 64 * (DV / 8); c += NTHR) { const int r = c / (DV / 8), ch = c - r * (DV / 8);
            const v4u w = *(const v4u*)(V + ((size_t)b * SEQ + k0 + r) * vp + h * vhs + ch * 8); float f[8]; unpack8(w, f);
            LAS f32x4* d = (LAS f32x4*)(Vs + r * DV + ch * 8); d[0] = (f32x4){f[0], f[1], f[2], f[3]}; d[1] = (f32x4){f[4], f[5], f[6], f[7]}; }
        __syncthreads();
        if (k0 > wave_last) continue;
        const int nblk = k0 >> 8;
        bool tile_ok = true;
        if (MOBA) { tile_ok = (nblk == qblk) || ((mask >> nblk) & 1u); if (!__any(tile_ok)) continue; }
        for (int jj = 0; jj < 64; ++jj) {
            const int kj = k0 + jj;
            const bool ok = MOBA ? (tile_ok && (nblk != qblk || kj <= qi)) : (kj <= qi);
            if (ok) {
                const LAS f32x4* kr = (const LAS f32x4*)(Ks + jj * DK);
                float s0 = 0.f, s1 = 0.f;
#pragma unroll
                for (int c = 0; c < DK / 8; ++c) { const f32x4 a = kr[2 * c], bq = kr[2 * c + 1];
                    s0 += q[8 * c] * a[0]; s1 += q[8 * c + 1] * a[1]; s0 += q[8 * c + 2] * a[2]; s1 += q[8 * c + 3] * a[3];
                    s0 += q[8 * c + 4] * bq[0]; s1 += q[8 * c + 5] * bq[1]; s0 += q[8 * c + 6] * bq[2]; s1 += q[8 * c + 7] * bq[3]; }
                const float s = s0 + s1;
                if (s > m) { const float cf = __builtin_amdgcn_exp2f(m - s); l *= cf;
#pragma unroll
                    for (int d = 0; d < DV; ++d) o[d] *= cf;
                    m = s; }
                const float p = __builtin_amdgcn_exp2f(s - m); l += p;
                const LAS f32x4* vr = (const LAS f32x4*)(Vs + jj * DV);
#pragma unroll
                for (int c = 0; c < DV / 4; ++c) { const f32x4 a = vr[c]; o[4 * c] += p * a[0]; o[4 * c + 1] += p * a[1]; o[4 * c + 2] += p * a[2]; o[4 * c + 3] += p * a[3]; }
            }
        }
    }
    const float inv = 1.0f / l;
    v4u* od = (v4u*)(O + tok * op + h * DV);
#pragma unroll
    for (int c = 0; c < DV / 8; ++c) { float t8[8];
#pragma unroll
        for (int j = 0; j < 8; ++j) t8[j] = o[8 * c + j] * inv;
        od[c] = pack8(t8); }
    __syncthreads();
}

constexpr int SGU_P = 136;
__device__ __forceinline__ void sgu_unit(LAS unsigned char* lds, const bf16* PROJ, bf16* O, const float* __restrict__ lng, const float* __restrict__ lnb, const bf16* __restrict__ WM, const float* __restrict__ bs, int unit, const int tid) {
    LAS bf16* vnT = (LAS bf16*)lds;
    const int lane = tid & 63, wave = __builtin_amdgcn_readfirstlane(tid >> 6), r32 = lane & 31, hi = lane >> 5;
    const size_t t0 = (size_t)unit * 128;
    const f32x4 g4 = *(const f32x4*)(lng + 4 * lane), b4 = *(const f32x4*)(lnb + 4 * lane);
    bf16x8 wf[20];
    { const int g_ = wave >> 1; const bf16* wb = WM + ((size_t)(g_ * 128 + r32) * 128 + 8 * hi);
#pragma unroll
      for (int nt = 0; nt < 4; ++nt)
#pragma unroll
          for (int ks = 0; ks < 2 * nt + 2; ++ks) wf[nt * (nt + 1) + ks] = *(const bf16x8*)(wb + (size_t)(32 * nt) * 128 + 16 * ks); }
    {
        typedef unsigned u32x2v __attribute__((ext_vector_type(2)));
        u32x2v xr[16];
#pragma unroll
        for (int i = 0; i < 16; ++i) xr[i] = *(const u32x2v*)(PROJ + (t0 + wave * 16 + i) * PJ_LD + PJ_V + 4 * lane);
        unsigned ow[4][8];
#pragma unroll
        for (int i4 = 0; i4 < 4; ++i4) {
            float x[4][4], mu[4], var[4];
#pragma unroll
            for (int u = 0; u < 4; ++u) { const u32x2v r = xr[4 * i4 + u]; x[u][0] = bflo(r.x); x[u][1] = bfhi(r.x); x[u][2] = bflo(r.y); x[u][3] = bfhi(r.y); mu[u] = (x[u][0] + x[u][1]) + (x[u][2] + x[u][3]); }
#pragma unroll
            for (int u = 0; u < 4; ++u) mu[u] = wave_sum(mu[u]) * (1.0f / 256.0f);
#pragma unroll
            for (int u = 0; u < 4; ++u) { x[u][0] -= mu[u]; x[u][1] -= mu[u]; x[u][2] -= mu[u]; x[u][3] -= mu[u]; var[u] = (x[u][0] * x[u][0] + x[u][1] * x[u][1]) + (x[u][2] * x[u][2] + x[u][3] * x[u][3]); }
#pragma unroll
            for (int u = 0; u < 4; ++u) var[u] = wave_sum(var[u]) * (1.0f / 256.0f);
#pragma unroll
            for (int u = 0; u < 4; ++u) { const float rstd = rsqrtf(var[u] + EPS);
#pragma unroll
                for (int c = 0; c < 4; ++c) x[u][c] = x[u][c] * rstd * g4[c] + b4[c]; }
#pragma unroll
            for (int c = 0; c < 4; ++c) { ow[c][2 * i4] = pkbf(x[0][c], x[1][c]); ow[c][2 * i4 + 1] = pkbf(x[2][c], x[3][c]); }
        }
#pragma unroll
        for (int c = 0; c < 4; ++c) { LAS v4u* dst = (LAS v4u*)(vnT + (4 * lane + c) * SGU_P + wave * 16);
            dst[0] = (v4u){ow[c][0], ow[c][1], ow[c][2], ow[c][3]}; dst[1] = (v4u){ow[c][4], ow[c][5], ow[c][6], ow[c][7]}; }
    }
    __syncthreads();
    const int g = wave >> 1, dt = wave & 1;
    bf16x8 af[8];
#pragma unroll
    for (int ks = 0; ks < 8; ++ks) af[ks] = *(const LAS bf16x8*)(vnT + (g * 64 + dt * 32 + r32) * SGU_P + 16 * ks + 8 * hi);
    typedef float f32x16s __attribute__((ext_vector_type(16)));
    f32x16s acc[4];
#pragma unroll
    for (int nt = 0; nt < 4; ++nt) {
#pragma unroll
        for (int r = 0; r < 16; ++r) acc[nt][r] = 0.f;
#pragma unroll
        for (int ks = 0; ks < 2 * nt + 2; ++ks) {
            acc[nt] = __builtin_amdgcn_mfma_f32_32x32x16_bf16(af[ks], wf[nt * (nt + 1) + ks], acc[nt], 0, 0, 0);
        }
    }
    typedef unsigned u32x2v __attribute__((ext_vector_type(2)));
    u32x2v uva[4][4]; float biasv[4];
#pragma unroll
    for (int nt = 0; nt < 4; ++nt) { const int t = 32 * nt + r32; biasv[nt] = bs[g * 128 + t]; const bf16* up = PROJ + (t0 + t) * PJ_LD + PJ_U + g * 64 + dt * 32 + 4 * hi;
#pragma unroll
        for (int j = 0; j < 4; ++j) uva[nt][j] = *(const u32x2v*)(up + 8 * j); }
#pragma unroll
    for (int nt = 0; nt < 4; ++nt) {
        const int t = 32 * nt + r32; const float bias = biasv[nt];
        bf16* op = O + (t0 + t) * DM + g * 64 + dt * 32 + 4 * hi;
#pragma unroll
        for (int j = 0; j < 4; ++j) {
            const u32x2v uu = uva[nt][j];
            u32x2v w; w.x = pkbf(bflo(uu.x) * (acc[nt][4 * j] + bias), bfhi(uu.x) * (acc[nt][4 * j + 1] + bias)); w.y = pkbf(bflo(uu.y) * (acc[nt][4 * j + 2] + bias), bfhi(uu.y) * (acc[nt][4 * j + 3] + bias));
            *(u32x2v*)(op + 8 * j) = w;
        }
    }
    __syncthreads();
}

__device__ __forceinline__ void prep_block(LAS unsigned char* lds, bf16* PROJ, const float* __restrict__ ROPE, const float* __restrict__ qn, const float* __restrict__ kn, float* KMEAN, unsigned* kmx_out, int item, const int tid) {
    const int b = item >> 5, blk = (item >> 1) & 15, hf = item & 1;
    const int sub = tid & 7;
    const size_t tok0 = (size_t)b * SEQ + blk * 256 + hf * 128;
    float ksum[8] = {0.f, 0.f, 0.f, 0.f, 0.f, 0.f, 0.f, 0.f};
    float kmx = 0.f;
    f32x4 gq0 = *(const f32x4*)(qn + 8 * sub), gq1 = *(const f32x4*)(qn + 8 * sub + 4), gk0 = *(const f32x4*)(kn + 8 * sub), gk1 = *(const f32x4*)(kn + 8 * sub + 4);
#pragma unroll 1
    for (int pass = 0; pass < 16; pass += 4) {
        v4u raw[4];
#pragma unroll
        for (int u = 0; u < 4; ++u) { const int row = (pass + u) * 64 + (tid >> 3);
            const int tk = row >> 3, which = (row >> 2) & 1, hd = row & 3;
            raw[u] = *(const v4u*)(PROJ + (tok0 + tk) * PJ_LD + (which ? PJ_BK : PJ_BQ) + hd * 64 + 8 * sub); }
#pragma unroll
        for (int u = 0; u < 4; ++u) { const int row = (pass + u) * 64 + (tid >> 3);
            const int tk = row >> 3, which = (row >> 2) & 1, hd = row & 3;
            float v[8]; unpack8(raw[u], v);
            float ss = ((v[0] * v[0] + v[1] * v[1]) + (v[2] * v[2] + v[3] * v[3])) + ((v[4] * v[4] + v[5] * v[5]) + (v[6] * v[6] + v[7] * v[7]));
            ss += swz_xor<1>(ss); ss += swz_xor<2>(ss); ss += swz_xor<4>(ss);
            const float rstd = rsqrtf(ss * (1.0f / 64.0f) + EPS);
            const f32x4 g0 = which ? gk0 : gq0, g1 = which ? gk1 : gq1;
#pragma unroll
            for (int j = 0; j < 4; ++j) { v[j] *= rstd * g0[j]; v[4 + j] *= rstd * g1[j]; }
            const float* tab = ROPE + (tok0 + tk) * 48;
#pragma unroll
            for (int j = 0; j < 8; ++j) { const float other = swz_xor<1>(v[j]);
                if (sub < 2) { const float cs = tab[2 * j], sn = tab[2 * j + 1]; v[j] = (sub == 0) ? (v[j] * cs - other * sn) : (v[j] * cs + other * sn); } }
            if (!which) {
#pragma unroll
                for (int j = 0; j < 8; ++j) v[j] *= QS_B;
            } else {
                float s2 = ((v[0] * v[0] + v[1] * v[1]) + (v[2] * v[2] + v[3] * v[3])) + ((v[4] * v[4] + v[5] * v[5]) + (v[6] * v[6] + v[7] * v[7]));
                s2 += swz_xor<1>(s2); s2 += swz_xor<2>(s2); s2 += swz_xor<4>(s2); kmx = fmaxf(kmx, s2);
#pragma unroll
                for (int j = 0; j < 8; ++j) ksum[j] += v[j];
            }
            *(v4u*)(PROJ + (tok0 + tk) * PJ_LD + (which ? PJ_BK : PJ_BQ) + hd * 64 + 8 * sub) = pack8(v);
        }
    }
    {
        LAS float* kl = (LAS float*)lds; kl[tid] = kmx;
        LAS float* ks = (LAS float*)(lds + 4096);
        if ((tid >> 5) & 1) { LAS f32x4* kd = (LAS f32x4*)(ks + (tid >> 6) * 256 + ((tid >> 3) & 3) * 64 + 8 * sub); kd[0] = (f32x4){ksum[0], ksum[1], ksum[2], ksum[3]}; kd[1] = (f32x4){ksum[4], ksum[5], ksum[6], ksum[7]}; }
        __syncthreads();
        if (tid < 4) { float mx = 0.f; for (int i = 0; i < NTHR; ++i) { const bool mine = (((i >> 5) & 1) == 1) && (((i >> 3) & 3) == tid); mx = mine ? fmaxf(mx, kl[i]) : mx; }
            __hip_atomic_fetch_max(kmx_out + b * 4 + tid, __float_as_uint(mx), __ATOMIC_RELAXED, __HIP_MEMORY_SCOPE_AGENT); }
        if (tid >= 256) { const int hd = tid - 256; float s = 0.f;
#pragma unroll
            for (int w = 0; w < 8; ++w) s += ks[w * 256 + hd];
            KMEAN[(((size_t)(b * 4 + (hd >> 6)) * 16 + blk) * 2 + hf) * 64 + (hd & 63)] = s; }
    }
    __syncthreads();
}

__device__ __forceinline__ void conv_unit(LAS unsigned char* lds, const bf16* PROJ, bf16* O, const float* __restrict__ cw, const float* __restrict__ cb, const float* __restrict__ lng, const float* __restrict__ lnb, int unit, const int tid) {
    LAS float* zc = (LAS float*)lds;
    const int lane = tid & 63, wave = __builtin_amdgcn_readfirstlane(tid >> 6);
    const int b = unit >> 6, p0 = (unit & 63) * 64;
    const int ch = tid & 255, half = tid >> 8;
    {
        typedef unsigned u32x2v __attribute__((ext_vector_type(2)));
        u32x2v av[12], gv[12];
#pragma unroll
        for (int i = 0; i < 12; ++i) { const int r = wave + 8 * i, p = p0 - 30 + r; av[i] = (u32x2v){0u, 0u}; gv[i] = (u32x2v){0u, 0u};
            if (r < 94 && p >= 0) { const bf16* row = PROJ + ((size_t)b * SEQ + p) * PJ_LD; av[i] = *(const u32x2v*)(row + PJ_DA + 4 * lane); gv[i] = *(const u32x2v*)(row + PJ_DG + 4 * lane); } }
#pragma unroll
        for (int i = 0; i < 12; ++i) { const int r = wave + 8 * i;
            if (r < 94) *(LAS f32x4*)(zc + r * 256 + 4 * lane) = (f32x4){bflo(av[i].x) * fast_sigmoid(bflo(gv[i].x)), bfhi(av[i].x) * fast_sigmoid(bfhi(gv[i].x)), bflo(av[i].y) * fast_sigmoid(bflo(gv[i].y)), bfhi(av[i].y) * fast_sigmoid(bfhi(gv[i].y))}; }
    }
    float w[31];
#pragma unroll
    for (int j = 0; j < 31; ++j) w[j] = cw[j * 256 + ch];
    const float bias = cb[ch];
    __syncthreads();
    float acc[32];
    {
        float z[62];
#pragma unroll
        for (int j = 0; j < 62; ++j) z[j] = zc[(half * 32 + j) * 256 + ch];
#pragma unroll
        for (int t = 0; t < 32; ++t) { float a = bias;
#pragma unroll
            for (int j = 0; j < 31; ++j) a += w[j] * z[t + j];
            acc[t] = a; }
    }
    __syncthreads();
#pragma unroll
    for (int t = 0; t < 32; ++t) zc[(half * 32 + t) * 256 + ch] = acc[t];
    __syncthreads();
    const f32x4 g4 = *(const f32x4*)(lng + lane * 4), b4 = *(const f32x4*)(lnb + lane * 4);
    for (int i4 = 0; i4 < 2; ++i4) {
        f32x4 x[4]; float mu[4], var[4];
#pragma unroll
        for (int u = 0; u < 4; ++u) { x[u] = *(const LAS f32x4*)(zc + (wave * 8 + i4 * 4 + u) * 256 + lane * 4); mu[u] = (x[u][0] + x[u][1]) + (x[u][2] + x[u][3]); }
#pragma unroll
        for (int u = 0; u < 4; ++u) mu[u] = wave_sum(mu[u]) * (1.0f / 256.0f);
#pragma unroll
        for (int u = 0; u < 4; ++u) { x[u] = x[u] - mu[u]; var[u] = (x[u][0] * x[u][0] + x[u][1] * x[u][1]) + (x[u][2] * x[u][2] + x[u][3] * x[u][3]); }
#pragma unroll
        for (int u = 0; u < 4; ++u) var[u] = wave_sum(var[u]) * (1.0f / 256.0f);
#pragma unroll
        for (int u = 0; u < 4; ++u) { const float rstd = rsqrtf(var[u] + EPS);
            const float y0 = x[u][0] * rstd * g4[0] + b4[0], y1 = x[u][1] * rstd * g4[1] + b4[1], y2 = x[u][2] * rstd * g4[2] + b4[2], y3 = x[u][3] * rstd * g4[3] + b4[3];
            typedef unsigned u32x2v __attribute__((ext_vector_type(2)));
            u32x2v wv; wv.x = pkbf(fast_silu(y0), fast_silu(y1)); wv.y = pkbf(fast_silu(y2), fast_silu(y3));
            *(u32x2v*)(O + ((size_t)b * SEQ + p0 + wave * 8 + i4 * 4 + u) * DM + 768 + lane * 4) = wv; }
    }
    __syncthreads();
}

typedef float f32x16 __attribute__((ext_vector_type(16)));
template <int DK> struct AttnLds { static constexpr int KBYTES = 64 * DK * 2  , VP = 68, VBYTES = 64 * VP * 2, K0 = 0, K1 = KBYTES, V0 = 2 * KBYTES, V1 = 2 * KBYTES + VBYTES, UM = 2 * KBYTES + 2 * VBYTES; };
__device__ __forceinline__ float half_max(float v) { auto rr = __builtin_amdgcn_permlane32_swap(__float_as_uint(v), __float_as_uint(v), false, false); return fmaxf(__uint_as_float(rr[0]), __uint_as_float(rr[1])); }
#define ATT_FAST_BOUND 30.0f
__device__ __forceinline__ void softmax_fast(f32x16& s, float& l, bf16x8 (&p)[2], const bool diag, const bool blocked, const int qi, const int kbase) {
    if (diag) {
#pragma unroll
        for (int r = 0; r < 16; ++r) { const int key = kbase + (r & 3) + 8 * (r >> 2); if (key > qi) s[r] = -INFINITY; }
    }
    float sum = 0.f;
#pragma unroll
    for (int r = 0; r < 16; ++r) { const float e = __builtin_amdgcn_exp2f(s[r]); s[r] = e; sum += e; }
    v4u w0, w1;
    w0.x = pkbf(s[0], s[1]); w0.y = pkbf(s[2], s[3]); w0.z = pkbf(s[4], s[5]); w0.w = pkbf(s[6], s[7]);
    w1.x = pkbf(s[8], s[9]); w1.y = pkbf(s[10], s[11]); w1.z = pkbf(s[12], s[13]); w1.w = pkbf(s[14], s[15]);
    if (blocked) { sum = 0.f; w0 = (v4u){0u, 0u, 0u, 0u}; w1 = (v4u){0u, 0u, 0u, 0u}; }
    l += sum;
    p[0] = __builtin_bit_cast(bf16x8, w0); p[1] = __builtin_bit_cast(bf16x8, w1);
}
__device__ __forceinline__ void softmax_group(f32x16& s, f32x16 (&o)[2], float& m, float& l, bf16x8 (&p)[2], const bool diag, const bool blocked, const int qi, const int kbase) {
    if (diag) {
#pragma unroll
        for (int r = 0; r < 16; ++r) { const int key = kbase + (r & 3) + 8 * (r >> 2); if (key > qi) s[r] = -INFINITY; }
    }
    float mx = fmaxf(s[0], s[1]);
#pragma unroll
    for (int r = 2; r < 16; ++r) mx = fmaxf(mx, s[r]);
    mx = half_max(mx);
    if (blocked) mx = -INFINITY;
    const float mn = fmaxf(m, mx);
    const float ms = (mn == -INFINITY) ? 0.f : mn;
    const float alpha = __builtin_amdgcn_exp2f(m - ms);
    const float mse = blocked ? INFINITY : ms;
    float sum = 0.f;
#pragma unroll
    for (int r = 0; r < 16; ++r) { const float e = __builtin_amdgcn_exp2f(s[r] - mse); s[r] = e; sum += e; }
    l = l * alpha + sum; m = mn;
    if (__any(alpha != 1.f)) {
#pragma unroll
        for (int dt = 0; dt < 2; ++dt)
#pragma unroll
            for (int r = 0; r < 16; ++r) o[dt][r] *= alpha;
    }
#pragma unroll
    for (int st = 0; st < 2; ++st) { const int bs = 8 * st;
        v4u w; w.x = pkbf(s[bs], s[bs + 1]); w.y = pkbf(s[bs + 2], s[bs + 3]); w.z = pkbf(s[bs + 4], s[bs + 5]); w.w = pkbf(s[bs + 6], s[bs + 7]);
        p[st] = __builtin_bit_cast(bf16x8, w); }
}
template <int NKS, int DK>
__device__ __forceinline__ float qpost(bf16x8 (&qf)[NKS], const float* __restrict__ qgain, const float* __restrict__ tabrow, const int hi) {
    float qv[8 * NKS]; float ss = 0.f;
#pragma unroll
    for (int ks = 0; ks < NKS; ++ks) unpack8(__builtin_bit_cast(v4u, qf[ks]), qv + 8 * ks);
#pragma unroll
    for (int i = 0; i < 8 * NKS; ++i) ss += qv[i] * qv[i];
    const float rstd = rsqrtf(half_sum(ss) * (1.0f / (float)DK) + EPS);
#pragma unroll
    for (int ks = 0; ks < NKS; ++ks) { const f32x4 ga = *(const f32x4*)(qgain + 16 * ks + 8 * hi), gb = *(const f32x4*)(qgain + 16 * ks + 8 * hi + 4);
#pragma unroll
        for (int j = 0; j < 4; ++j) { qv[8 * ks + j] *= rstd * ga[j]; qv[8 * ks + 4 + j] *= rstd * gb[j]; } }
    const float* tb = tabrow + 16 + 16 * hi;
#pragma unroll
    for (int j = 0; j < 8; ++j) { const float cs = tb[2 * j], sn = tb[2 * j + 1], x1 = qv[32 + j], x2 = qv[40 + j]; qv[32 + j] = x1 * cs - x2 * sn; qv[40 + j] = x2 * cs + x1 * sn; }
    float q2 = 0.f;
#pragma unroll
    for (int i = 0; i < 8 * NKS; ++i) { qv[i] *= QS_C; q2 += qv[i] * qv[i]; }
#pragma unroll
    for (int ks = 0; ks < NKS; ++ks) qf[ks] = __builtin_bit_cast(bf16x8, pack8(qv + 8 * ks));
    return half_sum(q2);
}
template <int DK, bool MOBA, bool QPOST, int qp, int qhs, int kp, int khs, int vp, int vhs, int op>
__device__ __forceinline__ void attn_unit(LAS unsigned char* lds, const bf16* __restrict__ Q, const bf16* __restrict__ K,
                                          const bf16* __restrict__ V, bf16* O, const int b, const int h, const int qc, const float* __restrict__ kmean, const float* __restrict__ qgain, const float* __restrict__ rope, const unsigned* __restrict__ kmx, const int tid) {
    using L = AttnLds<DK>;
    constexpr int NKS = DK / 16, KCH = DK / 8;
    const int lane = tid & 63, w = __builtin_amdgcn_readfirstlane(tid >> 6), r32 = lane & 31, hi = lane >> 5;
    const int q0 = qc * 512;
    const size_t tokbase = (size_t)b * SEQ;
    const int g0 = w, g1 = 15 - w;
    const int qi0 = q0 + 32 * g0 + r32, qi1 = q0 + 32 * g1 + r32;
    const int tl0 = (q0 + 32 * g0 + 31) >> 6, tl1 = (q0 + 32 * g1 + 31) >> 6;
    const int ob0 = (q0 + 32 * g0) >> 8, ob1 = (q0 + 32 * g1) >> 8;
    bf16x8 qf0[NKS], qf1[NKS];
    { const bf16* p0 = Q + (tokbase + qi0) * qp + h * qhs + 8 * hi;
#pragma unroll
      for (int ks = 0; ks < NKS; ++ks) qf0[ks] = *(const bf16x8*)(p0 + 16 * ks); }
    float q2a = 0.f, q2b = 0.f;
    if (QPOST) { q2a = qpost<NKS, DK>(qf0, qgain, rope + (tokbase + qi0) * 48, hi); asm volatile("" ::: "memory"); }
    { const bf16* p1 = Q + (tokbase + qi1) * qp + h * qhs + 8 * hi;
#pragma unroll
      for (int ks = 0; ks < NKS; ++ks) qf1[ks] = *(const bf16x8*)(p1 + 16 * ks); }
    if (QPOST) { q2b = qpost<NKS, DK>(qf1, qgain, rope + (tokbase + qi1) * 48, hi); asm volatile("" ::: "memory"); }
    unsigned mk0 = 0u, mk1 = 0u, umask = 0xffffffffu;
    if (MOBA) {
        LAS float* kml = (LAS float*)(lds + L::UM + 16);
        { const float* kmg = kmean + (size_t)(b * 4 + h) * 16 * 128;
          for (int i = tid; i < 1024; i += NTHR) { const int n = i >> 6, d = i & 63; kml[i] = (kmg[n * 128 + d] + kmg[n * 128 + 64 + d]) * (1.0f / 256.0f); } }
        __syncthreads();
        const LAS float* km = kml + 8 * hi;
#pragma unroll
        for (int g = 0; g < 2; ++g) {
            float qv[8 * NKS];
#pragma unroll
            for (int ks = 0; ks < NKS; ++ks) unpack8(__builtin_bit_cast(v4u, g ? qf1[ks] : qf0[ks]), qv + 8 * ks);
            { float q2 = 0.f;
#pragma unroll
              for (int i = 0; i < 8 * NKS; ++i) q2 += qv[i] * qv[i];
              q2 = half_sum(q2); if (g) q2b = q2; else q2a = q2; }
            const int ob = g ? ob1 : ob0;
            float s0 = -INFINITY, s1 = -INFINITY, s2 = -INFINITY; int i0 = 0, i1 = 0, i2 = 0;
            for (int n = 0; n < ob; ++n) {
                const LAS float* kmp = km + n * 64; float sc = 0.f;
#pragma unroll
                for (int ks = 0; ks < NKS; ++ks) { const f32x4 ka = *(const LAS f32x4*)(kmp + 16 * ks), kb2 = *(const LAS f32x4*)(kmp + 16 * ks + 4);
                    sc += qv[8 * ks] * ka[0]; sc += qv[8 * ks + 1] * ka[1]; sc += qv[8 * ks + 2] * ka[2]; sc += qv[8 * ks + 3] * ka[3];
                    sc += qv[8 * ks + 4] * kb2[0]; sc += qv[8 * ks + 5] * kb2[1]; sc += qv[8 * ks + 6] * kb2[2]; sc += qv[8 * ks + 7] * kb2[3]; }
                sc = half_sum(sc);
                if (sc > s0) { s2 = s1; i2 = i1; s1 = s0; i1 = i0; s0 = sc; i0 = n; }
                else if (sc > s1) { s2 = s1; i2 = i1; s1 = sc; i1 = n; }
                else if (sc > s2) { s2 = sc; i2 = n; }
            }
            unsigned mk = 0u; if (ob > 0) mk |= 1u << i0; if (ob > 1) mk |= 1u << i1; if (ob > 2) mk |= 1u << i2;
            if (g) mk1 = mk; else mk0 = mk;
        }
        LAS unsigned* um = (LAS unsigned*)(lds + L::UM);
        if (tid == 0) *um = 0u;
        __syncthreads();
        __hip_atomic_fetch_or(um, mk0 | mk1, __ATOMIC_RELAXED, __HIP_MEMORY_SCOPE_WORKGROUP);
        __syncthreads();
        umask = *um;
    }
    const float k2m = __uint_as_float(__hip_atomic_load(kmx + b * 4 + h, __ATOMIC_RELAXED, __HIP_MEMORY_SCOPE_AGENT));
    const bool fast = __all(fmaxf(q2a, q2b) * k2m <= ATT_FAST_BOUND * ATT_FAST_BOUND);
    const int ntile = qc * 8 + 8;
    v4u vreg = {0u, 0u, 0u, 0u};
#define ATT_NEEDED(t) (!MOBA || ((t) >> 2) >= 2 * qc || ((umask >> ((t) >> 2)) & 1u))
#define ATT_LOADK(t, buf) do { const bf16* kt_ = K + (tokbase + (size_t)(t) * 64) * kp + h * khs; int ln_ = lane; asm volatile("" : "+v"(ln_)); \
        LAS unsigned char* kd_ = lds + ((buf) ? L::K1 : L::K0) + w * 1024; \
        __builtin_amdgcn_global_load_lds((const unsigned*)(kt_ + ln_ * kp + w * 8), (LAS unsigned*)kd_, 16, 0, 0); \
        if (DK == 96 && w < 4) __builtin_amdgcn_global_load_lds((const unsigned*)(kt_ + ln_ * kp + (8 + w) * 8), (LAS unsigned*)(kd_ + 8192), 16, 0, 0); } while (0)
#define ATT_LOADV(t) do { int t2_ = tid; asm volatile("" : "+v"(t2_)); const int vkey = t2_ >> 3, vch = t2_ & 7; \
        vreg = *(const v4u*)(V + (tokbase + (size_t)(t) * 64) * vp + (vkey * vp + h * vhs + vch * 8)); } while (0)
    unsigned krd_lane = (unsigned)(hi * 1024 + r32 * 16), vrd_lane = (unsigned)((r32 * L::VP + 4 * hi) * 2);
    asm volatile("" : "+v"(krd_lane), "+v"(vrd_lane));
#define ATT_STOREV(buf) do { int t2_ = tid; asm volatile("" : "+v"(t2_)); const int vkey = t2_ >> 3, vch = t2_ & 7; \
        LAS unsigned char* vtb_ = lds + ((buf) ? L::V1 : L::V0) + ((vch * 8) * L::VP + vkey) * 2; asm volatile("" : "+v"(vtb_)); LAS bf16* vt_ = (LAS bf16*)vtb_; \
        vt_[0 * L::VP] = (bf16)(vreg.x & 0xffffu); vt_[1 * L::VP] = (bf16)(vreg.x >> 16); vt_[2 * L::VP] = (bf16)(vreg.y & 0xffffu); vt_[3 * L::VP] = (bf16)(vreg.y >> 16); \
        vt_[4 * L::VP] = (bf16)(vreg.z & 0xffffu); vt_[5 * L::VP] = (bf16)(vreg.z >> 16); vt_[6 * L::VP] = (bf16)(vreg.w & 0xffffu); vt_[7 * L::VP] = (bf16)(vreg.w >> 16); } while (0)
    int t = 0; while (t < ntile && !ATT_NEEDED(t)) t += 4;
    ATT_LOADK(t, 0); ATT_LOADV(t); ATT_STOREV(0);
    asm volatile("s_waitcnt vmcnt(0)" ::: "memory");
    __syncthreads();
    f32x16 o0[2], o1[2];
#pragma unroll
    for (int dt = 0; dt < 2; ++dt)
#pragma unroll
        for (int r = 0; r < 16; ++r) { o0[dt][r] = 0.f; o1[dt][r] = 0.f; }
    float m0 = -INFINITY, m1 = -INFINITY, l0 = 0.f, l1 = 0.f;
    int cur = 0;
#define ATT_LOOP(FASTP) do { \
    while (t < ntile) { \
        int tn = t + 1; while (tn < ntile && (tn & 3) == 0 && !ATT_NEEDED(tn)) tn += 4; \
        if (tn < ntile) { ATT_LOADK(tn, cur ^ 1); ATT_LOADV(tn); }    \
        const int nblk = t >> 2; \
        bool a0 = (t <= tl0), a1 = (t <= tl1); \
        bool bl0 = false, bl1 = false; \
        if (MOBA) { \
            bl0 = (nblk != ob0) && !((mk0 >> nblk) & 1u); bl1 = (nblk != ob1) && !((mk1 >> nblk) & 1u); \
            a0 = a0 && __any(!bl0); a1 = a1 && __any(!bl1); \
        } \
        if (a0 || a1) { \
            const LAS unsigned char* kb = lds + (cur ? L::K1 : L::K0) + krd_lane; const LAS unsigned char* vb = lds + (cur ? L::V1 : L::V0) + vrd_lane; \
            asm volatile("" : "+v"(kb), "+v"(vb)); \
_Pragma("unroll") \
            for (int kt = 0; kt < 2; ++kt) { \
                f32x16 s0, s1; \
_Pragma("unroll") \
                for (int r = 0; r < 16; ++r) { s0[r] = 0.f; s1[r] = 0.f; } \
_Pragma("unroll") \
                for (int ks = 0; ks < NKS; ++ks) { \
                    const bf16x8 kf = *(const LAS bf16x8*)(kb + (2 * ks * 1024 + 32 * kt * 16)); \
                    if (a0) s0 = __builtin_amdgcn_mfma_f32_32x32x16_bf16(kf, qf0[ks], s0, 0, 0, 0); \
                    if (a1) s1 = __builtin_amdgcn_mfma_f32_32x32x16_bf16(kf, qf1[ks], s1, 0, 0, 0); \
                } \
                bf16x8 p0[2], p1[2]; \
                const int kbase = 64 * t + 32 * kt + 4 * hi; \
                if (a0) { if (FASTP) softmax_fast(s0, l0, p0, t == tl0, bl0, qi0, kbase); else softmax_group(s0, o0, m0, l0, p0, t == tl0, bl0, qi0, kbase); } \
                __builtin_amdgcn_sched_barrier(0);    \
                if (a1) { if (FASTP) softmax_fast(s1, l1, p1, t == tl1, bl1, qi1, kbase); else softmax_group(s1, o1, m1, l1, p1, t == tl1, bl1, qi1, kbase); } \
                __builtin_amdgcn_sched_barrier(0); \
_Pragma("unroll") \
                for (int st = 0; st < 2; ++st) \
_Pragma("unroll") \
                    for (int dt = 0; dt < 2; ++dt) { \
                        typedef unsigned u32x2v __attribute__((ext_vector_type(2))); \
                        const LAS unsigned char* vp_ = vb + (32 * dt * L::VP + 32 * kt + 16 * st) * 2; \
                        const u32x2v va = *(const LAS u32x2v*)vp_, vc = *(const LAS u32x2v*)(vp_ + 16); \
                        const v4u vv = {va.x, va.y, vc.x, vc.y}; const bf16x8 vf = __builtin_bit_cast(bf16x8, vv); \
                        if (a0) o0[dt] = __builtin_amdgcn_mfma_f32_32x32x16_bf16(vf, p0[st], o0[dt], 0, 0, 0); \
                        if (a1) o1[dt] = __builtin_amdgcn_mfma_f32_32x32x16_bf16(vf, p1[st], o1[dt], 0, 0, 0); \
                    } \
            } \
        } \
        if (tn < ntile) ATT_STOREV(cur ^ 1); \
        asm volatile("s_waitcnt vmcnt(0)" ::: "memory"); \
        __syncthreads(); \
        t = tn; cur ^= 1; \
    } \
    } while (0)
    if (fast) ATT_LOOP(true); else ATT_LOOP(false);
#undef ATT_LOOP
#undef ATT_NEEDED
#undef ATT_LOADK
#undef ATT_LOADV
#undef ATT_STOREV
    {
        typedef unsigned u32x2v __attribute__((ext_vector_type(2)));
        const float i0 = 1.0f / half_sum(l0), i1 = 1.0f / half_sum(l1);
        bf16* d0 = O + (tokbase + qi0) * op + h * 64 + 4 * hi; bf16* d1 = O + (tokbase + qi1) * op + h * 64 + 4 * hi;
#pragma unroll
        for (int dt = 0; dt < 2; ++dt)
#pragma unroll
            for (int j = 0; j < 4; ++j) {
                u32x2v wa; wa.x = pkbf(o0[dt][4 * j] * i0, o0[dt][4 * j + 1] * i0); wa.y = pkbf(o0[dt][4 * j + 2] * i0, o0[dt][4 * j + 3] * i0); *(u32x2v*)(d0 + 32 * dt + 8 * j) = wa;
                u32x2v wb; wb.x = pkbf(o1[dt][4 * j] * i1, o1[dt][4 * j + 1] * i1); wb.y = pkbf(o1[dt][4 * j + 2] * i1, o1[dt][4 * j + 3] * i1); *(u32x2v*)(d1 + 32 * dt + 8 * j) = wb;
            }
    }
}
struct Args { const void* in[31]; float* out; unsigned char* ws; int ph_lo, ph_hi; };
constexpr int N_PHASES = 1 + 8 + 11 + 8 + 11;
typedef const __attribute__((address_space(4))) Args* KArgs;
__device__ __forceinline__ KArgs kargs() { KArgs p = (KArgs)__builtin_amdgcn_kernarg_segment_ptr(); asm volatile("" : "+s"(p)); return p; }
#define IN_F(i) ((const float*)A->in[i])
#define WSP(type, off) ((type*)(ws + (off)))
#ifndef TPROBE
#define TPROBE 0
#endif
#define TP_BID 203
#define TP_ACC(lds) ((LAS unsigned long long*)((lds) + MISC_OFF + 64))
#define TP_BEGIN(id) unsigned long long tp0_##id = 0ull; if (TPROBE == (id)) { __syncthreads(); tp0_##id = __builtin_amdgcn_s_memrealtime(); }
#define TP_END(id, lds) if (TPROBE == (id)) { __syncthreads(); if (blockIdx.x == TP_BID && threadIdx.x == 0) *TP_ACC(lds) += __builtin_amdgcn_s_memrealtime() - tp0_##id; }
struct Ctx { int tid, lane, wave, G, bid, gw, NGW, gt, NGT; };
__device__ __forceinline__ Ctx mkctx(int wv) {
    Ctx c; unsigned m = ~0u; asm volatile("" : "+s"(m)); const int ln = (int)__builtin_amdgcn_mbcnt_hi(m, __builtin_amdgcn_mbcnt_lo(m, 0u));
    int b = blockIdx.x; asm volatile("" : "+s"(b)); int w = wv; asm volatile("" : "+s"(w));
    c.tid = w * 64 + ln; c.lane = ln; c.wave = w; c.G = gridDim.x; c.bid = b;
    c.gw = c.bid * NWAVES + c.wave; c.NGW = c.G * NWAVES; c.gt = c.bid * NTHR + c.tid; c.NGT = c.G * NTHR; return c; }

__device__ __forceinline__ void conv_mixer_weights(int wv, LAS unsigned char* lds, int l) {
    const Ctx c = mkctx(wv);
    KArgs A = kargs(); unsigned char* ws = A->ws;
    const int lane = c.lane, gw = c.gw, NGW = c.NGW, gt = c.gt, NGT = c.NGT;
    LAS float* scr = (LAS float*)(lds + RING_OFF + c.wave * 16384); LAS TrDesc* tab = (LAS TrDesc*)(lds + RING_OFF + TR_TAB_OFF); asm volatile("" : "+v"(tab));
    bf16* WINR = WSP(bf16, W_INR); bf16* WUQ = WSP(bf16, W_UQ); bf16* WUKV = WSP(bf16, W_UKV);
    int total = 0;
    if (c.tid == 0) {
        int n = 0, cum = 0;
        const float* an = IN_F(2) + l * DM; const float* win = IN_F(4) + (size_t)l * DM * IN_COLS;
        tr_add(tab, n, cum, win, IN_COLS, DM, 4096, 0, WSP(bf16, W_G), DM, 0, 3, an);
        tr_add(tab, n, cum, win, IN_COLS, DM, 1280, 4096, WINR, DM, 0, 0, an);
        tr_add(tab, n, cum, win, IN_COLS, DM, 512, 5728, WINR, DM, 1280, 0, an);
        tr_add(tab, n, cum, win, IN_COLS, DM, 352, 5376, WINR, DM, 1792, 0, an);
        tr_add(tab, n, cum, IN_F(13) + (size_t)l * 192 * 384, 384, 192, 384, 0, WUQ, 256, 0, 0, IN_F(11) + l * 192);
        tr_add(tab, n, cum, IN_F(14) + (size_t)l * 128 * 512, 512, 128, 512, 0, WUKV, 256, 0, 2, IN_F(12) + l * 128);
        for (int nb = 0; nb < 4; ++nb) tr_add(tab, n, cum, IN_F(21) + ((size_t)l * 4 + nb) * 256 * DM, DM, 256, DM, 0, WSP(bf16, W_B), 256, nb * 1024, 0, nullptr);
        tr_add(tab, n, cum, IN_F(22) + (size_t)l * DM * DM, DM, DM, DM, 0, WSP(bf16, W_OUT), DM, 0, 0, nullptr);
        tab[n].cum = cum; tab[31].cum = cum;
    }
    __syncthreads();
    total = tab[31].cum;
    tr_run(tab, total, scr, lane, gw, NGW);
    unsigned zz = 0u; asm volatile("" : "+v"(zz)); const v4u z4 = {zz, zz, zz, zz};
    for (int i = gt; i < 160 * DM / 8; i += NGT) ((v4u*)(WINR + (size_t)2144 * DM))[i] = z4;
    for (int i = gt; i < 128 * 256 / 8; i += NGT) ((v4u*)(WUQ + (size_t)384 * 256))[i] = z4;
    for (int i = gt; i < 384 * 8; i += NGT) ((v4u*)(WUQ + (size_t)(i >> 3) * 256 + 192))[i & 7] = z4;
    for (int i = gt; i < 512 * 16; i += NGT) ((v4u*)(WUKV + (size_t)(i >> 4) * 256 + 128))[i & 15] = z4;
    {
        const float* wsrc = IN_F(7) + (size_t)l * 4 * 128 * 128; bf16* wm = WSP(bf16, MS_WSGU);
        for (int i = gt; i < 4 * 128 * 128 / 8; i += NGT) {
            const int t = (i >> 4) & 127, s0 = (i & 15) * 8; const f32x4 a = *(const f32x4*)(wsrc + (size_t)i * 8), b = *(const f32x4*)(wsrc + (size_t)i * 8 + 4);
            float f[8] = {a[0], a[1], a[2], a[3], b[0], b[1], b[2], b[3]};
#pragma unroll
            for (int j = 0; j < 8; ++j) f[j] = (s0 + j <= t) ? f[j] : 0.f;
            *(v4u*)(wm + (size_t)i * 8) = pack8(f);
        }
    }
    __syncthreads();
}
__device__ __forceinline__ void conv_ffn_weights(int wv, LAS unsigned char* lds, int l) {
    const Ctx c = mkctx(wv);
    KArgs A = kargs(); unsigned char* ws = A->ws;
    LAS float* scr = (LAS float*)(lds + RING_OFF + c.wave * 16384); LAS TrDesc* tab = (LAS TrDesc*)(lds + RING_OFF + TR_TAB_OFF); asm volatile("" : "+v"(tab));
    if (c.tid == 0) {
        int n = 0, cum = 0; const bool moe = (l & 1) != 0; const int li = l >> 1; const float* fn = IN_F(3) + l * DM;
        if (!moe) {
            tr_add(tab, n, cum, IN_F(23) + (size_t)li * DM * FFN, FFN, DM, FFN, 0, WSP(bf16, W_F1), DM, 0, 1, fn);
            tr_add(tab, n, cum, IN_F(24) + (size_t)li * DM * FFN, FFN, DM, FFN, 0, WSP(bf16, W_F1), DM, 128, 1, fn);
            tr_add(tab, n, cum, IN_F(25) + (size_t)li * FFN * DM, DM, FFN, DM, 0, WSP(bf16, W_F2), FFN, 0, 0, nullptr);
        } else {
            for (int e = 0; e < NE; ++e) {
                tr_add(tab, n, cum, IN_F(28) + ((size_t)li * NE + e) * DM * EDIM, EDIM, DM, EDIM, 0, WSP(bf16, W_F1), DM, e * 2 * EDIM, 1, fn);
                tr_add(tab, n, cum, IN_F(29) + ((size_t)li * NE + e) * DM * EDIM, EDIM, DM, EDIM, 0, WSP(bf16, W_F1), DM, e * 2 * EDIM + 128, 1, fn);
                tr_add(tab, n, cum, IN_F(30) + ((size_t)li * NE + e) * EDIM * DM, DM, EDIM, DM, 0, WSP(bf16, W_F2), EDIM, e * DM, 0, nullptr);
            }
        }
        tab[n].cum = cum; tab[31].cum = cum;
    }
    __syncthreads();
    tr_run(tab, tab[31].cum, scr, c.lane, c.gw, c.NGW);
    __syncthreads();
}
__device__ __forceinline__ void ph_prologue(int wv, LAS unsigned char* lds) {
    conv_mixer_weights(wv, lds, 0);
    const Ctx c = mkctx(wv);
    KArgs A = kargs(); unsigned char* ws = A->ws;
    const int lane = c.lane, gw = c.gw, NGW = c.NGW, gt = c.gt, NGT = c.NGT;
    {
        const float* x_in = IN_F(0); const int* positions = (const int*)A->in[1];
        bf16* XB = WSP(bf16, WS_XB); float* SSA = WSP(float, WS_SSA); float* ROPE = WSP(float, WS_ROPE);
        for (int mrow = gw; mrow < T; mrow += NGW) {
            const f32x4* xr = (const f32x4*)(x_in + (size_t)mrow * DM) + lane; float s = 0.f;
            typedef unsigned u32x2v __attribute__((ext_vector_type(2)));
            u32x2v* o8 = (u32x2v*)(XB + (size_t)mrow * DM) + lane;
#pragma unroll
            for (int j = 0; j < 4; ++j) { const f32x4 v = xr[64 * j]; s += (v[0] * v[0] + v[1] * v[1]) + (v[2] * v[2] + v[3] * v[3]); u32x2v w; w.x = pkbf(v[0], v[1]); w.y = pkbf(v[2], v[3]); o8[64 * j] = w; }
            s = wave_sum(s);
            if (lane < 4) SSA[(size_t)mrow * 4 + lane] = (lane == 0) ? s : 0.f;
        }
        for (int i = gt; i < T * 24; i += NGT) {
            const int tok = i / 24, a = i - tok * 24;
            const float inv = (a < 8) ? powf(500000.0f, -(float)a * 0.125f) : powf(500000.0f, -(float)(a - 8) * 0.0625f);
            const float ang = (float)positions[tok] * inv; float sn, cs; sincosf(ang, &sn, &cs);
            ROPE[(size_t)tok * 48 + 2 * a] = cs; ROPE[(size_t)tok * 48 + 2 * a + 1] = sn;
        }
    }
}
__device__ __forceinline__ void ph_inproj(int wv, LAS unsigned char* lds) {
    const Ctx c = mkctx(wv);
    KArgs A = kargs(); unsigned char* ws = A->ws;
    pg8::Gemm g{WSP(bf16, WS_XB), WSP(bf16, W_INR), DM, DM, DM}; pg8::StaticOrder S; S.init(T, PJ_LD, c.G, c.bid);
    pg8::EpiScale<0> E{WSP(bf16, B_PROJ), PJ_LD, pg8::RowScale{WSP(float, WS_SSA), 1}, WSP(float, WS_SSC)};
    pg8::gemm_phase<pg8::EpiScale<0>, pg8::StaticOrder, true, true>(lds + RING_OFF, g, S, E, c.tid);
}
__device__ __forceinline__ void mla_up_gemms(int wv, LAS unsigned char* lds, int l) {
    const Ctx c = mkctx(wv);
    { KArgs A = kargs(); unsigned char* ws = A->ws;
      pg8::Gemm g{WSP(bf16, B_PROJ) + PJ_CQ, WSP(bf16, W_UQ), PJ_LD, 256, 256}; pg8::StaticOrder S; S.init(T, 512, c.G, c.bid);
      pg8::EpiScale<0> E{WSP(bf16, B_QPRE), 512, pg8::RowScale{WSP(float, WS_SSC), 3}, nullptr};
      pg8::gemm_phase<pg8::EpiScale<0>, pg8::StaticOrder, true, true>(lds + RING_OFF, g, S, E, c.tid); }
    { KArgs A = kargs(); unsigned char* ws = A->ws;
      pg8::Gemm g{WSP(bf16, B_PROJ) + PJ_CKV, WSP(bf16, W_UKV), PJ_LD, 256, 256}; pg8::StaticOrder S; S.init(T, 512, c.G, c.bid);
      pg8::EpiKV E{WSP(bf16, B_CK), WSP(bf16, B_KVPRE), WSP(bf16, B_PROJ), WSP(float, WS_SSC), WSP(float, WS_ROPE), IN_F(16) + l * 96, (unsigned*)(ws + WS_CTL) + CW_KMX + (l * 2 + 1) * 32};
      pg8::gemm_phase<pg8::EpiKV, pg8::StaticOrder, true, true>(lds + RING_OFF, g, S, E, c.tid); }
}
__device__ __forceinline__ void ph_prep(int wv, LAS unsigned char* lds, int l) {
    TP_BEGIN(4) mla_up_gemms(wv, lds, l); TP_END(4, lds)
    {
        const Ctx c = mkctx(wv);
        KArgs A = kargs(); unsigned char* ws = A->ws;
        bf16* PROJ = WSP(bf16, B_PROJ); bf16* OB = WSP(bf16, B_O);
        TP_BEGIN(5) for (int it = c.bid; it < NB * 32; it += c.G) prep_block(lds + RING_OFF, PROJ, WSP(float, WS_ROPE), IN_F(9) + l * 64, IN_F(10) + l * 64, WSP(float, MS_KMEAN), (unsigned*)(ws + WS_CTL) + CW_KMX + (l * 2 + 0) * 32, it, c.tid); TP_END(5, lds)
        TP_BEGIN(6) for (int u = c.bid; u < T / 128; u += c.G) sgu_unit(lds + RING_OFF, PROJ, OB, IN_F(5) + l * 256, IN_F(6) + l * 256, WSP(bf16, MS_WSGU), IN_F(8) + l * 4 * 128, u, c.tid); TP_END(6, lds)
        TP_BEGIN(7) for (int u = c.bid; u < T / 64; u += c.G) conv_unit(lds + RING_OFF, PROJ, OB, IN_F(17) + (size_t)l * 31 * 256, IN_F(18) + l * 256, IN_F(19) + l * 256, IN_F(20) + l * 256, u, c.tid); TP_END(7, lds)
        __syncthreads();
    }
    TP_BEGIN(8) conv_ffn_weights(wv, lds, l); TP_END(8, lds)
}
template <int WHICH>
__device__ __forceinline__ void mla_post_pass(const Ctx& c, int l) {
    KArgs A = kargs(); unsigned char* ws = A->ws;
    const float* gn = IN_F(WHICH ? 16 : 15) + l * 96;
    const bf16* PROJ = WSP(bf16, B_PROJ); const bf16* QPRE = WSP(bf16, B_QPRE); const bf16* KVPRE = WSP(bf16, B_KVPRE);
    bf16* DST = WHICH ? WSP(bf16, B_CK) : WSP(bf16, B_CQ); const float* ROPE = WSP(float, WS_ROPE);
    for (int idx = c.gt; idx < T * 4; idx += c.NGT) {
        const int tok = idx >> 2, h = idx & 3; const float* tab = ROPE + (size_t)tok * 48 + 16;
        float v[96]; float ss = 0.f;
        if (WHICH == 0) {
#pragma unroll
            for (int cc = 0; cc < 12; ++cc) unpack8(((const v4u*)(QPRE + (size_t)tok * 512 + h * 96))[cc], v + 8 * cc);
        } else {
#pragma unroll
            for (int cc = 0; cc < 8; ++cc) unpack8(((const v4u*)(KVPRE + (size_t)tok * 512 + h * 128))[cc], v + 8 * cc);
#pragma unroll
            for (int cc = 0; cc < 4; ++cc) unpack8(((const v4u*)(PROJ + (size_t)tok * PJ_LD + PJ_KR))[cc], v + 64 + 8 * cc);
        }
#pragma unroll
        for (int d = 0; d < 96; ++d) ss += v[d] * v[d];
        const float rstd = rsqrtf(ss * (1.0f / 96.0f) + EPS);
#pragma unroll
        for (int d = 0; d < 96; ++d) v[d] = v[d] * rstd * gn[d];
#pragma unroll
        for (int i = 0; i < 16; ++i) { const float cs = tab[2 * i], sn = tab[2 * i + 1], x1 = v[64 + i], x2 = v[80 + i]; v[64 + i] = x1 * cs - x2 * sn; v[80 + i] = x2 * cs + x1 * sn; }
        if (WHICH == 0) {
#pragma unroll
            for (int d = 0; d < 96; ++d) v[d] *= QS_C;
        }
        bf16* dst = DST + (size_t)tok * 384 + h * 96;
#pragma unroll
        for (int cc = 0; cc < 12; ++cc) ((v4u*)dst)[cc] = pack8(v + 8 * cc);
    }
}
__device__ __forceinline__ void ph_mla_post(int wv, int l) {
    { const Ctx c = mkctx(wv); mla_post_pass<0>(c, l); }
    { const Ctx c = mkctx(wv); mla_post_pass<1>(c, l); }
}
__device__ __forceinline__ void ph_attn(int wv, LAS unsigned char* lds, int l) {
    const Ctx c = mkctx(wv);
    for (int u = c.bid; u < NB * 4 * 8; u += c.G) {
        const int qc = u & 7, h = (u >> 3) & 3, b = u >> 5;
        TP_BEGIN(1) { KArgs A = kargs(); unsigned char* ws = A->ws;
          attn_unit<96, false, true, 512, 96, 384, 96, 256, 64, DM>(lds + RING_OFF, WSP(bf16, B_QPRE), WSP(bf16, B_CK), WSP(bf16, B_KVPRE), WSP(bf16, B_O) + 512, b, h, qc, nullptr, IN_F(15) + l * 96, WSP(float, WS_ROPE), (const unsigned*)(ws + WS_CTL) + CW_KMX + (l * 2 + 1) * 32, c.tid); } TP_END(1, lds)
        TP_BEGIN(2) { KArgs A = kargs(); unsigned char* ws = A->ws; bf16* PROJ = WSP(bf16, B_PROJ);
          attn_unit<64, true, false, PJ_LD, 64, PJ_LD, 64, PJ_LD, 64, DM>(lds + RING_OFF, PROJ + PJ_BQ, PROJ + PJ_BK, PROJ + PJ_BV, WSP(bf16, B_O) + 256, b, h, 7 - qc, WSP(float, MS_KMEAN), nullptr, nullptr, (const unsigned*)(ws + WS_CTL) + CW_KMX + (l * 2 + 0) * 32, c.tid); } TP_END(2, lds)
    }
}
__device__ __forceinline__ void ph_gates(int wv, LAS unsigned char* lds) {
    const Ctx c = mkctx(wv);
    KArgs A = kargs(); unsigned char* ws = A->ws;
    pg8::Gemm g{WSP(bf16, WS_XB), WSP(bf16, W_G), DM, DM, DM}; pg8::StaticOrder S; S.init(T, 4096, c.G, c.bid);
    pg8::EpiGates E{WSP(bf16, B_SG), pg8::RowScale{WSP(float, WS_SSA), 1}};
    pg8::gemm_phase<pg8::EpiGates, pg8::StaticOrder, true, true>(lds + RING_OFF, g, S, E, c.tid);
}
__device__ __forceinline__ void ph_merge(int wv, LAS unsigned char* lds) {
    const Ctx c = mkctx(wv);
    KArgs A = kargs(); unsigned char* ws = A->ws;
    pg8::Gemm g{WSP(bf16, B_O), WSP(bf16, W_B), DM, 256, 256}; pg8::MergeOrder S; S.so.init(T, DM, c.G, c.bid);
    pg8::EpiMerge E{WSP(bf16, B_SG), WSP(bf16, B_Y)};
    pg8::gemm_phase<pg8::EpiMerge, pg8::MergeOrder, true, true>(lds + RING_OFF, g, S, E, c.tid);
}
__device__ __forceinline__ void ph_wout(int wv, LAS unsigned char* lds, int l) {
    const Ctx c = mkctx(wv);
    KArgs A = kargs(); unsigned char* ws = A->ws;
    pg8::Gemm g{WSP(bf16, B_Y), WSP(bf16, W_OUT), DM, DM, DM}; pg8::StaticOrder S; S.init(T, DM, c.G, c.bid);
    pg8::EpiResidual E{l == 0 ? IN_F(0) : (const float*)A->out, A->out, WSP(bf16, WS_XB), WSP(float, WS_SSB), (LAS float*)(lds + EPI_RED_OFF)};
    pg8::gemm_phase<pg8::EpiResidual, pg8::StaticOrder, true, true>(lds + RING_OFF, g, S, E, c.tid);
}
__device__ __forceinline__ void ph_ffn_up(int wv, LAS unsigned char* lds) {
    const Ctx c = mkctx(wv);
    KArgs A = kargs(); unsigned char* ws = A->ws;
    pg8::Gemm g{WSP(bf16, WS_XB), WSP(bf16, W_F1), DM, DM, DM}; pg8::StaticOrder S; S.init(T, 2 * FFN, c.G, c.bid);
    pg8::EpiScale<2> E{WSP(bf16, B_HID), FFN, pg8::RowScale{WSP(float, WS_SSB), 1}, nullptr};
    pg8::gemm_phase<pg8::EpiScale<2>, pg8::StaticOrder, true, true>(lds + RING_OFF, g, S, E, c.tid);
}
__device__ __forceinline__ void ph_ffn_down(int wv, LAS unsigned char* lds, int l) {
    const Ctx c = mkctx(wv);
    KArgs A = kargs(); unsigned char* ws = A->ws;
    pg8::Gemm g{WSP(bf16, B_HID), WSP(bf16, W_F2), FFN, FFN, FFN}; pg8::StaticOrder S; S.init(T, DM, c.G, c.bid);
    pg8::EpiResidual E{A->out, A->out, WSP(bf16, WS_XB), WSP(float, WS_SSA), (LAS float*)(lds + EPI_RED_OFF)};
    pg8::gemm_phase<pg8::EpiResidual, pg8::StaticOrder, true, true>(lds + RING_OFF, g, S, E, c.tid);
    TP_BEGIN(9) if (l < DEPTH - 1) conv_mixer_weights(wv, lds, l + 1); TP_END(9, lds)
}
__device__ __forceinline__ int wave_sum_i(int v) {
    v += __builtin_amdgcn_ds_swizzle(v, (1 << 10) | 0x1f); v += __builtin_amdgcn_ds_swizzle(v, (2 << 10) | 0x1f); v += __builtin_amdgcn_ds_swizzle(v, (4 << 10) | 0x1f);
    v += __builtin_amdgcn_ds_swizzle(v, (8 << 10) | 0x1f); v += __builtin_amdgcn_ds_swizzle(v, (16 << 10) | 0x1f);
    auto rr = __builtin_amdgcn_permlane32_swap((unsigned)v, (unsigned)v, false, false); return (int)rr[0] + (int)rr[1];
}
__device__ __forceinline__ void ph_router(int wv, LAS unsigned char* lds, int l) {
    const Ctx c = mkctx(wv);
    KArgs A = kargs(); unsigned char* ws = A->ws; const int li = l >> 1; const int lane = c.lane;
    const float* fn = IN_F(3) + l * DM; const float* wr_ = IN_F(26) + (size_t)li * DM * NE; const float* rb = IN_F(27) + li * NE;
    const float* xout = A->out; const float* SSB = WSP(float, WS_SSB); int* TOKE = WSP(int, MS_TOKE); float* TOKW = WSP(float, MS_TOKW);
    int* WCNT = WSP(int, MS_WCNT); int* WGCNT = WSP(int, MS_WGCNT);
    int cnt[8];
#pragma unroll
    for (int e = 0; e < 8; ++e) cnt[e] = 0;
    float wq[16][8];
#pragma unroll
    for (int j = 0; j < 4; ++j) { const int k0 = (64 * j + lane) * 4; const f32x4 gv = *(const f32x4*)(fn + k0);
#pragma unroll
        for (int q = 0; q < 4; ++q) { const f32x4 w0 = *(const f32x4*)(wr_ + (size_t)(k0 + q) * 8), w1 = *(const f32x4*)(wr_ + (size_t)(k0 + q) * 8 + 4);
#pragma unroll
            for (int e = 0; e < 4; ++e) { wq[4 * j + q][e] = gv[q] * w0[e]; wq[4 * j + q][4 + e] = gv[q] * w1[e]; } } }
    float rbv[8];
#pragma unroll
    for (int e = 0; e < 8; ++e) rbv[e] = rb[e];
    for (int tok0 = c.gw; tok0 < T; tok0 += 2 * c.NGW) {
        f32x4 sp[2], xv[2][4]; bool ok[2];
#pragma unroll
        for (int u = 0; u < 2; ++u) { const int tok = tok0 + u * c.NGW; ok[u] = tok < T; const int tk = ok[u] ? tok : tok0;
            sp[u] = *(const f32x4*)(SSB + (size_t)tk * 4);
#pragma unroll
            for (int j = 0; j < 4; ++j) xv[u][j] = *(const f32x4*)(xout + (size_t)tk * DM + (64 * j + lane) * 4); }
        float pl[2][8];
#pragma unroll
        for (int u = 0; u < 2; ++u) { const float rstd = rsqrtf(((sp[u][0] + sp[u][1]) + (sp[u][2] + sp[u][3])) * (1.0f / 1024.0f) + EPS);
#pragma unroll
            for (int e = 0; e < 8; ++e) pl[u][e] = 0.f;
#pragma unroll
            for (int j = 0; j < 4; ++j)
#pragma unroll
                for (int q = 0; q < 4; ++q) { const float hv = xv[u][j][q] * rstd;
#pragma unroll
                    for (int e = 0; e < 8; ++e) pl[u][e] += hv * wq[4 * j + q][e]; } }
#pragma unroll
        for (int e = 0; e < 8; ++e) { pl[0][e] = wave_sum(pl[0][e]) + rbv[e]; pl[1][e] = wave_sum(pl[1][e]) + rbv[e]; }
#pragma unroll
        for (int u = 0; u < 2; ++u) {
            int e0 = 0; float l0 = pl[u][0];
#pragma unroll
            for (int e = 1; e < 8; ++e) if (pl[u][e] > l0) { l0 = pl[u][e]; e0 = e; }
            int e1 = -1; float l1 = -INFINITY;
#pragma unroll
            for (int e = 0; e < 8; ++e) if (e != e0 && pl[u][e] > l1) { l1 = pl[u][e]; e1 = e; }
            const float tt = expf(l1 - l0); const float w0 = 1.0f / (1.0f + tt), w1 = tt / (1.0f + tt);
            if (ok[u]) {
#pragma unroll
                for (int e = 0; e < 8; ++e) cnt[e] += (e == e0 ? 1 : 0) + (e == e1 ? 1 : 0);
                const int tok = tok0 + u * c.NGW;
                if (lane == 0) { TOKE[tok * 2] = e0; TOKE[tok * 2 + 1] = e1; TOKW[tok * 2] = w0; TOKW[tok * 2 + 1] = w1; }
            }
        }
    }
    LAS int* red = (LAS int*)(lds + RING_OFF);
    int mine = 0;
#pragma unroll
    for (int e = 0; e < 8; ++e) mine = (lane == e) ? cnt[e] : mine;
    if (lane < 8) { WCNT[c.gw * 8 + lane] = mine; red[c.wave * 8 + lane] = mine; }
    __syncthreads();
    if (c.tid < 8) { int s = 0;
#pragma unroll
        for (int w = 0; w < NWAVES; ++w) s += red[w * 8 + c.tid];
        WGCNT[c.bid * 8 + c.tid] = s; }
    __syncthreads();
}
__device__ __forceinline__ void ph_assign(int wv, LAS unsigned char* lds, int l) {
    const Ctx c = mkctx(wv);
    KArgs A = kargs(); unsigned char* ws = A->ws; const int lane = c.lane;
    const float* SSB = WSP(float, WS_SSB); const int* TOKE = WSP(int, MS_TOKE); int* TOKS = WSP(int, MS_TOKS); float* RSSLOT = WSP(float, MS_RSSLOT);
    const int* WCNT = WSP(int, MS_WCNT); const int* WGCNT = WSP(int, MS_WGCNT); int* MTOT = WSP(int, MS_MTOT);
    const bf16* XB = WSP(bf16, WS_XB); bf16* XS = WSP(bf16, B_XS);
    int tot[8], bas[8];
#pragma unroll
    for (int e = 0; e < 8; ++e) { tot[e] = 0; bas[e] = 0; }
    for (int t = c.tid; t < c.G; t += NTHR) {
        typedef int i32x4 __attribute__((ext_vector_type(4)));
        const i32x4 a = *(const i32x4*)(WGCNT + t * 8), b = *(const i32x4*)(WGCNT + t * 8 + 4); const int lt = (t < c.bid) ? 1 : 0;
        tot[0] += a[0]; tot[1] += a[1]; tot[2] += a[2]; tot[3] += a[3]; tot[4] += b[0]; tot[5] += b[1]; tot[6] += b[2]; tot[7] += b[3];
        bas[0] += lt * a[0]; bas[1] += lt * a[1]; bas[2] += lt * a[2]; bas[3] += lt * a[3]; bas[4] += lt * b[0]; bas[5] += lt * b[1]; bas[6] += lt * b[2]; bas[7] += lt * b[3];
    }
    LAS int* red = (LAS int*)(lds + RING_OFF);
#pragma unroll
    for (int e = 0; e < 8; ++e) { tot[e] = wave_sum_i(tot[e]); bas[e] = wave_sum_i(bas[e]); }
    if (lane == 0) {
#pragma unroll
        for (int e = 0; e < 8; ++e) { red[c.wave * 16 + e] = tot[e]; red[c.wave * 16 + 8 + e] = bas[e]; } }
    __syncthreads();
#pragma unroll
    for (int e = 0; e < 8; ++e) { int st = 0, sb = 0;
#pragma unroll
        for (int w = 0; w < NWAVES; ++w) { st += red[w * 16 + e]; sb += red[w * 16 + 8 + e]; }
        tot[e] = st; bas[e] = sb; }
    int run[8]; { int acc = 0;
#pragma unroll
        for (int e = 0; e < 8; ++e) { run[e] = acc * 256 + bas[e]; acc += (tot[e] + 255) >> 8; } }
    if (c.bid == 0 && c.tid < 8) { int v = 0;
#pragma unroll
        for (int e = 0; e < 8; ++e) v = (c.tid == e) ? tot[e] : v;
        MTOT[c.tid] = v; }
    for (int w = 0; w < c.wave; ++w) {
        typedef int i32x4 __attribute__((ext_vector_type(4)));
        const i32x4 a = *(const i32x4*)(WCNT + (c.bid * NWAVES + w) * 8), b = *(const i32x4*)(WCNT + (c.bid * NWAVES + w) * 8 + 4);
        run[0] += a[0]; run[1] += a[1]; run[2] += a[2]; run[3] += a[3]; run[4] += b[0]; run[5] += b[1]; run[6] += b[2]; run[7] += b[3];
    }
    for (int tok0 = c.gw; tok0 < T; tok0 += 4 * c.NGW) {
        f32x4 sp[4]; int ee[4][2]; v4u ra[4], rb2[4]; bool ok[4];
#pragma unroll
        for (int u = 0; u < 4; ++u) { const int tok = tok0 + u * c.NGW; ok[u] = tok < T; const int tk = ok[u] ? tok : tok0;
            sp[u] = *(const f32x4*)(SSB + (size_t)tk * 4); ee[u][0] = TOKE[tk * 2]; ee[u][1] = TOKE[tk * 2 + 1];
            const v4u* src = (const v4u*)(XB + (size_t)tk * DM) + lane; ra[u] = src[0]; rb2[u] = src[64]; }
#pragma unroll
        for (int u = 0; u < 4; ++u) if (ok[u]) {
            const int tok = tok0 + u * c.NGW;
            const float rstd = rsqrtf(((sp[u][0] + sp[u][1]) + (sp[u][2] + sp[u][3])) * (1.0f / 1024.0f) + EPS);
            int s0 = 0, s1 = 0;
#pragma unroll
            for (int e = 0; e < 8; ++e) { if (e == ee[u][0]) { s0 = run[e]; run[e] += 1; } }
#pragma unroll
            for (int e = 0; e < 8; ++e) { if (e == ee[u][1]) { s1 = run[e]; run[e] += 1; } }
            if (lane == 0) { TOKS[tok * 2] = s0; TOKS[tok * 2 + 1] = s1; RSSLOT[s0] = rstd; RSSLOT[s1] = rstd; }
            v4u* d0 = (v4u*)(XS + (size_t)s0 * DM) + lane; v4u* d1 = (v4u*)(XS + (size_t)s1 * DM) + lane;
            d0[0] = ra[u]; d0[64] = rb2[u]; d1[0] = ra[u]; d1[64] = rb2[u];
        }
    }
    __syncthreads();
}
__device__ __forceinline__ void moe_panels(const int* mtot, int (&ps)[9]) { int acc = 0;
#pragma unroll
    for (int e = 0; e < 8; ++e) { ps[e] = acc; const int cn = __hip_atomic_load(mtot + e, RLX_AGENT); acc += (cn + 255) >> 8; } ps[8] = acc; }
__device__ __forceinline__ void ph_moe_up(int wv, LAS unsigned char* lds, int l) {
    const Ctx c = mkctx(wv);
    KArgs A = kargs(); unsigned char* ws = A->ws;
    pg8::MoeOrder S; S.nN = 11; moe_panels(WSP(int, MS_MTOT), S.ps);
    S.so.init(S.ps[8] * 256, 2 * EDIM, c.G, c.bid);
    pg8::Gemm g{WSP(bf16, B_XS), WSP(bf16, W_F1), DM, DM, DM};
    pg8::EpiScale<2> E{WSP(bf16, B_HIDM), EDIM, pg8::RowScale{WSP(float, MS_RSSLOT), 2}, nullptr};
    pg8::gemm_phase<pg8::EpiScale<2>, pg8::MoeOrder, true, true>(lds + RING_OFF, g, S, E, c.tid);
}
__device__ __forceinline__ void ph_moe_down(int wv, LAS unsigned char* lds, int l) {
    const Ctx c = mkctx(wv);
    KArgs A = kargs(); unsigned char* ws = A->ws;
    pg8::MoeOrder S; S.nN = 4; moe_panels(WSP(int, MS_MTOT), S.ps);
    S.so.init(S.ps[8] * 256, DM, c.G, c.bid);
    pg8::Gemm g{WSP(bf16, B_HIDM), WSP(bf16, W_F2), EDIM, EDIM, EDIM};
    pg8::EpiScale<0> E{WSP(bf16, B_Y2), DM, pg8::RowScale{nullptr, 0}, nullptr};
    pg8::gemm_phase<pg8::EpiScale<0>, pg8::MoeOrder, true, true>(lds + RING_OFF, g, S, E, c.tid);
}
__device__ __forceinline__ void ph_combine(int wv, LAS unsigned char* lds, int l) {
    const Ctx c = mkctx(wv);
    KArgs A = kargs(); unsigned char* ws = A->ws; const int lane = c.lane;
    float* xout = A->out; const int* TOKS = WSP(int, MS_TOKS); const float* TOKW = WSP(float, MS_TOKW); const bf16* Y2 = WSP(bf16, B_Y2); bf16* XB = WSP(bf16, WS_XB); float* SSA = WSP(float, WS_SSA);
    for (int tok0 = c.gw; tok0 < T; tok0 += 2 * c.NGW) {
        typedef unsigned u32x2v __attribute__((ext_vector_type(2)));
        int ss_[2][2]; float ww[2][2]; f32x4 xv[2][4]; bool ok[2];
#pragma unroll
        for (int u = 0; u < 2; ++u) { const int tok = tok0 + u * c.NGW; ok[u] = tok < T; const int tk = ok[u] ? tok : tok0;
            ss_[u][0] = TOKS[tk * 2]; ss_[u][1] = TOKS[tk * 2 + 1]; ww[u][0] = TOKW[tk * 2]; ww[u][1] = TOKW[tk * 2 + 1];
#pragma unroll
            for (int j = 0; j < 4; ++j) xv[u][j] = *((const f32x4*)(xout + (size_t)tk * DM) + 64 * j + lane); }
        u32x2v ya[2][4], yb[2][4];
#pragma unroll
        for (int u = 0; u < 2; ++u)
#pragma unroll
            for (int j = 0; j < 4; ++j) { ya[u][j] = *((const u32x2v*)(Y2 + (size_t)ss_[u][0] * DM) + 64 * j + lane); yb[u][j] = *((const u32x2v*)(Y2 + (size_t)ss_[u][1] * DM) + 64 * j + lane); }
#pragma unroll
        for (int u = 0; u < 2; ++u) if (ok[u]) {
            const int tok = tok0 + u * c.NGW; const float w0 = ww[u][0], w1 = ww[u][1]; float ss = 0.f;
#pragma unroll
            for (int j = 0; j < 4; ++j) {
                const int c4 = 64 * j + lane; f32x4 x = xv[u][j]; const u32x2v a = ya[u][j], b = yb[u][j];
                x[0] += w0 * bflo(a.x) + w1 * bflo(b.x); x[1] += w0 * bfhi(a.x) + w1 * bfhi(b.x); x[2] += w0 * bflo(a.y) + w1 * bflo(b.y); x[3] += w0 * bfhi(a.y) + w1 * bfhi(b.y);
                *((f32x4*)(xout + (size_t)tok * DM) + c4) = x;
                u32x2v w; w.x = pkbf(x[0], x[1]); w.y = pkbf(x[2], x[3]); *((u32x2v*)(XB + (size_t)tok * DM) + c4) = w;
                ss += (x[0] * x[0] + x[1] * x[1]) + (x[2] * x[2] + x[3] * x[3]);
            }
            ss = wave_sum(ss);
            if (lane < 4) SSA[(size_t)tok * 4 + lane] = (lane == 0) ? ss : 0.f;
        }
    }
    if (l < DEPTH - 1) { __syncthreads(); conv_mixer_weights(wv, lds, l + 1); }
}

__global__ void __launch_bounds__(NTHR, 2) trunk_fwd(Args args) {
    extern __shared__ __attribute__((aligned(16))) unsigned char lds_raw[];
    LAS unsigned char* lds = (LAS unsigned char*)lds_raw;
    const int wv = __builtin_amdgcn_readfirstlane((int)threadIdx.x >> 6);
    for (int u = threadIdx.x; u < (LDS_BYTES - LDSCTL_OFF) / 4; u += NTHR) ((LAS unsigned*)(lds + LDSCTL_OFF))[u] = 0u;
    __syncthreads();
    volatile LAS unsigned* MISC = (volatile LAS unsigned*)(lds + MISC_OFF);
    XcdBarrier bar = xcd_barrier_post((unsigned*)((gu32*)(args.ws + WS_CTL) + CW_BAR), MISC + 8, (int)threadIdx.x);
    const int lo = args.ph_lo, hi = args.ph_hi;
    int pc = 0;
#define PH_BEGIN if (pc >= lo && pc < hi) {
#define PH_END if (pc + 1 < hi) xcd_barrier(bar, mkctx(wv).tid); } ++pc;
    PH_BEGIN ph_prologue(wv, lds); PH_END
    for (int l = 0; l < DEPTH; ++l) {
        PH_BEGIN ph_inproj(wv, lds); PH_END
        PH_BEGIN ph_prep(wv, lds, l); PH_END
        PH_BEGIN ph_attn(wv, lds, l); PH_END
        PH_BEGIN ph_gates(wv, lds); PH_END
        PH_BEGIN ph_merge(wv, lds); PH_END
        PH_BEGIN ph_wout(wv, lds, l); PH_END
        if (!(l & 1)) {
            PH_BEGIN ph_ffn_up(wv, lds); PH_END
            PH_BEGIN ph_ffn_down(wv, lds, l); PH_END
        } else {
            PH_BEGIN ph_router(wv, lds, l); PH_END
            PH_BEGIN ph_assign(wv, lds, l); PH_END
            PH_BEGIN ph_moe_up(wv, lds, l); PH_END
            PH_BEGIN ph_moe_down(wv, lds, l); PH_END
            PH_BEGIN ph_combine(wv, lds, l); PH_END
        }
    }
    if (TPROBE != 0 && blockIdx.x == TP_BID && threadIdx.x == 0) { const unsigned long long tt_ = *TP_ACC(lds), te_ = __builtin_amdgcn_s_memrealtime(); while (__builtin_amdgcn_s_memrealtime() - te_ < 7ull * tt_) __builtin_amdgcn_s_sleep(32); }
#undef PH_BEGIN
#undef PH_END
}

#ifndef MK_MULTI
#define MK_MULTI 0
#endif
extern "C" void kernel_launch(void* const* d_in, const int* in_sizes, int n_in, void* d_out, int out_size, void* d_ws, size_t ws_size, hipStream_t stream) {
    static int grid = 0;
    if (grid == 0) {
        if (n_in != 31 || out_size != T * DM || ws_size < WS_END) { fprintf(stderr, "kernel_launch: unexpected problem: n_in %d out %d ws %zu (need %zu)\n", n_in, out_size, ws_size, (size_t)WS_END); grid = -1; return; }
        int dev = 0, cus = 0;
        if (hipGetDevice(&dev) != hipSuccess || hipDeviceGetAttribute(&cus, hipDeviceAttributeMultiprocessorCount, dev) != hipSuccess) { grid = -1; return; }
        if (hipFuncSetAttribute((const void*)trunk_fwd, hipFuncAttributeMaxDynamicSharedMemorySize, LDS_BYTES) != hipSuccess) { fprintf(stderr, "kernel_launch: hipFuncSetAttribute failed\n"); grid = -1; return; }
        int per_cu = 0;
        if (hipOccupancyMaxActiveBlocksPerMultiprocessor(&per_cu, (const void*)trunk_fwd, NTHR, LDS_BYTES) != hipSuccess || per_cu < 1) fprintf(stderr, "kernel_launch: occupancy query says %d\n", per_cu);
        (void)hipGetLastError();
        grid = cus;
    }
    if (grid < 0) return;
    (void)hipMemsetAsync((char*)d_ws + WS_CTL, 0, CTL_ZERO_BYTES, stream);
    Args a{};
    for (int i = 0; i < 31; ++i) a.in[i] = d_in[i];
    a.out = (float*)d_out; a.ws = (unsigned char*)d_ws;
#if MK_MULTI
    for (int p = 0; p < N_PHASES; ++p) { a.ph_lo = p; a.ph_hi = p + 1; hipLaunchKernelGGL(trunk_fwd, dim3(grid), dim3(NTHR), LDS_BYTES, stream, a); }
#else
    a.ph_lo = 0; a.ph_hi = N_PHASES;
    hipLaunchKernelGGL(trunk_fwd, dim3(grid), dim3(NTHR), LDS_BYTES, stream, a);
#endif
}
```

```cpp
#include <hip/hip_runtime.h>
#include <cstdio>
#include <cstdint>
#include <cmath>
namespace pg8 {
#define PG8_LAS __attribute__((address_space(3)))
typedef unsigned short bf16_t;
typedef short bf16x8 __attribute__((ext_vector_type(8)));
typedef float f32x4 __attribute__((ext_vector_type(4)));
typedef unsigned u32x4 __attribute__((ext_vector_type(4)));
constexpr int BM = 256, BK = 64, HALF = 128, HTB = HALF * BK * 2  , STAGE_BYTES = 8 * HTB, NXCD = 8, WGM = 8;

__host__ __device__ __forceinline__ int lds_byte(int r, int c) { const int st = (r >> 4) * 2 + (c >> 5), rr = r & 15, cc = c & 31, ob = rr * 64 + cc * 2; return st * 1024 + (ob ^ (((ob >> 9) & 1) << 5)); }
__host__ __device__ __forceinline__ void stage_rc(int b, int& R, int& C) { const int st = b / 1024, sb = b % 1024, swz = sb ^ (((sb >> 9) & 1) << 5); R = (st >> 1) * 16 + swz / 64; C = (st & 1) * 32 + (swz % 64) / 2; }
__host__ __device__ __forceinline__ int perm32(int rho) { const int n = rho >> 4, i = rho & 15; return 8 * (i >> 2) + 4 * n + (i & 3); }

struct Unit { int pm, pn, pb, ak; };
struct Gemm { const bf16_t* A; const bf16_t* Bt; int lda, ldb, K; };

struct StaticOrder {
    int nM, nN, nwg, G, c;
    __host__ __device__ void init(int M, int N, int G_, int c_) { nM = M / BM; nN = N / BM; nwg = nM * nN; G = G_; c = c_; }
    __host__ __device__ bool next(int i, Unit& u) const {
        const long L = (long)i * G + c; if (L >= nwg) return false;
        int wgid = (int)L; { const int q = nwg / NXCD, r = nwg % NXCD, xcd = wgid % NXCD, off = wgid / NXCD; wgid = (xcd < r ? xcd * (q + 1) : r * (q + 1) + (xcd - r) * q) + off; }
        const int nig = WGM * nN, gid = wgid / nig, fm = gid * WGM, gsz = (nM - fm) < WGM ? (nM - fm) : WGM;
        u.pm = fm + ((wgid % nig) % gsz); u.pn = (wgid % nig) / gsz; u.pb = u.pn; u.ak = 0; return true;
    }
    __device__ __forceinline__ void a_ready(const Unit&) const {}
    __device__ __forceinline__ void done(const Unit&) const {}
};

template <class Epi, class Sched, bool ALIGN_EPI = false, bool SP2 = false>
__device__ __forceinline__ void gemm_phase(PG8_LAS unsigned char* lds, const Gemm g, const Sched& S, const Epi& E, const int tid) {
    const int wid = __builtin_amdgcn_readfirstlane(tid >> 6), lane = tid & 63, wr = wid >> 2, wc = wid & 3, fr = lane & 15, fq = lane >> 4;
    const int K = g.K, nt = K / BK;
    unsigned voffA[2], voffB[2];
#pragma unroll
    for (int i = 0; i < 2; ++i) { int R, C; stage_rc(tid * 16 + i * 8192, R, C); const int Rb = Epi::PERM ? ((R & ~31) + perm32(R & 31)) : R;
        voffA[i] = (unsigned)(R * g.lda + C) * 2u; voffB[i] = (unsigned)(Rb * g.ldb + C) * 2u; }
    const size_t kstep = (size_t)(BK * 2);
    const size_t hstepA = (size_t)HALF * g.lda * 2, hstepB = (size_t)HALF * g.ldb * 2;
    const size_t tstepA = 2 * hstepA, tstepB = 2 * hstepB;
    const unsigned ldsw = (unsigned)wid * 1024u;
    const int aoff = lds_byte(wr * 64 + fr, fq * 8), boff = lds_byte(wc * 32 + fr, fq * 8);
#define PG8_SA(b, h) (((b) * 2 + (h)) * HTB)
#define PG8_SB(b, h) ((4 + (b) * 2 + (h)) * HTB)
#define PG8_STAGE(bufoff, gbase, voff) do { _Pragma("unroll") for (int _i = 0; _i < 2; ++_i) \
        __builtin_amdgcn_global_load_lds((const unsigned*)((const char*)(gbase) + (voff)[_i]), (PG8_LAS unsigned*)(lds + (bufoff) + ldsw + _i * 8192), 16, 0, 0); } while (0)
#define PG8_LDA(dst, b, h) do { _Pragma("unroll") for (int m = 0; m < 4; ++m) _Pragma("unroll") for (int k = 0; k < 2; ++k) dst[m][k] = *(const PG8_LAS bf16x8*)(lds + PG8_SA(b, h) + aoff + m * 2048 + k * 1024); } while (0)
#define PG8_LDB(dst, b, h) do { _Pragma("unroll") for (int n = 0; n < 2; ++n) _Pragma("unroll") for (int k = 0; k < 2; ++k) dst[n][k] = *(const PG8_LAS bf16x8*)(lds + PG8_SB(b, h) + boff + n * 2048 + k * 1024); } while (0)
#define PG8_MMA(ai, bj, At, Bt) do { __builtin_amdgcn_s_setprio(1); _Pragma("unroll") for (int m = 0; m < 4; ++m) _Pragma("unroll") for (int n = 0; n < 2; ++n) _Pragma("unroll") for (int k = 0; k < 2; ++k) \
        acc[ai][bj][m][n] = __builtin_amdgcn_mfma_f32_16x16x32_bf16(Bt[n][k], At[m][k], acc[ai][bj][m][n], 0, 0, 0); __builtin_amdgcn_s_setprio(0); } while (0)
#define PG8_WAIT_V(n) asm volatile("s_waitcnt vmcnt(" #n ")" ::: "memory")
#define PG8_WAIT_L(n) asm volatile("s_waitcnt lgkmcnt(" #n ")" ::: "memory")
#define PG8_BAR __builtin_amdgcn_s_barrier()
#define PG8_SCHED __builtin_amdgcn_sched_barrier(0)
    Unit cur, nxt; int ui = 0;
    if (!S.next(0, cur)) return;
    f32x4 acc[2][2][4][2];
#pragma unroll
    for (int a = 0; a < 2; ++a)
#pragma unroll
        for (int b = 0; b < 2; ++b)
#pragma unroll
            for (int m = 0; m < 4; ++m)
#pragma unroll
                for (int n = 0; n < 2; ++n) acc[a][b][m][n] = (f32x4){0.f, 0.f, 0.f, 0.f};
    bf16x8 At[4][2], B0[2][2], B1[2][2];
    const char* cA = (const char*)g.A + (size_t)cur.pm * tstepA + (size_t)cur.ak * 2; const char* cB = (const char*)g.Bt + (size_t)cur.pb * tstepB;
    S.a_ready(cur);
    if constexpr (SP2) {
        PG8_STAGE(PG8_SB(0, 0), cB, voffB); PG8_STAGE(PG8_SB(0, 1), cB + hstepB, voffB); PG8_STAGE(PG8_SA(0, 0), cA, voffA); PG8_STAGE(PG8_SA(0, 1), cA + hstepA, voffA);
        if (wr == 1) PG8_BAR;
        PG8_WAIT_V(2); PG8_BAR;
        PG8_STAGE(PG8_SB(1, 0), cB + kstep, voffB); PG8_STAGE(PG8_SA(1, 0), cA + kstep, voffA); PG8_STAGE(PG8_SB(1, 1), cB + hstepB + kstep, voffB);
        PG8_WAIT_V(6); PG8_BAR;
    } else {
        PG8_STAGE(PG8_SB(0, 0), cB, voffB); PG8_STAGE(PG8_SA(0, 0), cA, voffA); PG8_STAGE(PG8_SB(0, 1), cB + hstepB, voffB); PG8_STAGE(PG8_SA(0, 1), cA + hstepA, voffA);
        if (wr == 1) PG8_BAR;
        PG8_WAIT_V(4); PG8_BAR;
        PG8_STAGE(PG8_SB(1, 0), cB + kstep, voffB); PG8_STAGE(PG8_SA(1, 0), cA + kstep, voffA); PG8_STAGE(PG8_SB(1, 1), cB + hstepB + kstep, voffB);
        PG8_WAIT_V(6); PG8_BAR;
    }
    for (;;) {
        const bool has_next = S.next(ui + 1, nxt);
        const char* nA = has_next ? (const char*)g.A + (size_t)nxt.pm * tstepA + (size_t)nxt.ak * 2 : cA; const char* nB = has_next ? (const char*)g.Bt + (size_t)nxt.pb * tstepB : cB;
        for (int t = 0; t < nt; t += 2) {
            const bool last = (t == nt - 2);
            const char* a1 = cA + (size_t)(t + 1) * kstep;
            const char* a2 = last ? nA : cA + (size_t)(t + 2) * kstep; const char* b2 = last ? nB : cB + (size_t)(t + 2) * kstep;
            const char* a3 = a2 + kstep; const char* b3 = b2 + kstep;
            if (last && has_next) S.a_ready(nxt);
            if constexpr (SP2) {
            PG8_LDB(B0, 0, 0); PG8_LDB(B1, 0, 1); PG8_SCHED; PG8_LDA(At, 0, 0); PG8_STAGE(PG8_SA(1, 1), a1 + hstepA, voffA);
            PG8_WAIT_V(8); PG8_WAIT_L(0); PG8_BAR; PG8_MMA(0, 0, At, B0); PG8_MMA(0, 1, At, B1); PG8_BAR; PG8_SCHED;
            PG8_LDA(At, 0, 1); PG8_STAGE(PG8_SB(0, 0), b2, voffB); PG8_STAGE(PG8_SB(0, 1), b2 + hstepB, voffB); PG8_STAGE(PG8_SA(0, 0), a2, voffA);
            PG8_WAIT_V(8); PG8_WAIT_L(0); PG8_BAR; PG8_MMA(1, 0, At, B0); PG8_MMA(1, 1, At, B1); PG8_BAR; PG8_SCHED;
            PG8_LDB(B0, 1, 0); PG8_LDB(B1, 1, 1); PG8_SCHED; PG8_LDA(At, 1, 0); PG8_STAGE(PG8_SA(0, 1), a2 + hstepA, voffA);
            PG8_WAIT_V(8); PG8_WAIT_L(0); PG8_BAR; PG8_MMA(0, 0, At, B0); PG8_MMA(0, 1, At, B1); PG8_BAR; PG8_SCHED;
            PG8_LDA(At, 1, 1); PG8_STAGE(PG8_SB(1, 0), b3, voffB); PG8_STAGE(PG8_SB(1, 1), b3 + hstepB, voffB); PG8_STAGE(PG8_SA(1, 0), a3, voffA);
            PG8_WAIT_V(8); PG8_WAIT_L(0); PG8_BAR; PG8_MMA(1, 0, At, B0); PG8_MMA(1, 1, At, B1); PG8_BAR; PG8_SCHED;
            } else {
            PG8_LDB(B0, 0, 0); PG8_SCHED; PG8_LDA(At, 0, 0); PG8_STAGE(PG8_SA(1, 1), a1 + hstepA, voffA);
            PG8_WAIT_L(8); PG8_BAR; PG8_WAIT_L(0); PG8_MMA(0, 0, At, B0); PG8_BAR; PG8_SCHED;
            PG8_LDB(B1, 0, 1); PG8_STAGE(PG8_SB(0, 0), b2, voffB);
            PG8_BAR; PG8_WAIT_L(0); PG8_MMA(0, 1, At, B1); PG8_BAR;
            PG8_LDA(At, 0, 1); PG8_STAGE(PG8_SA(0, 0), a2, voffA);
            PG8_BAR; PG8_WAIT_L(0); PG8_MMA(1, 0, At, B0); PG8_BAR; PG8_SCHED;
            PG8_STAGE(PG8_SB(0, 1), b2 + hstepB, voffB);
            PG8_WAIT_V(6); PG8_BAR; PG8_MMA(1, 1, At, B1); PG8_BAR;
            PG8_LDB(B0, 1, 0); PG8_SCHED; PG8_LDA(At, 1, 0); PG8_STAGE(PG8_SA(0, 1), a2 + hstepA, voffA);
            PG8_WAIT_L(8); PG8_BAR; PG8_WAIT_L(0); PG8_MMA(0, 0, At, B0); PG8_BAR; PG8_SCHED;
            PG8_LDB(B1, 1, 1); PG8_STAGE(PG8_SB(1, 0), b3, voffB);
            PG8_BAR; PG8_WAIT_L(0); PG8_MMA(0, 1, At, B1); PG8_BAR;
            PG8_LDA(At, 1, 1); PG8_STAGE(PG8_SA(1, 0), a3, voffA);
            PG8_BAR; PG8_WAIT_L(0); PG8_MMA(1, 0, At, B0); PG8_BAR; PG8_SCHED;
            PG8_STAGE(PG8_SB(1, 1), b3 + hstepB, voffB);
            PG8_WAIT_V(6); PG8_BAR; PG8_MMA(1, 1, At, B1); PG8_BAR;
            }
        }
        if constexpr (ALIGN_EPI) { if (wr == 0) PG8_BAR; }
        const bool keep = E(acc, cur, wr, wc, fr, fq);
        if (!has_next) break;
        if (!keep) {
#pragma unroll
        for (int a = 0; a < 2; ++a)
#pragma unroll
            for (int b = 0; b < 2; ++b)
#pragma unroll
                for (int m = 0; m < 4; ++m)
#pragma unroll
                    for (int n = 0; n < 2; ++n) acc[a][b][m][n] = (f32x4){0.f, 0.f, 0.f, 0.f};
        }
        cur = nxt; cA = nA; cB = nB; ++ui;
        if constexpr (ALIGN_EPI) { if (wr == 1) PG8_BAR; }
    }
    PG8_WAIT_V(0);
    if constexpr (!ALIGN_EPI) { if (wr == 0) PG8_BAR; }
    PG8_BAR;
#undef PG8_SA
#undef PG8_SB
#undef PG8_STAGE
#undef PG8_LDA
#undef PG8_LDB
#undef PG8_MMA
#undef PG8_WAIT_V
#undef PG8_WAIT_L
#undef PG8_BAR
#undef PG8_SCHED
}
}
#define GAS __attribute__((address_space(1)))
#define LAS __attribute__((address_space(3)))
typedef unsigned short bf16;
typedef unsigned v4u __attribute__((ext_vector_type(4)));
typedef float f32x4 __attribute__((ext_vector_type(4)));
typedef short bf16x8 __attribute__((ext_vector_type(8)));
typedef GAS unsigned gu32;
typedef GAS unsigned long long gu64;
#define RLX_AGENT __ATOMIC_RELAXED, __HIP_MEMORY_SCOPE_AGENT
#define LDS_WAIT() asm volatile("s_waitcnt lgkmcnt(0)" ::: "memory")
#define VM_WAIT() asm volatile("s_waitcnt vmcnt(0)" ::: "memory")
__device__ __forceinline__ unsigned long long rt() { return __builtin_amdgcn_s_memrealtime(); }
__device__ __forceinline__ unsigned f2bf(float f) { unsigned u = __builtin_bit_cast(unsigned, f); return (u + 0x7fffu + ((u >> 16) & 1u)) >> 16; }
__device__ __forceinline__ unsigned pk2(float lo, float hi) { return f2bf(lo) | (f2bf(hi) << 16); }

#define XB_TMO      128
#define XB_XCNT(j)  (256  + 64 * (j))
#define XB_XSUB(j)  (1280 + 64 * (j))
#define XB_XGEN(j)  (2304 + 64 * (j))
#define XB_TOP      3328
#define XB_TOPGEN   3392
#define XCD_BAR_WORDS 3456
#define XB_SPIN_CAP (1u << 18)

__device__ __forceinline__ unsigned xb_ld(unsigned* p)              { return __hip_atomic_load(p, __ATOMIC_RELAXED, __HIP_MEMORY_SCOPE_AGENT); }
__device__ __forceinline__ unsigned xb_add(unsigned* p, unsigned v) { return __hip_atomic_fetch_add(p, v, __ATOMIC_RELAXED, __HIP_MEMORY_SCOPE_AGENT); }
__device__ __forceinline__ unsigned xb_xcc_id() { return (unsigned)__builtin_amdgcn_s_getreg((3 << 11) | 20) & 0xFu; }
#define XB_SPIN(cond, bar) do { unsigned _sp = 0; while (cond) { __builtin_amdgcn_s_sleep(1); \
    if ((++_sp & 255u) == 0u) { if (xb_ld(&(bar)[XB_TMO])) break; if (_sp > XB_SPIN_CAP) { atomicAdd(&(bar)[XB_TMO], 1u); break; } } } } while (0)

struct XcdBarrier {
    unsigned* bar; unsigned x;
    volatile LAS unsigned* st;
};

__device__ __forceinline__ XcdBarrier xcd_barrier_post(unsigned* bar, volatile LAS unsigned* st, const int tid) {
    XcdBarrier b; b.bar = bar; b.x = xb_xcc_id(); b.st = st;
    if (tid == 0) (void)xb_add(&bar[XB_XCNT(b.x)], 1u);
    return b;
}
__device__ __forceinline__ void xcd_barrier_complete(unsigned* bar, unsigned x, unsigned& nloc, unsigned& nx) {
    const unsigned G = gridDim.x * gridDim.y * gridDim.z;
    unsigned sum, cnt, mine, sp = 0u;
    for (;;) {
        sum = 0u; cnt = 0u; mine = 0u;
#pragma unroll
        for (unsigned j = 0; j < 16; ++j) { const unsigned c = xb_ld(&bar[XB_XCNT(j)]); sum += c; cnt += (c > 0u) ? 1u : 0u; mine = (j == x) ? c : mine; }
        if (sum == G) break;
        __builtin_amdgcn_s_sleep(1);
        if ((++sp & 255u) == 0u) { if (xb_ld(&bar[XB_TMO])) break; if (sp > XB_SPIN_CAP) { atomicAdd(&bar[XB_TMO], 1u); break; } }
    }
    nloc = mine > 0u ? mine : 1u; nx = cnt > 0u ? cnt : 1u;
}

__device__ __forceinline__ void xcd_barrier(const XcdBarrier& b, const int tid) {
    asm volatile("s_waitcnt vmcnt(0)" ::: "memory");
    __syncthreads();
    if (tid == 0) {
        unsigned* bar = b.bar; asm volatile("" : "+s"(bar));
        __builtin_amdgcn_s_waitcnt(0);
        unsigned nloc = b.st[0], nx = b.st[1];
        if (nloc == 0u) { unsigned xl_ = b.x; asm volatile("" : "+s"(xl_)); xcd_barrier_complete(bar, xl_, nloc, nx); b.st[0] = nloc; b.st[1] = nx; }
        const unsigned old = xb_add(&bar[XB_XSUB(b.x)], 1u);
        const unsigned gen = old / nloc;
        if (old + 1u == (gen + 1u) * nloc) {
            __builtin_amdgcn_fence(__ATOMIC_RELEASE, "agent");
            asm volatile("s_waitcnt vmcnt(0)" ::: "memory");
            const unsigned og = xb_add(&bar[XB_TOP], 1u);
            const unsigned tg = og / nx;
            if (og + 1u == (tg + 1u) * nx) xb_add(&bar[XB_TOPGEN], 1u);
            else XB_SPIN(xb_ld(&bar[XB_TOPGEN]) == tg, bar);
            __builtin_amdgcn_fence(__ATOMIC_ACQUIRE, "agent");
            xb_add(&bar[XB_XGEN(b.x)], 1u);
            asm volatile("s_waitcnt vmcnt(0)" ::: "memory");
        } else {
            XB_SPIN(xb_ld(&bar[XB_XGEN(b.x)]) == gen, bar);
            __builtin_amdgcn_fence(__ATOMIC_ACQUIRE, "agent");
            asm volatile("s_waitcnt vmcnt(0)" ::: "memory");
        }
    }
    __syncthreads();
}
constexpr int NB = 8, SEQ = 4096, DM = 1024, T = NB * SEQ, DEPTH = 4, IN_COLS = 6240;
constexpr int FFN = 2816, NE = 8, EDIM = 1408;
constexpr float EPS = 1e-6f, LOG2E = 1.4426950408889634f;
constexpr int PJ_LD = 2304, PJ_U = 0, PJ_V = 256, PJ_BQ = 512, PJ_BK = 768, PJ_BV = 1024, PJ_DA = 1280, PJ_DG = 1536, PJ_CQ = 1792, PJ_CKV = 1984, PJ_KR = 2112;
constexpr float QS_B = 0.125f * LOG2E;
constexpr float QS_C = 0.10206207261596577f * LOG2E;
constexpr int NWAVES = 8, NTHR = 512;

constexpr size_t MiB = 1u << 20;
constexpr size_t WS_CTL = 0, CTL_ZERO_BYTES = 1 * MiB;
constexpr size_t WS_SSA = 1 * MiB, WS_SSB = 3 * MiB;
constexpr size_t WS_ROPE = 5 * MiB;
constexpr size_t WS_MISC = 11 * MiB;
constexpr size_t MS_RSCQ = WS_MISC, MS_RSCKV = WS_MISC + 128 * 1024, MS_SEL = WS_MISC + 256 * 1024, MS_KMEAN = WS_MISC + 768 * 1024,
                 MS_TOKE = WS_MISC + 1024 * 1024, MS_TOKW = WS_MISC + 1280 * 1024, MS_TOKS = WS_MISC + 1536 * 1024, MS_RSSLOT = WS_MISC + 1792 * 1024,
                 MS_WCNT = WS_MISC + 2304 * 1024, MS_WGCNT = WS_MISC + 2560 * 1024, MS_MTOT = WS_MISC + 2816 * 1024, MS_WSGU = WS_MISC + 2880 * 1024;
constexpr size_t WS_W = 14 * MiB;
constexpr size_t W_INR = WS_W, W_G = WS_W + 4 * MiB + 512 * 1024, W_UQ = WS_W + 12 * MiB + 512 * 1024, W_UKV = W_UQ + 256 * 1024, W_B = WS_W + 13 * MiB, W_OUT = WS_W + 15 * MiB,
                 W_F1 = WS_W + 17 * MiB, W_F2 = WS_W + 61 * MiB;
constexpr size_t WS_SSC = 98 * MiB;
constexpr size_t WS_XB = 100 * MiB;
constexpr size_t WS_BIG = 164 * MiB;
constexpr size_t B_PROJ = WS_BIG, B_QPRE = WS_BIG + 144 * MiB, B_KVPRE = WS_BIG + 176 * MiB  , B_CQ = WS_BIG + 208 * MiB, B_CK = WS_BIG + 232 * MiB, B_O = WS_BIG + 256 * MiB;
constexpr size_t B_SG = WS_BIG, B_Y = WS_BIG + 320 * MiB;
constexpr size_t B_HID = WS_BIG;
constexpr size_t B_XS = WS_BIG, B_HIDM = WS_BIG + 132 * MiB, B_Y2 = WS_BIG;
constexpr size_t WS_END = WS_BIG + 384 * MiB;
constexpr int MOE_ROWS_MAX = 65536 + 8 * 256;
static_assert(B_HIDM + (size_t)MOE_ROWS_MAX * EDIM * 2 <= WS_END && (size_t)MOE_ROWS_MAX * 1024 * 2 <= 132 * MiB, "moe map");
constexpr int CW_TMO = 0, CW_BAR = 4096, CW_MOE = 8192, CW_KMX = 9216;

constexpr int RING_OFF = 0, RING_BYTES = 131072;
constexpr int LDSCTL_OFF = RING_BYTES, MISC_OFF = LDSCTL_OFF + 320;
constexpr int LDS_BYTES = 147456;
constexpr int EPI_RED_OFF = 132096;

typedef float f32x2 __attribute__((ext_vector_type(2)));
typedef __bf16 bf16x2_t __attribute__((ext_vector_type(2)));
__device__ __forceinline__ unsigned pkbf(float lo, float hi) { f32x2 v = {lo, hi}; bf16x2_t b = __builtin_convertvector(v, bf16x2_t); return __builtin_bit_cast(unsigned, b); }
__device__ __forceinline__ float bflo(unsigned w) { return __uint_as_float(w << 16); }
__device__ __forceinline__ float bfhi(unsigned w) { return __uint_as_float(w & 0xffff0000u); }
__device__ __forceinline__ float bf1(bf16 b) { return __uint_as_float((unsigned)b << 16); }
__device__ __forceinline__ void unpack8(const v4u w, float* o) { o[0] = bflo(w.x); o[1] = bfhi(w.x); o[2] = bflo(w.y); o[3] = bfhi(w.y); o[4] = bflo(w.z); o[5] = bfhi(w.z); o[6] = bflo(w.w); o[7] = bfhi(w.w); }
__device__ __forceinline__ v4u pack8(const float* o) { v4u w; w.x = pkbf(o[0], o[1]); w.y = pkbf(o[2], o[3]); w.z = pkbf(o[4], o[5]); w.w = pkbf(o[6], o[7]); return w; }
template <int X> __device__ __forceinline__ float swz_xor(float v) { return __int_as_float(__builtin_amdgcn_ds_swizzle(__float_as_int(v), (X << 10) | 0x1f)); }
__device__ __forceinline__ float half_sum(float v) { auto rr = __builtin_amdgcn_permlane32_swap(__float_as_uint(v), __float_as_uint(v), false, false); return __uint_as_float(rr[0]) + __uint_as_float(rr[1]); }
__device__ __forceinline__ float wave_sum(float v) {
    v += swz_xor<1>(v); v += swz_xor<2>(v); v += swz_xor<4>(v); v += swz_xor<8>(v); v += swz_xor<16>(v);
    return half_sum(v);
}
__device__ __forceinline__ float fast_sigmoid(float x) { return __builtin_amdgcn_rcpf(1.0f + __builtin_amdgcn_exp2f(-x * LOG2E)); }
__device__ __forceinline__ float fast_silu(float x) { return x * fast_sigmoid(x); }
namespace pg8 {
struct RowScale { const float* p; int mode; };
__device__ __forceinline__ float row_scale(const RowScale& rs, int row) {
    if (rs.mode == 0) return 1.f;
    if (rs.mode == 2) return rs.p[row];
    if (rs.mode == 3) { const f32x4 p = *(const f32x4*)(rs.p + (size_t)row * 12); return rsqrtf(((p[0] + p[1]) + (p[2] + p[3])) * (1.0f / 192.0f) + EPS); }
    if (rs.mode == 4) { const f32x4 p = *(const f32x4*)(rs.p + (size_t)row * 12 + 4); return rsqrtf(((p[0] + p[1]) + (p[2] + p[3])) * (1.0f / 128.0f) + EPS); }
    { const f32x4 p = *(const f32x4*)(rs.p + (size_t)row * 4); return rsqrtf(((p[0] + p[1]) + (p[2] + p[3])) * (1.0f / 1024.0f) + EPS); }
}
template <int ACT> struct EpiScale {
    static constexpr bool PERM = true;
    bf16_t* O; int ldc; RowScale rs; float* ssc;
    __device__ __forceinline__ bool operator()(f32x4 (&acc)[2][2][4][2], const Unit& u, int wr, int wc, int fr, int fq) const {
        const int row0 = u.pm * BM + wr * 64 + fr;
        float scv[2][4];
#pragma unroll
        for (int ai = 0; ai < 2; ++ai)
#pragma unroll
            for (int m = 0; m < 4; ++m) scv[ai][m] = row_scale(rs, row0 + ai * HALF + m * 16);
#pragma unroll
        for (int ai = 0; ai < 2; ++ai)
#pragma unroll
            for (int m = 0; m < 4; ++m) {
                const int row = row0 + ai * HALF + m * 16; const float sc = scv[ai][m];
                if (ACT == 2) {
                    bf16_t* rowp = O + (size_t)row * ldc + u.pn * HALF + wc * 32 + 8 * fq;
                    const f32x4 g0 = acc[ai][0][m][0] * sc, g1 = acc[ai][0][m][1] * sc, u0 = acc[ai][1][m][0] * sc, u1 = acc[ai][1][m][1] * sc;
                    u32x4 w; w.x = pkbf(fast_silu(g0[0]) * u0[0], fast_silu(g0[1]) * u0[1]); w.y = pkbf(fast_silu(g0[2]) * u0[2], fast_silu(g0[3]) * u0[3]);
                    w.z = pkbf(fast_silu(g1[0]) * u1[0], fast_silu(g1[1]) * u1[1]); w.w = pkbf(fast_silu(g1[2]) * u1[2], fast_silu(g1[3]) * u1[3]);
                    *(u32x4*)rowp = w;
                } else {
                    bf16_t* rowp = O + (size_t)row * ldc + u.pn * BM + wc * 32 + 8 * fq;
                    float sq[2] = {0.f, 0.f};
#pragma unroll
                    for (int bj = 0; bj < 2; ++bj) {
                        f32x4 v0 = acc[ai][bj][m][0] * sc, v1 = acc[ai][bj][m][1] * sc;
                        if (ACT == 0) sq[bj] = ((v0[0] * v0[0] + v0[1] * v0[1]) + (v0[2] * v0[2] + v0[3] * v0[3])) + ((v1[0] * v1[0] + v1[1] * v1[1]) + (v1[2] * v1[2] + v1[3] * v1[3]));
                        if (ACT == 1) {
#pragma unroll
                            for (int j = 0; j < 4; ++j) { v0[j] = fmaxf(fast_sigmoid(v0[j]), 8.6736174e-19f); v1[j] = fmaxf(fast_sigmoid(v1[j]), 8.6736174e-19f); }
                        }
                        u32x4 w; w.x = pkbf(v0[0], v0[1]); w.y = pkbf(v0[2], v0[3]); w.z = pkbf(v1[0], v1[1]); w.w = pkbf(v1[2], v1[3]);
                        *(u32x4*)(rowp + bj * HALF) = w;
                    }
                    if (ACT == 0 && ssc != nullptr && (u.pn == 7 || u.pn == 8)) {
                        float a = (u.pn == 7) ? (sq[0] + (wc < 2 ? sq[1] : 0.f)) : sq[0];
                        float c = sq[1];
                        a += swz_xor<16>(a); a = half_sum(a); c += swz_xor<16>(c); c = half_sum(c);
                        if (fq == 0) {
                            float* sp = ssc + (size_t)row * 12;
                            if (u.pn == 7) { sp[wc] = a; if (wc >= 2) sp[4 + wc] = c; }
                            else { if (wc < 2) sp[4 + wc] = a; if (wc == 2) sp[8] = a; }
                        }
                    }
                }
            }
        return false;
    }
};
struct EpiResidual {
    static constexpr bool PERM = false;
    const float* base; float* out; bf16_t* xb; float* ssp; PG8_LAS float* red;
    __device__ __forceinline__ bool operator()(f32x4 (&acc)[2][2][4][2], const Unit& u, int wr, int wc, int fr, int fq) const {
        typedef unsigned u32x2v __attribute__((ext_vector_type(2)));
        const int row0 = u.pm * BM + wr * 64 + fr, col0 = u.pn * BM + wc * 32 + 4 * fq;
#pragma unroll
        for (int ai = 0; ai < 2; ++ai)
#pragma unroll
            for (int mp = 0; mp < 2; ++mp) {
                f32x4 bv[2][2][2];
#pragma unroll
                for (int mm = 0; mm < 2; ++mm)
#pragma unroll
                    for (int bj = 0; bj < 2; ++bj)
#pragma unroll
                        for (int n = 0; n < 2; ++n) bv[mm][bj][n] = *(const f32x4*)(base + (size_t)(row0 + ai * HALF + (2 * mp + mm) * 16) * DM + col0 + bj * HALF + n * 16);
#pragma unroll
                for (int mm = 0; mm < 2; ++mm) {
                    const int m = 2 * mp + mm, row = row0 + ai * HALF + m * 16; const size_t off = (size_t)row * DM + col0; float ss = 0.f;
#pragma unroll
                    for (int bj = 0; bj < 2; ++bj)
#pragma unroll
                        for (int n = 0; n < 2; ++n) {
                            const size_t o2 = off + bj * HALF + n * 16; const f32x4 o = bv[mm][bj][n] + acc[ai][bj][m][n];
                            *(f32x4*)(out + o2) = o;
                            u32x2v w; w.x = pkbf(o[0], o[1]); w.y = pkbf(o[2], o[3]); *(u32x2v*)(xb + o2) = w;
                            ss += (o[0] * o[0] + o[1] * o[1]) + (o[2] * o[2] + o[3] * o[3]);
                        }
                    ss += swz_xor<16>(ss); ss = half_sum(ss);
                    if (fq == 0) red[(ai * HALF + wr * 64 + m * 16 + fr) * 4 + wc] = ss;
                }
            }
        asm volatile("s_waitcnt lgkmcnt(0)" ::: "memory"); __builtin_amdgcn_s_barrier(); asm volatile("" ::: "memory");
        const int t = (wr * 4 + wc) * 64 + fq * 16 + fr;
        if (t < 256) { const f32x4 p = *(const PG8_LAS f32x4*)(red + t * 4); ssp[(size_t)(u.pm * BM + t) * 4 + u.pn] = (p[0] + p[1]) + (p[2] + p[3]); }
        return false;
    }
};
struct EpiKV {
    static constexpr bool PERM = true;
    bf16_t* CK; bf16_t* VB; const bf16_t* PROJ; const float* ssc; const float* rope; const float* ckn; unsigned* kmx;
    __device__ __forceinline__ bool operator()(f32x4 (&acc)[2][2][4][2], const Unit& u, int wr, int wc, int fr, int fq) const {
        typedef unsigned u32x2v __attribute__((ext_vector_type(2)));
        { unsigned mk_ = ~0u; asm volatile("" : "+s"(mk_)); const int ln_ = (int)__builtin_amdgcn_mbcnt_hi(mk_, __builtin_amdgcn_mbcnt_lo(mk_, 0u)); fr = ln_ & 15; fq = ln_ >> 4; }
        const int hh = 2 * u.pn + (wc >> 1); const bool isv = (wc & 1) != 0; const int row0 = u.pm * BM + wr * 64 + fr;
        float k2max = 0.f;
#pragma unroll
        for (int ai = 0; ai < 2; ++ai)
#pragma unroll
            for (int m = 0; m < 4; ++m) {
                const int row = row0 + ai * HALF + m * 16;
                const float* sp = ssc + (size_t)row * 12; const f32x4 pp = *(const f32x4*)(sp + 4);
                const float rs = rsqrtf(((pp[0] + pp[1]) + (pp[2] + pp[3])) * (1.0f / 128.0f) + EPS);
                if (isv) {
#pragma unroll
                    for (int bj = 0; bj < 2; ++bj) { const f32x4 v0 = acc[ai][bj][m][0] * rs, v1 = acc[ai][bj][m][1] * rs;
                        u32x4 w; w.x = pkbf(v0[0], v0[1]); w.y = pkbf(v0[2], v0[3]); w.z = pkbf(v1[0], v1[1]); w.w = pkbf(v1[2], v1[3]);
                        *(u32x4*)(VB + (size_t)row * 256 + hh * 64 + 32 * bj + 8 * fq) = w; }
                } else {
                    float ss = 0.f;
#pragma unroll
                    for (int bj = 0; bj < 2; ++bj)
#pragma unroll
                        for (int n = 0; n < 2; ++n) { const f32x4 a = acc[ai][bj][m][n]; ss += (a[0] * a[0] + a[1] * a[1]) + (a[2] * a[2] + a[3] * a[3]); }
                    ss += swz_xor<16>(ss); ss = half_sum(ss); ss *= rs * rs;
                    const float rk = rsqrtf((ss + sp[8]) * (1.0f / 96.0f) + EPS); const float rr = rs * rk;
                    bf16_t* kd = CK + (size_t)row * 384 + hh * 96; float kn2 = 0.f;
#pragma unroll
                    for (int bj = 0; bj < 2; ++bj) { const f32x4 g0 = *(const f32x4*)(ckn + 32 * bj + 8 * fq), g1 = *(const f32x4*)(ckn + 32 * bj + 8 * fq + 4);
                        const f32x4 a = acc[ai][bj][m][0] * rr * g0, b = acc[ai][bj][m][1] * rr * g1;
                        kn2 += ((a[0] * a[0] + a[1] * a[1]) + (a[2] * a[2] + a[3] * a[3])) + ((b[0] * b[0] + b[1] * b[1]) + (b[2] * b[2] + b[3] * b[3]));
                        u32x4 w; w.x = pkbf(a[0], a[1]); w.y = pkbf(a[2], a[3]); w.z = pkbf(b[0], b[1]); w.w = pkbf(b[2], b[3]);
                        *(u32x4*)(kd + 32 * bj + 8 * fq) = w; }
                    const u32x2v k1 = *(const u32x2v*)(PROJ + (size_t)row * PJ_LD + PJ_KR + 4 * fq), k2 = *(const u32x2v*)(PROJ + (size_t)row * PJ_LD + PJ_KR + 16 + 4 * fq);
                    const f32x4 ga = *(const f32x4*)(ckn + 64 + 4 * fq), gb = *(const f32x4*)(ckn + 80 + 4 * fq);
                    const float* tb = rope + (size_t)row * 48 + 16 + 8 * fq; const f32x4 t0 = *(const f32x4*)tb, t1 = *(const f32x4*)(tb + 4);
                    const float x1[4] = {bflo(k1.x) * rk * ga[0], bfhi(k1.x) * rk * ga[1], bflo(k1.y) * rk * ga[2], bfhi(k1.y) * rk * ga[3]};
                    const float x2[4] = {bflo(k2.x) * rk * gb[0], bfhi(k2.x) * rk * gb[1], bflo(k2.y) * rk * gb[2], bfhi(k2.y) * rk * gb[3]};
                    const float cs[4] = {t0[0], t0[2], t1[0], t1[2]}, sn[4] = {t0[1], t0[3], t1[1], t1[3]};
                    u32x2v y1, y2;
                    y1.x = pkbf(x1[0] * cs[0] - x2[0] * sn[0], x1[1] * cs[1] - x2[1] * sn[1]); y1.y = pkbf(x1[2] * cs[2] - x2[2] * sn[2], x1[3] * cs[3] - x2[3] * sn[3]);
                    y2.x = pkbf(x2[0] * cs[0] + x1[0] * sn[0], x2[1] * cs[1] + x1[1] * sn[1]); y2.y = pkbf(x2[2] * cs[2] + x1[2] * sn[2], x2[3] * cs[3] + x1[3] * sn[3]);
                    *(u32x2v*)(kd + 64 + 4 * fq) = y1; *(u32x2v*)(kd + 80 + 4 * fq) = y2;
                    kn2 += ((x1[0] * x1[0] + x2[0] * x2[0]) + (x1[1] * x1[1] + x2[1] * x2[1])) + ((x1[2] * x1[2] + x2[2] * x2[2]) + (x1[3] * x1[3] + x2[3] * x2[3]));
                    kn2 += swz_xor<16>(kn2); kn2 = half_sum(kn2); k2max = fmaxf(k2max, kn2);
                }
                asm volatile("" ::: "memory");
            }
        if (!isv) {
            k2max = fmaxf(k2max, swz_xor<1>(k2max)); k2max = fmaxf(k2max, swz_xor<2>(k2max)); k2max = fmaxf(k2max, swz_xor<4>(k2max)); k2max = fmaxf(k2max, swz_xor<8>(k2max));
            if (fr == 0 && fq == 0) __hip_atomic_fetch_max(kmx + ((u.pm * BM) / SEQ) * 4 + hh, __float_as_uint(k2max), __ATOMIC_RELAXED, __HIP_MEMORY_SCOPE_AGENT);
        }
        return false;
    }
};
struct EpiGates {
    static constexpr bool PERM = true;
    bf16_t* RG; RowScale rs;
    __device__ __forceinline__ bool operator()(f32x4 (&acc)[2][2][4][2], const Unit& u, int wr, int wc, int fr, int fq) const {
        typedef unsigned u32x2v __attribute__((ext_vector_type(2)));
        const int row0 = u.pm * BM + wr * 64 + fr, oc = u.pn * 64 + wc * 16 + fq * 4;
        float scv[2][4];
#pragma unroll
        for (int ai = 0; ai < 2; ++ai)
#pragma unroll
            for (int m = 0; m < 4; ++m) scv[ai][m] = row_scale(rs, row0 + ai * HALF + m * 16);
#pragma unroll
        for (int ai = 0; ai < 2; ++ai)
#pragma unroll
            for (int m = 0; m < 4; ++m) {
                const int row = row0 + ai * HALF + m * 16; const float sc = scv[ai][m];
                f32x4 s[4];
#pragma unroll
                for (int b = 0; b < 4; ++b) { const f32x4 g = acc[ai][b >> 1][m][b & 1] * sc;
#pragma unroll
                    for (int j = 0; j < 4; ++j) s[b][j] = fmaxf(fast_sigmoid(g[j]), 8.6736174e-19f); }
                bf16_t* rp = RG + (size_t)row * 4096 + oc;
#pragma unroll
                for (int b = 0; b < 4; ++b) { f32x4 r = s[b];
                    if (b < 3) {
#pragma unroll
                        for (int j = 0; j < 4; ++j) r[j] = s[b][j] * __builtin_amdgcn_rcpf(s[b + 1][j]); }
                    u32x2v w; w.x = pkbf(r[0], r[1]); w.y = pkbf(r[2], r[3]); *(u32x2v*)(rp + b * 1024) = w; }
            }
        return false;
    }
};
struct EpiMerge {
    static constexpr bool PERM = true;
    const bf16_t* SG; bf16_t* Y;
    __device__ __forceinline__ bool operator()(f32x4 (&acc)[2][2][4][2], const Unit& u, int wr, int wc, int fr, int fq) const {
        const int n = u.ak >> 8; const int row0 = u.pm * BM + wr * 64 + fr, col0 = u.pn * BM + wc * 32 + 8 * fq;
#pragma unroll
        for (int ai = 0; ai < 2; ++ai)
#pragma unroll
            for (int mp = 0; mp < 2; ++mp) {
              u32x4 av[2][2];
#pragma unroll
              for (int mm = 0; mm < 2; ++mm)
#pragma unroll
                for (int bj = 0; bj < 2; ++bj) av[mm][bj] = *(const u32x4*)(SG + (size_t)(row0 + ai * HALF + (2 * mp + mm) * 16) * 4096 + n * 1024 + col0 + bj * HALF);
#pragma unroll
              for (int mm = 0; mm < 2; ++mm) {
                const int m = 2 * mp + mm, row = row0 + ai * HALF + m * 16;
#pragma unroll
                for (int bj = 0; bj < 2; ++bj) {
                    float sa[8]; unpack8(av[mm][bj], sa);
#pragma unroll
                    for (int j = 0; j < 4; ++j) { acc[ai][bj][m][0][j] *= sa[j]; acc[ai][bj][m][1][j] *= sa[4 + j]; }
                    if (n == 3) {
                        float o[8];
#pragma unroll
                        for (int j = 0; j < 4; ++j) { o[j] = acc[ai][bj][m][0][j]; o[4 + j] = acc[ai][bj][m][1][j]; }
                        *(u32x4*)(Y + (size_t)row * DM + col0 + bj * HALF) = pack8(o);
                    }
                }
              }
            }
        return n < 3;
    }
};
struct MergeOrder {
    StaticOrder so;
    __device__ bool next(int i, Unit& u) const { if (!so.next(i >> 2, u)) return false; const int n = i & 3; u.pb = n * 4 + u.pn; u.ak = n * 256; return true; }
    __device__ __forceinline__ void a_ready(const Unit&) const {}
    __device__ __forceinline__ void done(const Unit&) const {}
};
struct MoeOrder {
    StaticOrder so; int nN; int ps[9];
    __device__ bool next(int i, Unit& u) const {
        if (!so.next(i, u)) return false; int e = 0;
#pragma unroll
        for (int k = 1; k < 8; ++k) e = (u.pm >= ps[k]) ? k : e;
        u.pb = e * nN + u.pn; u.ak = 0; return true; }
    __device__ __forceinline__ void a_ready(const Unit&) const {}
    __device__ __forceinline__ void done(const Unit&) const {}
};
}

struct TrDesc { const float* src; bf16* dst; const float* gain; int ldw, ldd, nnb, nsrc0, drow0, map, cum, pad; };
constexpr int TR_TAB_OFF = 8448;
struct TrItem { const float* W; bf16* dst; const float* gain; int ldw, ldd, k0, n0, perm; };
__device__ __forceinline__ void tr_load(const TrItem& it, float (&v)[32], int lane) {
#pragma unroll
    for (int i = 0; i < 32; ++i) { const int kk = 2 * i + (lane >> 5); v[i] = it.W[(size_t)(it.k0 + kk) * it.ldw + it.n0 + (lane & 31)]; }
}
__device__ __forceinline__ void tr_finish(const TrItem& it, float (&v)[32], LAS float* scr, int lane) {
    if (it.gain) {
#pragma unroll
        for (int i = 0; i < 32; ++i) v[i] *= it.gain[it.k0 + 2 * i + (lane >> 5)];
    }
#pragma unroll
    for (int i = 0; i < 32; ++i) scr[(2 * i + (lane >> 5)) * 33 + (lane & 31)] = v[i];
    LDS_WAIT(); asm volatile("" ::: "memory");
    const int c = lane & 7;
#pragma unroll
    for (int j = 0; j < 4; ++j) { const int n = (lane >> 3) + 8 * j; const LAS float* s = scr + (8 * c) * 33 + n;
        v4u o; o.x = pkbf(s[0 * 33], s[1 * 33]); o.y = pkbf(s[2 * 33], s[3 * 33]); o.z = pkbf(s[4 * 33], s[5 * 33]); o.w = pkbf(s[6 * 33], s[7 * 33]);
        const int nr = it.perm ? (32 * (n >> 4) + 8 * ((n >> 2) & 3) + (n & 3)) : n;
        *(v4u*)(it.dst + (size_t)nr * it.ldd + 8 * c) = o; }
    LDS_WAIT(); asm volatile("" ::: "memory");
}
__device__ __forceinline__ void tr_add(LAS TrDesc* t, int& n, int& cum, const float* src, int ldw, int Ktot, int ncols, int nsrc0, bf16* dst, int ldd, int drow0, int map, const float* gain) {
    int z = 0; asm volatile("" : "+s"(z));
    asm volatile("" : "+s"(gain));
    t[n].src = src; t[n].dst = dst; t[n].gain = gain; t[n].ldw = ldw + z; t[n].ldd = ldd + z; t[n].nnb = ncols / 32 + z; t[n].nsrc0 = nsrc0 + z; t[n].drow0 = drow0 + z; t[n].map = map + z; t[n].cum = cum + z;
    cum += (Ktot / 64) * (ncols / 32); ++n;
}
__device__ __forceinline__ TrItem tr_lookup(const LAS TrDesc* t, int& d, int it) {
    while (it >= t[d + 1].cum) ++d;
    const int local = it - t[d].cum, nnb = t[d].nnb, kb = local / nnb, nb = local - kb * nnb, k0 = kb * 64, nl = nb * 32;
    const int mp = t[d].map;
    const int drow = t[d].drow0 + (mp == 1 ? ((nl >> 7) * 256 + (nl & 127)) : mp == 2 ? (256 * (nl >> 8) + 128 * ((nl >> 5) & 1) + 32 * ((((nl >> 7) & 1) << 1) + ((nl >> 6) & 1)))
                                 : mp == 3 ? (256 * ((nl & 1023) >> 6) + 128 * (nl >> 11) + 32 * (((nl & 1023) >> 4) & 3) + 4 * ((nl >> 10) & 1)) : nl); const int ldd = t[d].ldd;
    TrItem r; r.W = t[d].src; r.dst = t[d].dst + (size_t)drow * ldd + k0; r.gain = t[d].gain; r.ldw = t[d].ldw; r.ldd = ldd; r.k0 = k0; r.n0 = t[d].nsrc0 + nl; r.perm = (mp == 3) ? 1 : 0; return r;
}
__device__ __forceinline__ void tr_run(const LAS TrDesc* t, int total, LAS float* scr, int lane, int gw, int NGW) {
    const int per = (total + NGW - 1) / NGW, lo = gw * per, hi = (lo + per < total) ? lo + per : total;
    if (lo >= hi) return;
    int d = 0; TrItem cur = tr_lookup(t, d, lo); float va[32], vb[32];
    tr_load(cur, va, lane);
    for (int it = lo; it < hi; it += 2) {
        TrItem nx = cur; const bool h1 = it + 1 < hi;
        if (h1) { nx = tr_lookup(t, d, it + 1); tr_load(nx, vb, lane); }
        tr_finish(cur, va, scr, lane);
        if (!h1) break;
        const bool h2 = it + 2 < hi;
        if (h2) { cur = tr_lookup(t, d, it + 2); tr_load(cur, va, lane); }
        tr_finish(nx, vb, scr, lane);
    }
}

template <int DK, int DV, bool MOBA>
__device__ __forceinline__ void naive_attn_unit(LAS unsigned char* lds, const bf16* Q, int qp, int qhs, const bf16* K, int kp, int khs, const bf16* V, int vp, int vhs,
                                                bf16* O, int op, int b, int h, int qc, const int* sel, const int tid) {
    LAS float* Ks = (LAS float*)lds; LAS float* Vs = Ks + 64 * DK;
    const int qi = qc * 512 + tid;
    const size_t tok = (size_t)b * SEQ + qi;
    float q[DK];
    { const v4u* qsrc = (const v4u*)(Q + tok * qp + h * qhs);
#pragma unroll
      for (int c = 0; c < DK / 8; ++c) unpack8(qsrc[c], q + 8 * c); }
    float o[DV];
#pragma unroll
    for (int d = 0; d < DV; ++d) o[d] = 0.f;
    float m = -1e30f, l = 0.f;
    const int qblk = qi >> 8; unsigned mask = 0u;
    if (MOBA) { const int sv = sel[tok * 4 + h]; const int ns = (sv >> 12) & 3;
        if (ns > 0) mask |= 1u << (sv & 15); if (ns > 1) mask |= 1u << ((sv >> 4) & 15); if (ns > 2) mask |= 1u << ((sv >> 8) & 15); }
    const int ntile = qc * 8 + 8;
    const int wave_last = qc * 512 + (tid | 63);
    for (int kt = 0; kt < ntile; ++kt) {
        __syncthreads();
        const int k0 = kt * 64;
        for (int c = tid; c < 64 * (DK / 8); c += NTHR) { const int r = c / (DK / 8), ch = c - r * (DK / 8);
            const v4u w = *(const v4u*)(K + ((size_t)b * SEQ + k0 + r) * kp + h * khs + ch * 8); float f[8]; unpack8(w, f);
            LAS f32x4* d = (LAS f32x4*)(Ks + r * DK + ch * 8); d[0] = (f32x4){f[0], f[1], f[2], f[3]}; d[1] = (f32x4){f[4], f[5], f[6], f[7]}; }
        for (int c = tid; c < 64 * (DV / 8); c += NTHR) { const int r = c / (DV / 8), ch = c - r * (DV / 8);
            const v4u w = *(const v4u*)(V + ((size_t)b * SEQ + k0 + r) * vp + h * vhs + ch * 8); float f[8]; unpack8(w, f);
            LAS f32x4* d = (LAS f32x4*)(Vs + r * DV + ch * 8); d[0] = (f32x4){f[0], f[1], f[2], f[3]}; d[1] = (f32x4){f[4], f[5], f[6], f[7]}; }
        __syncthreads();
        if (k0 > wave_last) continue;
        const int nblk = k0 >> 8;
        bool tile_ok = true;
        if (MOBA) { tile_ok = (nblk == qblk) || ((mask >> nblk) & 1u); if (!__any(tile_ok)) continue; }
        for (int jj = 0; jj < 64; ++jj) {
            const int kj = k0 + jj;
            const bool ok = MOBA ? (tile_ok && (nblk != qblk || kj <= qi)) : (kj <= qi);
            if (ok) {
                const LAS f32x4* kr = (const LAS f32x4*)(Ks + jj * DK);
                float s0 = 0.f, s1 = 0.f;
#pragma unroll
                for (int c = 0; c < DK / 8; ++c) { const f32x4 a = kr[2 * c], bq = kr[2 * c + 1];
                    s0 += q[8 * c] * a[0]; s1 += q[8 * c + 1] * a[1]; s0 += q[8 * c + 2] * a[2]; s1 += q[8 * c + 3] * a[3];
                    s0 += q[8 * c + 4] * bq[0]; s1 += q[8 * c + 5] * bq[1]; s0 += q[8 * c + 6] * bq[2]; s1 += q[8 * c + 7] * bq[3]; }
                const float s = s0 + s1;
                if (s > m) { const float cf = __builtin_amdgcn_exp2f(m - s); l *= cf;
#pragma unroll
                    for (int d = 0; d < DV; ++d) o[d] *= cf;
                    m = s; }
                const float p = __builtin_amdgcn_exp2f(s - m); l += p;
                const LAS f32x4* vr = (const LAS f32x4*)(Vs + jj * DV);
#pragma unroll
                for (int c = 0; c < DV / 4; ++c) { const f32x4 a = vr[c]; o[4 * c] += p * a[0]; o[4 * c + 1] += p * a[1]; o[4 * c + 2] += p * a[2]; o[4 * c + 3] += p * a[3]; }
            }
        }
    }
    const float inv = 1.0f / l;
    v4u* od = (v4u*)(O + tok * op + h * DV);
#pragma unroll
    for (int c = 0; c < DV / 8; ++c) { float t8[8];
#pragma unroll
        for (int j = 0; j < 8; ++j) t8[j] = o[8 * c + j] * inv;
        od[c] = pack8(t8); }
    __syncthreads();
}

constexpr int SGU_P = 136;
__device__ __forceinline__ void sgu_unit(LAS unsigned char* lds, const bf16* PROJ, bf16* O, const float* __restrict__ lng, const float* __restrict__ lnb, const bf16* __restrict__ WM, const float* __restrict__ bs, int unit, const int tid) {
    LAS bf16* vnT = (LAS bf16*)lds;
    const int lane = tid & 63, wave = __builtin_amdgcn_readfirstlane(tid >> 6), r32 = lane & 31, hi = lane >> 5;
    const size_t t0 = (size_t)unit * 128;
    const f32x4 g4 = *(const f32x4*)(lng + 4 * lane), b4 = *(const f32x4*)(lnb + 4 * lane);
    bf16x8 wf[20];
    { const int g_ = wave >> 1; const bf16* wb = WM + ((size_t)(g_ * 128 + r32) * 128 + 8 * hi);
#pragma unroll
      for (int nt = 0; nt < 4; ++nt)
#pragma unroll
          for (int ks = 0; ks < 2 * nt + 2; ++ks) wf[nt * (nt + 1) + ks] = *(const bf16x8*)(wb + (size_t)(32 * nt) * 128 + 16 * ks); }
    {
        typedef unsigned u32x2v __attribute__((ext_vector_type(2)));
        u32x2v xr[16];
#pragma unroll
        for (int i = 0; i < 16; ++i) xr[i] = *(const u32x2v*)(PROJ + (t0 + wave * 16 + i) * PJ_LD + PJ_V + 4 * lane);
        unsigned ow[4][8];
#pragma unroll
        for (int i4 = 0; i4 < 4; ++i4) {
            float x[4][4], mu[4], var[4];
#pragma unroll
            for (int u = 0; u < 4; ++u) { const u32x2v r = xr[4 * i4 + u]; x[u][0] = bflo(r.x); x[u][1] = bfhi(r.x); x[u][2] = bflo(r.y); x[u][3] = bfhi(r.y); mu[u] = (x[u][0] + x[u][1]) + (x[u][2] + x[u][3]); }
#pragma unroll
            for (int u = 0; u < 4; ++u) mu[u] = wave_sum(mu[u]) * (1.0f / 256.0f);
#pragma unroll
            for (int u = 0; u < 4; ++u) { x[u][0] -= mu[u]; x[u][1] -= mu[u]; x[u][2] -= mu[u]; x[u][3] -= mu[u]; var[u] = (x[u][0] * x[u][0] + x[u][1] * x[u][1]) + (x[u][2] * x[u][2] + x[u][3] * x[u][3]); }
#pragma unroll
            for (int u = 0; u < 4; ++u) var[u] = wave_sum(var[u]) * (1.0f / 256.0f);
#pragma unroll
            for (int u = 0; u < 4; ++u) { const float rstd = rsqrtf(var[u] + EPS);
#pragma unroll
                for (int c = 0; c < 4; ++c) x[u][c] = x[u][c] * rstd * g4[c] + b4[c]; }
#pragma unroll
            for (int c = 0; c < 4; ++c) { ow[c][2 * i4] = pkbf(x[0][c], x[1][c]); ow[c][2 * i4 + 1] = pkbf(x[2][c], x[3][c]); }
        }
#pragma unroll
        for (int c = 0; c < 4; ++c) { LAS v4u* dst = (LAS v4u*)(vnT + (4 * lane + c) * SGU_P + wave * 16);
            dst[0] = (v4u){ow[c][0], ow[c][1], ow[c][2], ow[c][3]}; dst[1] = (v4u){ow[c][4], ow[c][5], ow[c][6], ow[c][7]}; }
    }
    __syncthreads();
    const int g = wave >> 1, dt = wave & 1;
    bf16x8 af[8];
#pragma unroll
    for (int ks = 0; ks < 8; ++ks) af[ks] = *(const LAS bf16x8*)(vnT + (g * 64 + dt * 32 + r32) * SGU_P + 16 * ks + 8 * hi);
    typedef float f32x16s __attribute__((ext_vector_type(16)));
    f32x16s acc[4];
#pragma unroll
    for (int nt = 0; nt < 4; ++nt) {
#pragma unroll
        for (int r = 0; r < 16; ++r) acc[nt][r] = 0.f;
#pragma unroll
        for (int ks = 0; ks < 2 * nt + 2; ++ks) {
            acc[nt] = __builtin_amdgcn_mfma_f32_32x32x16_bf16(af[ks], wf[nt * (nt + 1) + ks], acc[nt], 0, 0, 0);
        }
    }
    typedef unsigned u32x2v __attribute__((ext_vector_type(2)));
    u32x2v uva[4][4]; float biasv[4];
#pragma unroll
    for (int nt = 0; nt < 4; ++nt) { const int t = 32 * nt + r32; biasv[nt] = bs[g * 128 + t]; const bf16* up = PROJ + (t0 + t) * PJ_LD + PJ_U + g * 64 + dt * 32 + 4 * hi;
#pragma unroll
        for (int j = 0; j < 4; ++j) uva[nt][j] = *(const u32x2v*)(up + 8 * j); }
#pragma unroll
    for (int nt = 0; nt < 4; ++nt) {
        const int t = 32 * nt + r32; const float bias = biasv[nt];
        bf16* op = O + (t0 + t) * DM + g * 64 + dt * 32 + 4 * hi;
#pragma unroll
        for (int j = 0; j < 4; ++j) {
            const u32x2v uu = uva[nt][j];
            u32x2v w; w.x = pkbf(bflo(uu.x) * (acc[nt][4 * j] + bias), bfhi(uu.x) * (acc[nt][4 * j + 1] + bias)); w.y = pkbf(bflo(uu.y) * (acc[nt][4 * j + 2] + bias), bfhi(uu.y) * (acc[nt][4 * j + 3] + bias));
            *(u32x2v*)(op + 8 * j) = w;
        }
    }
    __syncthreads();
}

__device__ __forceinline__ void prep_block(LAS unsigned char* lds, bf16* PROJ, const float* __restrict__ ROPE, const float* __restrict__ qn, const float* __restrict__ kn, float* KMEAN, unsigned* kmx_out, int item, const int tid) {
    const int b = item >> 5, blk = (item >> 1) & 15, hf = item & 1;
    const int sub = tid & 7;
    const size_t tok0 = (size_t)b * SEQ + blk * 256 + hf * 128;
    float ksum[8] = {0.f, 0.f, 0.f, 0.f, 0.f, 0.f, 0.f, 0.f};
    float kmx = 0.f;
    f32x4 gq0 = *(const f32x4*)(qn + 8 * sub), gq1 = *(const f32x4*)(qn + 8 * sub + 4), gk0 = *(const f32x4*)(kn + 8 * sub), gk1 = *(const f32x4*)(kn + 8 * sub + 4);
    LAS float* rl = (LAS float*)(lds + 16384);
    { const f32x4 r = *(const f32x4*)(ROPE + (tok0 + (tid >> 2)) * 48 + 4 * (tid & 3)); *(LAS f32x4*)(rl + (tid >> 2) * 16 + 4 * (tid & 3)) = r; }
    v4u raw[16];
#pragma unroll
    for (int u = 0; u < 16; ++u) { const int row = u * 64 + (tid >> 3);
        const int tk = row >> 3, which = (row >> 2) & 1, hd = row & 3;
        raw[u] = *(const v4u*)(PROJ + (tok0 + tk) * PJ_LD + (which ? PJ_BK : PJ_BQ) + hd * 64 + 8 * sub); }
    __syncthreads();
#pragma unroll
    for (int u = 0; u < 16; ++u) { const int row = u * 64 + (tid >> 3);
        const int tk = row >> 3, which = (row >> 2) & 1, hd = row & 3;
        float v[8]; unpack8(raw[u], v);
        float ss = ((v[0] * v[0] + v[1] * v[1]) + (v[2] * v[2] + v[3] * v[3])) + ((v[4] * v[4] + v[5] * v[5]) + (v[6] * v[6] + v[7] * v[7]));
        ss += swz_xor<1>(ss); ss += swz_xor<2>(ss); ss += swz_xor<4>(ss);
        const float rstd = rsqrtf(ss * (1.0f / 64.0f) + EPS);
        const f32x4 g0 = which ? gk0 : gq0, g1 = which ? gk1 : gq1;
#pragma unroll
        for (int j = 0; j < 4; ++j) { v[j] *= rstd * g0[j]; v[4 + j] *= rstd * g1[j]; }
        f32x4 rp[4];
#pragma unroll
        for (int q = 0; q < 4; ++q) rp[q] = *(const LAS f32x4*)(rl + tk * 16 + 4 * q);
#pragma unroll
        for (int j = 0; j < 8; ++j) { const float other = swz_xor<1>(v[j]);
            if (sub < 2) { const float cs = rp[j >> 1][2 * (j & 1)], sn = rp[j >> 1][2 * (j & 1) + 1]; v[j] = (sub == 0) ? (v[j] * cs - other * sn) : (v[j] * cs + other * sn); } }
        if (!which) {
#pragma unroll
            for (int j = 0; j < 8; ++j) v[j] *= QS_B;
        } else {
            float s2 = ((v[0] * v[0] + v[1] * v[1]) + (v[2] * v[2] + v[3] * v[3])) + ((v[4] * v[4] + v[5] * v[5]) + (v[6] * v[6] + v[7] * v[7]));
            s2 += swz_xor<1>(s2); s2 += swz_xor<2>(s2); s2 += swz_xor<4>(s2); kmx = fmaxf(kmx, s2);
#pragma unroll
            for (int j = 0; j < 8; ++j) ksum[j] += v[j];
        }
        *(v4u*)(PROJ + (tok0 + tk) * PJ_LD + (which ? PJ_BK : PJ_BQ) + hd * 64 + 8 * sub) = pack8(v);
    }
    {
        LAS float* kl = (LAS float*)lds; if (((tid >> 5) & 1) && sub == 0) kl[(tid >> 6) * 4 + ((tid >> 3) & 3)] = kmx;
        LAS float* ks = (LAS float*)(lds + 4096);
        if ((tid >> 5) & 1) { LAS f32x4* kd = (LAS f32x4*)(ks + (tid >> 6) * 256 + ((tid >> 3) & 3) * 64 + 8 * sub); kd[0] = (f32x4){ksum[0], ksum[1], ksum[2], ksum[3]}; kd[1] = (f32x4){ksum[4], ksum[5], ksum[6], ksum[7]}; }
        __syncthreads();
        if (tid < 4) { float mx = 0.f;
#pragma unroll
            for (int w = 0; w < 8; ++w) mx = fmaxf(mx, kl[w * 4 + tid]);
            __hip_atomic_fetch_max(kmx_out + b * 4 + tid, __float_as_uint(mx), __ATOMIC_RELAXED, __HIP_MEMORY_SCOPE_AGENT); }
        if (tid >= 256) { const int hd = tid - 256; float s = 0.f;
#pragma unroll
            for (int w = 0; w < 8; ++w) s += ks[w * 256 + hd];
            KMEAN[(((size_t)(b * 4 + (hd >> 6)) * 16 + blk) * 2 + hf) * 64 + (hd & 63)] = s; }
    }
    __syncthreads();
}

__device__ __forceinline__ void conv_unit(LAS unsigned char* lds, const bf16* PROJ, bf16* O, const float* __restrict__ cw, const float* __restrict__ cb, const float* __restrict__ lng, const float* __restrict__ lnb, int unit, const int tid) {
    LAS float* zc = (LAS float*)lds;
    const int lane = tid & 63, wave = __builtin_amdgcn_readfirstlane(tid >> 6);
    const int b = unit >> 6, p0 = (unit & 63) * 64;
    const int ch = tid & 255, half = tid >> 8;
    {
        typedef unsigned u32x2v __attribute__((ext_vector_type(2)));
        u32x2v av[12], gv[12];
#pragma unroll
        for (int i = 0; i < 12; ++i) { const int r = wave + 8 * i, p = p0 - 30 + r; av[i] = (u32x2v){0u, 0u}; gv[i] = (u32x2v){0u, 0u};
            if (r < 94 && p >= 0) { const bf16* row = PROJ + ((size_t)b * SEQ + p) * PJ_LD; av[i] = *(const u32x2v*)(row + PJ_DA + 4 * lane); gv[i] = *(const u32x2v*)(row + PJ_DG + 4 * lane); } }
#pragma unroll
        for (int i = 0; i < 12; ++i) { const int r = wave + 8 * i;
            if (r < 94) *(LAS f32x4*)(zc + r * 256 + 4 * lane) = (f32x4){bflo(av[i].x) * fast_sigmoid(bflo(gv[i].x)), bfhi(av[i].x) * fast_sigmoid(bfhi(gv[i].x)), bflo(av[i].y) * fast_sigmoid(bflo(gv[i].y)), bfhi(av[i].y) * fast_sigmoid(bfhi(gv[i].y))}; }
    }
    float w[31];
#pragma unroll
    for (int j = 0; j < 31; ++j) w[j] = cw[j * 256 + ch];
    const float bias = cb[ch];
    __syncthreads();
    float acc[32];
    {
        float z[62];
#pragma unroll
        for (int j = 0; j < 62; ++j) z[j] = zc[(half * 32 + j) * 256 + ch];
#pragma unroll
        for (int t = 0; t < 32; ++t) { float a = bias;
#pragma unroll
            for (int j = 0; j < 31; ++j) a += w[j] * z[t + j];
            acc[t] = a; }
    }
    __syncthreads();
#pragma unroll
    for (int t = 0; t < 32; ++t) zc[(half * 32 + t) * 256 + ch] = acc[t];
    __syncthreads();
    const f32x4 g4 = *(const f32x4*)(lng + lane * 4), b4 = *(const f32x4*)(lnb + lane * 4);
    for (int i4 = 0; i4 < 2; ++i4) {
        f32x4 x[4]; float mu[4], var[4];
#pragma unroll
        for (int u = 0; u < 4; ++u) { x[u] = *(const LAS f32x4*)(zc + (wave * 8 + i4 * 4 + u) * 256 + lane * 4); mu[u] = (x[u][0] + x[u][1]) + (x[u][2] + x[u][3]); }
#pragma unroll
        for (int u = 0; u < 4; ++u) mu[u] = wave_sum(mu[u]) * (1.0f / 256.0f);
#pragma unroll
        for (int u = 0; u < 4; ++u) { x[u] = x[u] - mu[u]; var[u] = (x[u][0] * x[u][0] + x[u][1] * x[u][1]) + (x[u][2] * x[u][2] + x[u][3] * x[u][3]); }
#pragma unroll
        for (int u = 0; u < 4; ++u) var[u] = wave_sum(var[u]) * (1.0f / 256.0f);
#pragma unroll
        for (int u = 0; u < 4; ++u) { const float rstd = rsqrtf(var[u] + EPS);
            const float y0 = x[u][0] * rstd * g4[0] + b4[0], y1 = x[u][1] * rstd * g4[1] + b4[1], y2 = x[u][2] * rstd * g4[2] + b4[2], y3 = x[u][3] * rstd * g4[3] + b4[3];
            typedef unsigned u32x2v __attribute__((ext_vector_type(2)));
            u32x2v wv; wv.x = pkbf(fast_silu(y0), fast_silu(y1)); wv.y = pkbf(fast_silu(y2), fast_silu(y3));
            *(u32x2v*)(O + ((size_t)b * SEQ + p0 + wave * 8 + i4 * 4 + u) * DM + 768 + lane * 4) = wv; }
    }
    __syncthreads();
}

typedef float f32x16 __attribute__((ext_vector_type(16)));
template <int DK> struct AttnLds { static constexpr int KBYTES = 64 * DK * 2  , VP = 68, VBYTES = 64 * VP * 2, K0 = 0, K1 = KBYTES, V0 = 2 * KBYTES, V1 = 2 * KBYTES + VBYTES, UM = 2 * KBYTES + 2 * VBYTES; };
__device__ __forceinline__ float half_max(float v) { auto rr = __builtin_amdgcn_permlane32_swap(__float_as_uint(v), __float_as_uint(v), false, false); return fmaxf(__uint_as_float(rr[0]), __uint_as_float(rr[1])); }
#define ATT_FAST_BOUND 30.0f
__device__ __forceinline__ void softmax_fast(f32x16& s, float& l, bf16x8 (&p)[2], const bool diag, const bool blocked, const int qi, const int kbase) {
    if (diag) {
#pragma unroll
        for (int r = 0; r < 16; ++r) { const int key = kbase + (r & 3) + 8 * (r >> 2); if (key > qi) s[r] = -INFINITY; }
    }
    float sum = 0.f;
#pragma unroll
    for (int r = 0; r < 16; ++r) { const float e = __builtin_amdgcn_exp2f(s[r]); s[r] = e; sum += e; }
    v4u w0, w1;
    w0.x = pkbf(s[0], s[1]); w0.y = pkbf(s[2], s[3]); w0.z = pkbf(s[4], s[5]); w0.w = pkbf(s[6], s[7]);
    w1.x = pkbf(s[8], s[9]); w1.y = pkbf(s[10], s[11]); w1.z = pkbf(s[12], s[13]); w1.w = pkbf(s[14], s[15]);
    if (blocked) { sum = 0.f; w0 = (v4u){0u, 0u, 0u, 0u}; w1 = (v4u){0u, 0u, 0u, 0u}; }
    l += sum;
    p[0] = __builtin_bit_cast(bf16x8, w0); p[1] = __builtin_bit_cast(bf16x8, w1);
}
__device__ __forceinline__ void softmax_group(f32x16& s, f32x16 (&o)[2], float& m, float& l, bf16x8 (&p)[2], const bool diag, const bool blocked, const int qi, const int kbase) {
    if (diag) {
#pragma unroll
        for (int r = 0; r < 16; ++r) { const int key = kbase + (r & 3) + 8 * (r >> 2); if (key > qi) s[r] = -INFINITY; }
    }
    float mx = fmaxf(s[0], s[1]);
#pragma unroll
    for (int r = 2; r < 16; ++r) mx = fmaxf(mx, s[r]);
    mx = half_max(mx);
    if (blocked) mx = -INFINITY;
    const float mn = fmaxf(m, mx);
    const float ms = (mn == -INFINITY) ? 0.f : mn;
    const float alpha = __builtin_amdgcn_exp2f(m - ms);
    const float mse = blocked ? INFINITY : ms;
    float sum = 0.f;
#pragma unroll
    for (int r = 0; r < 16; ++r) { const float e = __builtin_amdgcn_exp2f(s[r] - mse); s[r] = e; sum += e; }
    l = l * alpha + sum; m = mn;
    if (__any(alpha != 1.f)) {
#pragma unroll
        for (int dt = 0; dt < 2; ++dt)
#pragma unroll
            for (int r = 0; r < 16; ++r) o[dt][r] *= alpha;
    }
#pragma unroll
    for (int st = 0; st < 2; ++st) { const int bs = 8 * st;
        v4u w; w.x = pkbf(s[bs], s[bs + 1]); w.y = pkbf(s[bs + 2], s[bs + 3]); w.z = pkbf(s[bs + 4], s[bs + 5]); w.w = pkbf(s[bs + 6], s[bs + 7]);
        p[st] = __builtin_bit_cast(bf16x8, w); }
}
template <int NKS, int DK>
__device__ __forceinline__ float qpost(bf16x8 (&qf)[NKS], const float* __restrict__ qgain, const float* __restrict__ tabrow, const int hi) {
    float qv[8 * NKS]; float ss = 0.f;
#pragma unroll
    for (int ks = 0; ks < NKS; ++ks) unpack8(__builtin_bit_cast(v4u, qf[ks]), qv + 8 * ks);
#pragma unroll
    for (int i = 0; i < 8 * NKS; ++i) ss += qv[i] * qv[i];
    const float rstd = rsqrtf(half_sum(ss) * (1.0f / (float)DK) + EPS);
#pragma unroll
    for (int ks = 0; ks < NKS; ++ks) { const f32x4 ga = *(const f32x4*)(qgain + 16 * ks + 8 * hi), gb = *(const f32x4*)(qgain + 16 * ks + 8 * hi + 4);
#pragma unroll
        for (int j = 0; j < 4; ++j) { qv[8 * ks + j] *= rstd * ga[j]; qv[8 * ks + 4 + j] *= rstd * gb[j]; } }
    const float* tb = tabrow + 16 + 16 * hi;
#pragma unroll
    for (int j = 0; j < 8; ++j) { const float cs = tb[2 * j], sn = tb[2 * j + 1], x1 = qv[32 + j], x2 = qv[40 + j]; qv[32 + j] = x1 * cs - x2 * sn; qv[40 + j] = x2 * cs + x1 * sn; }
    float q2 = 0.f;
#pragma unroll
    for (int i = 0; i < 8 * NKS; ++i) { qv[i] *= QS_C; q2 += qv[i] * qv[i]; }
#pragma unroll
    for (int ks = 0; ks < NKS; ++ks) qf[ks] = __builtin_bit_cast(bf16x8, pack8(qv + 8 * ks));
    return half_sum(q2);
}
template <int DK, bool MOBA, bool QPOST, int qp, int qhs, int kp, int khs, int vp, int vhs, int op>
__device__ __forceinline__ void attn_unit(LAS unsigned char* lds, const bf16* __restrict__ Q, const bf16* __restrict__ K,
                                          const bf16* __restrict__ V, bf16* O, const int b, const int h, const int qc, const float* __restrict__ kmean, const float* __restrict__ qgain, const float* __restrict__ rope, const unsigned* __restrict__ kmx, const int tid) {
    using L = AttnLds<DK>;
    constexpr int NKS = DK / 16, KCH = DK / 8;
    const int lane = tid & 63, w = __builtin_amdgcn_readfirstlane(tid >> 6), r32 = lane & 31, hi = lane >> 5;
    const int q0 = qc * 512;
    const size_t tokbase = (size_t)b * SEQ;
    const int g0 = w, g1 = 15 - w;
    const int qi0 = q0 + 32 * g0 + r32, qi1 = q0 + 32 * g1 + r32;
    const int tl0 = (q0 + 32 * g0 + 31) >> 6, tl1 = (q0 + 32 * g1 + 31) >> 6;
    const int ob0 = (q0 + 32 * g0) >> 8, ob1 = (q0 + 32 * g1) >> 8;
    bf16x8 qf0[NKS], qf1[NKS];
    { const bf16* p0 = Q + (tokbase + qi0) * qp + h * qhs + 8 * hi;
#pragma unroll
      for (int ks = 0; ks < NKS; ++ks) qf0[ks] = *(const bf16x8*)(p0 + 16 * ks); }
    float q2a = 0.f, q2b = 0.f;
    if (QPOST) { q2a = qpost<NKS, DK>(qf0, qgain, rope + (tokbase + qi0) * 48, hi); asm volatile("" ::: "memory"); }
    { const bf16* p1 = Q + (tokbase + qi1) * qp + h * qhs + 8 * hi;
#pragma unroll
      for (int ks = 0; ks < NKS; ++ks) qf1[ks] = *(const bf16x8*)(p1 + 16 * ks); }
    if (QPOST) { q2b = qpost<NKS, DK>(qf1, qgain, rope + (tokbase + qi1) * 48, hi); asm volatile("" ::: "memory"); }
    unsigned mk0 = 0u, mk1 = 0u, umask = 0xffffffffu;
    if (MOBA) {
        LAS float* kml = (LAS float*)(lds + L::UM + 16);
        { const float* kmg = kmean + (size_t)(b * 4 + h) * 16 * 128;
          for (int i = tid; i < 1024; i += NTHR) { const int n = i >> 6, d = i & 63; kml[i] = (kmg[n * 128 + d] + kmg[n * 128 + 64 + d]) * (1.0f / 256.0f); } }
        __syncthreads();
        const LAS float* km = kml + 8 * hi;
#pragma unroll
        for (int g = 0; g < 2; ++g) {
            float qv[8 * NKS];
#pragma unroll
            for (int ks = 0; ks < NKS; ++ks) unpack8(__builtin_bit_cast(v4u, g ? qf1[ks] : qf0[ks]), qv + 8 * ks);
            { float q2 = 0.f;
#pragma unroll
              for (int i = 0; i < 8 * NKS; ++i) q2 += qv[i] * qv[i];
              q2 = half_sum(q2); if (g) q2b = q2; else q2a = q2; }
            const int ob = g ? ob1 : ob0;
            float s0 = -INFINITY, s1 = -INFINITY, s2 = -INFINITY; int i0 = 0, i1 = 0, i2 = 0;
            for (int n = 0; n < ob; ++n) {
                const LAS float* kmp = km + n * 64; float sc = 0.f;
#pragma unroll
                for (int ks = 0; ks < NKS; ++ks) { const f32x4 ka = *(const LAS f32x4*)(kmp + 16 * ks), kb2 = *(const LAS f32x4*)(kmp + 16 * ks + 4);
                    sc += qv[8 * ks] * ka[0]; sc += qv[8 * ks + 1] * ka[1]; sc += qv[8 * ks + 2] * ka[2]; sc += qv[8 * ks + 3] * ka[3];
                    sc += qv[8 * ks + 4] * kb2[0]; sc += qv[8 * ks + 5] * kb2[1]; sc += qv[8 * ks + 6] * kb2[2]; sc += qv[8 * ks + 7] * kb2[3]; }
                sc = half_sum(sc);
                if (sc > s0) { s2 = s1; i2 = i1; s1 = s0; i1 = i0; s0 = sc; i0 = n; }
                else if (sc > s1) { s2 = s1; i2 = i1; s1 = sc; i1 = n; }
                else if (sc > s2) { s2 = sc; i2 = n; }
            }
            unsigned mk = 0u; if (ob > 0) mk |= 1u << i0; if (ob > 1) mk |= 1u << i1; if (ob > 2) mk |= 1u << i2;
            if (g) mk1 = mk; else mk0 = mk;
        }
        LAS unsigned* um = (LAS unsigned*)(lds + L::UM);
        if (tid == 0) *um = 0u;
        __syncthreads();
        __hip_atomic_fetch_or(um, mk0 | mk1, __ATOMIC_RELAXED, __HIP_MEMORY_SCOPE_WORKGROUP);
        __syncthreads();
        umask = *um;
    }
    const float k2m = __uint_as_float(__hip_atomic_load(kmx + b * 4 + h, __ATOMIC_RELAXED, __HIP_MEMORY_SCOPE_AGENT));
    const bool fast = __all(fmaxf(q2a, q2b) * k2m <= ATT_FAST_BOUND * ATT_FAST_BOUND);
    const int ntile = qc * 8 + 8;
    v4u vreg = {0u, 0u, 0u, 0u};
#define ATT_NEEDED(t) (!MOBA || ((t) >> 2) >= 2 * qc || ((umask >> ((t) >> 2)) & 1u))
#define ATT_LOADK(t, buf) do { const bf16* kt_ = K + (tokbase + (size_t)(t) * 64) * kp + h * khs; int ln_ = lane; asm volatile("" : "+v"(ln_)); \
        LAS unsigned char* kd_ = lds + ((buf) ? L::K1 : L::K0) + w * 1024; \
        __builtin_amdgcn_global_load_lds((const unsigned*)(kt_ + ln_ * kp + w * 8), (LAS unsigned*)kd_, 16, 0, 0); \
        if (DK == 96 && w < 4) __builtin_amdgcn_global_load_lds((const unsigned*)(kt_ + ln_ * kp + (8 + w) * 8), (LAS unsigned*)(kd_ + 8192), 16, 0, 0); } while (0)
#define ATT_LOADV(t) do { int t2_ = tid; asm volatile("" : "+v"(t2_)); const int vkey = t2_ >> 3, vch = t2_ & 7; \
        vreg = *(const v4u*)(V + (tokbase + (size_t)(t) * 64) * vp + (vkey * vp + h * vhs + vch * 8)); } while (0)
    unsigned krd_lane = (unsigned)(hi * 1024 + r32 * 16), vrd_lane = (unsigned)((r32 * L::VP + 4 * hi) * 2);
    asm volatile("" : "+v"(krd_lane), "+v"(vrd_lane));
#define ATT_STOREV(buf) do { int t2_ = tid; asm volatile("" : "+v"(t2_)); const int vkey = t2_ >> 3, vch = t2_ & 7; \
        LAS unsigned char* vtb_ = lds + ((buf) ? L::V1 : L::V0) + ((vch * 8) * L::VP + vkey) * 2; asm volatile("" : "+v"(vtb_)); LAS bf16* vt_ = (LAS bf16*)vtb_; \
        vt_[0 * L::VP] = (bf16)(vreg.x & 0xffffu); vt_[1 * L::VP] = (bf16)(vreg.x >> 16); vt_[2 * L::VP] = (bf16)(vreg.y & 0xffffu); vt_[3 * L::VP] = (bf16)(vreg.y >> 16); \
        vt_[4 * L::VP] = (bf16)(vreg.z & 0xffffu); vt_[5 * L::VP] = (bf16)(vreg.z >> 16); vt_[6 * L::VP] = (bf16)(vreg.w & 0xffffu); vt_[7 * L::VP] = (bf16)(vreg.w >> 16); } while (0)
    int t = 0; while (t < ntile && !ATT_NEEDED(t)) t += 4;
    ATT_LOADK(t, 0); ATT_LOADV(t); ATT_STOREV(0);
    asm volatile("s_waitcnt vmcnt(0)" ::: "memory");
    __syncthreads();
    f32x16 o0[2], o1[2];
#pragma unroll
    for (int dt = 0; dt < 2; ++dt)
#pragma unroll
        for (int r = 0; r < 16; ++r) { o0[dt][r] = 0.f; o1[dt][r] = 0.f; }
    float m0 = -INFINITY, m1 = -INFINITY, l0 = 0.f, l1 = 0.f;
    int cur = 0;
#define ATT_LOOP(FASTP) do { \
    while (t < ntile) { \
        int tn = t + 1; while (tn < ntile && (tn & 3) == 0 && !ATT_NEEDED(tn)) tn += 4; \
        if (tn < ntile) { ATT_LOADK(tn, cur ^ 1); ATT_LOADV(tn); }    \
        const int nblk = t >> 2; \
        bool a0 = (t <= tl0), a1 = (t <= tl1); \
        bool bl0 = false, bl1 = false; \
        if (MOBA) { \
            bl0 = (nblk != ob0) && !((mk0 >> nblk) & 1u); bl1 = (nblk != ob1) && !((mk1 >> nblk) & 1u); \
            a0 = a0 && __any(!bl0); a1 = a1 && __any(!bl1); \
        } \
        if (a0 || a1) { \
            const LAS unsigned char* kb = lds + (cur ? L::K1 : L::K0) + krd_lane; const LAS unsigned char* vb = lds + (cur ? L::V1 : L::V0) + vrd_lane; \
            asm volatile("" : "+v"(kb), "+v"(vb)); \
_Pragma("unroll") \
            for (int kt = 0; kt < 2; ++kt) { \
                f32x16 s0, s1; \
_Pragma("unroll") \
                for (int r = 0; r < 16; ++r) { s0[r] = 0.f; s1[r] = 0.f; } \
_Pragma("unroll") \
                for (int ks = 0; ks < NKS; ++ks) { \
                    const bf16x8 kf = *(const LAS bf16x8*)(kb + (2 * ks * 1024 + 32 * kt * 16)); \
                    if (a0) s0 = __builtin_amdgcn_mfma_f32_32x32x16_bf16(kf, qf0[ks], s0, 0, 0, 0); \
                    if (a1) s1 = __builtin_amdgcn_mfma_f32_32x32x16_bf16(kf, qf1[ks], s1, 0, 0, 0); \
                } \
                bf16x8 p0[2], p1[2]; \
                const int kbase = 64 * t + 32 * kt + 4 * hi; \
                if (a0) { if (FASTP) softmax_fast(s0, l0, p0, t == tl0, bl0, qi0, kbase); else softmax_group(s0, o0, m0, l0, p0, t == tl0, bl0, qi0, kbase); } \
                __builtin_amdgcn_sched_barrier(0);    \
                if (a1) { if (FASTP) softmax_fast(s1, l1, p1, t == tl1, bl1, qi1, kbase); else softmax_group(s1, o1, m1, l1, p1, t == tl1, bl1, qi1, kbase); } \
                __builtin_amdgcn_sched_barrier(0); \
_Pragma("unroll") \
                for (int st = 0; st < 2; ++st) \
_Pragma("unroll") \
                    for (int dt = 0; dt < 2; ++dt) { \
                        typedef unsigned u32x2v __attribute__((ext_vector_type(2))); \
                        const LAS unsigned char* vp_ = vb + (32 * dt * L::VP + 32 * kt + 16 * st) * 2; \
                        const u32x2v va = *(const LAS u32x2v*)vp_, vc = *(const LAS u32x2v*)(vp_ + 16); \
                        const v4u vv = {va.x, va.y, vc.x, vc.y}; const bf16x8 vf = __builtin_bit_cast(bf16x8, vv); \
                        if (a0) o0[dt] = __builtin_amdgcn_mfma_f32_32x32x16_bf16(vf, p0[st], o0[dt], 0, 0, 0); \
                        if (a1) o1[dt] = __builtin_amdgcn_mfma_f32_32x32x16_bf16(vf, p1[st], o1[dt], 0, 0, 0); \
                    } \
            } \
        } \
        if (tn < ntile) ATT_STOREV(cur ^ 1); \
        asm volatile("s_waitcnt vmcnt(0)" ::: "memory"); \
        __syncthreads(); \
        t = tn; cur ^= 1; \
    } \
    } while (0)
    if (fast) ATT_LOOP(true); else ATT_LOOP(false);
#undef ATT_LOOP
#undef ATT_NEEDED
#undef ATT_LOADK
#undef ATT_LOADV
#undef ATT_STOREV
    {
        typedef unsigned u32x2v __attribute__((ext_vector_type(2)));
        const float i0 = 1.0f / half_sum(l0), i1 = 1.0f / half_sum(l1);
        bf16* d0 = O + (tokbase + qi0) * op + h * 64 + 4 * hi; bf16* d1 = O + (tokbase + qi1) * op + h * 64 + 4 * hi;
#pragma unroll
        for (int dt = 0; dt < 2; ++dt)
#pragma unroll
            for (int j = 0; j < 4; ++j) {
                u32x2v wa; wa.x = pkbf(o0[dt][4 * j] * i0, o0[dt][4 * j + 1] * i0); wa.y = pkbf(o0[dt][4 * j + 2] * i0, o0[dt][4 * j + 3] * i0); *(u32x2v*)(d0 + 32 * dt + 8 * j) = wa;
                u32x2v wb; wb.x = pkbf(o1[dt][4 * j] * i1, o1[dt][4 * j + 1] * i1); wb.y = pkbf(o1[dt][4 * j + 2] * i1, o1[dt][4 * j + 3] * i1); *(u32x2v*)(d1 + 32 * dt + 8 * j) = wb;
            }
    }
}
struct Args { const void* in[31]; float* out; unsigned char* ws; int ph_lo, ph_hi; };
constexpr int N_PHASES = 1 + 8 + 11 + 8 + 11;
typedef const __attribute__((address_space(4))) Args* KArgs;
__device__ __forceinline__ KArgs kargs() { KArgs p = (KArgs)__builtin_amdgcn_kernarg_segment_ptr(); asm volatile("" : "+s"(p)); return p; }
#define IN_F(i) ((const float*)A->in[i])
#define WSP(type, off) ((type*)(ws + (off)))
#ifndef TPROBE
#define TPROBE 0
#endif
#define TP_BID 203
#define TP_ACC(lds) ((LAS unsigned long long*)((lds) + MISC_OFF + 64))
#define TP_BEGIN(id) unsigned long long tp0_##id = 0ull; if (TPROBE == (id)) { __syncthreads(); tp0_##id = __builtin_amdgcn_s_memrealtime(); }
#define TP_END(id, lds) if (TPROBE == (id)) { __syncthreads(); if (blockIdx.x == TP_BID && threadIdx.x == 0) *TP_ACC(lds) += __builtin_amdgcn_s_memrealtime() - tp0_##id; }
struct Ctx { int tid, lane, wave, G, bid, gw, NGW, gt, NGT; };
__device__ __forceinline__ Ctx mkctx(int wv) {
    Ctx c; unsigned m = ~0u; asm volatile("" : "+s"(m)); const int ln = (int)__builtin_amdgcn_mbcnt_hi(m, __builtin_amdgcn_mbcnt_lo(m, 0u));
    int b = blockIdx.x; asm volatile("" : "+s"(b)); int w = wv; asm volatile("" : "+s"(w));
    c.tid = w * 64 + ln; c.lane = ln; c.wave = w; c.G = gridDim.x; c.bid = b;
    c.gw = c.bid * NWAVES + c.wave; c.NGW = c.G * NWAVES; c.gt = c.bid * NTHR + c.tid; c.NGT = c.G * NTHR; return c; }

__device__ __forceinline__ void conv_mixer_weights(int wv, LAS unsigned char* lds, int l) {
    const Ctx c = mkctx(wv);
    KArgs A = kargs(); unsigned char* ws = A->ws;
    const int lane = c.lane, gw = c.gw, NGW = c.NGW, gt = c.gt, NGT = c.NGT;
    LAS float* scr = (LAS float*)(lds + RING_OFF + c.wave * 16384); LAS TrDesc* tab = (LAS TrDesc*)(lds + RING_OFF + TR_TAB_OFF); asm volatile("" : "+v"(tab));
    bf16* WINR = WSP(bf16, W_INR); bf16* WUQ = WSP(bf16, W_UQ); bf16* WUKV = WSP(bf16, W_UKV);
    int total = 0;
    if (c.tid == 0) {
        int n = 0, cum = 0;
        const float* an = IN_F(2) + l * DM; const float* win = IN_F(4) + (size_t)l * DM * IN_COLS;
        tr_add(tab, n, cum, win, IN_COLS, DM, 4096, 0, WSP(bf16, W_G), DM, 0, 3, an);
        tr_add(tab, n, cum, win, IN_COLS, DM, 1280, 4096, WINR, DM, 0, 0, an);
        tr_add(tab, n, cum, win, IN_COLS, DM, 512, 5728, WINR, DM, 1280, 0, an);
        tr_add(tab, n, cum, win, IN_COLS, DM, 352, 5376, WINR, DM, 1792, 0, an);
        tr_add(tab, n, cum, IN_F(13) + (size_t)l * 192 * 384, 384, 192, 384, 0, WUQ, 256, 0, 0, IN_F(11) + l * 192);
        tr_add(tab, n, cum, IN_F(14) + (size_t)l * 128 * 512, 512, 128, 512, 0, WUKV, 256, 0, 2, IN_F(12) + l * 128);
        for (int nb = 0; nb < 4; ++nb) tr_add(tab, n, cum, IN_F(21) + ((size_t)l * 4 + nb) * 256 * DM, DM, 256, DM, 0, WSP(bf16, W_B), 256, nb * 1024, 0, nullptr);
        tr_add(tab, n, cum, IN_F(22) + (size_t)l * DM * DM, DM, DM, DM, 0, WSP(bf16, W_OUT), DM, 0, 0, nullptr);
        tab[n].cum = cum; tab[31].cum = cum;
    }
    __syncthreads();
    total = tab[31].cum;
    tr_run(tab, total, scr, lane, gw, NGW);
    unsigned zz = 0u; asm volatile("" : "+v"(zz)); const v4u z4 = {zz, zz, zz, zz};
    for (int i = gt; i < 160 * DM / 8; i += NGT) ((v4u*)(WINR + (size_t)2144 * DM))[i] = z4;
    for (int i = gt; i < 128 * 256 / 8; i += NGT) ((v4u*)(WUQ + (size_t)384 * 256))[i] = z4;
    for (int i = gt; i < 384 * 8; i += NGT) ((v4u*)(WUQ + (size_t)(i >> 3) * 256 + 192))[i & 7] = z4;
    for (int i = gt; i < 512 * 16; i += NGT) ((v4u*)(WUKV + (size_t)(i >> 4) * 256 + 128))[i & 15] = z4;
    {
        const float* wsrc = IN_F(7) + (size_t)l * 4 * 128 * 128; bf16* wm = WSP(bf16, MS_WSGU);
        for (int i = gt; i < 4 * 128 * 128 / 8; i += NGT) {
            const int t = (i >> 4) & 127, s0 = (i & 15) * 8; const f32x4 a = *(const f32x4*)(wsrc + (size_t)i * 8), b = *(const f32x4*)(wsrc + (size_t)i * 8 + 4);
            float f[8] = {a[0], a[1], a[2], a[3], b[0], b[1], b[2], b[3]};
#pragma unroll
            for (int j = 0; j < 8; ++j) f[j] = (s0 + j <= t) ? f[j] : 0.f;
            *(v4u*)(wm + (size_t)i * 8) = pack8(f);
        }
    }
    __syncthreads();
}
__device__ __forceinline__ void conv_ffn_weights(int wv, LAS unsigned char* lds, int l) {
    const Ctx c = mkctx(wv);
    KArgs A = kargs(); unsigned char* ws = A->ws;
    LAS float* scr = (LAS float*)(lds + RING_OFF + c.wave * 16384); LAS TrDesc* tab = (LAS TrDesc*)(lds + RING_OFF + TR_TAB_OFF); asm volatile("" : "+v"(tab));
    if (c.tid == 0) {
        int n = 0, cum = 0; const bool moe = (l & 1) != 0; const int li = l >> 1; const float* fn = IN_F(3) + l * DM;
        if (!moe) {
            tr_add(tab, n, cum, IN_F(23) + (size_t)li * DM * FFN, FFN, DM, FFN, 0, WSP(bf16, W_F1), DM, 0, 1, fn);
            tr_add(tab, n, cum, IN_F(24) + (size_t)li * DM * FFN, FFN, DM, FFN, 0, WSP(bf16, W_F1), DM, 128, 1, fn);
            tr_add(tab, n, cum, IN_F(25) + (size_t)li * FFN * DM, DM, FFN, DM, 0, WSP(bf16, W_F2), FFN, 0, 0, nullptr);
        } else {
            for (int e = 0; e < NE; ++e) {
                tr_add(tab, n, cum, IN_F(28) + ((size_t)li * NE + e) * DM * EDIM, EDIM, DM, EDIM, 0, WSP(bf16, W_F1), DM, e * 2 * EDIM, 1, fn);
                tr_add(tab, n, cum, IN_F(29) + ((size_t)li * NE + e) * DM * EDIM, EDIM, DM, EDIM, 0, WSP(bf16, W_F1), DM, e * 2 * EDIM + 128, 1, fn);
                tr_add(tab, n, cum, IN_F(30) + ((size_t)li * NE + e) * EDIM * DM, DM, EDIM, DM, 0, WSP(bf16, W_F2), EDIM, e * DM, 0, nullptr);
            }
        }
        tab[n].cum = cum; tab[31].cum = cum;
    }
    __syncthreads();
    tr_run(tab, tab[31].cum, scr, c.lane, c.gw, c.NGW);
    __syncthreads();
}
__device__ __forceinline__ void ph_prologue(int wv, LAS unsigned char* lds) {
    conv_mixer_weights(wv, lds, 0);
    const Ctx c = mkctx(wv);
    KArgs A = kargs(); unsigned char* ws = A->ws;
    const int lane = c.lane, gw = c.gw, NGW = c.NGW, gt = c.gt, NGT = c.NGT;
    {
        const float* x_in = IN_F(0); const int* positions = (const int*)A->in[1];
        bf16* XB = WSP(bf16, WS_XB); float* SSA = WSP(float, WS_SSA); float* ROPE = WSP(float, WS_ROPE);
        for (int mrow = gw; mrow < T; mrow += NGW) {
            const f32x4* xr = (const f32x4*)(x_in + (size_t)mrow * DM) + lane; float s = 0.f;
            typedef unsigned u32x2v __attribute__((ext_vector_type(2)));
            u32x2v* o8 = (u32x2v*)(XB + (size_t)mrow * DM) + lane;
#pragma unroll
            for (int j = 0; j < 4; ++j) { const f32x4 v = xr[64 * j]; s += (v[0] * v[0] + v[1] * v[1]) + (v[2] * v[2] + v[3] * v[3]); u32x2v w; w.x = pkbf(v[0], v[1]); w.y = pkbf(v[2], v[3]); o8[64 * j] = w; }
            s = wave_sum(s);
            if (lane < 4) SSA[(size_t)mrow * 4 + lane] = (lane == 0) ? s : 0.f;
        }
        for (int i = gt; i < T * 24; i += NGT) {
            const int tok = i / 24, a = i - tok * 24;
            const float inv = (a < 8) ? powf(500000.0f, -(float)a * 0.125f) : powf(500000.0f, -(float)(a - 8) * 0.0625f);
            const float ang = (float)positions[tok] * inv; float sn, cs; sincosf(ang, &sn, &cs);
            ROPE[(size_t)tok * 48 + 2 * a] = cs; ROPE[(size_t)tok * 48 + 2 * a + 1] = sn;
        }
    }
}
__device__ __forceinline__ void ph_inproj(int wv, LAS unsigned char* lds) {
    const Ctx c = mkctx(wv);
    KArgs A = kargs(); unsigned char* ws = A->ws;
    pg8::Gemm g{WSP(bf16, WS_XB), WSP(bf16, W_INR), DM, DM, DM}; pg8::StaticOrder S; S.init(T, PJ_LD, c.G, c.bid);
    pg8::EpiScale<0> E{WSP(bf16, B_PROJ), PJ_LD, pg8::RowScale{WSP(float, WS_SSA), 1}, WSP(float, WS_SSC)};
    pg8::gemm_phase<pg8::EpiScale<0>, pg8::StaticOrder, true, true>(lds + RING_OFF, g, S, E, c.tid);
}
__device__ __forceinline__ void mla_up_gemms(int wv, LAS unsigned char* lds, int l) {
    const Ctx c = mkctx(wv);
    { KArgs A = kargs(); unsigned char* ws = A->ws;
      pg8::Gemm g{WSP(bf16, B_PROJ) + PJ_CQ, WSP(bf16, W_UQ), PJ_LD, 256, 256}; pg8::StaticOrder S; S.init(T, 512, c.G, c.bid);
      pg8::EpiScale<0> E{WSP(bf16, B_QPRE), 512, pg8::RowScale{WSP(float, WS_SSC), 3}, nullptr};
      pg8::gemm_phase<pg8::EpiScale<0>, pg8::StaticOrder, true, true>(lds + RING_OFF, g, S, E, c.tid); }
    { KArgs A = kargs(); unsigned char* ws = A->ws;
      pg8::Gemm g{WSP(bf16, B_PROJ) + PJ_CKV, WSP(bf16, W_UKV), PJ_LD, 256, 256}; pg8::StaticOrder S; S.init(T, 512, c.G, c.bid);
      pg8::EpiKV E{WSP(bf16, B_CK), WSP(bf16, B_KVPRE), WSP(bf16, B_PROJ), WSP(float, WS_SSC), WSP(float, WS_ROPE), IN_F(16) + l * 96, (unsigned*)(ws + WS_CTL) + CW_KMX + (l * 2 + 1) * 32};
      pg8::gemm_phase<pg8::EpiKV, pg8::StaticOrder, true, true>(lds + RING_OFF, g, S, E, c.tid); }
}
__device__ __forceinline__ void ph_prep(int wv, LAS unsigned char* lds, int l) {
    TP_BEGIN(4) mla_up_gemms(wv, lds, l); TP_END(4, lds)
    {
        const Ctx c = mkctx(wv);
        KArgs A = kargs(); unsigned char* ws = A->ws;
        bf16* PROJ = WSP(bf16, B_PROJ); bf16* OB = WSP(bf16, B_O);
        TP_BEGIN(5) for (int it = c.bid; it < NB * 32; it += c.G) prep_block(lds + RING_OFF, PROJ, WSP(float, WS_ROPE), IN_F(9) + l * 64, IN_F(10) + l * 64, WSP(float, MS_KMEAN), (unsigned*)(ws + WS_CTL) + CW_KMX + (l * 2 + 0) * 32, it, c.tid); TP_END(5, lds)
        TP_BEGIN(6) for (int u = c.bid; u < T / 128; u += c.G) sgu_unit(lds + RING_OFF, PROJ, OB, IN_F(5) + l * 256, IN_F(6) + l * 256, WSP(bf16, MS_WSGU), IN_F(8) + l * 4 * 128, u, c.tid); TP_END(6, lds)
        TP_BEGIN(7) for (int u = c.bid; u < T / 64; u += c.G) conv_unit(lds + RING_OFF, PROJ, OB, IN_F(17) + (size_t)l * 31 * 256, IN_F(18) + l * 256, IN_F(19) + l * 256, IN_F(20) + l * 256, u, c.tid); TP_END(7, lds)
        __syncthreads();
    }
    TP_BEGIN(8) conv_ffn_weights(wv, lds, l); TP_END(8, lds)
}
template <int WHICH>
__device__ __forceinline__ void mla_post_pass(const Ctx& c, int l) {
    KArgs A = kargs(); unsigned char* ws = A->ws;
    const float* gn = IN_F(WHICH ? 16 : 15) + l * 96;
    const bf16* PROJ = WSP(bf16, B_PROJ); const bf16* QPRE = WSP(bf16, B_QPRE); const bf16* KVPRE = WSP(bf16, B_KVPRE);
    bf16* DST = WHICH ? WSP(bf16, B_CK) : WSP(bf16, B_CQ); const float* ROPE = WSP(float, WS_ROPE);
    for (int idx = c.gt; idx < T * 4; idx += c.NGT) {
        const int tok = idx >> 2, h = idx & 3; const float* tab = ROPE + (size_t)tok * 48 + 16;
        float v[96]; float ss = 0.f;
        if (WHICH == 0) {
#pragma unroll
            for (int cc = 0; cc < 12; ++cc) unpack8(((const v4u*)(QPRE + (size_t)tok * 512 + h * 96))[cc], v + 8 * cc);
        } else {
#pragma unroll
            for (int cc = 0; cc < 8; ++cc) unpack8(((const v4u*)(KVPRE + (size_t)tok * 512 + h * 128))[cc], v + 8 * cc);
#pragma unroll
            for (int cc = 0; cc < 4; ++cc) unpack8(((const v4u*)(PROJ + (size_t)tok * PJ_LD + PJ_KR))[cc], v + 64 + 8 * cc);
        }
#pragma unroll
        for (int d = 0; d < 96; ++d) ss += v[d] * v[d];
        const float rstd = rsqrtf(ss * (1.0f / 96.0f) + EPS);
#pragma unroll
        for (int d = 0; d < 96; ++d) v[d] = v[d] * rstd * gn[d];
#pragma unroll
        for (int i = 0; i < 16; ++i) { const float cs = tab[2 * i], sn = tab[2 * i + 1], x1 = v[64 + i], x2 = v[80 + i]; v[64 + i] = x1 * cs - x2 * sn; v[80 + i] = x2 * cs + x1 * sn; }
        if (WHICH == 0) {
#pragma unroll
            for (int d = 0; d < 96; ++d) v[d] *= QS_C;
        }
        bf16* dst = DST + (size_t)tok * 384 + h * 96;
#pragma unroll
        for (int cc = 0; cc < 12; ++cc) ((v4u*)dst)[cc] = pack8(v + 8 * cc);
    }
}
__device__ __forceinline__ void ph_mla_post(int wv, int l) {
    { const Ctx c = mkctx(wv); mla_post_pass<0>(c, l); }
    { const Ctx c = mkctx(wv); mla_post_pass<1>(c, l); }
}
__device__ __forceinline__ void ph_attn(int wv, LAS unsigned char* lds, int l) {
    const Ctx c = mkctx(wv);
    for (int u = c.bid; u < NB * 4 * 8; u += c.G) {
        const int qc = u & 7, h = (u >> 3) & 3, b = u >> 5;
        TP_BEGIN(1) { KArgs A = kargs(); unsigned char* ws = A->ws;
          attn_unit<96, false, true, 512, 96, 384, 96, 256, 64, DM>(lds + RING_OFF, WSP(bf16, B_QPRE), WSP(bf16, B_CK), WSP(bf16, B_KVPRE), WSP(bf16, B_O) + 512, b, h, qc, nullptr, IN_F(15) + l * 96, WSP(float, WS_ROPE), (const unsigned*)(ws + WS_CTL) + CW_KMX + (l * 2 + 1) * 32, c.tid); } TP_END(1, lds)
        TP_BEGIN(2) { KArgs A = kargs(); unsigned char* ws = A->ws; bf16* PROJ = WSP(bf16, B_PROJ);
          attn_unit<64, true, false, PJ_LD, 64, PJ_LD, 64, PJ_LD, 64, DM>(lds + RING_OFF, PROJ + PJ_BQ, PROJ + PJ_BK, PROJ + PJ_BV, WSP(bf16, B_O) + 256, b, h, 7 - qc, WSP(float, MS_KMEAN), nullptr, nullptr, (const unsigned*)(ws + WS_CTL) + CW_KMX + (l * 2 + 0) * 32, c.tid); } TP_END(2, lds)
    }
}
__device__ __forceinline__ void ph_gates(int wv, LAS unsigned char* lds) {
    const Ctx c = mkctx(wv);
    KArgs A = kargs(); unsigned char* ws = A->ws;
    pg8::Gemm g{WSP(bf16, WS_XB), WSP(bf16, W_G), DM, DM, DM}; pg8::StaticOrder S; S.init(T, 4096, c.G, c.bid);
    pg8::EpiGates E{WSP(bf16, B_SG), pg8::RowScale{WSP(float, WS_SSA), 1}};
    pg8::gemm_phase<pg8::EpiGates, pg8::StaticOrder, true, true>(lds + RING_OFF, g, S, E, c.tid);
}
__device__ __forceinline__ void ph_merge(int wv, LAS unsigned char* lds) {
    const Ctx c = mkctx(wv);
    KArgs A = kargs(); unsigned char* ws = A->ws;
    pg8::Gemm g{WSP(bf16, B_O), WSP(bf16, W_B), DM, 256, 256}; pg8::MergeOrder S; S.so.init(T, DM, c.G, c.bid);
    pg8::EpiMerge E{WSP(bf16, B_SG), WSP(bf16, B_Y)};
    pg8::gemm_phase<pg8::EpiMerge, pg8::MergeOrder, true, true>(lds + RING_OFF, g, S, E, c.tid);
}
__device__ __forceinline__ void ph_wout(int wv, LAS unsigned char* lds, int l) {
    const Ctx c = mkctx(wv);
    KArgs A = kargs(); unsigned char* ws = A->ws;
    pg8::Gemm g{WSP(bf16, B_Y), WSP(bf16, W_OUT), DM, DM, DM}; pg8::StaticOrder S; S.init(T, DM, c.G, c.bid);
    pg8::EpiResidual E{l == 0 ? IN_F(0) : (const float*)A->out, A->out, WSP(bf16, WS_XB), WSP(float, WS_SSB), (LAS float*)(lds + EPI_RED_OFF)};
    pg8::gemm_phase<pg8::EpiResidual, pg8::StaticOrder, true, true>(lds + RING_OFF, g, S, E, c.tid);
}
__device__ __forceinline__ void ph_ffn_up(int wv, LAS unsigned char* lds) {
    const Ctx c = mkctx(wv);
    KArgs A = kargs(); unsigned char* ws = A->ws;
    pg8::Gemm g{WSP(bf16, WS_XB), WSP(bf16, W_F1), DM, DM, DM}; pg8::StaticOrder S; S.init(T, 2 * FFN, c.G, c.bid);
    pg8::EpiScale<2> E{WSP(bf16, B_HID), FFN, pg8::RowScale{WSP(float, WS_SSB), 1}, nullptr};
    pg8::gemm_phase<pg8::EpiScale<2>, pg8::StaticOrder, true, true>(lds + RING_OFF, g, S, E, c.tid);
}
__device__ __forceinline__ void ph_ffn_down(int wv, LAS unsigned char* lds, int l) {
    const Ctx c = mkctx(wv);
    KArgs A = kargs(); unsigned char* ws = A->ws;
    pg8::Gemm g{WSP(bf16, B_HID), WSP(bf16, W_F2), FFN, FFN, FFN}; pg8::StaticOrder S; S.init(T, DM, c.G, c.bid);
    pg8::EpiResidual E{A->out, A->out, WSP(bf16, WS_XB), WSP(float, WS_SSA), (LAS float*)(lds + EPI_RED_OFF)};
    pg8::gemm_phase<pg8::EpiResidual, pg8::StaticOrder, true, true>(lds + RING_OFF, g, S, E, c.tid);
    TP_BEGIN(9) if (l < DEPTH - 1) conv_mixer_weights(wv, lds, l + 1); TP_END(9, lds)
}
__device__ __forceinline__ int wave_sum_i(int v) {
    v += __builtin_amdgcn_ds_swizzle(v, (1 << 10) | 0x1f); v += __builtin_amdgcn_ds_swizzle(v, (2 << 10) | 0x1f); v += __builtin_amdgcn_ds_swizzle(v, (4 << 10) | 0x1f);
    v += __builtin_amdgcn_ds_swizzle(v, (8 << 10) | 0x1f); v += __builtin_amdgcn_ds_swizzle(v, (16 << 10) | 0x1f);
    auto rr = __builtin_amdgcn_permlane32_swap((unsigned)v, (unsigned)v, false, false); return (int)rr[0] + (int)rr[1];
}
__device__ __forceinline__ void ph_router(int wv, LAS unsigned char* lds, int l) {
    const Ctx c = mkctx(wv);
    KArgs A = kargs(); unsigned char* ws = A->ws; const int li = l >> 1; const int lane = c.lane;
    const float* fn = IN_F(3) + l * DM; const float* wr_ = IN_F(26) + (size_t)li * DM * NE; const float* rb = IN_F(27) + li * NE;
    const float* xout = A->out; const float* SSB = WSP(float, WS_SSB); int* TOKE = WSP(int, MS_TOKE); float* TOKW = WSP(float, MS_TOKW);
    int* WCNT = WSP(int, MS_WCNT); int* WGCNT = WSP(int, MS_WGCNT);
    int cnt[8];
#pragma unroll
    for (int e = 0; e < 8; ++e) cnt[e] = 0;
    float wq[16][8];
#pragma unroll
    for (int j = 0; j < 4; ++j) { const int k0 = (64 * j + lane) * 4; const f32x4 gv = *(const f32x4*)(fn + k0);
#pragma unroll
        for (int q = 0; q < 4; ++q) { const f32x4 w0 = *(const f32x4*)(wr_ + (size_t)(k0 + q) * 8), w1 = *(const f32x4*)(wr_ + (size_t)(k0 + q) * 8 + 4);
#pragma unroll
            for (int e = 0; e < 4; ++e) { wq[4 * j + q][e] = gv[q] * w0[e]; wq[4 * j + q][4 + e] = gv[q] * w1[e]; } } }
    float rbv[8];
#pragma unroll
    for (int e = 0; e < 8; ++e) rbv[e] = rb[e];
    for (int tok0 = c.gw; tok0 < T; tok0 += 2 * c.NGW) {
        f32x4 sp[2], xv[2][4]; bool ok[2];
#pragma unroll
        for (int u = 0; u < 2; ++u) { const int tok = tok0 + u * c.NGW; ok[u] = tok < T; const int tk = ok[u] ? tok : tok0;
            sp[u] = *(const f32x4*)(SSB + (size_t)tk * 4);
#pragma unroll
            for (int j = 0; j < 4; ++j) xv[u][j] = *(const f32x4*)(xout + (size_t)tk * DM + (64 * j + lane) * 4); }
        float pl[2][8];
#pragma unroll
        for (int u = 0; u < 2; ++u) { const float rstd = rsqrtf(((sp[u][0] + sp[u][1]) + (sp[u][2] + sp[u][3])) * (1.0f / 1024.0f) + EPS);
#pragma unroll
            for (int e = 0; e < 8; ++e) pl[u][e] = 0.f;
#pragma unroll
            for (int j = 0; j < 4; ++j)
#pragma unroll
                for (int q = 0; q < 4; ++q) { const float hv = xv[u][j][q] * rstd;
#pragma unroll
                    for (int e = 0; e < 8; ++e) pl[u][e] += hv * wq[4 * j + q][e]; } }
#pragma unroll
        for (int e = 0; e < 8; ++e) { pl[0][e] = wave_sum(pl[0][e]) + rbv[e]; pl[1][e] = wave_sum(pl[1][e]) + rbv[e]; }
#pragma unroll
        for (int u = 0; u < 2; ++u) {
            int e0 = 0; float l0 = pl[u][0];
#pragma unroll
            for (int e = 1; e < 8; ++e) if (pl[u][e] > l0) { l0 = pl[u][e]; e0 = e; }
            int e1 = -1; float l1 = -INFINITY;
#pragma unroll
            for (int e = 0; e < 8; ++e) if (e != e0 && pl[u][e] > l1) { l1 = pl[u][e]; e1 = e; }
            const float tt = expf(l1 - l0); const float w0 = 1.0f / (1.0f + tt), w1 = tt / (1.0f + tt);
            if (ok[u]) {
#pragma unroll
                for (int e = 0; e < 8; ++e) cnt[e] += (e == e0 ? 1 : 0) + (e == e1 ? 1 : 0);
                const int tok = tok0 + u * c.NGW;
                if (lane == 0) { TOKE[tok * 2] = e0; TOKE[tok * 2 + 1] = e1; TOKW[tok * 2] = w0; TOKW[tok * 2 + 1] = w1; }
            }
        }
    }
    LAS int* red = (LAS int*)(lds + RING_OFF);
    int mine = 0;
#pragma unroll
    for (int e = 0; e < 8; ++e) mine = (lane == e) ? cnt[e] : mine;
    if (lane < 8) { WCNT[c.gw * 8 + lane] = mine; red[c.wave * 8 + lane] = mine; }
    __syncthreads();
    if (c.tid < 8) { int s = 0;
#pragma unroll
        for (int w = 0; w < NWAVES; ++w) s += red[w * 8 + c.tid];
        WGCNT[c.bid * 8 + c.tid] = s; }
    __syncthreads();
}
__device__ __forceinline__ void ph_assign(int wv, LAS unsigned char* lds, int l) {
    const Ctx c = mkctx(wv);
    KArgs A = kargs(); unsigned char* ws = A->ws; const int lane = c.lane;
    const float* SSB = WSP(float, WS_SSB); const int* TOKE = WSP(int, MS_TOKE); int* TOKS = WSP(int, MS_TOKS); float* RSSLOT = WSP(float, MS_RSSLOT);
    const int* WCNT = WSP(int, MS_WCNT); const int* WGCNT = WSP(int, MS_WGCNT); int* MTOT = WSP(int, MS_MTOT);
    const bf16* XB = WSP(bf16, WS_XB); bf16* XS = WSP(bf16, B_XS);
    int tot[8], bas[8];
#pragma unroll
    for (int e = 0; e < 8; ++e) { tot[e] = 0; bas[e] = 0; }
    for (int t = c.tid; t < c.G; t += NTHR) {
        typedef int i32x4 __attribute__((ext_vector_type(4)));
        const i32x4 a = *(const i32x4*)(WGCNT + t * 8), b = *(const i32x4*)(WGCNT + t * 8 + 4); const int lt = (t < c.bid) ? 1 : 0;
        tot[0] += a[0]; tot[1] += a[1]; tot[2] += a[2]; tot[3] += a[3]; tot[4] += b[0]; tot[5] += b[1]; tot[6] += b[2]; tot[7] += b[3];
        bas[0] += lt * a[0]; bas[1] += lt * a[1]; bas[2] += lt * a[2]; bas[3] += lt * a[3]; bas[4] += lt * b[0]; bas[5] += lt * b[1]; bas[6] += lt * b[2]; bas[7] += lt * b[3];
    }
    LAS int* red = (LAS int*)(lds + RING_OFF);
#pragma unroll
    for (int e = 0; e < 8; ++e) { tot[e] = wave_sum_i(tot[e]); bas[e] = wave_sum_i(bas[e]); }
    if (lane == 0) {
#pragma unroll
        for (int e = 0; e < 8; ++e) { red[c.wave * 16 + e] = tot[e]; red[c.wave * 16 + 8 + e] = bas[e]; } }
    __syncthreads();
#pragma unroll
    for (int e = 0; e < 8; ++e) { int st = 0, sb = 0;
#pragma unroll
        for (int w = 0; w < NWAVES; ++w) { st += red[w * 16 + e]; sb += red[w * 16 + 8 + e]; }
        tot[e] = st; bas[e] = sb; }
    int run[8]; { int acc = 0;
#pragma unroll
        for (int e = 0; e < 8; ++e) { run[e] = acc * 256 + bas[e]; acc += (tot[e] + 255) >> 8; } }
    if (c.bid == 0 && c.tid < 8) { int v = 0;
#pragma unroll
        for (int e = 0; e < 8; ++e) v = (c.tid == e) ? tot[e] : v;
        MTOT[c.tid] = v; }
    for (int w = 0; w < c.wave; ++w) {
        typedef int i32x4 __attribute__((ext_vector_type(4)));
        const i32x4 a = *(const i32x4*)(WCNT + (c.bid * NWAVES + w) * 8), b = *(const i32x4*)(WCNT + (c.bid * NWAVES + w) * 8 + 4);
        run[0] += a[0]; run[1] += a[1]; run[2] += a[2]; run[3] += a[3]; run[4] += b[0]; run[5] += b[1]; run[6] += b[2]; run[7] += b[3];
    }
    for (int tok0 = c.gw; tok0 < T; tok0 += 4 * c.NGW) {
        f32x4 sp[4]; int ee[4][2]; v4u ra[4], rb2[4]; bool ok[4];
#pragma unroll
        for (int u = 0; u < 4; ++u) { const int tok = tok0 + u * c.NGW; ok[u] = tok < T; const int tk = ok[u] ? tok : tok0;
            sp[u] = *(const f32x4*)(SSB + (size_t)tk * 4); ee[u][0] = TOKE[tk * 2]; ee[u][1] = TOKE[tk * 2 + 1];
            const v4u* src = (const v4u*)(XB + (size_t)tk * DM) + lane; ra[u] = src[0]; rb2[u] = src[64]; }
#pragma unroll
        for (int u = 0; u < 4; ++u) if (ok[u]) {
            const int tok = tok0 + u * c.NGW;
            const float rstd = rsqrtf(((sp[u][0] + sp[u][1]) + (sp[u][2] + sp[u][3])) * (1.0f / 1024.0f) + EPS);
            int s0 = 0, s1 = 0;
#pragma unroll
            for (int e = 0; e < 8; ++e) { if (e == ee[u][0]) { s0 = run[e]; run[e] += 1; } }
#pragma unroll
            for (int e = 0; e < 8; ++e) { if (e == ee[u][1]) { s1 = run[e]; run[e] += 1; } }
            if (lane == 0) { TOKS[tok * 2] = s0; TOKS[tok * 2 + 1] = s1; RSSLOT[s0] = rstd; RSSLOT[s1] = rstd; }
            v4u* d0 = (v4u*)(XS + (size_t)s0 * DM) + lane; v4u* d1 = (v4u*)(XS + (size_t)s1 * DM) + lane;
            d0[0] = ra[u]; d0[64] = rb2[u]; d1[0] = ra[u]; d1[64] = rb2[u];
        }
    }
    __syncthreads();
}
__device__ __forceinline__ void moe_panels(const int* mtot, int (&ps)[9]) { int acc = 0;
#pragma unroll
    for (int e = 0; e < 8; ++e) { ps[e] = acc; const int cn = __hip_atomic_load(mtot + e, RLX_AGENT); acc += (cn + 255) >> 8; } ps[8] = acc; }
__device__ __forceinline__ void ph_moe_up(int wv, LAS unsigned char* lds, int l) {
    const Ctx c = mkctx(wv);
    KArgs A = kargs(); unsigned char* ws = A->ws;
    pg8::MoeOrder S; S.nN = 11; moe_panels(WSP(int, MS_MTOT), S.ps);
    S.so.init(S.ps[8] * 256, 2 * EDIM, c.G, c.bid);
    pg8::Gemm g{WSP(bf16, B_XS), WSP(bf16, W_F1), DM, DM, DM};
    pg8::EpiScale<2> E{WSP(bf16, B_HIDM), EDIM, pg8::RowScale{WSP(float, MS_RSSLOT), 2}, nullptr};
    pg8::gemm_phase<pg8::EpiScale<2>, pg8::MoeOrder, true, true>(lds + RING_OFF, g, S, E, c.tid);
}
__device__ __forceinline__ void ph_moe_down(int wv, LAS unsigned char* lds, int l) {
    const Ctx c = mkctx(wv);
    KArgs A = kargs(); unsigned char* ws = A->ws;
    pg8::MoeOrder S; S.nN = 4; moe_panels(WSP(int, MS_MTOT), S.ps);
    S.so.init(S.ps[8] * 256, DM, c.G, c.bid);
    pg8::Gemm g{WSP(bf16, B_HIDM), WSP(bf16, W_F2), EDIM, EDIM, EDIM};
    pg8::EpiScale<0> E{WSP(bf16, B_Y2), DM, pg8::RowScale{nullptr, 0}, nullptr};
    pg8::gemm_phase<pg8::EpiScale<0>, pg8::MoeOrder, true, true>(lds + RING_OFF, g, S, E, c.tid);
}
__device__ __forceinline__ void ph_combine(int wv, LAS unsigned char* lds, int l) {
    const Ctx c = mkctx(wv);
    KArgs A = kargs(); unsigned char* ws = A->ws; const int lane = c.lane;
    float* xout = A->out; const int* TOKS = WSP(int, MS_TOKS); const float* TOKW = WSP(float, MS_TOKW); const bf16* Y2 = WSP(bf16, B_Y2); bf16* XB = WSP(bf16, WS_XB); float* SSA = WSP(float, WS_SSA);
    for (int tok0 = c.gw; tok0 < T; tok0 += 2 * c.NGW) {
        typedef unsigned u32x2v __attribute__((ext_vector_type(2)));
        int ss_[2][2]; float ww[2][2]; f32x4 xv[2][4]; bool ok[2];
#pragma unroll
        for (int u = 0; u < 2; ++u) { const int tok = tok0 + u * c.NGW; ok[u] = tok < T; const int tk = ok[u] ? tok : tok0;
            ss_[u][0] = TOKS[tk * 2]; ss_[u][1] = TOKS[tk * 2 + 1]; ww[u][0] = TOKW[tk * 2]; ww[u][1] = TOKW[tk * 2 + 1];
#pragma unroll
            for (int j = 0; j < 4; ++j) xv[u][j] = *((const f32x4*)(xout + (size_t)tk * DM) + 64 * j + lane); }
        u32x2v ya[2][4], yb[2][4];
#pragma unroll
        for (int u = 0; u < 2; ++u)
#pragma unroll
            for (int j = 0; j < 4; ++j) { ya[u][j] = *((const u32x2v*)(Y2 + (size_t)ss_[u][0] * DM) + 64 * j + lane); yb[u][j] = *((const u32x2v*)(Y2 + (size_t)ss_[u][1] * DM) + 64 * j + lane); }
#pragma unroll
        for (int u = 0; u < 2; ++u) if (ok[u]) {
            const int tok = tok0 + u * c.NGW; const float w0 = ww[u][0], w1 = ww[u][1]; float ss = 0.f;
#pragma unroll
            for (int j = 0; j < 4; ++j) {
                const int c4 = 64 * j + lane; f32x4 x = xv[u][j]; const u32x2v a = ya[u][j], b = yb[u][j];
                x[0] += w0 * bflo(a.x) + w1 * bflo(b.x); x[1] += w0 * bfhi(a.x) + w1 * bfhi(b.x); x[2] += w0 * bflo(a.y) + w1 * bflo(b.y); x[3] += w0 * bfhi(a.y) + w1 * bfhi(b.y);
                *((f32x4*)(xout + (size_t)tok * DM) + c4) = x;
                u32x2v w; w.x = pkbf(x[0], x[1]); w.y = pkbf(x[2], x[3]); *((u32x2v*)(XB + (size_t)tok * DM) + c4) = w;
                ss += (x[0] * x[0] + x[1] * x[1]) + (x[2] * x[2] + x[3] * x[3]);
            }
            ss = wave_sum(ss);
            if (lane < 4) SSA[(size_t)tok * 4 + lane] = (lane == 0) ? ss : 0.f;
        }
    }
    if (l < DEPTH - 1) { __syncthreads(); conv_mixer_weights(wv, lds, l + 1); }
}

__global__ void __launch_bounds__(NTHR, 2) trunk_fwd(Args args) {
    extern __shared__ __attribute__((aligned(16))) unsigned char lds_raw[];
    LAS unsigned char* lds = (LAS unsigned char*)lds_raw;
    const int wv = __builtin_amdgcn_readfirstlane((int)threadIdx.x >> 6);
    for (int u = threadIdx.x; u < (LDS_BYTES - LDSCTL_OFF) / 4; u += NTHR) ((LAS unsigned*)(lds + LDSCTL_OFF))[u] = 0u;
    __syncthreads();
    volatile LAS unsigned* MISC = (volatile LAS unsigned*)(lds + MISC_OFF);
    XcdBarrier bar = xcd_barrier_post((unsigned*)((gu32*)(args.ws + WS_CTL) + CW_BAR), MISC + 8, (int)threadIdx.x);
    const int lo = args.ph_lo, hi = args.ph_hi;
    int pc = 0;
#define PH_BEGIN if (pc >= lo && pc < hi) {
#define PH_END if (pc + 1 < hi) xcd_barrier(bar, mkctx(wv).tid); } ++pc;
    PH_BEGIN ph_prologue(wv, lds); PH_END
    for (int l = 0; l < DEPTH; ++l) {
        PH_BEGIN ph_inproj(wv, lds); PH_END
        PH_BEGIN ph_prep(wv, lds, l); PH_END
        PH_BEGIN ph_attn(wv, lds, l); PH_END
        PH_BEGIN ph_gates(wv, lds); PH_END
        PH_BEGIN ph_merge(wv, lds); PH_END
        PH_BEGIN ph_wout(wv, lds, l); PH_END
        if (!(l & 1)) {
            PH_BEGIN ph_ffn_up(wv, lds); PH_END
            PH_BEGIN ph_ffn_down(wv, lds, l); PH_END
        } else {
            PH_BEGIN ph_router(wv, lds, l); PH_END
            PH_BEGIN ph_assign(wv, lds, l); PH_END
            PH_BEGIN ph_moe_up(wv, lds, l); PH_END
            PH_BEGIN ph_moe_down(wv, lds, l); PH_END
            PH_BEGIN ph_combine(wv, lds, l); PH_END
        }
    }
    if (TPROBE != 0 && blockIdx.x == TP_BID && threadIdx.x == 0) { const unsigned long long tt_ = *TP_ACC(lds), te_ = __builtin_amdgcn_s_memrealtime(); while (__builtin_amdgcn_s_memrealtime() - te_ < 7ull * tt_) __builtin_amdgcn_s_sleep(32); }
#undef PH_BEGIN
#undef PH_END
}

#ifndef MK_MULTI
#define MK_MULTI 0
#endif
extern "C" void kernel_launch(void* const* d_in, const int* in_sizes, int n_in, void* d_out, int out_size, void* d_ws, size_t ws_size, hipStream_t stream) {
    static int grid = 0;
    if (grid == 0) {
        if (n_in != 31 || out_size != T * DM || ws_size < WS_END) { fprintf(stderr, "kernel_launch: unexpected problem: n_in %d out %d ws %zu (need %zu)\n", n_in, out_size, ws_size, (size_t)WS_END); grid = -1; return; }
        int dev = 0, cus = 0;
        if (hipGetDevice(&dev) != hipSuccess || hipDeviceGetAttribute(&cus, hipDeviceAttributeMultiprocessorCount, dev) != hipSuccess) { grid = -1; return; }
        if (hipFuncSetAttribute((const void*)trunk_fwd, hipFuncAttributeMaxDynamicSharedMemorySize, LDS_BYTES) != hipSuccess) { fprintf(stderr, "kernel_launch: hipFuncSetAttribute failed\n"); grid = -1; return; }
        int per_cu = 0;
        if (hipOccupancyMaxActiveBlocksPerMultiprocessor(&per_cu, (const void*)trunk_fwd, NTHR, LDS_BYTES) != hipSuccess || per_cu < 1) fprintf(stderr, "kernel_launch: occupancy query says %d\n", per_cu);
        (void)hipGetLastError();
        grid = cus;
    }
    if (grid < 0) return;
    (void)hipMemsetAsync((char*)d_ws + WS_CTL, 0, CTL_ZERO_BYTES, stream);
    Args a{};
    for (int i = 0; i < 31; ++i) a.in[i] = d_in[i];
    a.out = (float*)d_out; a.ws = (unsigned char*)d_ws;
#if MK_MULTI
    for (int p = 0; p < N_PHASES; ++p) { a.ph_lo = p; a.ph_hi = p + 1; hipLaunchKernelGGL(trunk_fwd, dim3(grid), dim3(NTHR), LDS_BYTES, stream, a); }
#else
    a.ph_lo = 0; a.ph_hi = N_PHASES;
    hipLaunchKernelGGL(trunk_fwd, dim3(grid), dim3(NTHR), LDS_BYTES, stream, a);
#endif
}
```

```cpp
#include <hip/hip_runtime.h>
#include <cstdio>
#include <cstdint>
#include <cmath>
namespace pg8 {
#define PG8_LAS __attribute__((address_space(3)))
typedef unsigned short bf16_t;
typedef short bf16x8 __attribute__((ext_vector_type(8)));
typedef float f32x4 __attribute__((ext_vector_type(4)));
typedef unsigned u32x4 __attribute__((ext_vector_type(4)));
constexpr int BM = 256, BK = 64, HALF = 128, HTB = HALF * BK * 2  , STAGE_BYTES = 8 * HTB, NXCD = 8, WGM = 8;

__host__ __device__ __forceinline__ int lds_byte(int r, int c) { const int st = (r >> 4) * 2 + (c >> 5), rr = r & 15, cc = c & 31, ob = rr * 64 + cc * 2; return st * 1024 + (ob ^ (((ob >> 9) & 1) << 5)); }
__host__ __device__ __forceinline__ void stage_rc(int b, int& R, int& C) { const int st = b / 1024, sb = b % 1024, swz = sb ^ (((sb >> 9) & 1) << 5); R = (st >> 1) * 16 + swz / 64; C = (st & 1) * 32 + (swz % 64) / 2; }
__host__ __device__ __forceinline__ int perm32(int rho) { const int n = rho >> 4, i = rho & 15; return 8 * (i >> 2) + 4 * n + (i & 3); }

struct Unit { int pm, pn, pb, ak; };
struct Gemm { const bf16_t* A; const bf16_t* Bt; int lda, ldb, K; };

struct StaticOrder {
    int nM, nN, nwg, G, c;
    __host__ __device__ void init(int M, int N, int G_, int c_) { nM = M / BM; nN = N / BM; nwg = nM * nN; G = G_; c = c_; }
    __host__ __device__ bool next(int i, Unit& u) const {
        const long L = (long)i * G + c; if (L >= nwg) return false;
        int wgid = (int)L; { const int q = nwg / NXCD, r = nwg % NXCD, xcd = wgid % NXCD, off = wgid / NXCD; wgid = (xcd < r ? xcd * (q + 1) : r * (q + 1) + (xcd - r) * q) + off; }
        const int nig = WGM * nN, gid = wgid / nig, fm = gid * WGM, gsz = (nM - fm) < WGM ? (nM - fm) : WGM;
        u.pm = fm + ((wgid % nig) % gsz); u.pn = (wgid % nig) / gsz; u.pb = u.pn; u.ak = 0; return true;
    }
    __device__ __forceinline__ void a_ready(const Unit&) const {}
    __device__ __forceinline__ void done(const Unit&) const {}
};

template <class Epi, class Sched, bool ALIGN_EPI = false, bool SP2 = false>
__device__ __forceinline__ void gemm_phase(PG8_LAS unsigned char* lds, const Gemm g, const Sched& S, const Epi& E, const int tid) {
    const int wid = __builtin_amdgcn_readfirstlane(tid >> 6), lane = tid & 63, wr = wid >> 2, wc = wid & 3, fr = lane & 15, fq = lane >> 4;
    const int K = g.K, nt = K / BK;
    unsigned voffA[2], voffB[2];
#pragma unroll
    for (int i = 0; i < 2; ++i) { int R, C; stage_rc(tid * 16 + i * 8192, R, C); const int Rb = Epi::PERM ? ((R & ~31) + perm32(R & 31)) : R;
        voffA[i] = (unsigned)(R * g.lda + C) * 2u; voffB[i] = (unsigned)(Rb * g.ldb + C) * 2u; }
    const size_t kstep = (size_t)(BK * 2);
    const size_t hstepA = (size_t)HALF * g.lda * 2, hstepB = (size_t)HALF * g.ldb * 2;
    const size_t tstepA = 2 * hstepA, tstepB = 2 * hstepB;
    const unsigned ldsw = (unsigned)wid * 1024u;
    const int aoff = lds_byte(wr * 64 + fr, fq * 8), boff = lds_byte(wc * 32 + fr, fq * 8);
#define PG8_SA(b, h) (((b) * 2 + (h)) * HTB)
#define PG8_SB(b, h) ((4 + (b) * 2 + (h)) * HTB)
#define PG8_STAGE(bufoff, gbase, voff) do { _Pragma("unroll") for (int _i = 0; _i < 2; ++_i) \
        __builtin_amdgcn_global_load_lds((const unsigned*)((const char*)(gbase) + (voff)[_i]), (PG8_LAS unsigned*)(lds + (bufoff) + ldsw + _i * 8192), 16, 0, 0); } while (0)
#define PG8_LDA(dst, b, h) do { _Pragma("unroll") for (int m = 0; m < 4; ++m) _Pragma("unroll") for (int k = 0; k < 2; ++k) dst[m][k] = *(const PG8_LAS bf16x8*)(lds + PG8_SA(b, h) + aoff + m * 2048 + k * 1024); } while (0)
#define PG8_LDB(dst, b, h) do { _Pragma("unroll") for (int n = 0; n < 2; ++n) _Pragma("unroll") for (int k = 0; k < 2; ++k) dst[n][k] = *(const PG8_LAS bf16x8*)(lds + PG8_SB(b, h) + boff + n * 2048 + k * 1024); } while (0)
#define PG8_MMA(ai, bj, At, Bt) do { __builtin_amdgcn_s_setprio(1); _Pragma("unroll") for (int m = 0; m < 4; ++m) _Pragma("unroll") for (int n = 0; n < 2; ++n) _Pragma("unroll") for (int k = 0; k < 2; ++k) \
        acc[ai][bj][m][n] = __builtin_amdgcn_mfma_f32_16x16x32_bf16(Bt[n][k], At[m][k], acc[ai][bj][m][n], 0, 0, 0); __builtin_amdgcn_s_setprio(0); } while (0)
#define PG8_WAIT_V(n) asm volatile("s_waitcnt vmcnt(" #n ")" ::: "memory")
#define PG8_WAIT_L(n) asm volatile("s_waitcnt lgkmcnt(" #n ")" ::: "memory")
#define PG8_BAR __builtin_amdgcn_s_barrier()
#define PG8_SCHED __builtin_amdgcn_sched_barrier(0)
    Unit cur, nxt; int ui = 0;
    if (!S.next(0, cur)) return;
    f32x4 acc[2][2][4][2];
#pragma unroll
    for (int a = 0; a < 2; ++a)
#pragma unroll
        for (int b = 0; b < 2; ++b)
#pragma unroll
            for (int m = 0; m < 4; ++m)
#pragma unroll
                for (int n = 0; n < 2; ++n) acc[a][b][m][n] = (f32x4){0.f, 0.f, 0.f, 0.f};
    bf16x8 At[4][2], B0[2][2], B1[2][2];
    const char* cA = (const char*)g.A + (size_t)cur.pm * tstepA + (size_t)cur.ak * 2; const char* cB = (const char*)g.Bt + (size_t)cur.pb * tstepB;
    S.a_ready(cur);
    if constexpr (SP2) {
        PG8_STAGE(PG8_SB(0, 0), cB, voffB); PG8_STAGE(PG8_SB(0, 1), cB + hstepB, voffB); PG8_STAGE(PG8_SA(0, 0), cA, voffA); PG8_STAGE(PG8_SA(0, 1), cA + hstepA, voffA);
        if (wr == 1) PG8_BAR;
        PG8_WAIT_V(2); PG8_BAR;
        PG8_STAGE(PG8_SB(1, 0), cB + kstep, voffB); PG8_STAGE(PG8_SA(1, 0), cA + kstep, voffA); PG8_STAGE(PG8_SB(1, 1), cB + hstepB + kstep, voffB);
        PG8_WAIT_V(6); PG8_BAR;
    } else {
        PG8_STAGE(PG8_SB(0, 0), cB, voffB); PG8_STAGE(PG8_SA(0, 0), cA, voffA); PG8_STAGE(PG8_SB(0, 1), cB + hstepB, voffB); PG8_STAGE(PG8_SA(0, 1), cA + hstepA, voffA);
        if (wr == 1) PG8_BAR;
        PG8_WAIT_V(4); PG8_BAR;
        PG8_STAGE(PG8_SB(1, 0), cB + kstep, voffB); PG8_STAGE(PG8_SA(1, 0), cA + kstep, voffA); PG8_STAGE(PG8_SB(1, 1), cB + hstepB + kstep, voffB);
        PG8_WAIT_V(6); PG8_BAR;
    }
    for (;;) {
        const bool has_next = S.next(ui + 1, nxt);
        const char* nA = has_next ? (const char*)g.A + (size_t)nxt.pm * tstepA + (size_t)nxt.ak * 2 : cA; const char* nB = has_next ? (const char*)g.Bt + (size_t)nxt.pb * tstepB : cB;
        for (int t = 0; t < nt; t += 2) {
            const bool last = (t == nt - 2);
            const char* a1 = cA + (size_t)(t + 1) * kstep;
            const char* a2 = last ? nA : cA + (size_t)(t + 2) * kstep; const char* b2 = last ? nB : cB + (size_t)(t + 2) * kstep;
            const char* a3 = a2 + kstep; const char* b3 = b2 + kstep;
            if (last && has_next) S.a_ready(nxt);
            if constexpr (SP2) {
            PG8_LDB(B0, 0, 0); PG8_LDB(B1, 0, 1); PG8_SCHED; PG8_LDA(At, 0, 0); PG8_STAGE(PG8_SA(1, 1), a1 + hstepA, voffA);
            PG8_WAIT_V(8); PG8_WAIT_L(0); PG8_BAR; PG8_MMA(0, 0, At, B0); PG8_MMA(0, 1, At, B1); PG8_BAR; PG8_SCHED;
            PG8_LDA(At, 0, 1); PG8_STAGE(PG8_SB(0, 0), b2, voffB); PG8_STAGE(PG8_SB(0, 1), b2 + hstepB, voffB); PG8_STAGE(PG8_SA(0, 0), a2, voffA);
            PG8_WAIT_V(8); PG8_WAIT_L(0); PG8_BAR; PG8_MMA(1, 0, At, B0); PG8_MMA(1, 1, At, B1); PG8_BAR; PG8_SCHED;
            PG8_LDB(B0, 1, 0); PG8_LDB(B1, 1, 1); PG8_SCHED; PG8_LDA(At, 1, 0); PG8_STAGE(PG8_SA(0, 1), a2 + hstepA, voffA);
            PG8_WAIT_V(8); PG8_WAIT_L(0); PG8_BAR; PG8_MMA(0, 0, At, B0); PG8_MMA(0, 1, At, B1); PG8_BAR; PG8_SCHED;
            PG8_LDA(At, 1, 1); PG8_STAGE(PG8_SB(1, 0), b3, voffB); PG8_STAGE(PG8_SB(1, 1), b3 + hstepB, voffB); PG8_STAGE(PG8_SA(1, 0), a3, voffA);
            PG8_WAIT_V(8); PG8_WAIT_L(0); PG8_BAR; PG8_MMA(1, 0, At, B0); PG8_MMA(1, 1, At, B1); PG8_BAR; PG8_SCHED;
            } else {
            PG8_LDB(B0, 0, 0); PG8_SCHED; PG8_LDA(At, 0, 0); PG8_STAGE(PG8_SA(1, 1), a1 + hstepA, voffA);
            PG8_WAIT_L(8); PG8_BAR; PG8_WAIT_L(0); PG8_MMA(0, 0, At, B0); PG8_BAR; PG8_SCHED;
            PG8_LDB(B1, 0, 1); PG8_STAGE(PG8_SB(0, 0), b2, voffB);
            PG8_BAR; PG8_WAIT_L(0); PG8_MMA(0, 1, At, B1); PG8_BAR;
            PG8_LDA(At, 0, 1); PG8_STAGE(PG8_SA(0, 0), a2, voffA);
            PG8_BAR; PG8_WAIT_L(0); PG8_MMA(1, 0, At, B0); PG8_BAR; PG8_SCHED;
            PG8_STAGE(PG8_SB(0, 1), b2 + hstepB, voffB);
            PG8_WAIT_V(6); PG8_BAR; PG8_MMA(1, 1, At, B1); PG8_BAR;
            PG8_LDB(B0, 1, 0); PG8_SCHED; PG8_LDA(At, 1, 0); PG8_STAGE(PG8_SA(0, 1), a2 + hstepA, voffA);
            PG8_WAIT_L(8); PG8_BAR; PG8_WAIT_L(0); PG8_MMA(0, 0, At, B0); PG8_BAR; PG8_SCHED;
            PG8_LDB(B1, 1, 1); PG8_STAGE(PG8_SB(1, 0), b3, voffB);
            PG8_BAR; PG8_WAIT_L(0); PG8_MMA(0, 1, At, B1); PG8_BAR;
            PG8_LDA(At, 1, 1); PG8_STAGE(PG8_SA(1, 0), a3, voffA);
            PG8_BAR; PG8_WAIT_L(0); PG8_MMA(1, 0, At, B0); PG8_BAR; PG8_SCHED;
            PG8_STAGE(PG8_SB(1, 1), b3 + hstepB, voffB);
            PG8_WAIT_V(6); PG8_BAR; PG8_MMA(1, 1, At, B1); PG8_BAR;
            }
        }
        if constexpr (ALIGN_EPI) { if (wr == 0) PG8_BAR; }
        const bool keep = E(acc, cur, wr, wc, fr, fq);
        if (!has_next) break;
        if (!keep) {
#pragma unroll
        for (int a = 0; a < 2; ++a)
#pragma unroll
            for (int b = 0; b < 2; ++b)
#pragma unroll
                for (int m = 0; m < 4; ++m)
#pragma unroll
                    for (int n = 0; n < 2; ++n) acc[a][b][m][n] = (f32x4){0.f, 0.f, 0.f, 0.f};
        }
        cur = nxt; cA = nA; cB = nB; ++ui;
        if constexpr (ALIGN_EPI) { if (wr == 1) PG8_BAR; }
    }
    PG8_WAIT_V(0);
    if constexpr (!ALIGN_EPI) { if (wr == 0) PG8_BAR; }
    PG8_BAR;
#undef PG8_SA
#undef PG8_SB
#undef PG8_STAGE
#undef PG8_LDA
#undef PG8_LDB
#undef PG8_MMA
#undef PG8_WAIT_V
#undef PG8_WAIT_L
#undef PG8_BAR
#undef PG8_SCHED
}
}
#define GAS __attribute__((address_space(1)))
#define LAS __attribute__((address_space(3)))
typedef unsigned short bf16;
typedef unsigned v4u __attribute__((ext_vector_type(4)));
typedef float f32x4 __attribute__((ext_vector_type(4)));
typedef short bf16x8 __attribute__((ext_vector_type(8)));
typedef GAS unsigned gu32;
typedef GAS unsigned long long gu64;
#define RLX_AGENT __ATOMIC_RELAXED, __HIP_MEMORY_SCOPE_AGENT
#define LDS_WAIT() asm volatile("s_waitcnt lgkmcnt(0)" ::: "memory")
#define VM_WAIT() asm volatile("s_waitcnt vmcnt(0)" ::: "memory")
__device__ __forceinline__ unsigned long long rt() { return __builtin_amdgcn_s_memrealtime(); }
__device__ __forceinline__ unsigned f2bf(float f) { unsigned u = __builtin_bit_cast(unsigned, f); return (u + 0x7fffu + ((u >> 16) & 1u)) >> 16; }
__device__ __forceinline__ unsigned pk2(float lo, float hi) { return f2bf(lo) | (f2bf(hi) << 16); }

#define XB_TMO      128
#define XB_XCNT(j)  (256  + 64 * (j))
#define XB_XSUB(j)  (1280 + 64 * (j))
#define XB_XGEN(j)  (2304 + 64 * (j))
#define XB_TOP      3328
#define XB_TOPGEN   3392
#define XCD_BAR_WORDS 3456
#define XB_SPIN_CAP (1u << 18)

__device__ __forceinline__ unsigned xb_ld(unsigned* p)              { return __hip_atomic_load(p, __ATOMIC_RELAXED, __HIP_MEMORY_SCOPE_AGENT); }
__device__ __forceinline__ unsigned xb_add(unsigned* p, unsigned v) { return __hip_atomic_fetch_add(p, v, __ATOMIC_RELAXED, __HIP_MEMORY_SCOPE_AGENT); }
__device__ __forceinline__ unsigned xb_xcc_id() { return (unsigned)__builtin_amdgcn_s_getreg((3 << 11) | 20) & 0xFu; }
#define XB_SPIN(cond, bar) do { unsigned _sp = 0; while (cond) { __builtin_amdgcn_s_sleep(1); \
    if ((++_sp & 255u) == 0u) { if (xb_ld(&(bar)[XB_TMO])) break; if (_sp > XB_SPIN_CAP) { atomicAdd(&(bar)[XB_TMO], 1u); break; } } } } while (0)

struct XcdBarrier {
    unsigned* bar; unsigned x;
    volatile LAS unsigned* st;
};

__device__ __forceinline__ XcdBarrier xcd_barrier_post(unsigned* bar, volatile LAS unsigned* st, const int tid) {
    XcdBarrier b; b.bar = bar; b.x = xb_xcc_id(); b.st = st;
    if (tid == 0) (void)xb_add(&bar[XB_XCNT(b.x)], 1u);
    return b;
}
__device__ __forceinline__ void xcd_barrier_complete(unsigned* bar, unsigned x, unsigned& nloc, unsigned& nx) {
    const unsigned G = gridDim.x * gridDim.y * gridDim.z;
    unsigned sum, cnt, mine, sp = 0u;
    for (;;) {
        sum = 0u; cnt = 0u; mine = 0u;
#pragma unroll
        for (unsigned j = 0; j < 16; ++j) { const unsigned c = xb_ld(&bar[XB_XCNT(j)]); sum += c; cnt += (c > 0u) ? 1u : 0u; mine = (j == x) ? c : mine; }
        if (sum == G) break;
        __builtin_amdgcn_s_sleep(1);
        if ((++sp & 255u) == 0u) { if (xb_ld(&bar[XB_TMO])) break; if (sp > XB_SPIN_CAP) { atomicAdd(&bar[XB_TMO], 1u); break; } }
    }
    nloc = mine > 0u ? mine : 1u; nx = cnt > 0u ? cnt : 1u;
}

__device__ __forceinline__ void xcd_barrier(const XcdBarrier& b, const int tid) {
    asm volatile("s_waitcnt vmcnt(0)" ::: "memory");
    __syncthreads();
    if (tid == 0) {
        unsigned* bar = b.bar; asm volatile("" : "+s"(bar));
        __builtin_amdgcn_s_waitcnt(0);
        unsigned nloc = b.st[0], nx = b.st[1];
        if (nloc == 0u) { unsigned xl_ = b.x; asm volatile("" : "+s"(xl_)); xcd_barrier_complete(bar, xl_, nloc, nx); b.st[0] = nloc; b.st[1] = nx; }
        const unsigned old = xb_add(&bar[XB_XSUB(b.x)], 1u);
        const unsigned gen = old / nloc;
        if (old + 1u == (gen + 1u) * nloc) {
            __builtin_amdgcn_fence(__ATOMIC_RELEASE, "agent");
            asm volatile("s_waitcnt vmcnt(0)" ::: "memory");
            const unsigned og = xb_add(&bar[XB_TOP], 1u);
            const unsigned tg = og / nx;
            if (og + 1u == (tg + 1u) * nx) xb_add(&bar[XB_TOPGEN], 1u);
            else XB_SPIN(xb_ld(&bar[XB_TOPGEN]) == tg, bar);
            __builtin_amdgcn_fence(__ATOMIC_ACQUIRE, "agent");
            xb_add(&bar[XB_XGEN(b.x)], 1u);
            asm volatile("s_waitcnt vmcnt(0)" ::: "memory");
        } else {
            XB_SPIN(xb_ld(&bar[XB_XGEN(b.x)]) == gen, bar);
            __builtin_amdgcn_fence(__ATOMIC_ACQUIRE, "agent");
            asm volatile("s_waitcnt vmcnt(0)" ::: "memory");
        }
    }
    __syncthreads();
}
constexpr int NB = 8, SEQ = 4096, DM = 1024, T = NB * SEQ, DEPTH = 4, IN_COLS = 6240;
constexpr int FFN = 2816, NE = 8, EDIM = 1408;
constexpr float EPS = 1e-6f, LOG2E = 1.4426950408889634f;
constexpr int PJ_LD = 2304, PJ_U = 0, PJ_V = 256, PJ_BQ = 512, PJ_BK = 768, PJ_BV = 1024, PJ_DA = 1280, PJ_DG = 1536, PJ_CQ = 1792, PJ_CKV = 1984, PJ_KR = 2112;
constexpr float QS_B = 0.125f * LOG2E;
constexpr float QS_C = 0.10206207261596577f * LOG2E;
constexpr int NWAVES = 8, NTHR = 512;

constexpr size_t MiB = 1u << 20;
constexpr size_t WS_CTL = 0, CTL_ZERO_BYTES = 1 * MiB;
constexpr size_t WS_SSA = 1 * MiB, WS_SSB = 3 * MiB;
constexpr size_t WS_ROPE = 5 * MiB;
constexpr size_t WS_MISC = 11 * MiB;
constexpr size_t MS_RSCQ = WS_MISC, MS_RSCKV = WS_MISC + 128 * 1024, MS_SEL = WS_MISC + 256 * 1024, MS_KMEAN = WS_MISC + 768 * 1024,
                 MS_TOKE = WS_MISC + 1024 * 1024, MS_TOKW = WS_MISC + 1280 * 1024, MS_TOKS = WS_MISC + 1536 * 1024, MS_RSSLOT = WS_MISC + 1792 * 1024,
                 MS_WCNT = WS_MISC + 2304 * 1024, MS_WGCNT = WS_MISC + 2560 * 1024, MS_MTOT = WS_MISC + 2816 * 1024, MS_WSGU = WS_MISC + 2880 * 1024;
constexpr size_t WS_W = 14 * MiB;
constexpr size_t W_INR = WS_W, W_G = WS_W + 4 * MiB + 512 * 1024, W_UQ = WS_W + 12 * MiB + 512 * 1024, W_UKV = W_UQ + 256 * 1024, W_B = WS_W + 13 * MiB, W_OUT = WS_W + 15 * MiB,
                 W_F1 = WS_W + 17 * MiB, W_F2 = WS_W + 61 * MiB;
constexpr size_t WS_SSC = 98 * MiB;
constexpr size_t WS_XB = 100 * MiB;
constexpr size_t WS_BIG = 164 * MiB;
constexpr size_t B_PROJ = WS_BIG, B_QPRE = WS_BIG + 144 * MiB, B_KVPRE = WS_BIG + 176 * MiB  , B_CQ = WS_BIG + 208 * MiB, B_CK = WS_BIG + 232 * MiB, B_O = WS_BIG + 256 * MiB;
constexpr size_t B_SG = WS_BIG, B_Y = WS_BIG + 320 * MiB;
constexpr size_t B_HID = WS_BIG;
constexpr size_t B_XS = WS_BIG, B_HIDM = WS_BIG + 132 * MiB, B_Y2 = WS_BIG;
constexpr size_t WS_END = WS_BIG + 384 * MiB;
constexpr int MOE_ROWS_MAX = 65536 + 8 * 256;
static_assert(B_HIDM + (size_t)MOE_ROWS_MAX * EDIM * 2 <= WS_END && (size_t)MOE_ROWS_MAX * 1024 * 2 <= 132 * MiB, "moe map");
constexpr int CW_TMO = 0, CW_BAR = 4096, CW_MOE = 8192, CW_KMX = 9216;

constexpr int RING_OFF = 0, RING_BYTES = 131072;
constexpr int LDSCTL_OFF = RING_BYTES, MISC_OFF = LDSCTL_OFF + 320;
constexpr int LDS_BYTES = 147456;
constexpr int EPI_RED_OFF = 132096;

typedef float f32x2 __attribute__((ext_vector_type(2)));
typedef __bf16 bf16x2_t __attribute__((ext_vector_type(2)));
__device__ __forceinline__ unsigned pkbf(float lo, float hi) { f32x2 v = {lo, hi}; bf16x2_t b = __builtin_convertvector(v, bf16x2_t); return __builtin_bit_cast(unsigned, b); }
__device__ __forceinline__ float bflo(unsigned w) { return __uint_as_float(w << 16); }
__device__ __forceinline__ float bfhi(unsigned w) { return __uint_as_float(w & 0xffff0000u); }
__device__ __forceinline__ float bf1(bf16 b) { return __uint_as_float((unsigned)b << 16); }
__device__ __forceinline__ void unpack8(const v4u w, float* o) { o[0] = bflo(w.x); o[1] = bfhi(w.x); o[2] = bflo(w.y); o[3] = bfhi(w.y); o[4] = bflo(w.z); o[5] = bfhi(w.z); o[6] = bflo(w.w); o[7] = bfhi(w.w); }
__device__ __forceinline__ v4u pack8(const float* o) { v4u w; w.x = pkbf(o[0], o[1]); w.y = pkbf(o[2], o[3]); w.z = pkbf(o[4], o[5]); w.w = pkbf(o[6], o[7]); return w; }
template <int X> __device__ __forceinline__ float swz_xor(float v) { return __int_as_float(__builtin_amdgcn_ds_swizzle(__float_as_int(v), (X << 10) | 0x1f)); }
__device__ __forceinline__ float half_sum(float v) { auto rr = __builtin_amdgcn_permlane32_swap(__float_as_uint(v), __float_as_uint(v), false, false); return __uint_as_float(rr[0]) + __uint_as_float(rr[1]); }
__device__ __forceinline__ float wave_sum(float v) {
    v += swz_xor<1>(v); v += swz_xor<2>(v); v += swz_xor<4>(v); v += swz_xor<8>(v); v += swz_xor<16>(v);
    return half_sum(v);
}
__device__ __forceinline__ float fast_sigmoid(float x) { return __builtin_amdgcn_rcpf(1.0f + __builtin_amdgcn_exp2f(-x * LOG2E)); }
__device__ __forceinline__ float fast_silu(float x) { return x * fast_sigmoid(x); }
namespace pg8 {
struct RowScale { const float* p; int mode; };
__device__ __forceinline__ float row_scale(const RowScale& rs, int row) {
    if (rs.mode == 0) return 1.f;
    if (rs.mode == 2) return rs.p[row];
    if (rs.mode == 3) { const f32x4 p = *(const f32x4*)(rs.p + (size_t)row * 12); return rsqrtf(((p[0] + p[1]) + (p[2] + p[3])) * (1.0f / 192.0f) + EPS); }
    if (rs.mode == 4) { const f32x4 p = *(const f32x4*)(rs.p + (size_t)row * 12 + 4); return rsqrtf(((p[0] + p[1]) + (p[2] + p[3])) * (1.0f / 128.0f) + EPS); }
    { const f32x4 p = *(const f32x4*)(rs.p + (size_t)row * 4); return rsqrtf(((p[0] + p[1]) + (p[2] + p[3])) * (1.0f / 1024.0f) + EPS); }
}
template <int ACT> struct EpiScale {
    static constexpr bool PERM = true;
    bf16_t* O; int ldc; RowScale rs; float* ssc;
    __device__ __forceinline__ bool operator()(f32x4 (&acc)[2][2][4][2], const Unit& u, int wr, int wc, int fr, int fq) const {
        const int row0 = u.pm * BM + wr * 64 + fr;
        float scv[2][4];
#pragma unroll
        for (int ai = 0; ai < 2; ++ai)
#pragma unroll
            for (int m = 0; m < 4; ++m) scv[ai][m] = row_scale(rs, row0 + ai * HALF + m * 16);
#pragma unroll
        for (int ai = 0; ai < 2; ++ai)
#pragma unroll
            for (int m = 0; m < 4; ++m) {
                const int row = row0 + ai * HALF + m * 16; const float sc = scv[ai][m];
                if (ACT == 2) {
                    bf16_t* rowp = O + (size_t)row * ldc + u.pn * HALF + wc * 32 + 8 * fq;
                    const f32x4 g0 = acc[ai][0][m][0] * sc, g1 = acc[ai][0][m][1] * sc, u0 = acc[ai][1][m][0] * sc, u1 = acc[ai][1][m][1] * sc;
                    u32x4 w; w.x = pkbf(fast_silu(g0[0]) * u0[0], fast_silu(g0[1]) * u0[1]); w.y = pkbf(fast_silu(g0[2]) * u0[2], fast_silu(g0[3]) * u0[3]);
                    w.z = pkbf(fast_silu(g1[0]) * u1[0], fast_silu(g1[1]) * u1[1]); w.w = pkbf(fast_silu(g1[2]) * u1[2], fast_silu(g1[3]) * u1[3]);
                    *(u32x4*)rowp = w;
                } else {
                    bf16_t* rowp = O + (size_t)row * ldc + u.pn * BM + wc * 32 + 8 * fq;
                    float sq[2] = {0.f, 0.f};
#pragma unroll
                    for (int bj = 0; bj < 2; ++bj) {
                        f32x4 v0 = acc[ai][bj][m][0] * sc, v1 = acc[ai][bj][m][1] * sc;
                        if (ACT == 0) sq[bj] = ((v0[0] * v0[0] + v0[1] * v0[1]) + (v0[2] * v0[2] + v0[3] * v0[3])) + ((v1[0] * v1[0] + v1[1] * v1[1]) + (v1[2] * v1[2] + v1[3] * v1[3]));
                        if (ACT == 1) {
#pragma unroll
                            for (int j = 0; j < 4; ++j) { v0[j] = fmaxf(fast_sigmoid(v0[j]), 8.6736174e-19f); v1[j] = fmaxf(fast_sigmoid(v1[j]), 8.6736174e-19f); }
                        }
                        u32x4 w; w.x = pkbf(v0[0], v0[1]); w.y = pkbf(v0[2], v0[3]); w.z = pkbf(v1[0], v1[1]); w.w = pkbf(v1[2], v1[3]);
                        *(u32x4*)(rowp + bj * HALF) = w;
                    }
                    if (ACT == 0 && ssc != nullptr && (u.pn == 7 || u.pn == 8)) {
                        float a = (u.pn == 7) ? (sq[0] + (wc < 2 ? sq[1] : 0.f)) : sq[0];
                        float c = sq[1];
                        a += swz_xor<16>(a); a = half_sum(a); c += swz_xor<16>(c); c = half_sum(c);
                        if (fq == 0) {
                            float* sp = ssc + (size_t)row * 12;
                            if (u.pn == 7) { sp[wc] = a; if (wc >= 2) sp[4 + wc] = c; }
                            else { if (wc < 2) sp[4 + wc] = a; if (wc == 2) sp[8] = a; }
                        }
                    }
                }
            }
        return false;
    }
};
struct EpiResidual {
    static constexpr bool PERM = false;
    bf16_t* xb; float* ssp; PG8_LAS float* red;
    __device__ __forceinline__ bool operator()(f32x4 (&acc)[2][2][4][2], const Unit& u, int wr, int wc, int fr, int fq) const {
        typedef unsigned u32x2v __attribute__((ext_vector_type(2)));
        const int row0 = u.pm * BM + wr * 64 + fr, col0 = u.pn * BM + wc * 32 + 4 * fq;
#pragma unroll
        for (int ai = 0; ai < 2; ++ai) {
            u32x2v bv[4][2][2];
#pragma unroll
            for (int m = 0; m < 4; ++m)
#pragma unroll
                for (int bj = 0; bj < 2; ++bj)
#pragma unroll
                    for (int n = 0; n < 2; ++n) bv[m][bj][n] = *(const u32x2v*)(xb + (size_t)(row0 + ai * HALF + m * 16) * DM + col0 + bj * HALF + n * 16);
#pragma unroll
            for (int m = 0; m < 4; ++m) {
                const int row = row0 + ai * HALF + m * 16; const size_t off = (size_t)row * DM + col0; float ss = 0.f;
#pragma unroll
                for (int bj = 0; bj < 2; ++bj)
#pragma unroll
                    for (int n = 0; n < 2; ++n) {
                        const size_t o2 = off + bj * HALF + n * 16; const u32x2v bb = bv[m][bj][n]; const f32x4 a = acc[ai][bj][m][n];
                        const f32x4 o = {bflo(bb.x) + a[0], bfhi(bb.x) + a[1], bflo(bb.y) + a[2], bfhi(bb.y) + a[3]};
                        u32x2v w; w.x = pkbf(o[0], o[1]); w.y = pkbf(o[2], o[3]); *(u32x2v*)(xb + o2) = w;
                        ss += (o[0] * o[0] + o[1] * o[1]) + (o[2] * o[2] + o[3] * o[3]);
                    }
                ss += swz_xor<16>(ss); ss = half_sum(ss);
                if (fq == 0) red[(ai * HALF + wr * 64 + m * 16 + fr) * 4 + wc] = ss;
            }
        }
        asm volatile("s_waitcnt lgkmcnt(0)" ::: "memory"); __builtin_amdgcn_s_barrier(); asm volatile("" ::: "memory");
        const int t = (wr * 4 + wc) * 64 + fq * 16 + fr;
        if (t < 256) { const f32x4 p = *(const PG8_LAS f32x4*)(red + t * 4); ssp[(size_t)(u.pm * BM + t) * 4 + u.pn] = (p[0] + p[1]) + (p[2] + p[3]); }
        return false;
    }
};
struct EpiKV {
    static constexpr bool PERM = true;
    bf16_t* CK; bf16_t* VB; const bf16_t* PROJ; const float* ssc; const float* rope; const float* ckn; unsigned* kmx;
    __device__ __forceinline__ bool operator()(f32x4 (&acc)[2][2][4][2], const Unit& u, int wr, int wc, int fr, int fq) const {
        typedef unsigned u32x2v __attribute__((ext_vector_type(2)));
        { unsigned mk_ = ~0u; asm volatile("" : "+s"(mk_)); const int ln_ = (int)__builtin_amdgcn_mbcnt_hi(mk_, __builtin_amdgcn_mbcnt_lo(mk_, 0u)); fr = ln_ & 15; fq = ln_ >> 4; }
        const int hh = 2 * u.pn + (wc >> 1); const bool isv = (wc & 1) != 0; const int row0 = u.pm * BM + wr * 64 + fr;
        float k2max = 0.f;
#pragma unroll
        for (int ai = 0; ai < 2; ++ai)
#pragma unroll
            for (int m = 0; m < 4; ++m) {
                const int row = row0 + ai * HALF + m * 16;
                const float* sp = ssc + (size_t)row * 12; const f32x4 pp = *(const f32x4*)(sp + 4);
                const float rs = rsqrtf(((pp[0] + pp[1]) + (pp[2] + pp[3])) * (1.0f / 128.0f) + EPS);
                if (isv) {
#pragma unroll
                    for (int bj = 0; bj < 2; ++bj) { const f32x4 v0 = acc[ai][bj][m][0] * rs, v1 = acc[ai][bj][m][1] * rs;
                        u32x4 w; w.x = pkbf(v0[0], v0[1]); w.y = pkbf(v0[2], v0[3]); w.z = pkbf(v1[0], v1[1]); w.w = pkbf(v1[2], v1[3]);
                        *(u32x4*)(VB + (size_t)row * 256 + hh * 64 + 32 * bj + 8 * fq) = w; }
                } else {
                    float ss = 0.f;
#pragma unroll
                    for (int bj = 0; bj < 2; ++bj)
#pragma unroll
                        for (int n = 0; n < 2; ++n) { const f32x4 a = acc[ai][bj][m][n]; ss += (a[0] * a[0] + a[1] * a[1]) + (a[2] * a[2] + a[3] * a[3]); }
                    ss += swz_xor<16>(ss); ss = half_sum(ss); ss *= rs * rs;
                    const float rk = rsqrtf((ss + sp[8]) * (1.0f / 96.0f) + EPS); const float rr = rs * rk;
                    bf16_t* kd = CK + (size_t)row * 384 + hh * 96; float kn2 = 0.f;
#pragma unroll
                    for (int bj = 0; bj < 2; ++bj) { const f32x4 g0 = *(const f32x4*)(ckn + 32 * bj + 8 * fq), g1 = *(const f32x4*)(ckn + 32 * bj + 8 * fq + 4);
                        const f32x4 a = acc[ai][bj][m][0] * rr * g0, b = acc[ai][bj][m][1] * rr * g1;
                        kn2 += ((a[0] * a[0] + a[1] * a[1]) + (a[2] * a[2] + a[3] * a[3])) + ((b[0] * b[0] + b[1] * b[1]) + (b[2] * b[2] + b[3] * b[3]));
                        u32x4 w; w.x = pkbf(a[0], a[1]); w.y = pkbf(a[2], a[3]); w.z = pkbf(b[0], b[1]); w.w = pkbf(b[2], b[3]);
                        *(u32x4*)(kd + 32 * bj + 8 * fq) = w; }
                    const u32x2v k1 = *(const u32x2v*)(PROJ + (size_t)row * PJ_LD + PJ_KR + 4 * fq), k2 = *(const u32x2v*)(PROJ + (size_t)row * PJ_LD + PJ_KR + 16 + 4 * fq);
                    const f32x4 ga = *(const f32x4*)(ckn + 64 + 4 * fq), gb = *(const f32x4*)(ckn + 80 + 4 * fq);
                    const float* tb = rope + (size_t)row * 48 + 16 + 8 * fq; const f32x4 t0 = *(const f32x4*)tb, t1 = *(const f32x4*)(tb + 4);
                    const float x1[4] = {bflo(k1.x) * rk * ga[0], bfhi(k1.x) * rk * ga[1], bflo(k1.y) * rk * ga[2], bfhi(k1.y) * rk * ga[3]};
                    const float x2[4] = {bflo(k2.x) * rk * gb[0], bfhi(k2.x) * rk * gb[1], bflo(k2.y) * rk * gb[2], bfhi(k2.y) * rk * gb[3]};
                    const float cs[4] = {t0[0], t0[2], t1[0], t1[2]}, sn[4] = {t0[1], t0[3], t1[1], t1[3]};
                    u32x2v y1, y2;
                    y1.x = pkbf(x1[0] * cs[0] - x2[0] * sn[0], x1[1] * cs[1] - x2[1] * sn[1]); y1.y = pkbf(x1[2] * cs[2] - x2[2] * sn[2], x1[3] * cs[3] - x2[3] * sn[3]);
                    y2.x = pkbf(x2[0] * cs[0] + x1[0] * sn[0], x2[1] * cs[1] + x1[1] * sn[1]); y2.y = pkbf(x2[2] * cs[2] + x1[2] * sn[2], x2[3] * cs[3] + x1[3] * sn[3]);
                    *(u32x2v*)(kd + 64 + 4 * fq) = y1; *(u32x2v*)(kd + 80 + 4 * fq) = y2;
                    kn2 += ((x1[0] * x1[0] + x2[0] * x2[0]) + (x1[1] * x1[1] + x2[1] * x2[1])) + ((x1[2] * x1[2] + x2[2] * x2[2]) + (x1[3] * x1[3] + x2[3] * x2[3]));
                    kn2 += swz_xor<16>(kn2); kn2 = half_sum(kn2); k2max = fmaxf(k2max, kn2);
                }
                asm volatile("" ::: "memory");
            }
        if (!isv) {
            k2max = fmaxf(k2max, swz_xor<1>(k2max)); k2max = fmaxf(k2max, swz_xor<2>(k2max)); k2max = fmaxf(k2max, swz_xor<4>(k2max)); k2max = fmaxf(k2max, swz_xor<8>(k2max));
            if (fr == 0 && fq == 0) __hip_atomic_fetch_max(kmx + ((u.pm * BM) / SEQ) * 4 + hh, __float_as_uint(k2max), __ATOMIC_RELAXED, __HIP_MEMORY_SCOPE_AGENT);
        }
        return false;
    }
};
struct EpiGates {
    static constexpr bool PERM = true;
    bf16_t* RG; RowScale rs;
    __device__ __forceinline__ bool operator()(f32x4 (&acc)[2][2][4][2], const Unit& u, int wr, int wc, int fr, int fq) const {
        typedef unsigned u32x2v __attribute__((ext_vector_type(2)));
        const int row0 = u.pm * BM + wr * 64 + fr, oc = u.pn * 64 + wc * 16 + fq * 4;
        float scv[2][4];
#pragma unroll
        for (int ai = 0; ai < 2; ++ai)
#pragma unroll
            for (int m = 0; m < 4; ++m) scv[ai][m] = row_scale(rs, row0 + ai * HALF + m * 16);
#pragma unroll
        for (int ai = 0; ai < 2; ++ai)
#pragma unroll
            for (int m = 0; m < 4; ++m) {
                const int row = row0 + ai * HALF + m * 16; const float sc = scv[ai][m];
                f32x4 s[4];
#pragma unroll
                for (int b = 0; b < 4; ++b) { const f32x4 g = acc[ai][b >> 1][m][b & 1] * sc;
#pragma unroll
                    for (int j = 0; j < 4; ++j) s[b][j] = fmaxf(fast_sigmoid(g[j]), 8.6736174e-19f); }
                bf16_t* rp = RG + (size_t)row * 4096 + oc;
#pragma unroll
                for (int b = 0; b < 4; ++b) { f32x4 r = s[b];
                    if (b < 3) {
#pragma unroll
                        for (int j = 0; j < 4; ++j) r[j] = s[b][j] * __builtin_amdgcn_rcpf(s[b + 1][j]); }
                    u32x2v w; w.x = pkbf(r[0], r[1]); w.y = pkbf(r[2], r[3]); *(u32x2v*)(rp + b * 1024) = w; }
            }
        return false;
    }
};
struct EpiMerge {
    static constexpr bool PERM = true;
    const bf16_t* SG; bf16_t* Y;
    __device__ __forceinline__ bool operator()(f32x4 (&acc)[2][2][4][2], const Unit& u, int wr, int wc, int fr, int fq) const {
        const int n = u.ak >> 8; const int row0 = u.pm * BM + wr * 64 + fr, col0 = u.pn * BM + wc * 32 + 8 * fq;
#pragma unroll
        for (int ai = 0; ai < 2; ++ai)
#pragma unroll
            for (int mp = 0; mp < 2; ++mp) {
              u32x4 av[2][2];
#pragma unroll
              for (int mm = 0; mm < 2; ++mm)
#pragma unroll
                for (int bj = 0; bj < 2; ++bj) av[mm][bj] = *(const u32x4*)(SG + (size_t)(row0 + ai * HALF + (2 * mp + mm) * 16) * 4096 + n * 1024 + col0 + bj * HALF);
#pragma unroll
              for (int mm = 0; mm < 2; ++mm) {
                const int m = 2 * mp + mm, row = row0 + ai * HALF + m * 16;
#pragma unroll
                for (int bj = 0; bj < 2; ++bj) {
                    float sa[8]; unpack8(av[mm][bj], sa);
#pragma unroll
                    for (int j = 0; j < 4; ++j) { acc[ai][bj][m][0][j] *= sa[j]; acc[ai][bj][m][1][j] *= sa[4 + j]; }
                    if (n == 3) {
                        float o[8];
#pragma unroll
                        for (int j = 0; j < 4; ++j) { o[j] = acc[ai][bj][m][0][j]; o[4 + j] = acc[ai][bj][m][1][j]; }
                        *(u32x4*)(Y + (size_t)row * DM + col0 + bj * HALF) = pack8(o);
                    }
                }
              }
            }
        return n < 3;
    }
};
struct MergeOrder {
    StaticOrder so;
    __device__ bool next(int i, Unit& u) const { if (!so.next(i >> 2, u)) return false; const int n = i & 3; u.pb = n * 4 + u.pn; u.ak = n * 256; return true; }
    __device__ __forceinline__ void a_ready(const Unit&) const {}
    __device__ __forceinline__ void done(const Unit&) const {}
};
struct MoeOrder {
    StaticOrder so; int nN; int ps[9];
    __device__ bool next(int i, Unit& u) const {
        if (!so.next(i, u)) return false; int e = 0;
#pragma unroll
        for (int k = 1; k < 8; ++k) e = (u.pm >= ps[k]) ? k : e;
        u.pb = e * nN + u.pn; u.ak = 0; return true; }
    __device__ __forceinline__ void a_ready(const Unit&) const {}
    __device__ __forceinline__ void done(const Unit&) const {}
};
}

struct TrDesc { const float* src; bf16* dst; const float* gain; int ldw, ldd, nnb, nsrc0, drow0, map, cum, pad; };
constexpr int TR_TAB_OFF = 8448;
struct TrItem { const float* W; bf16* dst; const float* gain; int ldw, ldd, k0, n0, perm; };
__device__ __forceinline__ void tr_load(const TrItem& it, float (&v)[32], int lane) {
#pragma unroll
    for (int i = 0; i < 32; ++i) { const int kk = 2 * i + (lane >> 5); v[i] = it.W[(size_t)(it.k0 + kk) * it.ldw + it.n0 + (lane & 31)]; }
}
__device__ __forceinline__ void tr_finish(const TrItem& it, float (&v)[32], LAS float* scr, int lane) {
    if (it.gain) {
#pragma unroll
        for (int i = 0; i < 32; ++i) v[i] *= it.gain[it.k0 + 2 * i + (lane >> 5)];
    }
#pragma unroll
    for (int i = 0; i < 32; ++i) scr[(2 * i + (lane >> 5)) * 33 + (lane & 31)] = v[i];
    LDS_WAIT(); asm volatile("" ::: "memory");
    const int c = lane & 7;
#pragma unroll
    for (int j = 0; j < 4; ++j) { const int n = (lane >> 3) + 8 * j; const LAS float* s = scr + (8 * c) * 33 + n;
        v4u o; o.x = pkbf(s[0 * 33], s[1 * 33]); o.y = pkbf(s[2 * 33], s[3 * 33]); o.z = pkbf(s[4 * 33], s[5 * 33]); o.w = pkbf(s[6 * 33], s[7 * 33]);
        const int nr = it.perm ? (32 * (n >> 4) + 8 * ((n >> 2) & 3) + (n & 3)) : n;
        *(v4u*)(it.dst + (size_t)nr * it.ldd + 8 * c) = o; }
    LDS_WAIT(); asm volatile("" ::: "memory");
}
__device__ __forceinline__ void tr_add(LAS TrDesc* t, int& n, int& cum, const float* src, int ldw, int Ktot, int ncols, int nsrc0, bf16* dst, int ldd, int drow0, int map, const float* gain) {
    int z = 0; asm volatile("" : "+s"(z));
    asm volatile("" : "+s"(gain));
    t[n].src = src; t[n].dst = dst; t[n].gain = gain; t[n].ldw = ldw + z; t[n].ldd = ldd + z; t[n].nnb = ncols / 32 + z; t[n].nsrc0 = nsrc0 + z; t[n].drow0 = drow0 + z; t[n].map = map + z; t[n].cum = cum + z;
    cum += (Ktot / 64) * (ncols / 32); ++n;
}
__device__ __forceinline__ TrItem tr_lookup(const LAS TrDesc* t, int& d, int it) {
    while (it >= t[d + 1].cum) ++d;
    const int local = it - t[d].cum, nnb = t[d].nnb, kb = local / nnb, nb = local - kb * nnb, k0 = kb * 64, nl = nb * 32;
    const int mp = t[d].map;
    const int drow = t[d].drow0 + (mp == 1 ? ((nl >> 7) * 256 + (nl & 127)) : mp == 2 ? (256 * (nl >> 8) + 128 * ((nl >> 5) & 1) + 32 * ((((nl >> 7) & 1) << 1) + ((nl >> 6) & 1)))
                                 : mp == 3 ? (256 * ((nl & 1023) >> 6) + 128 * (nl >> 11) + 32 * (((nl & 1023) >> 4) & 3) + 4 * ((nl >> 10) & 1)) : nl); const int ldd = t[d].ldd;
    TrItem r; r.W = t[d].src; r.dst = t[d].dst + (size_t)drow * ldd + k0; r.gain = t[d].gain; r.ldw = t[d].ldw; r.ldd = ldd; r.k0 = k0; r.n0 = t[d].nsrc0 + nl; r.perm = (mp == 3) ? 1 : 0; return r;
}
__device__ __forceinline__ void tr_run(const LAS TrDesc* t, int total, LAS float* scr, int lane, int gw, int NGW) {
    const int per = (total + NGW - 1) / NGW, lo = gw * per, hi = (lo + per < total) ? lo + per : total;
    if (lo >= hi) return;
    int d = 0; TrItem cur = tr_lookup(t, d, lo); float va[32], vb[32];
    tr_load(cur, va, lane);
    for (int it = lo; it < hi; it += 2) {
        TrItem nx = cur; const bool h1 = it + 1 < hi;
        if (h1) { nx = tr_lookup(t, d, it + 1); tr_load(nx, vb, lane); }
        tr_finish(cur, va, scr, lane);
        if (!h1) break;
        const bool h2 = it + 2 < hi;
        if (h2) { cur = tr_lookup(t, d, it + 2); tr_load(cur, va, lane); }
        tr_finish(nx, vb, scr, lane);
    }
}

template <int DK, int DV, bool MOBA>
__device__ __forceinline__ void naive_attn_unit(LAS unsigned char* lds, const bf16* Q, int qp, int qhs, const bf16* K, int kp, int khs, const bf16* V, int vp, int vhs,
                                                bf16* O, int op, int b, int h, int qc, const int* sel, const int tid) {
    LAS float* Ks = (LAS float*)lds; LAS float* Vs = Ks + 64 * DK;
    const int qi = qc * 512 + tid;
    const size_t tok = (size_t)b * SEQ + qi;
    float q[DK];
    { const v4u* qsrc = (const v4u*)(Q + tok * qp + h * qhs);
#pragma unroll
      for (int c = 0; c < DK / 8; ++c) unpack8(qsrc[c], q + 8 * c); }
    float o[DV];
#pragma unroll
    for (int d = 0; d < DV; ++d) o[d] = 0.f;
    float m = -1e30f, l = 0.f;
    const int qblk = qi >> 8; unsigned mask = 0u;
    if (MOBA) { const int sv = sel[tok * 4 + h]; const int ns = (sv >> 12) & 3;
        if (ns > 0) mask |= 1u << (sv & 15); if (ns > 1) mask |= 1u << ((sv >> 4) & 15); if (ns > 2) mask |= 1u << ((sv >> 8) & 15); }
    const int ntile = qc * 8 + 8;
    const int wave_last = qc * 512 + (tid | 63);
    for (int kt = 0; kt < ntile; ++kt) {
        __syncthreads();
        const int k0 = kt * 64;
        for (int c = tid; c < 64 * (DK / 8); c += NTHR) { const int r = c / (DK / 8), ch = c - r * (DK / 8);
            const v4u w = *(const v4u*)(K + ((size_t)b * SEQ + k0 + r) * kp + h * khs + ch * 8); float f[8]; unpack8(w, f);
            LAS f32x4* d = (LAS f32x4*)(Ks + r * DK + ch * 8); d[0] = (f32x4){f[0], f[1], f[2], f[3]}; d[1] = (f32x4){f[4], f[5], f[6], f[7]}; }
        for (int c = tid; c < 64 * (DV / 8); c += NTHR) { const int r = c / (DV / 8), ch = c - r * (DV / 8);
            const v4u w = *(const v4u*)(V + ((size_t)b * SEQ + k0 + r) * vp + h * vhs + ch * 8); float f[8]; unpack8(w, f);
            LAS f32x4* d = (LAS f32x4*)(Vs + r * DV + ch * 8); d[0] = (f32x4){f[0], f[1], f[2], f[3]}; d[1] = (f32x4){f[4], f[5], f[6], f[7]}; }
        __syncthreads();
        if (k0 > wave_last) continue;
        const int nblk = k0 >> 8;
        bool tile_ok = true;
        if (MOBA) { tile_ok = (nblk == qblk) || ((mask >> nblk) & 1u); if (!__any(tile_ok)) continue; }
        for (int jj = 0; jj < 64; ++jj) {
            const int kj = k0 + jj;
            const bool ok = MOBA ? (tile_ok && (nblk != qblk || kj <= qi)) : (kj <= qi);
            if (ok) {
                const LAS f32x4* kr = (const LAS f32x4*)(Ks + jj * DK);
                float s0 = 0.f, s1 = 0.f;
#pragma unroll
                for (int c = 0; c < DK / 8; ++c) { const f32x4 a = kr[2 * c], bq = kr[2 * c + 1];
                    s0 += q[8 * c] * a[0]; s1 += q[8 * c + 1] * a[1]; s0 += q[8 * c + 2] * a[2]; s1 += q[8 * c + 3] * a[3];
                    s0 += q[8 * c + 4] * bq[0]; s1 += q[8 * c + 5] * bq[1]; s0 += q[8 * c + 6] * bq[2]; s1 += q[8 * c + 7] * bq[3]; }
                const float s = s0 + s1;
                if (s > m) { const float cf = __builtin_amdgcn_exp2f(m - s); l *= cf;
#pragma unroll
                    for (int d = 0; d < DV; ++d) o[d] *= cf;
                    m = s; }
                const float p = __builtin_amdgcn_exp2f(s - m); l += p;
                const LAS f32x4* vr = (const LAS f32x4*)(Vs + jj * DV);
#pragma unroll
                for (int c = 0; c < DV / 4; ++c) { const f32x4 a = vr[c]; o[4 * c] += p * a[0]; o[4 * c + 1] += p * a[1]; o[4 * c + 2] += p * a[2]; o[4 * c + 3] += p * a[3]; }
            }
        }
    }
    const float inv = 1.0f / l;
    v4u* od = (v4u*)(O + tok * op + h * DV);
#pragma unroll
    for (int c = 0; c < DV / 8; ++c) { float t8[8];
#pragma unroll
        for (int j = 0; j < 8; ++j) t8[j] = o[8 * c + j] * inv;
        od[c] = pack8(t8); }
    __syncthreads();
}

constexpr int SGU_P = 136;
__device__ __forceinline__ void sgu_unit(LAS unsigned char* lds, const bf16* PROJ, bf16* O, const float* __restrict__ lng, const float* __restrict__ lnb, const bf16* __restrict__ WM, const float* __restrict__ bs, int unit, const int tid) {
    LAS bf16* vnT = (LAS bf16*)lds;
    const int lane = tid & 63, wave = __builtin_amdgcn_readfirstlane(tid >> 6), r32 = lane & 31, hi = lane >> 5;
    const size_t t0 = (size_t)unit * 128;
    const f32x4 g4 = *(const f32x4*)(lng + 4 * lane), b4 = *(const f32x4*)(lnb + 4 * lane);
    bf16x8 wf[20];
    { const int g_ = wave >> 1; const bf16* wb = WM + ((size_t)(g_ * 128 + r32) * 128 + 8 * hi);
#pragma unroll
      for (int nt = 0; nt < 4; ++nt)
#pragma unroll
          for (int ks = 0; ks < 2 * nt + 2; ++ks) wf[nt * (nt + 1) + ks] = *(const bf16x8*)(wb + (size_t)(32 * nt) * 128 + 16 * ks); }
    {
        typedef unsigned u32x2v __attribute__((ext_vector_type(2)));
        u32x2v xr[16];
#pragma unroll
        for (int i = 0; i < 16; ++i) xr[i] = *(const u32x2v*)(PROJ + (t0 + wave * 16 + i) * PJ_LD + PJ_V + 4 * lane);
        unsigned ow[4][8];
#pragma unroll
        for (int i4 = 0; i4 < 4; ++i4) {
            float x[4][4], mu[4], var[4];
#pragma unroll
            for (int u = 0; u < 4; ++u) { const u32x2v r = xr[4 * i4 + u]; x[u][0] = bflo(r.x); x[u][1] = bfhi(r.x); x[u][2] = bflo(r.y); x[u][3] = bfhi(r.y); mu[u] = (x[u][0] + x[u][1]) + (x[u][2] + x[u][3]); }
#pragma unroll
            for (int u = 0; u < 4; ++u) mu[u] = wave_sum(mu[u]) * (1.0f / 256.0f);
#pragma unroll
            for (int u = 0; u < 4; ++u) { x[u][0] -= mu[u]; x[u][1] -= mu[u]; x[u][2] -= mu[u]; x[u][3] -= mu[u]; var[u] = (x[u][0] * x[u][0] + x[u][1] * x[u][1]) + (x[u][2] * x[u][2] + x[u][3] * x[u][3]); }
#pragma unroll
            for (int u = 0; u < 4; ++u) var[u] = wave_sum(var[u]) * (1.0f / 256.0f);
#pragma unroll
            for (int u = 0; u < 4; ++u) { const float rstd = rsqrtf(var[u] + EPS);
#pragma unroll
                for (int c = 0; c < 4; ++c) x[u][c] = x[u][c] * rstd * g4[c] + b4[c]; }
#pragma unroll
            for (int c = 0; c < 4; ++c) { ow[c][2 * i4] = pkbf(x[0][c], x[1][c]); ow[c][2 * i4 + 1] = pkbf(x[2][c], x[3][c]); }
        }
#pragma unroll
        for (int c = 0; c < 4; ++c) { LAS v4u* dst = (LAS v4u*)(vnT + (4 * lane + c) * SGU_P + wave * 16);
            dst[0] = (v4u){ow[c][0], ow[c][1], ow[c][2], ow[c][3]}; dst[1] = (v4u){ow[c][4], ow[c][5], ow[c][6], ow[c][7]}; }
    }
    __syncthreads();
    const int g = wave >> 1, dt = wave & 1;
    bf16x8 af[8];
#pragma unroll
    for (int ks = 0; ks < 8; ++ks) af[ks] = *(const LAS bf16x8*)(vnT + (g * 64 + dt * 32 + r32) * SGU_P + 16 * ks + 8 * hi);
    typedef float f32x16s __attribute__((ext_vector_type(16)));
    f32x16s acc[4];
#pragma unroll
    for (int nt = 0; nt < 4; ++nt) {
#pragma unroll
        for (int r = 0; r < 16; ++r) acc[nt][r] = 0.f;
#pragma unroll
        for (int ks = 0; ks < 2 * nt + 2; ++ks) {
            acc[nt] = __builtin_amdgcn_mfma_f32_32x32x16_bf16(af[ks], wf[nt * (nt + 1) + ks], acc[nt], 0, 0, 0);
        }
    }
    typedef unsigned u32x2v __attribute__((ext_vector_type(2)));
    u32x2v uva[4][4]; float biasv[4];
#pragma unroll
    for (int nt = 0; nt < 4; ++nt) { const int t = 32 * nt + r32; biasv[nt] = bs[g * 128 + t]; const bf16* up = PROJ + (t0 + t) * PJ_LD + PJ_U + g * 64 + dt * 32 + 4 * hi;
#pragma unroll
        for (int j = 0; j < 4; ++j) uva[nt][j] = *(const u32x2v*)(up + 8 * j); }
#pragma unroll
    for (int nt = 0; nt < 4; ++nt) {
        const int t = 32 * nt + r32; const float bias = biasv[nt];
        bf16* op = O + (t0 + t) * DM + g * 64 + dt * 32 + 4 * hi;
#pragma unroll
        for (int j = 0; j < 4; ++j) {
            const u32x2v uu = uva[nt][j];
            u32x2v w; w.x = pkbf(bflo(uu.x) * (acc[nt][4 * j] + bias), bfhi(uu.x) * (acc[nt][4 * j + 1] + bias)); w.y = pkbf(bflo(uu.y) * (acc[nt][4 * j + 2] + bias), bfhi(uu.y) * (acc[nt][4 * j + 3] + bias));
            *(u32x2v*)(op + 8 * j) = w;
        }
    }
    __syncthreads();
}

__device__ __forceinline__ void prep_block(LAS unsigned char* lds, bf16* PROJ, const float* __restrict__ ROPE, const float* __restrict__ qn, const float* __restrict__ kn, float* KMEAN, unsigned* kmx_out, int item, const int tid) {
    const int b = item >> 5, blk = (item >> 1) & 15, hf = item & 1;
    const int sub = tid & 7;
    const size_t tok0 = (size_t)b * SEQ + blk * 256 + hf * 128;
    float ksum[8] = {0.f, 0.f, 0.f, 0.f, 0.f, 0.f, 0.f, 0.f};
    float kmx = 0.f;
    f32x4 gq0 = *(const f32x4*)(qn + 8 * sub), gq1 = *(const f32x4*)(qn + 8 * sub + 4), gk0 = *(const f32x4*)(kn + 8 * sub), gk1 = *(const f32x4*)(kn + 8 * sub + 4);
    LAS float* rl = (LAS float*)(lds + 16384);
    { const f32x4 r = *(const f32x4*)(ROPE + (tok0 + (tid >> 2)) * 48 + 4 * (tid & 3)); *(LAS f32x4*)(rl + (tid >> 2) * 16 + 4 * (tid & 3)) = r; }
    v4u raw[16];
#pragma unroll
    for (int u = 0; u < 16; ++u) { const int row = u * 64 + (tid >> 3);
        const int tk = row >> 3, which = (row >> 2) & 1, hd = row & 3;
        raw[u] = *(const v4u*)(PROJ + (tok0 + tk) * PJ_LD + (which ? PJ_BK : PJ_BQ) + hd * 64 + 8 * sub); }
    __syncthreads();
#pragma unroll
    for (int u = 0; u < 16; ++u) { const int row = u * 64 + (tid >> 3);
        const int tk = row >> 3, which = (row >> 2) & 1, hd = row & 3;
        float v[8]; unpack8(raw[u], v);
        float ss = ((v[0] * v[0] + v[1] * v[1]) + (v[2] * v[2] + v[3] * v[3])) + ((v[4] * v[4] + v[5] * v[5]) + (v[6] * v[6] + v[7] * v[7]));
        ss += swz_xor<1>(ss); ss += swz_xor<2>(ss); ss += swz_xor<4>(ss);
        const float rstd = rsqrtf(ss * (1.0f / 64.0f) + EPS);
        const f32x4 g0 = which ? gk0 : gq0, g1 = which ? gk1 : gq1;
#pragma unroll
        for (int j = 0; j < 4; ++j) { v[j] *= rstd * g0[j]; v[4 + j] *= rstd * g1[j]; }
        f32x4 rp[4];
#pragma unroll
        for (int q = 0; q < 4; ++q) rp[q] = *(const LAS f32x4*)(rl + tk * 16 + 4 * q);
#pragma unroll
        for (int j = 0; j < 8; ++j) { const float other = swz_xor<1>(v[j]);
            if (sub < 2) { const float cs = rp[j >> 1][2 * (j & 1)], sn = rp[j >> 1][2 * (j & 1) + 1]; v[j] = (sub == 0) ? (v[j] * cs - other * sn) : (v[j] * cs + other * sn); } }
        if (!which) {
#pragma unroll
            for (int j = 0; j < 8; ++j) v[j] *= QS_B;
        } else {
            float s2 = ((v[0] * v[0] + v[1] * v[1]) + (v[2] * v[2] + v[3] * v[3])) + ((v[4] * v[4] + v[5] * v[5]) + (v[6] * v[6] + v[7] * v[7]));
            s2 += swz_xor<1>(s2); s2 += swz_xor<2>(s2); s2 += swz_xor<4>(s2); kmx = fmaxf(kmx, s2);
#pragma unroll
            for (int j = 0; j < 8; ++j) ksum[j] += v[j];
        }
        *(v4u*)(PROJ + (tok0 + tk) * PJ_LD + (which ? PJ_BK : PJ_BQ) + hd * 64 + 8 * sub) = pack8(v);
    }
    {
        LAS float* kl = (LAS float*)lds; if (((tid >> 5) & 1) && sub == 0) kl[(tid >> 6) * 4 + ((tid >> 3) & 3)] = kmx;
        LAS float* ks = (LAS float*)(lds + 4096);
        if ((tid >> 5) & 1) { LAS f32x4* kd = (LAS f32x4*)(ks + (tid >> 6) * 256 + ((tid >> 3) & 3) * 64 + 8 * sub); kd[0] = (f32x4){ksum[0], ksum[1], ksum[2], ksum[3]}; kd[1] = (f32x4){ksum[4], ksum[5], ksum[6], ksum[7]}; }
        __syncthreads();
        if (tid < 4) { float mx = 0.f;
#pragma unroll
            for (int w = 0; w < 8; ++w) mx = fmaxf(mx, kl[w * 4 + tid]);
            __hip_atomic_fetch_max(kmx_out + b * 4 + tid, __float_as_uint(mx), __ATOMIC_RELAXED, __HIP_MEMORY_SCOPE_AGENT); }
        if (tid >= 256) { const int hd = tid - 256; float s = 0.f;
#pragma unroll
            for (int w = 0; w < 8; ++w) s += ks[w * 256 + hd];
            KMEAN[(((size_t)(b * 4 + (hd >> 6)) * 16 + blk) * 2 + hf) * 64 + (hd & 63)] = s; }
    }
    __syncthreads();
}

__device__ __forceinline__ void conv_unit(LAS unsigned char* lds, const bf16* PROJ, bf16* O, const float* __restrict__ cw, const float* __restrict__ cb, const float* __restrict__ lng, const float* __restrict__ lnb, int unit, const int tid) {
    LAS float* zc = (LAS float*)lds;
    const int lane = tid & 63, wave = __builtin_amdgcn_readfirstlane(tid >> 6);
    const int b = unit >> 6, p0 = (unit & 63) * 64;
    const int ch = tid & 255, half = tid >> 8;
    {
        typedef unsigned u32x2v __attribute__((ext_vector_type(2)));
        u32x2v av[12], gv[12];
#pragma unroll
        for (int i = 0; i < 12; ++i) { const int r = wave + 8 * i, p = p0 - 30 + r; av[i] = (u32x2v){0u, 0u}; gv[i] = (u32x2v){0u, 0u};
            if (r < 94 && p >= 0) { const bf16* row = PROJ + ((size_t)b * SEQ + p) * PJ_LD; av[i] = *(const u32x2v*)(row + PJ_DA + 4 * lane); gv[i] = *(const u32x2v*)(row + PJ_DG + 4 * lane); } }
#pragma unroll
        for (int i = 0; i < 12; ++i) { const int r = wave + 8 * i;
            if (r < 94) *(LAS f32x4*)(zc + r * 256 + 4 * lane) = (f32x4){bflo(av[i].x) * fast_sigmoid(bflo(gv[i].x)), bfhi(av[i].x) * fast_sigmoid(bfhi(gv[i].x)), bflo(av[i].y) * fast_sigmoid(bflo(gv[i].y)), bfhi(av[i].y) * fast_sigmoid(bfhi(gv[i].y))}; }
    }
    float w[31];
#pragma unroll
    for (int j = 0; j < 31; ++j) w[j] = cw[j * 256 + ch];
    const float bias = cb[ch];
    __syncthreads();
    float acc[32];
    {
        float z[62];
#pragma unroll
        for (int j = 0; j < 62; ++j) z[j] = zc[(half * 32 + j) * 256 + ch];
#pragma unroll
        for (int t = 0; t < 32; ++t) { float a = bias;
#pragma unroll
            for (int j = 0; j < 31; ++j) a += w[j] * z[t + j];
            acc[t] = a; }
    }
    __syncthreads();
#pragma unroll
    for (int t = 0; t < 32; ++t) zc[(half * 32 + t) * 256 + ch] = acc[t];
    __syncthreads();
    const f32x4 g4 = *(const f32x4*)(lng + lane * 4), b4 = *(const f32x4*)(lnb + lane * 4);
    for (int i4 = 0; i4 < 2; ++i4) {
        f32x4 x[4]; float mu[4], var[4];
#pragma unroll
        for (int u = 0; u < 4; ++u) { x[u] = *(const LAS f32x4*)(zc + (wave * 8 + i4 * 4 + u) * 256 + lane * 4); mu[u] = (x[u][0] + x[u][1]) + (x[u][2] + x[u][3]); }
#pragma unroll
        for (int u = 0; u < 4; ++u) mu[u] = wave_sum(mu[u]) * (1.0f / 256.0f);
#pragma unroll
        for (int u = 0; u < 4; ++u) { x[u] = x[u] - mu[u]; var[u] = (x[u][0] * x[u][0] + x[u][1] * x[u][1]) + (x[u][2] * x[u][2] + x[u][3] * x[u][3]); }
#pragma unroll
        for (int u = 0; u < 4; ++u) var[u] = wave_sum(var[u]) * (1.0f / 256.0f);
#pragma unroll
        for (int u = 0; u < 4; ++u) { const float rstd = rsqrtf(var[u] + EPS);
            const float y0 = x[u][0] * rstd * g4[0] + b4[0], y1 = x[u][1] * rstd * g4[1] + b4[1], y2 = x[u][2] * rstd * g4[2] + b4[2], y3 = x[u][3] * rstd * g4[3] + b4[3];
            typedef unsigned u32x2v __attribute__((ext_vector_type(2)));
            u32x2v wv; wv.x = pkbf(fast_silu(y0), fast_silu(y1)); wv.y = pkbf(fast_silu(y2), fast_silu(y3));
            *(u32x2v*)(O + ((size_t)b * SEQ + p0 + wave * 8 + i4 * 4 + u) * DM + 768 + lane * 4) = wv; }
    }
    __syncthreads();
}

typedef float f32x16 __attribute__((ext_vector_type(16)));
template <int DK> struct AttnLds { static constexpr int KBYTES = 64 * DK * 2  , VP = 68, VBYTES = 64 * VP * 2, K0 = 0, K1 = KBYTES, V0 = 2 * KBYTES, V1 = 2 * KBYTES + VBYTES, UM = 2 * KBYTES + 2 * VBYTES; };
__device__ __forceinline__ float half_max(float v) { auto rr = __builtin_amdgcn_permlane32_swap(__float_as_uint(v), __float_as_uint(v), false, false); return fmaxf(__uint_as_float(rr[0]), __uint_as_float(rr[1])); }
#define ATT_FAST_BOUND 30.0f
__device__ __forceinline__ void softmax_fast(f32x16& s, float& l, bf16x8 (&p)[2], const bool diag, const bool blocked, const int qi, const int kbase) {
    if (diag) {
#pragma unroll
        for (int r = 0; r < 16; ++r) { const int key = kbase + (r & 3) + 8 * (r >> 2); if (key > qi) s[r] = -INFINITY; }
    }
    float sum = 0.f;
#pragma unroll
    for (int r = 0; r < 16; ++r) { const float e = __builtin_amdgcn_exp2f(s[r]); s[r] = e; sum += e; }
    v4u w0, w1;
    w0.x = pkbf(s[0], s[1]); w0.y = pkbf(s[2], s[3]); w0.z = pkbf(s[4], s[5]); w0.w = pkbf(s[6], s[7]);
    w1.x = pkbf(s[8], s[9]); w1.y = pkbf(s[10], s[11]); w1.z = pkbf(s[12], s[13]); w1.w = pkbf(s[14], s[15]);
    if (blocked) { sum = 0.f; w0 = (v4u){0u, 0u, 0u, 0u}; w1 = (v4u){0u, 0u, 0u, 0u}; }
    l += sum;
    p[0] = __builtin_bit_cast(bf16x8, w0); p[1] = __builtin_bit_cast(bf16x8, w1);
}
__device__ __forceinline__ void softmax_group(f32x16& s, f32x16 (&o)[2], float& m, float& l, bf16x8 (&p)[2], const bool diag, const bool blocked, const int qi, const int kbase) {
    if (diag) {
#pragma unroll
        for (int r = 0; r < 16; ++r) { const int key = kbase + (r & 3) + 8 * (r >> 2); if (key > qi) s[r] = -INFINITY; }
    }
    float mx = fmaxf(s[0], s[1]);
#pragma unroll
    for (int r = 2; r < 16; ++r) mx = fmaxf(mx, s[r]);
    mx = half_max(mx);
    if (blocked) mx = -INFINITY;
    const float mn = fmaxf(m, mx);
    const float ms = (mn == -INFINITY) ? 0.f : mn;
    const float alpha = __builtin_amdgcn_exp2f(m - ms);
    const float mse = blocked ? INFINITY : ms;
    float sum = 0.f;
#pragma unroll
    for (int r = 0; r < 16; ++r) { const float e = __builtin_amdgcn_exp2f(s[r] - mse); s[r] = e; sum += e; }
    l = l * alpha + sum; m = mn;
    if (__any(alpha != 1.f)) {
#pragma unroll
        for (int dt = 0; dt < 2; ++dt)
#pragma unroll
            for (int r = 0; r < 16; ++r) o[dt][r] *= alpha;
    }
#pragma unroll
    for (int st = 0; st < 2; ++st) { const int bs = 8 * st;
        v4u w; w.x = pkbf(s[bs], s[bs + 1]); w.y = pkbf(s[bs + 2], s[bs + 3]); w.z = pkbf(s[bs + 4], s[bs + 5]); w.w = pkbf(s[bs + 6], s[bs + 7]);
        p[st] = __builtin_bit_cast(bf16x8, w); }
}
template <int NKS, int DK>
__device__ __forceinline__ float qpost(bf16x8 (&qf)[NKS], const float* __restrict__ qgain, const float* __restrict__ tabrow, const int hi) {
    float qv[8 * NKS]; float ss = 0.f;
#pragma unroll
    for (int ks = 0; ks < NKS; ++ks) unpack8(__builtin_bit_cast(v4u, qf[ks]), qv + 8 * ks);
#pragma unroll
    for (int i = 0; i < 8 * NKS; ++i) ss += qv[i] * qv[i];
    const float rstd = rsqrtf(half_sum(ss) * (1.0f / (float)DK) + EPS);
#pragma unroll
    for (int ks = 0; ks < NKS; ++ks) { const f32x4 ga = *(const f32x4*)(qgain + 16 * ks + 8 * hi), gb = *(const f32x4*)(qgain + 16 * ks + 8 * hi + 4);
#pragma unroll
        for (int j = 0; j < 4; ++j) { qv[8 * ks + j] *= rstd * ga[j]; qv[8 * ks + 4 + j] *= rstd * gb[j]; } }
    const float* tb = tabrow + 16 + 16 * hi;
#pragma unroll
    for (int j = 0; j < 8; ++j) { const float cs = tb[2 * j], sn = tb[2 * j + 1], x1 = qv[32 + j], x2 = qv[40 + j]; qv[32 + j] = x1 * cs - x2 * sn; qv[40 + j] = x2 * cs + x1 * sn; }
    float q2 = 0.f;
#pragma unroll
    for (int i = 0; i < 8 * NKS; ++i) { qv[i] *= QS_C; q2 += qv[i] * qv[i]; }
#pragma unroll
    for (int ks = 0; ks < NKS; ++ks) qf[ks] = __builtin_bit_cast(bf16x8, pack8(qv + 8 * ks));
    return half_sum(q2);
}
template <int DK, bool MOBA, bool QPOST, int qp, int qhs, int kp, int khs, int vp, int vhs, int op>
__device__ __forceinline__ void attn_unit(LAS unsigned char* lds, const bf16* __restrict__ Q, const bf16* __restrict__ K,
                                          const bf16* __restrict__ V, bf16* O, const int b, const int h, const int qc, const float* __restrict__ kmean, const float* __restrict__ qgain, const float* __restrict__ rope, const unsigned* __restrict__ kmx, const int tid) {
    using L = AttnLds<DK>;
    constexpr int NKS = DK / 16, KCH = DK / 8;
    const int lane = tid & 63, w = __builtin_amdgcn_readfirstlane(tid >> 6), r32 = lane & 31, hi = lane >> 5;
    const int q0 = qc * 512;
    const size_t tokbase = (size_t)b * SEQ;
    const int g0 = w, g1 = 15 - w;
    const int qi0 = q0 + 32 * g0 + r32, qi1 = q0 + 32 * g1 + r32;
    const int tl0 = (q0 + 32 * g0 + 31) >> 6, tl1 = (q0 + 32 * g1 + 31) >> 6;
    const int ob0 = (q0 + 32 * g0) >> 8, ob1 = (q0 + 32 * g1) >> 8;
    bf16x8 qf0[NKS], qf1[NKS];
    { const bf16* p0 = Q + (tokbase + qi0) * qp + h * qhs + 8 * hi;
#pragma unroll
      for (int ks = 0; ks < NKS; ++ks) qf0[ks] = *(const bf16x8*)(p0 + 16 * ks); }
    float q2a = 0.f, q2b = 0.f;
    if (QPOST) { q2a = qpost<NKS, DK>(qf0, qgain, rope + (tokbase + qi0) * 48, hi); asm volatile("" ::: "memory"); }
    { const bf16* p1 = Q + (tokbase + qi1) * qp + h * qhs + 8 * hi;
#pragma unroll
      for (int ks = 0; ks < NKS; ++ks) qf1[ks] = *(const bf16x8*)(p1 + 16 * ks); }
    if (QPOST) { q2b = qpost<NKS, DK>(qf1, qgain, rope + (tokbase + qi1) * 48, hi); asm volatile("" ::: "memory"); }
    unsigned mk0 = 0u, mk1 = 0u, umask = 0xffffffffu;
    if (MOBA) {
        LAS float* kml = (LAS float*)(lds + L::UM + 16);
        { const float* kmg = kmean + (size_t)(b * 4 + h) * 16 * 128;
          for (int i = tid; i < 1024; i += NTHR) { const int n = i >> 6, d = i & 63; kml[i] = (kmg[n * 128 + d] + kmg[n * 128 + 64 + d]) * (1.0f / 256.0f); } }
        __syncthreads();
        const LAS float* km = kml + 8 * hi;
#pragma unroll
        for (int g = 0; g < 2; ++g) {
            float qv[8 * NKS];
#pragma unroll
            for (int ks = 0; ks < NKS; ++ks) unpack8(__builtin_bit_cast(v4u, g ? qf1[ks] : qf0[ks]), qv + 8 * ks);
            { float q2 = 0.f;
#pragma unroll
              for (int i = 0; i < 8 * NKS; ++i) q2 += qv[i] * qv[i];
              q2 = half_sum(q2); if (g) q2b = q2; else q2a = q2; }
            const int ob = g ? ob1 : ob0;
            float s0 = -INFINITY, s1 = -INFINITY, s2 = -INFINITY; int i0 = 0, i1 = 0, i2 = 0;
            for (int n = 0; n < ob; ++n) {
                const LAS float* kmp = km + n * 64; float sc = 0.f;
#pragma unroll
                for (int ks = 0; ks < NKS; ++ks) { const f32x4 ka = *(const LAS f32x4*)(kmp + 16 * ks), kb2 = *(const LAS f32x4*)(kmp + 16 * ks + 4);
                    sc += qv[8 * ks] * ka[0]; sc += qv[8 * ks + 1] * ka[1]; sc += qv[8 * ks + 2] * ka[2]; sc += qv[8 * ks + 3] * ka[3];
                    sc += qv[8 * ks + 4] * kb2[0]; sc += qv[8 * ks + 5] * kb2[1]; sc += qv[8 * ks + 6] * kb2[2]; sc += qv[8 * ks + 7] * kb2[3]; }
                sc = half_sum(sc);
                if (sc > s0) { s2 = s1; i2 = i1; s1 = s0; i1 = i0; s0 = sc; i0 = n; }
                else if (sc > s1) { s2 = s1; i2 = i1; s1 = sc; i1 = n; }
                else if (sc > s2) { s2 = sc; i2 = n; }
            }
            unsigned mk = 0u; if (ob > 0) mk |= 1u << i0; if (ob > 1) mk |= 1u << i1; if (ob > 2) mk |= 1u << i2;
            if (g) mk1 = mk; else mk0 = mk;
        }
        LAS unsigned* um = (LAS unsigned*)(lds + L::UM);
        if (tid == 0) *um = 0u;
        __syncthreads();
        __hip_atomic_fetch_or(um, mk0 | mk1, __ATOMIC_RELAXED, __HIP_MEMORY_SCOPE_WORKGROUP);
        __syncthreads();
        umask = *um;
    }
    const float k2m = __uint_as_float(__hip_atomic_load(kmx + b * 4 + h, __ATOMIC_RELAXED, __HIP_MEMORY_SCOPE_AGENT));
    const bool fast = __all(fmaxf(q2a, q2b) * k2m <= ATT_FAST_BOUND * ATT_FAST_BOUND);
    const int ntile = qc * 8 + 8;
    v4u vreg = {0u, 0u, 0u, 0u};
#define ATT_NEEDED(t) (!MOBA || ((t) >> 2) >= 2 * qc || ((umask >> ((t) >> 2)) & 1u))
#define ATT_LOADK(t, buf) do { const bf16* kt_ = K + (tokbase + (size_t)(t) * 64) * kp + h * khs; int ln_ = lane; asm volatile("" : "+v"(ln_)); \
        LAS unsigned char* kd_ = lds + ((buf) ? L::K1 : L::K0) + w * 1024; \
        __builtin_amdgcn_global_load_lds((const unsigned*)(kt_ + ln_ * kp + w * 8), (LAS unsigned*)kd_, 16, 0, 0); \
        if (DK == 96 && w < 4) __builtin_amdgcn_global_load_lds((const unsigned*)(kt_ + ln_ * kp + (8 + w) * 8), (LAS unsigned*)(kd_ + 8192), 16, 0, 0); } while (0)
#define ATT_LOADV(t) do { int t2_ = tid; asm volatile("" : "+v"(t2_)); const int vkey = t2_ >> 3, vch = t2_ & 7; \
        vreg = *(const v4u*)(V + (tokbase + (size_t)(t) * 64) * vp + (vkey * vp + h * vhs + vch * 8)); } while (0)
    unsigned krd_lane = (unsigned)(hi * 1024 + r32 * 16), vrd_lane = (unsigned)((r32 * L::VP + 4 * hi) * 2);
    asm volatile("" : "+v"(krd_lane), "+v"(vrd_lane));
#define ATT_STOREV(buf) do { int t2_ = tid; asm volatile("" : "+v"(t2_)); const int vkey = t2_ >> 3, vch = t2_ & 7; \
        LAS unsigned char* vtb_ = lds + ((buf) ? L::V1 : L::V0) + ((vch * 8) * L::VP + vkey) * 2; asm volatile("" : "+v"(vtb_)); LAS bf16* vt_ = (LAS bf16*)vtb_; \
        vt_[0 * L::VP] = (bf16)(vreg.x & 0xffffu); vt_[1 * L::VP] = (bf16)(vreg.x >> 16); vt_[2 * L::VP] = (bf16)(vreg.y & 0xffffu); vt_[3 * L::VP] = (bf16)(vreg.y >> 16); \
        vt_[4 * L::VP] = (bf16)(vreg.z & 0xffffu); vt_[5 * L::VP] = (bf16)(vreg.z >> 16); vt_[6 * L::VP] = (bf16)(vreg.w & 0xffffu); vt_[7 * L::VP] = (bf16)(vreg.w >> 16); } while (0)
    int t = 0; while (t < ntile && !ATT_NEEDED(t)) t += 4;
    ATT_LOADK(t, 0); ATT_LOADV(t); ATT_STOREV(0);
    asm volatile("s_waitcnt vmcnt(0)" ::: "memory");
    __syncthreads();
    f32x16 o0[2], o1[2];
#pragma unroll
    for (int dt = 0; dt < 2; ++dt)
#pragma unroll
        for (int r = 0; r < 16; ++r) { o0[dt][r] = 0.f; o1[dt][r] = 0.f; }
    float m0 = -INFINITY, m1 = -INFINITY, l0 = 0.f, l1 = 0.f;
    int cur = 0;
#define ATT_LOOP(FASTP) do { \
    while (t < ntile) { \
        int tn = t + 1; while (tn < ntile && (tn & 3) == 0 && !ATT_NEEDED(tn)) tn += 4; \
        if (tn < ntile) { ATT_LOADK(tn, cur ^ 1); ATT_LOADV(tn); }    \
        const int nblk = t >> 2; \
        bool a0 = (t <= tl0), a1 = (t <= tl1); \
        bool bl0 = false, bl1 = false; \
        if (MOBA) { \
            bl0 = (nblk != ob0) && !((mk0 >> nblk) & 1u); bl1 = (nblk != ob1) && !((mk1 >> nblk) & 1u); \
            a0 = a0 && __any(!bl0); a1 = a1 && __any(!bl1); \
        } \
        if (a0 || a1) { \
            const LAS unsigned char* kb = lds + (cur ? L::K1 : L::K0) + krd_lane; const LAS unsigned char* vb = lds + (cur ? L::V1 : L::V0) + vrd_lane; \
            asm volatile("" : "+v"(kb), "+v"(vb)); \
_Pragma("unroll") \
            for (int kt = 0; kt < 2; ++kt) { \
                f32x16 s0, s1; \
_Pragma("unroll") \
                for (int r = 0; r < 16; ++r) { s0[r] = 0.f; s1[r] = 0.f; } \
_Pragma("unroll") \
                for (int ks = 0; ks < NKS; ++ks) { \
                    const bf16x8 kf = *(const LAS bf16x8*)(kb + (2 * ks * 1024 + 32 * kt * 16)); \
                    if (a0) s0 = __builtin_amdgcn_mfma_f32_32x32x16_bf16(kf, qf0[ks], s0, 0, 0, 0); \
                    if (a1) s1 = __builtin_amdgcn_mfma_f32_32x32x16_bf16(kf, qf1[ks], s1, 0, 0, 0); \
                } \
                bf16x8 p0[2], p1[2]; \
                const int kbase = 64 * t + 32 * kt + 4 * hi; \
                if (a0) { if (FASTP) softmax_fast(s0, l0, p0, t == tl0, bl0, qi0, kbase); else softmax_group(s0, o0, m0, l0, p0, t == tl0, bl0, qi0, kbase); } \
                __builtin_amdgcn_sched_barrier(0);    \
                if (a1) { if (FASTP) softmax_fast(s1, l1, p1, t == tl1, bl1, qi1, kbase); else softmax_group(s1, o1, m1, l1, p1, t == tl1, bl1, qi1, kbase); } \
                __builtin_amdgcn_sched_barrier(0); \
_Pragma("unroll") \
                for (int st = 0; st < 2; ++st) \
_Pragma("unroll") \
                    for (int dt = 0; dt < 2; ++dt) { \
                        typedef unsigned u32x2v __attribute__((ext_vector_type(2))); \
                        const LAS unsigned char* vp_ = vb + (32 * dt * L::VP + 32 * kt + 16 * st) * 2; \
                        const u32x2v va = *(const LAS u32x2v*)vp_, vc = *(const LAS u32x2v*)(vp_ + 16); \
                        const v4u vv = {va.x, va.y, vc.x, vc.y}; const bf16x8 vf = __builtin_bit_cast(bf16x8, vv); \
                        if (a0) o0[dt] = __builtin_amdgcn_mfma_f32_32x32x16_bf16(vf, p0[st], o0[dt], 0, 0, 0); \
                        if (a1) o1[dt] = __builtin_amdgcn_mfma_f32_32x32x16_bf16(vf, p1[st], o1[dt], 0, 0, 0); \
                    } \
            } \
        } \
        if (tn < ntile) ATT_STOREV(cur ^ 1); \
        asm volatile("s_waitcnt vmcnt(0)" ::: "memory"); \
        __syncthreads(); \
        t = tn; cur ^= 1; \
    } \
    } while (0)
    if (fast) ATT_LOOP(true); else ATT_LOOP(false);
#undef ATT_LOOP
#undef ATT_NEEDED
#undef ATT_LOADK
#undef ATT_LOADV
#undef ATT_STOREV
    {
        typedef unsigned u32x2v __attribute__((ext_vector_type(2)));
        const float i0 = 1.0f / half_sum(l0), i1 = 1.0f / half_sum(l1);
        bf16* d0 = O + (tokbase + qi0) * op + h * 64 + 4 * hi; bf16* d1 = O + (tokbase + qi1) * op + h * 64 + 4 * hi;
#pragma unroll
        for (int dt = 0; dt < 2; ++dt)
#pragma unroll
            for (int j = 0; j < 4; ++j) {
                u32x2v wa; wa.x = pkbf(o0[dt][4 * j] * i0, o0[dt][4 * j + 1] * i0); wa.y = pkbf(o0[dt][4 * j + 2] * i0, o0[dt][4 * j + 3] * i0); *(u32x2v*)(d0 + 32 * dt + 8 * j) = wa;
                u32x2v wb; wb.x = pkbf(o1[dt][4 * j] * i1, o1[dt][4 * j + 1] * i1); wb.y = pkbf(o1[dt][4 * j + 2] * i1, o1[dt][4 * j + 3] * i1); *(u32x2v*)(d1 + 32 * dt + 8 * j) = wb;
            }
    }
}
struct Args { const void* in[31]; float* out; unsigned char* ws; int ph_lo, ph_hi; };
constexpr int N_PHASES = 1 + 8 + 11 + 8 + 11;
typedef const __attribute__((address_space(4))) Args* KArgs;
__device__ __forceinline__ KArgs kargs() { KArgs p = (KArgs)__builtin_amdgcn_kernarg_segment_ptr(); asm volatile("" : "+s"(p)); return p; }
#define IN_F(i) ((const float*)A->in[i])
#define WSP(type, off) ((type*)(ws + (off)))
#ifndef TPROBE
#define TPROBE 0
#endif
#define TP_BID 203
#define TP_ACC(lds) ((LAS unsigned long long*)((lds) + MISC_OFF + 64))
#define TP_BEGIN(id) unsigned long long tp0_##id = 0ull; if (TPROBE == (id)) { __syncthreads(); tp0_##id = __builtin_amdgcn_s_memrealtime(); }
#define TP_END(id, lds) if (TPROBE == (id)) { __syncthreads(); if (blockIdx.x == TP_BID && threadIdx.x == 0) *TP_ACC(lds) += __builtin_amdgcn_s_memrealtime() - tp0_##id; }
struct Ctx { int tid, lane, wave, G, bid, gw, NGW, gt, NGT; };
__device__ __forceinline__ Ctx mkctx(int wv) {
    Ctx c; unsigned m = ~0u; asm volatile("" : "+s"(m)); const int ln = (int)__builtin_amdgcn_mbcnt_hi(m, __builtin_amdgcn_mbcnt_lo(m, 0u));
    int b = blockIdx.x; asm volatile("" : "+s"(b)); int w = wv; asm volatile("" : "+s"(w));
    c.tid = w * 64 + ln; c.lane = ln; c.wave = w; c.G = gridDim.x; c.bid = b;
    c.gw = c.bid * NWAVES + c.wave; c.NGW = c.G * NWAVES; c.gt = c.bid * NTHR + c.tid; c.NGT = c.G * NTHR; return c; }

__device__ __forceinline__ void conv_mixer_weights(int wv, LAS unsigned char* lds, int l) {
    const Ctx c = mkctx(wv);
    KArgs A = kargs(); unsigned char* ws = A->ws;
    const int lane = c.lane, gw = c.gw, NGW = c.NGW, gt = c.gt, NGT = c.NGT;
    LAS float* scr = (LAS float*)(lds + RING_OFF + c.wave * 16384); LAS TrDesc* tab = (LAS TrDesc*)(lds + RING_OFF + TR_TAB_OFF); asm volatile("" : "+v"(tab));
    bf16* WINR = WSP(bf16, W_INR); bf16* WUQ = WSP(bf16, W_UQ); bf16* WUKV = WSP(bf16, W_UKV);
    int total = 0;
    if (c.tid == 0) {
        int n = 0, cum = 0;
        const float* an = IN_F(2) + l * DM; const float* win = IN_F(4) + (size_t)l * DM * IN_COLS;
        tr_add(tab, n, cum, win, IN_COLS, DM, 4096, 0, WSP(bf16, W_G), DM, 0, 3, an);
        tr_add(tab, n, cum, win, IN_COLS, DM, 1280, 4096, WINR, DM, 0, 0, an);
        tr_add(tab, n, cum, win, IN_COLS, DM, 512, 5728, WINR, DM, 1280, 0, an);
        tr_add(tab, n, cum, win, IN_COLS, DM, 352, 5376, WINR, DM, 1792, 0, an);
        tr_add(tab, n, cum, IN_F(13) + (size_t)l * 192 * 384, 384, 192, 384, 0, WUQ, 256, 0, 0, IN_F(11) + l * 192);
        tr_add(tab, n, cum, IN_F(14) + (size_t)l * 128 * 512, 512, 128, 512, 0, WUKV, 256, 0, 2, IN_F(12) + l * 128);
        for (int nb = 0; nb < 4; ++nb) tr_add(tab, n, cum, IN_F(21) + ((size_t)l * 4 + nb) * 256 * DM, DM, 256, DM, 0, WSP(bf16, W_B), 256, nb * 1024, 0, nullptr);
        tr_add(tab, n, cum, IN_F(22) + (size_t)l * DM * DM, DM, DM, DM, 0, WSP(bf16, W_OUT), DM, 0, 0, nullptr);
        tab[n].cum = cum; tab[31].cum = cum;
    }
    __syncthreads();
    total = tab[31].cum;
    tr_run(tab, total, scr, lane, gw, NGW);
    unsigned zz = 0u; asm volatile("" : "+v"(zz)); const v4u z4 = {zz, zz, zz, zz};
    for (int i = gt; i < 160 * DM / 8; i += NGT) ((v4u*)(WINR + (size_t)2144 * DM))[i] = z4;
    for (int i = gt; i < 128 * 256 / 8; i += NGT) ((v4u*)(WUQ + (size_t)384 * 256))[i] = z4;
    for (int i = gt; i < 384 * 8; i += NGT) ((v4u*)(WUQ + (size_t)(i >> 3) * 256 + 192))[i & 7] = z4;
    for (int i = gt; i < 512 * 16; i += NGT) ((v4u*)(WUKV + (size_t)(i >> 4) * 256 + 128))[i & 15] = z4;
    {
        const float* wsrc = IN_F(7) + (size_t)l * 4 * 128 * 128; bf16* wm = WSP(bf16, MS_WSGU);
        for (int i = gt; i < 4 * 128 * 128 / 8; i += NGT) {
            const int t = (i >> 4) & 127, s0 = (i & 15) * 8; const f32x4 a = *(const f32x4*)(wsrc + (size_t)i * 8), b = *(const f32x4*)(wsrc + (size_t)i * 8 + 4);
            float f[8] = {a[0], a[1], a[2], a[3], b[0], b[1], b[2], b[3]};
#pragma unroll
            for (int j = 0; j < 8; ++j) f[j] = (s0 + j <= t) ? f[j] : 0.f;
            *(v4u*)(wm + (size_t)i * 8) = pack8(f);
        }
    }
    __syncthreads();
}
__device__ __forceinline__ void conv_ffn_weights(int wv, LAS unsigned char* lds, int l) {
    const Ctx c = mkctx(wv);
    KArgs A = kargs(); unsigned char* ws = A->ws;
    LAS float* scr = (LAS float*)(lds + RING_OFF + c.wave * 16384); LAS TrDesc* tab = (LAS TrDesc*)(lds + RING_OFF + TR_TAB_OFF); asm volatile("" : "+v"(tab));
    if (c.tid == 0) {
        int n = 0, cum = 0; const bool moe = (l & 1) != 0; const int li = l >> 1; const float* fn = IN_F(3) + l * DM;
        if (!moe) {
            tr_add(tab, n, cum, IN_F(23) + (size_t)li * DM * FFN, FFN, DM, FFN, 0, WSP(bf16, W_F1), DM, 0, 1, fn);
            tr_add(tab, n, cum, IN_F(24) + (size_t)li * DM * FFN, FFN, DM, FFN, 0, WSP(bf16, W_F1), DM, 128, 1, fn);
            tr_add(tab, n, cum, IN_F(25) + (size_t)li * FFN * DM, DM, FFN, DM, 0, WSP(bf16, W_F2), FFN, 0, 0, nullptr);
        } else {
            for (int e = 0; e < NE; ++e) {
                tr_add(tab, n, cum, IN_F(28) + ((size_t)li * NE + e) * DM * EDIM, EDIM, DM, EDIM, 0, WSP(bf16, W_F1), DM, e * 2 * EDIM, 1, fn);
                tr_add(tab, n, cum, IN_F(29) + ((size_t)li * NE + e) * DM * EDIM, EDIM, DM, EDIM, 0, WSP(bf16, W_F1), DM, e * 2 * EDIM + 128, 1, fn);
                tr_add(tab, n, cum, IN_F(30) + ((size_t)li * NE + e) * EDIM * DM, DM, EDIM, DM, 0, WSP(bf16, W_F2), EDIM, e * DM, 0, nullptr);
            }
        }
        tab[n].cum = cum; tab[31].cum = cum;
    }
    __syncthreads();
    tr_run(tab, tab[31].cum, scr, c.lane, c.gw, c.NGW);
    __syncthreads();
}
__device__ __forceinline__ void ph_prologue(int wv, LAS unsigned char* lds) {
    conv_mixer_weights(wv, lds, 0);
    const Ctx c = mkctx(wv);
    KArgs A = kargs(); unsigned char* ws = A->ws;
    const int lane = c.lane, gw = c.gw, NGW = c.NGW, gt = c.gt, NGT = c.NGT;
    {
        const float* x_in = IN_F(0); const int* positions = (const int*)A->in[1];
        bf16* XB = WSP(bf16, WS_XB); float* SSA = WSP(float, WS_SSA); float* ROPE = WSP(float, WS_ROPE);
        for (int mrow = gw; mrow < T; mrow += NGW) {
            const f32x4* xr = (const f32x4*)(x_in + (size_t)mrow * DM) + lane; float s = 0.f;
            typedef unsigned u32x2v __attribute__((ext_vector_type(2)));
            u32x2v* o8 = (u32x2v*)(XB + (size_t)mrow * DM) + lane;
#pragma unroll
            for (int j = 0; j < 4; ++j) { const f32x4 v = xr[64 * j]; s += (v[0] * v[0] + v[1] * v[1]) + (v[2] * v[2] + v[3] * v[3]); u32x2v w; w.x = pkbf(v[0], v[1]); w.y = pkbf(v[2], v[3]); o8[64 * j] = w; }
            s = wave_sum(s);
            if (lane < 4) SSA[(size_t)mrow * 4 + lane] = (lane == 0) ? s : 0.f;
        }
        for (int i = gt; i < T * 24; i += NGT) {
            const int tok = i / 24, a = i - tok * 24;
            const float inv = (a < 8) ? powf(500000.0f, -(float)a * 0.125f) : powf(500000.0f, -(float)(a - 8) * 0.0625f);
            const float ang = (float)positions[tok] * inv; float sn, cs; sincosf(ang, &sn, &cs);
            ROPE[(size_t)tok * 48 + 2 * a] = cs; ROPE[(size_t)tok * 48 + 2 * a + 1] = sn;
        }
    }
}
__device__ __forceinline__ void ph_inproj(int wv, LAS unsigned char* lds) {
    const Ctx c = mkctx(wv);
    KArgs A = kargs(); unsigned char* ws = A->ws;
    pg8::Gemm g{WSP(bf16, WS_XB), WSP(bf16, W_INR), DM, DM, DM}; pg8::StaticOrder S; S.init(T, PJ_LD, c.G, c.bid);
    pg8::EpiScale<0> E{WSP(bf16, B_PROJ), PJ_LD, pg8::RowScale{WSP(float, WS_SSA), 1}, WSP(float, WS_SSC)};
    pg8::gemm_phase<pg8::EpiScale<0>, pg8::StaticOrder, true, true>(lds + RING_OFF, g, S, E, c.tid);
}
__device__ __forceinline__ void mla_up_gemms(int wv, LAS unsigned char* lds, int l) {
    const Ctx c = mkctx(wv);
    { KArgs A = kargs(); unsigned char* ws = A->ws;
      pg8::Gemm g{WSP(bf16, B_PROJ) + PJ_CQ, WSP(bf16, W_UQ), PJ_LD, 256, 256}; pg8::StaticOrder S; S.init(T, 512, c.G, c.bid);
      pg8::EpiScale<0> E{WSP(bf16, B_QPRE), 512, pg8::RowScale{WSP(float, WS_SSC), 3}, nullptr};
      pg8::gemm_phase<pg8::EpiScale<0>, pg8::StaticOrder, true, true>(lds + RING_OFF, g, S, E, c.tid); }
    { KArgs A = kargs(); unsigned char* ws = A->ws;
      pg8::Gemm g{WSP(bf16, B_PROJ) + PJ_CKV, WSP(bf16, W_UKV), PJ_LD, 256, 256}; pg8::StaticOrder S; S.init(T, 512, c.G, c.bid);
      pg8::EpiKV E{WSP(bf16, B_CK), WSP(bf16, B_KVPRE), WSP(bf16, B_PROJ), WSP(float, WS_SSC), WSP(float, WS_ROPE), IN_F(16) + l * 96, (unsigned*)(ws + WS_CTL) + CW_KMX + (l * 2 + 1) * 32};
      pg8::gemm_phase<pg8::EpiKV, pg8::StaticOrder, true, true>(lds + RING_OFF, g, S, E, c.tid); }
}
__device__ __forceinline__ void ph_prep(int wv, LAS unsigned char* lds, int l) {
    TP_BEGIN(4) mla_up_gemms(wv, lds, l); TP_END(4, lds)
    {
        const Ctx c = mkctx(wv);
        KArgs A = kargs(); unsigned char* ws = A->ws;
        bf16* PROJ = WSP(bf16, B_PROJ); bf16* OB = WSP(bf16, B_O);
        TP_BEGIN(5) for (int it = c.bid; it < NB * 32; it += c.G) prep_block(lds + RING_OFF, PROJ, WSP(float, WS_ROPE), IN_F(9) + l * 64, IN_F(10) + l * 64, WSP(float, MS_KMEAN), (unsigned*)(ws + WS_CTL) + CW_KMX + (l * 2 + 0) * 32, it, c.tid); TP_END(5, lds)
        TP_BEGIN(6) for (int u = c.bid; u < T / 128; u += c.G) sgu_unit(lds + RING_OFF, PROJ, OB, IN_F(5) + l * 256, IN_F(6) + l * 256, WSP(bf16, MS_WSGU), IN_F(8) + l * 4 * 128, u, c.tid); TP_END(6, lds)
        TP_BEGIN(7) for (int u = c.bid; u < T / 64; u += c.G) conv_unit(lds + RING_OFF, PROJ, OB, IN_F(17) + (size_t)l * 31 * 256, IN_F(18) + l * 256, IN_F(19) + l * 256, IN_F(20) + l * 256, u, c.tid); TP_END(7, lds)
        __syncthreads();
    }
    TP_BEGIN(8) conv_ffn_weights(wv, lds, l); TP_END(8, lds)
}
template <int WHICH>
__device__ __forceinline__ void mla_post_pass(const Ctx& c, int l) {
    KArgs A = kargs(); unsigned char* ws = A->ws;
    const float* gn = IN_F(WHICH ? 16 : 15) + l * 96;
    const bf16* PROJ = WSP(bf16, B_PROJ); const bf16* QPRE = WSP(bf16, B_QPRE); const bf16* KVPRE = WSP(bf16, B_KVPRE);
    bf16* DST = WHICH ? WSP(bf16, B_CK) : WSP(bf16, B_CQ); const float* ROPE = WSP(float, WS_ROPE);
    for (int idx = c.gt; idx < T * 4; idx += c.NGT) {
        const int tok = idx >> 2, h = idx & 3; const float* tab = ROPE + (size_t)tok * 48 + 16;
        float v[96]; float ss = 0.f;
        if (WHICH == 0) {
#pragma unroll
            for (int cc = 0; cc < 12; ++cc) unpack8(((const v4u*)(QPRE + (size_t)tok * 512 + h * 96))[cc], v + 8 * cc);
        } else {
#pragma unroll
            for (int cc = 0; cc < 8; ++cc) unpack8(((const v4u*)(KVPRE + (size_t)tok * 512 + h * 128))[cc], v + 8 * cc);
#pragma unroll
            for (int cc = 0; cc < 4; ++cc) unpack8(((const v4u*)(PROJ + (size_t)tok * PJ_LD + PJ_KR))[cc], v + 64 + 8 * cc);
        }
#pragma unroll
        for (int d = 0; d < 96; ++d) ss += v[d] * v[d];
        const float rstd = rsqrtf(ss * (1.0f / 96.0f) + EPS);
#pragma unroll
        for (int d = 0; d < 96; ++d) v[d] = v[d] * rstd * gn[d];
#pragma unroll
        for (int i = 0; i < 16; ++i) { const float cs = tab[2 * i], sn = tab[2 * i + 1], x1 = v[64 + i], x2 = v[80 + i]; v[64 + i] = x1 * cs - x2 * sn; v[80 + i] = x2 * cs + x1 * sn; }
        if (WHICH == 0) {
#pragma unroll
            for (int d = 0; d < 96; ++d) v[d] *= QS_C;
        }
        bf16* dst = DST + (size_t)tok * 384 + h * 96;
#pragma unroll
        for (int cc = 0; cc < 12; ++cc) ((v4u*)dst)[cc] = pack8(v + 8 * cc);
    }
}
__device__ __forceinline__ void ph_mla_post(int wv, int l) {
    { const Ctx c = mkctx(wv); mla_post_pass<0>(c, l); }
    { const Ctx c = mkctx(wv); mla_post_pass<1>(c, l); }
}
__device__ __forceinline__ void ph_attn(int wv, LAS unsigned char* lds, int l) {
    const Ctx c = mkctx(wv);
    for (int u = c.bid; u < NB * 4 * 8; u += c.G) {
        const int qc = u & 7, h = (u >> 3) & 3, b = u >> 5;
        TP_BEGIN(1) { KArgs A = kargs(); unsigned char* ws = A->ws;
          attn_unit<96, false, true, 512, 96, 384, 96, 256, 64, DM>(lds + RING_OFF, WSP(bf16, B_QPRE), WSP(bf16, B_CK), WSP(bf16, B_KVPRE), WSP(bf16, B_O) + 512, b, h, qc, nullptr, IN_F(15) + l * 96, WSP(float, WS_ROPE), (const unsigned*)(ws + WS_CTL) + CW_KMX + (l * 2 + 1) * 32, c.tid); } TP_END(1, lds)
        TP_BEGIN(2) { KArgs A = kargs(); unsigned char* ws = A->ws; bf16* PROJ = WSP(bf16, B_PROJ);
          attn_unit<64, true, false, PJ_LD, 64, PJ_LD, 64, PJ_LD, 64, DM>(lds + RING_OFF, PROJ + PJ_BQ, PROJ + PJ_BK, PROJ + PJ_BV, WSP(bf16, B_O) + 256, b, h, 7 - qc, WSP(float, MS_KMEAN), nullptr, nullptr, (const unsigned*)(ws + WS_CTL) + CW_KMX + (l * 2 + 0) * 32, c.tid); } TP_END(2, lds)
    }
}
__device__ __forceinline__ void ph_gates(int wv, LAS unsigned char* lds) {
    const Ctx c = mkctx(wv);
    KArgs A = kargs(); unsigned char* ws = A->ws;
    pg8::Gemm g{WSP(bf16, WS_XB), WSP(bf16, W_G), DM, DM, DM}; pg8::StaticOrder S; S.init(T, 4096, c.G, c.bid);
    pg8::EpiGates E{WSP(bf16, B_SG), pg8::RowScale{WSP(float, WS_SSA), 1}};
    pg8::gemm_phase<pg8::EpiGates, pg8::StaticOrder, true, true>(lds + RING_OFF, g, S, E, c.tid);
}
__device__ __forceinline__ void ph_merge(int wv, LAS unsigned char* lds) {
    const Ctx c = mkctx(wv);
    KArgs A = kargs(); unsigned char* ws = A->ws;
    pg8::Gemm g{WSP(bf16, B_O), WSP(bf16, W_B), DM, 256, 256}; pg8::MergeOrder S; S.so.init(T, DM, c.G, c.bid);
    pg8::EpiMerge E{WSP(bf16, B_SG), WSP(bf16, B_Y)};
    pg8::gemm_phase<pg8::EpiMerge, pg8::MergeOrder, true, true>(lds + RING_OFF, g, S, E, c.tid);
}
__device__ __forceinline__ void ph_wout(int wv, LAS unsigned char* lds, int l) {
    const Ctx c = mkctx(wv);
    KArgs A = kargs(); unsigned char* ws = A->ws;
    pg8::Gemm g{WSP(bf16, B_Y), WSP(bf16, W_OUT), DM, DM, DM}; pg8::StaticOrder S; S.init(T, DM, c.G, c.bid);
    pg8::EpiResidual E{WSP(bf16, WS_XB), WSP(float, WS_SSB), (LAS float*)(lds + EPI_RED_OFF)};
    pg8::gemm_phase<pg8::EpiResidual, pg8::StaticOrder, true, true>(lds + RING_OFF, g, S, E, c.tid);
}
__device__ __forceinline__ void ph_ffn_up(int wv, LAS unsigned char* lds) {
    const Ctx c = mkctx(wv);
    KArgs A = kargs(); unsigned char* ws = A->ws;
    pg8::Gemm g{WSP(bf16, WS_XB), WSP(bf16, W_F1), DM, DM, DM}; pg8::StaticOrder S; S.init(T, 2 * FFN, c.G, c.bid);
    pg8::EpiScale<2> E{WSP(bf16, B_HID), FFN, pg8::RowScale{WSP(float, WS_SSB), 1}, nullptr};
    pg8::gemm_phase<pg8::EpiScale<2>, pg8::StaticOrder, true, true>(lds + RING_OFF, g, S, E, c.tid);
}
__device__ __forceinline__ void ph_ffn_down(int wv, LAS unsigned char* lds, int l) {
    const Ctx c = mkctx(wv);
    KArgs A = kargs(); unsigned char* ws = A->ws;
    pg8::Gemm g{WSP(bf16, B_HID), WSP(bf16, W_F2), FFN, FFN, FFN}; pg8::StaticOrder S; S.init(T, DM, c.G, c.bid);
    pg8::EpiResidual E{WSP(bf16, WS_XB), WSP(float, WS_SSA), (LAS float*)(lds + EPI_RED_OFF)};
    pg8::gemm_phase<pg8::EpiResidual, pg8::StaticOrder, true, true>(lds + RING_OFF, g, S, E, c.tid);
    TP_BEGIN(9) if (l < DEPTH - 1) conv_mixer_weights(wv, lds, l + 1); TP_END(9, lds)
}
__device__ __forceinline__ int wave_sum_i(int v) {
    v += __builtin_amdgcn_ds_swizzle(v, (1 << 10) | 0x1f); v += __builtin_amdgcn_ds_swizzle(v, (2 << 10) | 0x1f); v += __builtin_amdgcn_ds_swizzle(v, (4 << 10) | 0x1f);
    v += __builtin_amdgcn_ds_swizzle(v, (8 << 10) | 0x1f); v += __builtin_amdgcn_ds_swizzle(v, (16 << 10) | 0x1f);
    auto rr = __builtin_amdgcn_permlane32_swap((unsigned)v, (unsigned)v, false, false); return (int)rr[0] + (int)rr[1];
}
__device__ __forceinline__ void ph_router(int wv, LAS unsigned char* lds, int l) {
    const Ctx c = mkctx(wv);
    KArgs A = kargs(); unsigned char* ws = A->ws; const int li = l >> 1; const int lane = c.lane;
    const float* fn = IN_F(3) + l * DM; const float* wr_ = IN_F(26) + (size_t)li * DM * NE; const float* rb = IN_F(27) + li * NE;
    const bf16* XBr = WSP(bf16, WS_XB); const float* SSB = WSP(float, WS_SSB); int* TOKE = WSP(int, MS_TOKE); float* TOKW = WSP(float, MS_TOKW);
    int* WCNT = WSP(int, MS_WCNT); int* WGCNT = WSP(int, MS_WGCNT);
    int cnt[8];
#pragma unroll
    for (int e = 0; e < 8; ++e) cnt[e] = 0;
    float wq[16][8];
#pragma unroll
    for (int j = 0; j < 4; ++j) { const int k0 = (64 * j + lane) * 4; const f32x4 gv = *(const f32x4*)(fn + k0);
#pragma unroll
        for (int q = 0; q < 4; ++q) { const f32x4 w0 = *(const f32x4*)(wr_ + (size_t)(k0 + q) * 8), w1 = *(const f32x4*)(wr_ + (size_t)(k0 + q) * 8 + 4);
#pragma unroll
            for (int e = 0; e < 4; ++e) { wq[4 * j + q][e] = gv[q] * w0[e]; wq[4 * j + q][4 + e] = gv[q] * w1[e]; } } }
    float rbv[8];
#pragma unroll
    for (int e = 0; e < 8; ++e) rbv[e] = rb[e];
    for (int tok0 = c.gw; tok0 < T; tok0 += 2 * c.NGW) {
        typedef unsigned u32x2v __attribute__((ext_vector_type(2)));
        f32x4 sp[2]; u32x2v xv[2][4]; bool ok[2];
#pragma unroll
        for (int u = 0; u < 2; ++u) { const int tok = tok0 + u * c.NGW; ok[u] = tok < T; const int tk = ok[u] ? tok : tok0;
            sp[u] = *(const f32x4*)(SSB + (size_t)tk * 4);
#pragma unroll
            for (int j = 0; j < 4; ++j) xv[u][j] = *(const u32x2v*)(XBr + (size_t)tk * DM + (64 * j + lane) * 4); }
        float pl[2][8];
#pragma unroll
        for (int u = 0; u < 2; ++u) { const float rstd = rsqrtf(((sp[u][0] + sp[u][1]) + (sp[u][2] + sp[u][3])) * (1.0f / 1024.0f) + EPS);
#pragma unroll
            for (int e = 0; e < 8; ++e) pl[u][e] = 0.f;
#pragma unroll
            for (int j = 0; j < 4; ++j)
#pragma unroll
                for (int q = 0; q < 4; ++q) { const unsigned xw = (q < 2) ? xv[u][j].x : xv[u][j].y; const float hv = ((q & 1) ? bfhi(xw) : bflo(xw)) * rstd;
#pragma unroll
                    for (int e = 0; e < 8; ++e) pl[u][e] += hv * wq[4 * j + q][e]; } }
#pragma unroll
        for (int e = 0; e < 8; ++e) { pl[0][e] = wave_sum(pl[0][e]) + rbv[e]; pl[1][e] = wave_sum(pl[1][e]) + rbv[e]; }
#pragma unroll
        for (int u = 0; u < 2; ++u) {
            int e0 = 0; float l0 = pl[u][0];
#pragma unroll
            for (int e = 1; e < 8; ++e) if (pl[u][e] > l0) { l0 = pl[u][e]; e0 = e; }
            int e1 = -1; float l1 = -INFINITY;
#pragma unroll
            for (int e = 0; e < 8; ++e) if (e != e0 && pl[u][e] > l1) { l1 = pl[u][e]; e1 = e; }
            const float tt = expf(l1 - l0); const float w0 = 1.0f / (1.0f + tt), w1 = tt / (1.0f + tt);
            if (ok[u]) {
#pragma unroll
                for (int e = 0; e < 8; ++e) cnt[e] += (e == e0 ? 1 : 0) + (e == e1 ? 1 : 0);
                const int tok = tok0 + u * c.NGW;
                if (lane == 0) { TOKE[tok * 2] = e0; TOKE[tok * 2 + 1] = e1; TOKW[tok * 2] = w0; TOKW[tok * 2 + 1] = w1; }
            }
        }
    }
    LAS int* red = (LAS int*)(lds + RING_OFF);
    int mine = 0;
#pragma unroll
    for (int e = 0; e < 8; ++e) mine = (lane == e) ? cnt[e] : mine;
    if (lane < 8) { WCNT[c.gw * 8 + lane] = mine; red[c.wave * 8 + lane] = mine; }
    __syncthreads();
    if (c.tid < 8) { int s = 0;
#pragma unroll
        for (int w = 0; w < NWAVES; ++w) s += red[w * 8 + c.tid];
        WGCNT[c.bid * 8 + c.tid] = s; }
    __syncthreads();
}
__device__ __forceinline__ void ph_assign(int wv, LAS unsigned char* lds, int l) {
    const Ctx c = mkctx(wv);
    KArgs A = kargs(); unsigned char* ws = A->ws; const int lane = c.lane;
    const float* SSB = WSP(float, WS_SSB); const int* TOKE = WSP(int, MS_TOKE); int* TOKS = WSP(int, MS_TOKS); float* RSSLOT = WSP(float, MS_RSSLOT);
    const int* WCNT = WSP(int, MS_WCNT); const int* WGCNT = WSP(int, MS_WGCNT); int* MTOT = WSP(int, MS_MTOT);
    const bf16* XB = WSP(bf16, WS_XB); bf16* XS = WSP(bf16, B_XS);
    int tot[8], bas[8];
#pragma unroll
    for (int e = 0; e < 8; ++e) { tot[e] = 0; bas[e] = 0; }
    for (int t = c.tid; t < c.G; t += NTHR) {
        typedef int i32x4 __attribute__((ext_vector_type(4)));
        const i32x4 a = *(const i32x4*)(WGCNT + t * 8), b = *(const i32x4*)(WGCNT + t * 8 + 4); const int lt = (t < c.bid) ? 1 : 0;
        tot[0] += a[0]; tot[1] += a[1]; tot[2] += a[2]; tot[3] += a[3]; tot[4] += b[0]; tot[5] += b[1]; tot[6] += b[2]; tot[7] += b[3];
        bas[0] += lt * a[0]; bas[1] += lt * a[1]; bas[2] += lt * a[2]; bas[3] += lt * a[3]; bas[4] += lt * b[0]; bas[5] += lt * b[1]; bas[6] += lt * b[2]; bas[7] += lt * b[3];
    }
    LAS int* red = (LAS int*)(lds + RING_OFF);
#pragma unroll
    for (int e = 0; e < 8; ++e) { tot[e] = wave_sum_i(tot[e]); bas[e] = wave_sum_i(bas[e]); }
    if (lane == 0) {
#pragma unroll
        for (int e = 0; e < 8; ++e) { red[c.wave * 16 + e] = tot[e]; red[c.wave * 16 + 8 + e] = bas[e]; } }
    __syncthreads();
#pragma unroll
    for (int e = 0; e < 8; ++e) { int st = 0, sb = 0;
#pragma unroll
        for (int w = 0; w < NWAVES; ++w) { st += red[w * 16 + e]; sb += red[w * 16 + 8 + e]; }
        tot[e] = st; bas[e] = sb; }
    int run[8]; { int acc = 0;
#pragma unroll
        for (int e = 0; e < 8; ++e) { run[e] = acc * 256 + bas[e]; acc += (tot[e] + 255) >> 8; } }
    if (c.bid == 0 && c.tid < 8) { int v = 0;
#pragma unroll
        for (int e = 0; e < 8; ++e) v = (c.tid == e) ? tot[e] : v;
        MTOT[c.tid] = v; }
    for (int w = 0; w < c.wave; ++w) {
        typedef int i32x4 __attribute__((ext_vector_type(4)));
        const i32x4 a = *(const i32x4*)(WCNT + (c.bid * NWAVES + w) * 8), b = *(const i32x4*)(WCNT + (c.bid * NWAVES + w) * 8 + 4);
        run[0] += a[0]; run[1] += a[1]; run[2] += a[2]; run[3] += a[3]; run[4] += b[0]; run[5] += b[1]; run[6] += b[2]; run[7] += b[3];
    }
    for (int tok0 = c.gw; tok0 < T; tok0 += 4 * c.NGW) {
        f32x4 sp[4]; int ee[4][2]; v4u ra[4], rb2[4]; bool ok[4];
#pragma unroll
        for (int u = 0; u < 4; ++u) { const int tok = tok0 + u * c.NGW; ok[u] = tok < T; const int tk = ok[u] ? tok : tok0;
            sp[u] = *(const f32x4*)(SSB + (size_t)tk * 4); ee[u][0] = TOKE[tk * 2]; ee[u][1] = TOKE[tk * 2 + 1];
            const v4u* src = (const v4u*)(XB + (size_t)tk * DM) + lane; ra[u] = src[0]; rb2[u] = src[64]; }
#pragma unroll
        for (int u = 0; u < 4; ++u) if (ok[u]) {
            const int tok = tok0 + u * c.NGW;
            const float rstd = rsqrtf(((sp[u][0] + sp[u][1]) + (sp[u][2] + sp[u][3])) * (1.0f / 1024.0f) + EPS);
            int s0 = 0, s1 = 0;
#pragma unroll
            for (int e = 0; e < 8; ++e) { if (e == ee[u][0]) { s0 = run[e]; run[e] += 1; } }
#pragma unroll
            for (int e = 0; e < 8; ++e) { if (e == ee[u][1]) { s1 = run[e]; run[e] += 1; } }
            if (lane == 0) { TOKS[tok * 2] = s0; TOKS[tok * 2 + 1] = s1; RSSLOT[s0] = rstd; RSSLOT[s1] = rstd; }
            v4u* d0 = (v4u*)(XS + (size_t)s0 * DM) + lane; v4u* d1 = (v4u*)(XS + (size_t)s1 * DM) + lane;
            d0[0] = ra[u]; d0[64] = rb2[u]; d1[0] = ra[u]; d1[64] = rb2[u];
        }
    }
    __syncthreads();
}
__device__ __forceinline__ void moe_panels(const int* mtot, int (&ps)[9]) { int acc = 0;
#pragma unroll
    for (int e = 0; e < 8; ++e) { ps[e] = acc; const int cn = __hip_atomic_load(mtot + e, RLX_AGENT); acc += (cn + 255) >> 8; } ps[8] = acc; }
__device__ __forceinline__ void ph_moe_up(int wv, LAS unsigned char* lds, int l) {
    const Ctx c = mkctx(wv);
    KArgs A = kargs(); unsigned char* ws = A->ws;
    pg8::MoeOrder S; S.nN = 11; moe_panels(WSP(int, MS_MTOT), S.ps);
    S.so.init(S.ps[8] * 256, 2 * EDIM, c.G, c.bid);
    pg8::Gemm g{WSP(bf16, B_XS), WSP(bf16, W_F1), DM, DM, DM};
    pg8::EpiScale<2> E{WSP(bf16, B_HIDM), EDIM, pg8::RowScale{WSP(float, MS_RSSLOT), 2}, nullptr};
    pg8::gemm_phase<pg8::EpiScale<2>, pg8::MoeOrder, true, true>(lds + RING_OFF, g, S, E, c.tid);
}
__device__ __forceinline__ void ph_moe_down(int wv, LAS unsigned char* lds, int l) {
    const Ctx c = mkctx(wv);
    KArgs A = kargs(); unsigned char* ws = A->ws;
    pg8::MoeOrder S; S.nN = 4; moe_panels(WSP(int, MS_MTOT), S.ps);
    S.so.init(S.ps[8] * 256, DM, c.G, c.bid);
    pg8::Gemm g{WSP(bf16, B_HIDM), WSP(bf16, W_F2), EDIM, EDIM, EDIM};
    pg8::EpiScale<0> E{WSP(bf16, B_Y2), DM, pg8::RowScale{nullptr, 0}, nullptr};
    pg8::gemm_phase<pg8::EpiScale<0>, pg8::MoeOrder, true, true>(lds + RING_OFF, g, S, E, c.tid);
}
__device__ __forceinline__ void ph_combine(int wv, LAS unsigned char* lds, int l) {
    const Ctx c = mkctx(wv);
    KArgs A = kargs(); unsigned char* ws = A->ws; const int lane = c.lane;
    float* xout = A->out; const bool fin = (l == DEPTH - 1);
    const int* TOKS = WSP(int, MS_TOKS); const float* TOKW = WSP(float, MS_TOKW); const bf16* Y2 = WSP(bf16, B_Y2); bf16* XB = WSP(bf16, WS_XB); float* SSA = WSP(float, WS_SSA);
    for (int tok0 = c.gw; tok0 < T; tok0 += 2 * c.NGW) {
        typedef unsigned u32x2v __attribute__((ext_vector_type(2)));
        int ss_[2][2]; float ww[2][2]; u32x2v xv[2][4]; bool ok[2];
#pragma unroll
        for (int u = 0; u < 2; ++u) { const int tok = tok0 + u * c.NGW; ok[u] = tok < T; const int tk = ok[u] ? tok : tok0;
            ss_[u][0] = TOKS[tk * 2]; ss_[u][1] = TOKS[tk * 2 + 1]; ww[u][0] = TOKW[tk * 2]; ww[u][1] = TOKW[tk * 2 + 1];
#pragma unroll
            for (int j = 0; j < 4; ++j) xv[u][j] = *((const u32x2v*)(XB + (size_t)tk * DM) + 64 * j + lane); }
        u32x2v ya[2][4], yb[2][4];
#pragma unroll
        for (int u = 0; u < 2; ++u)
#pragma unroll
            for (int j = 0; j < 4; ++j) { ya[u][j] = *((const u32x2v*)(Y2 + (size_t)ss_[u][0] * DM) + 64 * j + lane); yb[u][j] = *((const u32x2v*)(Y2 + (size_t)ss_[u][1] * DM) + 64 * j + lane); }
#pragma unroll
        for (int u = 0; u < 2; ++u) if (ok[u]) {
            const int tok = tok0 + u * c.NGW; const float w0 = ww[u][0], w1 = ww[u][1]; float ss = 0.f;
#pragma unroll
            for (int j = 0; j < 4; ++j) {
                const int c4 = 64 * j + lane; f32x4 x = {bflo(xv[u][j].x), bfhi(xv[u][j].x), bflo(xv[u][j].y), bfhi(xv[u][j].y)}; const u32x2v a = ya[u][j], b = yb[u][j];
                x[0] += w0 * bflo(a.x) + w1 * bflo(b.x); x[1] += w0 * bfhi(a.x) + w1 * bfhi(b.x); x[2] += w0 * bflo(a.y) + w1 * bflo(b.y); x[3] += w0 * bfhi(a.y) + w1 * bfhi(b.y);
                if (fin) *((f32x4*)(xout + (size_t)tok * DM) + c4) = x;
                u32x2v w; w.x = pkbf(x[0], x[1]); w.y = pkbf(x[2], x[3]); *((u32x2v*)(XB + (size_t)tok * DM) + c4) = w;
                ss += (x[0] * x[0] + x[1] * x[1]) + (x[2] * x[2] + x[3] * x[3]);
            }
            ss = wave_sum(ss);
            if (lane < 4) SSA[(size_t)tok * 4 + lane] = (lane == 0) ? ss : 0.f;
        }
    }
    if (l < DEPTH - 1) { __syncthreads(); conv_mixer_weights(wv, lds, l + 1); }
}

__global__ void __launch_bounds__(NTHR, 2) trunk_fwd(Args args) {
    extern __shared__ __attribute__((aligned(16))) unsigned char lds_raw[];
    LAS unsigned char* lds = (LAS unsigned char*)lds_raw;
    const int wv = __builtin_amdgcn_readfirstlane((int)threadIdx.x >> 6);
    for (int u = threadIdx.x; u < (LDS_BYTES - LDSCTL_OFF) / 4; u += NTHR) ((LAS unsigned*)(lds + LDSCTL_OFF))[u] = 0u;
    __syncthreads();
    volatile LAS unsigned* MISC = (volatile LAS unsigned*)(lds + MISC_OFF);
    XcdBarrier bar = xcd_barrier_post((unsigned*)((gu32*)(args.ws + WS_CTL) + CW_BAR), MISC + 8, (int)threadIdx.x);
    const int lo = args.ph_lo, hi = args.ph_hi;
    int pc = 0;
#define PH_BEGIN if (pc >= lo && pc < hi) {
#define PH_END if (pc + 1 < hi) xcd_barrier(bar, mkctx(wv).tid); } ++pc;
    PH_BEGIN ph_prologue(wv, lds); PH_END
    for (int l = 0; l < DEPTH; ++l) {
        PH_BEGIN ph_inproj(wv, lds); PH_END
        PH_BEGIN ph_prep(wv, lds, l); PH_END
        PH_BEGIN ph_attn(wv, lds, l); PH_END
        PH_BEGIN ph_gates(wv, lds); PH_END
        PH_BEGIN ph_merge(wv, lds); PH_END
        PH_BEGIN ph_wout(wv, lds, l); PH_END
        if (!(l & 1)) {
            PH_BEGIN ph_ffn_up(wv, lds); PH_END
            PH_BEGIN ph_ffn_down(wv, lds, l); PH_END
        } else {
            PH_BEGIN ph_router(wv, lds, l); PH_END
            PH_BEGIN ph_assign(wv, lds, l); PH_END
            PH_BEGIN ph_moe_up(wv, lds, l); PH_END
            PH_BEGIN ph_moe_down(wv, lds, l); PH_END
            PH_BEGIN ph_combine(wv, lds, l); PH_END
        }
    }
    if (TPROBE != 0 && blockIdx.x == TP_BID && threadIdx.x == 0) { const unsigned long long tt_ = *TP_ACC(lds), te_ = __builtin_amdgcn_s_memrealtime(); while (__builtin_amdgcn_s_memrealtime() - te_ < 7ull * tt_) __builtin_amdgcn_s_sleep(32); }
#undef PH_BEGIN
#undef PH_END
}

#ifndef MK_MULTI
#define MK_MULTI 0
#endif
extern "C" void kernel_launch(void* const* d_in, const int* in_sizes, int n_in, void* d_out, int out_size, void* d_ws, size_t ws_size, hipStream_t stream) {
    static int grid = 0;
    if (grid == 0) {
        if (n_in != 31 || out_size != T * DM || ws_size < WS_END) { fprintf(stderr, "kernel_launch: unexpected problem: n_in %d out %d ws %zu (need %zu)\n", n_in, out_size, ws_size, (size_t)WS_END); grid = -1; return; }
        int dev = 0, cus = 0;
        if (hipGetDevice(&dev) != hipSuccess || hipDeviceGetAttribute(&cus, hipDeviceAttributeMultiprocessorCount, dev) != hipSuccess) { grid = -1; return; }
        if (hipFuncSetAttribute((const void*)trunk_fwd, hipFuncAttributeMaxDynamicSharedMemorySize, LDS_BYTES) != hipSuccess) { fprintf(stderr, "kernel_launch: hipFuncSetAttribute failed\n"); grid = -1; return; }
        int per_cu = 0;
        if (hipOccupancyMaxActiveBlocksPerMultiprocessor(&per_cu, (const void*)trunk_fwd, NTHR, LDS_BYTES) != hipSuccess || per_cu < 1) fprintf(stderr, "kernel_launch: occupancy query says %d\n", per_cu);
        (void)hipGetLastError();
        grid = cus;
    }
    if (grid < 0) return;
    (void)hipMemsetAsync((char*)d_ws + WS_CTL, 0, CTL_ZERO_BYTES, stream);
    Args a{};
    for (int i = 0; i < 31; ++i) a.in[i] = d_in[i];
    a.out = (float*)d_out; a.ws = (unsigned char*)d_ws;
#if MK_MULTI
    for (int p = 0; p < N_PHASES; ++p) { a.ph_lo = p; a.ph_hi = p + 1; hipLaunchKernelGGL(trunk_fwd, dim3(grid), dim3(NTHR), LDS_BYTES, stream, a); }
#else
    a.ph_lo = 0; a.ph_hi = N_PHASES;
    hipLaunchKernelGGL(trunk_fwd, dim3(grid), dim3(NTHR), LDS_BYTES, stream, a);
#endif
}
```

```cpp
#include <hip/hip_runtime.h>
#include <cstdio>
#include <cstdint>
#include <cmath>
namespace pg8 {
#define PG8_LAS __attribute__((address_space(3)))
typedef unsigned short bf16_t;
typedef short bf16x8 __attribute__((ext_vector_type(8)));
typedef float f32x4 __attribute__((ext_vector_type(4)));
typedef unsigned u32x4 __attribute__((ext_vector_type(4)));
constexpr int BM = 256, BK = 64, HALF = 128, HTB = HALF * BK * 2  , STAGE_BYTES = 8 * HTB, NXCD = 8, WGM = 8;

__host__ __device__ __forceinline__ int lds_byte(int r, int c) { const int st = (r >> 4) * 2 + (c >> 5), rr = r & 15, cc = c & 31, ob = rr * 64 + cc * 2; return st * 1024 + (ob ^ (((ob >> 9) & 1) << 5)); }
__host__ __device__ __forceinline__ void stage_rc(int b, int& R, int& C) { const int st = b / 1024, sb = b % 1024, swz = sb ^ (((sb >> 9) & 1) << 5); R = (st >> 1) * 16 + swz / 64; C = (st & 1) * 32 + (swz % 64) / 2; }
__host__ __device__ __forceinline__ int perm32(int rho) { const int n = rho >> 4, i = rho & 15; return 8 * (i >> 2) + 4 * n + (i & 3); }

struct Unit { int pm, pn, pb, ak; };
struct Gemm { const bf16_t* A; const bf16_t* Bt; int lda, ldb, K; };

struct StaticOrder {
    int nM, nN, nwg, G, c;
    __host__ __device__ void init(int M, int N, int G_, int c_) { nM = M / BM; nN = N / BM; nwg = nM * nN; G = G_; c = c_; }
    __host__ __device__ bool next(int i, Unit& u) const {
        const long L = (long)i * G + c; if (L >= nwg) return false;
        int wgid = (int)L; { const int q = nwg / NXCD, r = nwg % NXCD, xcd = wgid % NXCD, off = wgid / NXCD; wgid = (xcd < r ? xcd * (q + 1) : r * (q + 1) + (xcd - r) * q) + off; }
        const int nig = WGM * nN, gid = wgid / nig, fm = gid * WGM, gsz = (nM - fm) < WGM ? (nM - fm) : WGM;
        u.pm = fm + ((wgid % nig) % gsz); u.pn = (wgid % nig) / gsz; u.pb = u.pn; u.ak = 0; return true;
    }
    __device__ __forceinline__ void a_ready(const Unit&) const {}
    __device__ __forceinline__ void done(const Unit&) const {}
};

template <class Epi, class Sched, bool ALIGN_EPI = false, bool SP2 = false>
__device__ __forceinline__ void gemm_phase(PG8_LAS unsigned char* lds, const Gemm g, const Sched& S, const Epi& E, const int tid) {
    const int wid = __builtin_amdgcn_readfirstlane(tid >> 6), lane = tid & 63, wr = wid >> 2, wc = wid & 3, fr = lane & 15, fq = lane >> 4;
    const int K = g.K, nt = K / BK;
    unsigned voffA[2], voffB[2];
#pragma unroll
    for (int i = 0; i < 2; ++i) { int R, C; stage_rc(tid * 16 + i * 8192, R, C); const int Rb = Epi::PERM ? ((R & ~31) + perm32(R & 31)) : R;
        voffA[i] = (unsigned)(R * g.lda + C) * 2u; voffB[i] = (unsigned)(Rb * g.ldb + C) * 2u; }
    const size_t kstep = (size_t)(BK * 2);
    const size_t hstepA = (size_t)HALF * g.lda * 2, hstepB = (size_t)HALF * g.ldb * 2;
    const size_t tstepA = 2 * hstepA, tstepB = 2 * hstepB;
    const unsigned ldsw = (unsigned)wid * 1024u;
    const int aoff = lds_byte(wr * 64 + fr, fq * 8), boff = lds_byte(wc * 32 + fr, fq * 8);
#define PG8_SA(b, h) (((b) * 2 + (h)) * HTB)
#define PG8_SB(b, h) ((4 + (b) * 2 + (h)) * HTB)
#define PG8_STAGE(bufoff, gbase, voff) do { _Pragma("unroll") for (int _i = 0; _i < 2; ++_i) \
        __builtin_amdgcn_global_load_lds((const unsigned*)((const char*)(gbase) + (voff)[_i]), (PG8_LAS unsigned*)(lds + (bufoff) + ldsw + _i * 8192), 16, 0, 0); } while (0)
#define PG8_LDA(dst, b, h) do { _Pragma("unroll") for (int m = 0; m < 4; ++m) _Pragma("unroll") for (int k = 0; k < 2; ++k) dst[m][k] = *(const PG8_LAS bf16x8*)(lds + PG8_SA(b, h) + aoff + m * 2048 + k * 1024); } while (0)
#define PG8_LDB(dst, b, h) do { _Pragma("unroll") for (int n = 0; n < 2; ++n) _Pragma("unroll") for (int k = 0; k < 2; ++k) dst[n][k] = *(const PG8_LAS bf16x8*)(lds + PG8_SB(b, h) + boff + n * 2048 + k * 1024); } while (0)
#define PG8_MMA(ai, bj, At, Bt) do { __builtin_amdgcn_s_setprio(1); _Pragma("unroll") for (int m = 0; m < 4; ++m) _Pragma("unroll") for (int n = 0; n < 2; ++n) _Pragma("unroll") for (int k = 0; k < 2; ++k) \
        acc[ai][bj][m][n] = __builtin_amdgcn_mfma_f32_16x16x32_bf16(Bt[n][k], At[m][k], acc[ai][bj][m][n], 0, 0, 0); __builtin_amdgcn_s_setprio(0); } while (0)
#define PG8_WAIT_V(n) asm volatile("s_waitcnt vmcnt(" #n ")" ::: "memory")
#define PG8_WAIT_L(n) asm volatile("s_waitcnt lgkmcnt(" #n ")" ::: "memory")
#define PG8_BAR __builtin_amdgcn_s_barrier()
#define PG8_SCHED __builtin_amdgcn_sched_barrier(0)
    Unit cur, nxt; int ui = 0;
    if (!S.next(0, cur)) return;
    f32x4 acc[2][2][4][2];
#pragma unroll
    for (int a = 0; a < 2; ++a)
#pragma unroll
        for (int b = 0; b < 2; ++b)
#pragma unroll
            for (int m = 0; m < 4; ++m)
#pragma unroll
                for (int n = 0; n < 2; ++n) acc[a][b][m][n] = (f32x4){0.f, 0.f, 0.f, 0.f};
    bf16x8 At[4][2], B0[2][2], B1[2][2];
    const char* cA = (const char*)g.A + (size_t)cur.pm * tstepA + (size_t)cur.ak * 2; const char* cB = (const char*)g.Bt + (size_t)cur.pb * tstepB;
    S.a_ready(cur);
    if constexpr (SP2) {
        PG8_STAGE(PG8_SB(0, 0), cB, voffB); PG8_STAGE(PG8_SB(0, 1), cB + hstepB, voffB); PG8_STAGE(PG8_SA(0, 0), cA, voffA); PG8_STAGE(PG8_SA(0, 1), cA + hstepA, voffA);
        if (wr == 1) PG8_BAR;
        PG8_WAIT_V(2); PG8_BAR;
        PG8_STAGE(PG8_SB(1, 0), cB + kstep, voffB); PG8_STAGE(PG8_SA(1, 0), cA + kstep, voffA); PG8_STAGE(PG8_SB(1, 1), cB + hstepB + kstep, voffB);
        PG8_WAIT_V(6); PG8_BAR;
    } else {
        PG8_STAGE(PG8_SB(0, 0), cB, voffB); PG8_STAGE(PG8_SA(0, 0), cA, voffA); PG8_STAGE(PG8_SB(0, 1), cB + hstepB, voffB); PG8_STAGE(PG8_SA(0, 1), cA + hstepA, voffA);
        if (wr == 1) PG8_BAR;
        PG8_WAIT_V(4); PG8_BAR;
        PG8_STAGE(PG8_SB(1, 0), cB + kstep, voffB); PG8_STAGE(PG8_SA(1, 0), cA + kstep, voffA); PG8_STAGE(PG8_SB(1, 1), cB + hstepB + kstep, voffB);
        PG8_WAIT_V(6); PG8_BAR;
    }
    for (;;) {
        const bool has_next = S.next(ui + 1, nxt);
        const char* nA = has_next ? (const char*)g.A + (size_t)nxt.pm * tstepA + (size_t)nxt.ak * 2 : cA; const char* nB = has_next ? (const char*)g.Bt + (size_t)nxt.pb * tstepB : cB;
        for (int t = 0; t < nt; t += 2) {
            const bool last = (t == nt - 2);
            const char* a1 = cA + (size_t)(t + 1) * kstep;
            const char* a2 = last ? nA : cA + (size_t)(t + 2) * kstep; const char* b2 = last ? nB : cB + (size_t)(t + 2) * kstep;
            const char* a3 = a2 + kstep; const char* b3 = b2 + kstep;
            if (last && has_next) S.a_ready(nxt);
            if constexpr (SP2) {
            PG8_LDB(B0, 0, 0); PG8_LDB(B1, 0, 1); PG8_SCHED; PG8_LDA(At, 0, 0); PG8_STAGE(PG8_SA(1, 1), a1 + hstepA, voffA);
            PG8_WAIT_V(8); PG8_WAIT_L(0); PG8_BAR; PG8_MMA(0, 0, At, B0); PG8_MMA(0, 1, At, B1); PG8_BAR; PG8_SCHED;
            PG8_LDA(At, 0, 1); PG8_STAGE(PG8_SB(0, 0), b2, voffB); PG8_STAGE(PG8_SB(0, 1), b2 + hstepB, voffB); PG8_STAGE(PG8_SA(0, 0), a2, voffA);
            PG8_WAIT_V(8); PG8_WAIT_L(0); PG8_BAR; PG8_MMA(1, 0, At, B0); PG8_MMA(1, 1, At, B1); PG8_BAR; PG8_SCHED;
            PG8_LDB(B0, 1, 0); PG8_LDB(B1, 1, 1); PG8_SCHED; PG8_LDA(At, 1, 0); PG8_STAGE(PG8_SA(0, 1), a2 + hstepA, voffA);
            PG8_WAIT_V(8); PG8_WAIT_L(0); PG8_BAR; PG8_MMA(0, 0, At, B0); PG8_MMA(0, 1, At, B1); PG8_BAR; PG8_SCHED;
            PG8_LDA(At, 1, 1); PG8_STAGE(PG8_SB(1, 0), b3, voffB); PG8_STAGE(PG8_SB(1, 1), b3 + hstepB, voffB); PG8_STAGE(PG8_SA(1, 0), a3, voffA);
            PG8_WAIT_V(8); PG8_WAIT_L(0); PG8_BAR; PG8_MMA(1, 0, At, B0); PG8_MMA(1, 1, At, B1); PG8_BAR; PG8_SCHED;
            } else {
            PG8_LDB(B0, 0, 0); PG8_SCHED; PG8_LDA(At, 0, 0); PG8_STAGE(PG8_SA(1, 1), a1 + hstepA, voffA);
            PG8_WAIT_L(8); PG8_BAR; PG8_WAIT_L(0); PG8_MMA(0, 0, At, B0); PG8_BAR; PG8_SCHED;
            PG8_LDB(B1, 0, 1); PG8_STAGE(PG8_SB(0, 0), b2, voffB);
            PG8_BAR; PG8_WAIT_L(0); PG8_MMA(0, 1, At, B1); PG8_BAR;
            PG8_LDA(At, 0, 1); PG8_STAGE(PG8_SA(0, 0), a2, voffA);
            PG8_BAR; PG8_WAIT_L(0); PG8_MMA(1, 0, At, B0); PG8_BAR; PG8_SCHED;
            PG8_STAGE(PG8_SB(0, 1), b2 + hstepB, voffB);
            PG8_WAIT_V(6); PG8_BAR; PG8_MMA(1, 1, At, B1); PG8_BAR;
            PG8_LDB(B0, 1, 0); PG8_SCHED; PG8_LDA(At, 1, 0); PG8_STAGE(PG8_SA(0, 1), a2 + hstepA, voffA);
            PG8_WAIT_L(8); PG8_BAR; PG8_WAIT_L(0); PG8_MMA(0, 0, At, B0); PG8_BAR; PG8_SCHED;
            PG8_LDB(B1, 1, 1); PG8_STAGE(PG8_SB(1, 0), b3, voffB);
            PG8_BAR; PG8_WAIT_L(0); PG8_MMA(0, 1, At, B1); PG8_BAR;
            PG8_LDA(At, 1, 1); PG8_STAGE(PG8_SA(1, 0), a3, voffA);
            PG8_BAR; PG8_WAIT_L(0); PG8_MMA(1, 0, At, B0); PG8_BAR; PG8_SCHED;
            PG8_STAGE(PG8_SB(1, 1), b3 + hstepB, voffB);
            PG8_WAIT_V(6); PG8_BAR; PG8_MMA(1, 1, At, B1); PG8_BAR;
            }
        }
        if constexpr (ALIGN_EPI) { if (wr == 0) PG8_BAR; }
        const bool keep = E(acc, cur, wr, wc, fr, fq);
        if (!has_next) break;
        if (!keep) {
#pragma unroll
        for (int a = 0; a < 2; ++a)
#pragma unroll
            for (int b = 0; b < 2; ++b)
#pragma unroll
                for (int m = 0; m < 4; ++m)
#pragma unroll
                    for (int n = 0; n < 2; ++n) acc[a][b][m][n] = (f32x4){0.f, 0.f, 0.f, 0.f};
        }
        cur = nxt; cA = nA; cB = nB; ++ui;
        if constexpr (ALIGN_EPI) { if (wr == 1) PG8_BAR; }
    }
    PG8_WAIT_V(0);
    if constexpr (!ALIGN_EPI) { if (wr == 0) PG8_BAR; }
    PG8_BAR;
#undef PG8_SA
#undef PG8_SB
#undef PG8_STAGE
#undef PG8_LDA
#undef PG8_LDB
#undef PG8_MMA
#undef PG8_WAIT_V
#undef PG8_WAIT_L
#undef PG8_BAR
#undef PG8_SCHED
}
}
#define GAS __attribute__((address_space(1)))
#define LAS __attribute__((address_space(3)))
typedef unsigned short bf16;
typedef unsigned v4u __attribute__((ext_vector_type(4)));
typedef float f32x4 __attribute__((ext_vector_type(4)));
typedef short bf16x8 __attribute__((ext_vector_type(8)));
typedef GAS unsigned gu32;
typedef GAS unsigned long long gu64;
#define RLX_AGENT __ATOMIC_RELAXED, __HIP_MEMORY_SCOPE_AGENT
#define LDS_WAIT() asm volatile("s_waitcnt lgkmcnt(0)" ::: "memory")
#define VM_WAIT() asm volatile("s_waitcnt vmcnt(0)" ::: "memory")
__device__ __forceinline__ unsigned long long rt() { return __builtin_amdgcn_s_memrealtime(); }
__device__ __forceinline__ unsigned f2bf(float f) { unsigned u = __builtin_bit_cast(unsigned, f); return (u + 0x7fffu + ((u >> 16) & 1u)) >> 16; }
__device__ __forceinline__ unsigned pk2(float lo, float hi) { return f2bf(lo) | (f2bf(hi) << 16); }

#define XB_TMO      128
#define XB_XCNT(j)  (256  + 64 * (j))
#define XB_XSUB(j)  (1280 + 64 * (j))
#define XB_XGEN(j)  (2304 + 64 * (j))
#define XB_TOP      3328
#define XB_TOPGEN   3392
#define XCD_BAR_WORDS 3456
#define XB_SPIN_CAP (1u << 18)

__device__ __forceinline__ unsigned xb_ld(unsigned* p)              { return __hip_atomic_load(p, __ATOMIC_RELAXED, __HIP_MEMORY_SCOPE_AGENT); }
__device__ __forceinline__ unsigned xb_add(unsigned* p, unsigned v) { return __hip_atomic_fetch_add(p, v, __ATOMIC_RELAXED, __HIP_MEMORY_SCOPE_AGENT); }
__device__ __forceinline__ unsigned xb_xcc_id() { return (unsigned)__builtin_amdgcn_s_getreg((3 << 11) | 20) & 0xFu; }
#define XB_SPIN(cond, bar) do { unsigned _sp = 0; while (cond) { __builtin_amdgcn_s_sleep(1); \
    if ((++_sp & 255u) == 0u) { if (xb_ld(&(bar)[XB_TMO])) break; if (_sp > XB_SPIN_CAP) { atomicAdd(&(bar)[XB_TMO], 1u); break; } } } } while (0)

struct XcdBarrier {
    unsigned* bar; unsigned x;
    volatile LAS unsigned* st;
};

__device__ __forceinline__ XcdBarrier xcd_barrier_post(unsigned* bar, volatile LAS unsigned* st, const int tid) {
    XcdBarrier b; b.bar = bar; b.x = xb_xcc_id(); b.st = st;
    if (tid == 0) (void)xb_add(&bar[XB_XCNT(b.x)], 1u);
    return b;
}
__device__ __forceinline__ void xcd_barrier_complete(unsigned* bar, unsigned x, unsigned& nloc, unsigned& nx) {
    const unsigned G = gridDim.x * gridDim.y * gridDim.z;
    unsigned sum, cnt, mine, sp = 0u;
    for (;;) {
        sum = 0u; cnt = 0u; mine = 0u;
#pragma unroll
        for (unsigned j = 0; j < 16; ++j) { const unsigned c = xb_ld(&bar[XB_XCNT(j)]); sum += c; cnt += (c > 0u) ? 1u : 0u; mine = (j == x) ? c : mine; }
        if (sum == G) break;
        __builtin_amdgcn_s_sleep(1);
        if ((++sp & 255u) == 0u) { if (xb_ld(&bar[XB_TMO])) break; if (sp > XB_SPIN_CAP) { atomicAdd(&bar[XB_TMO], 1u); break; } }
    }
    nloc = mine > 0u ? mine : 1u; nx = cnt > 0u ? cnt : 1u;
}

__device__ __forceinline__ void xcd_barrier(const XcdBarrier& b, const int tid) {
    asm volatile("s_waitcnt vmcnt(0)" ::: "memory");
    __syncthreads();
    if (tid == 0) {
        unsigned* bar = b.bar; asm volatile("" : "+s"(bar));
        __builtin_amdgcn_s_waitcnt(0);
        unsigned nloc = b.st[0], nx = b.st[1];
        if (nloc == 0u) { unsigned xl_ = b.x; asm volatile("" : "+s"(xl_)); xcd_barrier_complete(bar, xl_, nloc, nx); b.st[0] = nloc; b.st[1] = nx; }
        const unsigned old = xb_add(&bar[XB_XSUB(b.x)], 1u);
        const unsigned gen = old / nloc;
        if (old + 1u == (gen + 1u) * nloc) {
            __builtin_amdgcn_fence(__ATOMIC_RELEASE, "agent");
            asm volatile("s_waitcnt vmcnt(0)" ::: "memory");
            const unsigned og = xb_add(&bar[XB_TOP], 1u);
            const unsigned tg = og / nx;
            if (og + 1u == (tg + 1u) * nx) xb_add(&bar[XB_TOPGEN], 1u);
            else XB_SPIN(xb_ld(&bar[XB_TOPGEN]) == tg, bar);
            __builtin_amdgcn_fence(__ATOMIC_ACQUIRE, "agent");
            xb_add(&bar[XB_XGEN(b.x)], 1u);
            asm volatile("s_waitcnt vmcnt(0)" ::: "memory");
        } else {
            XB_SPIN(xb_ld(&bar[XB_XGEN(b.x)]) == gen, bar);
            __builtin_amdgcn_fence(__ATOMIC_ACQUIRE, "agent");
            asm volatile("s_waitcnt vmcnt(0)" ::: "memory");
        }
    }
    __syncthreads();
}
constexpr int NB = 8, SEQ = 4096, DM = 1024, T = NB * SEQ, DEPTH = 4, IN_COLS = 6240;
constexpr int FFN = 2816, NE = 8, EDIM = 1408;
constexpr float EPS = 1e-6f, LOG2E = 1.4426950408889634f;
constexpr int PJ_LD = 2304, PJ_U = 0, PJ_V = 256, PJ_BQ = 512, PJ_BK = 768, PJ_BV = 1024, PJ_DA = 1280, PJ_DG = 1536, PJ_CQ = 1792, PJ_CKV = 1984, PJ_KR = 2112;
constexpr float QS_B = 0.125f * LOG2E;
constexpr float QS_C = 0.10206207261596577f * LOG2E;
constexpr int NWAVES = 8, NTHR = 512;

constexpr size_t MiB = 1u << 20;
constexpr size_t WS_CTL = 0, CTL_ZERO_BYTES = 1 * MiB;
constexpr size_t WS_SSA = 1 * MiB, WS_SSB = 3 * MiB;
constexpr size_t WS_ROPE = 5 * MiB;
constexpr size_t WS_MISC = 11 * MiB;
constexpr size_t MS_RSCQ = WS_MISC, MS_RSCKV = WS_MISC + 128 * 1024, MS_SEL = WS_MISC + 256 * 1024, MS_KMEAN = WS_MISC + 768 * 1024,
                 MS_TOKE = WS_MISC + 1024 * 1024, MS_TOKW = WS_MISC + 1280 * 1024, MS_TOKS = WS_MISC + 1536 * 1024, MS_RSSLOT = WS_MISC + 1792 * 1024,
                 MS_WCNT = WS_MISC + 2304 * 1024, MS_WGCNT = WS_MISC + 2560 * 1024, MS_MTOT = WS_MISC + 2816 * 1024, MS_WSGU = WS_MISC + 2880 * 1024;
constexpr size_t WS_W = 14 * MiB;
constexpr size_t W_INR = WS_W, W_G = WS_W + 4 * MiB + 512 * 1024, W_UQ = WS_W + 12 * MiB + 512 * 1024, W_UKV = W_UQ + 256 * 1024, W_B = WS_W + 13 * MiB, W_OUT = WS_W + 15 * MiB,
                 W_F1 = WS_W + 17 * MiB, W_F2 = WS_W + 61 * MiB;
constexpr size_t WS_SSC = 98 * MiB;
constexpr size_t WS_XB = 100 * MiB;
constexpr size_t WS_BIG = 164 * MiB;
constexpr size_t B_PROJ = WS_BIG, B_QPRE = WS_BIG + 144 * MiB, B_KVPRE = WS_BIG + 176 * MiB  , B_CQ = WS_BIG + 208 * MiB, B_CK = WS_BIG + 232 * MiB, B_O = WS_BIG + 256 * MiB;
constexpr size_t B_SG = WS_BIG, B_Y = WS_BIG + 320 * MiB;
constexpr size_t B_HID = WS_BIG;
constexpr size_t B_XS = WS_BIG, B_HIDM = WS_BIG + 132 * MiB, B_Y2 = WS_BIG;
constexpr size_t WS_END = WS_BIG + 384 * MiB;
constexpr int MOE_ROWS_MAX = 65536 + 8 * 256;
static_assert(B_HIDM + (size_t)MOE_ROWS_MAX * EDIM * 2 <= WS_END && (size_t)MOE_ROWS_MAX * 1024 * 2 <= 132 * MiB, "moe map");
constexpr int CW_TMO = 0, CW_BAR = 4096, CW_MOE = 8192, CW_KMX = 9216;

constexpr int RING_OFF = 0, RING_BYTES = 131072;
constexpr int LDSCTL_OFF = RING_BYTES, MISC_OFF = LDSCTL_OFF + 320;
constexpr int LDS_BYTES = 147456;
constexpr int EPI_RED_OFF = 132096;

typedef float f32x2 __attribute__((ext_vector_type(2)));
typedef __bf16 bf16x2_t __attribute__((ext_vector_type(2)));
__device__ __forceinline__ unsigned pkbf(float lo, float hi) { f32x2 v = {lo, hi}; bf16x2_t b = __builtin_convertvector(v, bf16x2_t); return __builtin_bit_cast(unsigned, b); }
__device__ __forceinline__ float bflo(unsigned w) { return __uint_as_float(w << 16); }
__device__ __forceinline__ float bfhi(unsigned w) { return __uint_as_float(w & 0xffff0000u); }
__device__ __forceinline__ float bf1(bf16 b) { return __uint_as_float((unsigned)b << 16); }
__device__ __forceinline__ void unpack8(const v4u w, float* o) { o[0] = bflo(w.x); o[1] = bfhi(w.x); o[2] = bflo(w.y); o[3] = bfhi(w.y); o[4] = bflo(w.z); o[5] = bfhi(w.z); o[6] = bflo(w.w); o[7] = bfhi(w.w); }
__device__ __forceinline__ v4u pack8(const float* o) { v4u w; w.x = pkbf(o[0], o[1]); w.y = pkbf(o[2], o[3]); w.z = pkbf(o[4], o[5]); w.w = pkbf(o[6], o[7]); return w; }
template <int X> __device__ __forceinline__ float swz_xor(float v) { return __int_as_float(__builtin_amdgcn_ds_swizzle(__float_as_int(v), (X << 10) | 0x1f)); }
__device__ __forceinline__ float half_sum(float v) { auto rr = __builtin_amdgcn_permlane32_swap(__float_as_uint(v), __float_as_uint(v), false, false); return __uint_as_float(rr[0]) + __uint_as_float(rr[1]); }
__device__ __forceinline__ float wave_sum(float v) {
    v += swz_xor<1>(v); v += swz_xor<2>(v); v += swz_xor<4>(v); v += swz_xor<8>(v); v += swz_xor<16>(v);
    return half_sum(v);
}
__device__ __forceinline__ float fast_sigmoid(float x) { return __builtin_amdgcn_rcpf(1.0f + __builtin_amdgcn_exp2f(-x * LOG2E)); }
__device__ __forceinline__ float fast_silu(float x) { return x * fast_sigmoid(x); }
namespace pg8 {
struct RowScale { const float* p; int mode; };
__device__ __forceinline__ float row_scale(const RowScale& rs, int row) {
    if (rs.mode == 0) return 1.f;
    if (rs.mode == 2) return rs.p[row];
    if (rs.mode == 3) { const f32x4 p = *(const f32x4*)(rs.p + (size_t)row * 12); return rsqrtf(((p[0] + p[1]) + (p[2] + p[3])) * (1.0f / 192.0f) + EPS); }
    if (rs.mode == 4) { const f32x4 p = *(const f32x4*)(rs.p + (size_t)row * 12 + 4); return rsqrtf(((p[0] + p[1]) + (p[2] + p[3])) * (1.0f / 128.0f) + EPS); }
    { const f32x4 p = *(const f32x4*)(rs.p + (size_t)row * 4); return rsqrtf(((p[0] + p[1]) + (p[2] + p[3])) * (1.0f / 1024.0f) + EPS); }
}
template <int ACT> struct EpiScale {
    static constexpr bool PERM = true;
    bf16_t* O; int ldc; RowScale rs; float* ssc;
    __device__ __forceinline__ bool operator()(f32x4 (&acc)[2][2][4][2], const Unit& u, int wr, int wc, int fr, int fq) const {
        const int row0 = u.pm * BM + wr * 64 + fr;
        float scv[2][4];
#pragma unroll
        for (int ai = 0; ai < 2; ++ai)
#pragma unroll
            for (int m = 0; m < 4; ++m) scv[ai][m] = row_scale(rs, row0 + ai * HALF + m * 16);
#pragma unroll
        for (int ai = 0; ai < 2; ++ai)
#pragma unroll
            for (int m = 0; m < 4; ++m) {
                const int row = row0 + ai * HALF + m * 16; const float sc = scv[ai][m];
                if (ACT == 2) {
                    bf16_t* rowp = O + (size_t)row * ldc + u.pn * HALF + wc * 32 + 8 * fq;
                    const f32x4 g0 = acc[ai][0][m][0] * sc, g1 = acc[ai][0][m][1] * sc, u0 = acc[ai][1][m][0] * sc, u1 = acc[ai][1][m][1] * sc;
                    u32x4 w; w.x = pkbf(fast_silu(g0[0]) * u0[0], fast_silu(g0[1]) * u0[1]); w.y = pkbf(fast_silu(g0[2]) * u0[2], fast_silu(g0[3]) * u0[3]);
                    w.z = pkbf(fast_silu(g1[0]) * u1[0], fast_silu(g1[1]) * u1[1]); w.w = pkbf(fast_silu(g1[2]) * u1[2], fast_silu(g1[3]) * u1[3]);
                    *(u32x4*)rowp = w;
                } else {
                    bf16_t* rowp = O + (size_t)row * ldc + u.pn * BM + wc * 32 + 8 * fq;
                    float sq[2] = {0.f, 0.f};
#pragma unroll
                    for (int bj = 0; bj < 2; ++bj) {
                        f32x4 v0 = acc[ai][bj][m][0] * sc, v1 = acc[ai][bj][m][1] * sc;
                        if (ACT == 0) sq[bj] = ((v0[0] * v0[0] + v0[1] * v0[1]) + (v0[2] * v0[2] + v0[3] * v0[3])) + ((v1[0] * v1[0] + v1[1] * v1[1]) + (v1[2] * v1[2] + v1[3] * v1[3]));
                        if (ACT == 1) {
#pragma unroll
                            for (int j = 0; j < 4; ++j) { v0[j] = fmaxf(fast_sigmoid(v0[j]), 8.6736174e-19f); v1[j] = fmaxf(fast_sigmoid(v1[j]), 8.6736174e-19f); }
                        }
                        u32x4 w; w.x = pkbf(v0[0], v0[1]); w.y = pkbf(v0[2], v0[3]); w.z = pkbf(v1[0], v1[1]); w.w = pkbf(v1[2], v1[3]);
                        *(u32x4*)(rowp + bj * HALF) = w;
                    }
                    if (ACT == 0 && ssc != nullptr && (u.pn == 7 || u.pn == 8)) {
                        float a = (u.pn == 7) ? (sq[0] + (wc < 2 ? sq[1] : 0.f)) : sq[0];
                        float c = sq[1];
                        a += swz_xor<16>(a); a = half_sum(a); c += swz_xor<16>(c); c = half_sum(c);
                        if (fq == 0) {
                            float* sp = ssc + (size_t)row * 12;
                            if (u.pn == 7) { sp[wc] = a; if (wc >= 2) sp[4 + wc] = c; }
                            else { if (wc < 2) sp[4 + wc] = a; if (wc == 2) sp[8] = a; }
                        }
                    }
                }
            }
        return false;
    }
};
struct EpiResidual {
    static constexpr bool PERM = false;
    bf16_t* xb; float* ssp; PG8_LAS float* red;
    __device__ __forceinline__ bool operator()(f32x4 (&acc)[2][2][4][2], const Unit& u, int wr, int wc, int fr, int fq) const {
        typedef unsigned u32x2v __attribute__((ext_vector_type(2)));
        const int row0 = u.pm * BM + wr * 64 + fr, col0 = u.pn * BM + wc * 32 + 4 * fq;
#pragma unroll
        for (int ai = 0; ai < 2; ++ai) {
            u32x2v bv[4][2][2];
#pragma unroll
            for (int m = 0; m < 4; ++m)
#pragma unroll
                for (int bj = 0; bj < 2; ++bj)
#pragma unroll
                    for (int n = 0; n < 2; ++n) bv[m][bj][n] = *(const u32x2v*)(xb + (size_t)(row0 + ai * HALF + m * 16) * DM + col0 + bj * HALF + n * 16);
#pragma unroll
            for (int m = 0; m < 4; ++m) {
                const int row = row0 + ai * HALF + m * 16; const size_t off = (size_t)row * DM + col0; float ss = 0.f;
#pragma unroll
                for (int bj = 0; bj < 2; ++bj)
#pragma unroll
                    for (int n = 0; n < 2; ++n) {
                        const size_t o2 = off + bj * HALF + n * 16; const u32x2v bb = bv[m][bj][n]; const f32x4 a = acc[ai][bj][m][n];
                        const f32x4 o = {bflo(bb.x) + a[0], bfhi(bb.x) + a[1], bflo(bb.y) + a[2], bfhi(bb.y) + a[3]};
                        u32x2v w; w.x = pkbf(o[0], o[1]); w.y = pkbf(o[2], o[3]); *(u32x2v*)(xb + o2) = w;
                        ss += (o[0] * o[0] + o[1] * o[1]) + (o[2] * o[2] + o[3] * o[3]);
                    }
                ss += swz_xor<16>(ss); ss = half_sum(ss);
                if (fq == 0) red[(ai * HALF + wr * 64 + m * 16 + fr) * 4 + wc] = ss;
            }
        }
        asm volatile("s_waitcnt lgkmcnt(0)" ::: "memory"); __builtin_amdgcn_s_barrier(); asm volatile("" ::: "memory");
        const int t = (wr * 4 + wc) * 64 + fq * 16 + fr;
        if (t < 256) { const f32x4 p = *(const PG8_LAS f32x4*)(red + t * 4); ssp[(size_t)(u.pm * BM + t) * 4 + u.pn] = (p[0] + p[1]) + (p[2] + p[3]); }
        return false;
    }
};
struct EpiKV {
    static constexpr bool PERM = true;
    bf16_t* CK; bf16_t* VB; const bf16_t* PROJ; const float* ssc; const float* rope; const float* ckn; unsigned* kmx;
    __device__ __forceinline__ bool operator()(f32x4 (&acc)[2][2][4][2], const Unit& u, int wr, int wc, int fr, int fq) const {
        typedef unsigned u32x2v __attribute__((ext_vector_type(2)));
        { unsigned mk_ = ~0u; asm volatile("" : "+s"(mk_)); const int ln_ = (int)__builtin_amdgcn_mbcnt_hi(mk_, __builtin_amdgcn_mbcnt_lo(mk_, 0u)); fr = ln_ & 15; fq = ln_ >> 4; }
        const int hh = 2 * u.pn + (wc >> 1); const bool isv = (wc & 1) != 0; const int row0 = u.pm * BM + wr * 64 + fr;
        float k2max = 0.f;
#pragma unroll
        for (int ai = 0; ai < 2; ++ai)
#pragma unroll
            for (int m = 0; m < 4; ++m) {
                const int row = row0 + ai * HALF + m * 16;
                const float* sp = ssc + (size_t)row * 12; const f32x4 pp = *(const f32x4*)(sp + 4);
                const float rs = rsqrtf(((pp[0] + pp[1]) + (pp[2] + pp[3])) * (1.0f / 128.0f) + EPS);
                if (isv) {
#pragma unroll
                    for (int bj = 0; bj < 2; ++bj) { const f32x4 v0 = acc[ai][bj][m][0] * rs, v1 = acc[ai][bj][m][1] * rs;
                        u32x4 w; w.x = pkbf(v0[0], v0[1]); w.y = pkbf(v0[2], v0[3]); w.z = pkbf(v1[0], v1[1]); w.w = pkbf(v1[2], v1[3]);
                        *(u32x4*)(VB + (size_t)row * 256 + hh * 64 + 32 * bj + 8 * fq) = w; }
                } else {
                    float ss = 0.f;
#pragma unroll
                    for (int bj = 0; bj < 2; ++bj)
#pragma unroll
                        for (int n = 0; n < 2; ++n) { const f32x4 a = acc[ai][bj][m][n]; ss += (a[0] * a[0] + a[1] * a[1]) + (a[2] * a[2] + a[3] * a[3]); }
                    ss += swz_xor<16>(ss); ss = half_sum(ss); ss *= rs * rs;
                    const float rk = rsqrtf((ss + sp[8]) * (1.0f / 96.0f) + EPS); const float rr = rs * rk;
                    bf16_t* kd = CK + (size_t)row * 384 + hh * 96; float kn2 = 0.f;
#pragma unroll
                    for (int bj = 0; bj < 2; ++bj) { const f32x4 g0 = *(const f32x4*)(ckn + 32 * bj + 8 * fq), g1 = *(const f32x4*)(ckn + 32 * bj + 8 * fq + 4);
                        const f32x4 a = acc[ai][bj][m][0] * rr * g0, b = acc[ai][bj][m][1] * rr * g1;
                        kn2 += ((a[0] * a[0] + a[1] * a[1]) + (a[2] * a[2] + a[3] * a[3])) + ((b[0] * b[0] + b[1] * b[1]) + (b[2] * b[2] + b[3] * b[3]));
                        u32x4 w; w.x = pkbf(a[0], a[1]); w.y = pkbf(a[2], a[3]); w.z = pkbf(b[0], b[1]); w.w = pkbf(b[2], b[3]);
                        *(u32x4*)(kd + 32 * bj + 8 * fq) = w; }
                    const u32x2v k1 = *(const u32x2v*)(PROJ + (size_t)row * PJ_LD + PJ_KR + 4 * fq), k2 = *(const u32x2v*)(PROJ + (size_t)row * PJ_LD + PJ_KR + 16 + 4 * fq);
                    const f32x4 ga = *(const f32x4*)(ckn + 64 + 4 * fq), gb = *(const f32x4*)(ckn + 80 + 4 * fq);
                    const float* tb = rope + (size_t)row * 48 + 16 + 8 * fq; const f32x4 t0 = *(const f32x4*)tb, t1 = *(const f32x4*)(tb + 4);
                    const float x1[4] = {bflo(k1.x) * rk * ga[0], bfhi(k1.x) * rk * ga[1], bflo(k1.y) * rk * ga[2], bfhi(k1.y) * rk * ga[3]};
                    const float x2[4] = {bflo(k2.x) * rk * gb[0], bfhi(k2.x) * rk * gb[1], bflo(k2.y) * rk * gb[2], bfhi(k2.y) * rk * gb[3]};
                    const float cs[4] = {t0[0], t0[2], t1[0], t1[2]}, sn[4] = {t0[1], t0[3], t1[1], t1[3]};
                    u32x2v y1, y2;
                    y1.x = pkbf(x1[0] * cs[0] - x2[0] * sn[0], x1[1] * cs[1] - x2[1] * sn[1]); y1.y = pkbf(x1[2] * cs[2] - x2[2] * sn[2], x1[3] * cs[3] - x2[3] * sn[3]);
                    y2.x = pkbf(x2[0] * cs[0] + x1[0] * sn[0], x2[1] * cs[1] + x1[1] * sn[1]); y2.y = pkbf(x2[2] * cs[2] + x1[2] * sn[2], x2[3] * cs[3] + x1[3] * sn[3]);
                    *(u32x2v*)(kd + 64 + 4 * fq) = y1; *(u32x2v*)(kd + 80 + 4 * fq) = y2;
                    kn2 += ((x1[0] * x1[0] + x2[0] * x2[0]) + (x1[1] * x1[1] + x2[1] * x2[1])) + ((x1[2] * x1[2] + x2[2] * x2[2]) + (x1[3] * x1[3] + x2[3] * x2[3]));
                    kn2 += swz_xor<16>(kn2); kn2 = half_sum(kn2); k2max = fmaxf(k2max, kn2);
                }
                asm volatile("" ::: "memory");
            }
        if (!isv) {
            k2max = fmaxf(k2max, swz_xor<1>(k2max)); k2max = fmaxf(k2max, swz_xor<2>(k2max)); k2max = fmaxf(k2max, swz_xor<4>(k2max)); k2max = fmaxf(k2max, swz_xor<8>(k2max));
            if (fr == 0 && fq == 0) __hip_atomic_fetch_max(kmx + ((u.pm * BM) / SEQ) * 4 + hh, __float_as_uint(k2max), __ATOMIC_RELAXED, __HIP_MEMORY_SCOPE_AGENT);
        }
        return false;
    }
};
struct EpiGates {
    static constexpr bool PERM = true;
    bf16_t* RG; RowScale rs;
    __device__ __forceinline__ bool operator()(f32x4 (&acc)[2][2][4][2], const Unit& u, int wr, int wc, int fr, int fq) const {
        typedef unsigned u32x2v __attribute__((ext_vector_type(2)));
        const int row0 = u.pm * BM + wr * 64 + fr, oc = u.pn * 64 + wc * 16 + fq * 4;
        float scv[2][4];
#pragma unroll
        for (int ai = 0; ai < 2; ++ai)
#pragma unroll
            for (int m = 0; m < 4; ++m) scv[ai][m] = row_scale(rs, row0 + ai * HALF + m * 16);
#pragma unroll
        for (int ai = 0; ai < 2; ++ai)
#pragma unroll
            for (int m = 0; m < 4; ++m) {
                const int row = row0 + ai * HALF + m * 16; const float sc = scv[ai][m];
                f32x4 s[4];
#pragma unroll
                for (int b = 0; b < 4; ++b) { const f32x4 g = acc[ai][b >> 1][m][b & 1] * sc;
#pragma unroll
                    for (int j = 0; j < 4; ++j) s[b][j] = fmaxf(fast_sigmoid(g[j]), 8.6736174e-19f); }
                bf16_t* rp = RG + (size_t)row * 4096 + oc;
#pragma unroll
                for (int b = 0; b < 4; ++b) { f32x4 r = s[b];
                    if (b < 3) {
#pragma unroll
                        for (int j = 0; j < 4; ++j) r[j] = s[b][j] * __builtin_amdgcn_rcpf(s[b + 1][j]); }
                    u32x2v w; w.x = pkbf(r[0], r[1]); w.y = pkbf(r[2], r[3]); *(u32x2v*)(rp + b * 1024) = w; }
            }
        return false;
    }
};
struct EpiMerge {
    static constexpr bool PERM = true;
    const bf16_t* SG; bf16_t* Y;
    __device__ __forceinline__ bool operator()(f32x4 (&acc)[2][2][4][2], const Unit& u, int wr, int wc, int fr, int fq) const {
        const int n = u.ak >> 8; const int row0 = u.pm * BM + wr * 64 + fr, col0 = u.pn * BM + wc * 32 + 8 * fq;
#pragma unroll
        for (int ai = 0; ai < 2; ++ai)
#pragma unroll
            for (int mp = 0; mp < 2; ++mp) {
              u32x4 av[2][2];
#pragma unroll
              for (int mm = 0; mm < 2; ++mm)
#pragma unroll
                for (int bj = 0; bj < 2; ++bj) av[mm][bj] = *(const u32x4*)(SG + (size_t)(row0 + ai * HALF + (2 * mp + mm) * 16) * 4096 + n * 1024 + col0 + bj * HALF);
#pragma unroll
              for (int mm = 0; mm < 2; ++mm) {
                const int m = 2 * mp + mm, row = row0 + ai * HALF + m * 16;
#pragma unroll
                for (int bj = 0; bj < 2; ++bj) {
                    float sa[8]; unpack8(av[mm][bj], sa);
#pragma unroll
                    for (int j = 0; j < 4; ++j) { acc[ai][bj][m][0][j] *= sa[j]; acc[ai][bj][m][1][j] *= sa[4 + j]; }
                    if (n == 3) {
                        float o[8];
#pragma unroll
                        for (int j = 0; j < 4; ++j) { o[j] = acc[ai][bj][m][0][j]; o[4 + j] = acc[ai][bj][m][1][j]; }
                        *(u32x4*)(Y + (size_t)row * DM + col0 + bj * HALF) = pack8(o);
                    }
                }
              }
            }
        return n < 3;
    }
};
struct MergeOrder {
    StaticOrder so;
    __device__ bool next(int i, Unit& u) const { if (!so.next(i >> 2, u)) return false; const int n = i & 3; u.pb = n * 4 + u.pn; u.ak = n * 256; return true; }
    __device__ __forceinline__ void a_ready(const Unit&) const {}
    __device__ __forceinline__ void done(const Unit&) const {}
};
struct MoeOrder {
    StaticOrder so; int nN; int ps[9];
    __device__ bool next(int i, Unit& u) const {
        if (!so.next(i, u)) return false; int e = 0;
#pragma unroll
        for (int k = 1; k < 8; ++k) e = (u.pm >= ps[k]) ? k : e;
        u.pb = e * nN + u.pn; u.ak = 0; return true; }
    __device__ __forceinline__ void a_ready(const Unit&) const {}
    __device__ __forceinline__ void done(const Unit&) const {}
};
}

struct TrDesc { const float* src; bf16* dst; const float* gain; int ldw, ldd, nnb, nsrc0, drow0, map, cum, pad; };
constexpr int TR_TAB_OFF = 8448;
struct TrItem { const float* W; bf16* dst; const float* gain; int ldw, ldd, k0, n0, perm; };
__device__ __forceinline__ void tr_load(const TrItem& it, float (&v)[32], int lane) {
#pragma unroll
    for (int i = 0; i < 32; ++i) { const int kk = 2 * i + (lane >> 5); v[i] = it.W[(size_t)(it.k0 + kk) * it.ldw + it.n0 + (lane & 31)]; }
}
__device__ __forceinline__ void tr_finish(const TrItem& it, float (&v)[32], LAS float* scr, int lane) {
    if (it.gain) {
#pragma unroll
        for (int i = 0; i < 32; ++i) v[i] *= it.gain[it.k0 + 2 * i + (lane >> 5)];
    }
#pragma unroll
    for (int i = 0; i < 32; ++i) scr[(2 * i + (lane >> 5)) * 33 + (lane & 31)] = v[i];
    LDS_WAIT(); asm volatile("" ::: "memory");
    const int c = lane & 7;
#pragma unroll
    for (int j = 0; j < 4; ++j) { const int n = (lane >> 3) + 8 * j; const LAS float* s = scr + (8 * c) * 33 + n;
        v4u o; o.x = pkbf(s[0 * 33], s[1 * 33]); o.y = pkbf(s[2 * 33], s[3 * 33]); o.z = pkbf(s[4 * 33], s[5 * 33]); o.w = pkbf(s[6 * 33], s[7 * 33]);
        const int nr = it.perm ? (32 * (n >> 4) + 8 * ((n >> 2) & 3) + (n & 3)) : n;
        *(v4u*)(it.dst + (size_t)nr * it.ldd + 8 * c) = o; }
    LDS_WAIT(); asm volatile("" ::: "memory");
}
__device__ __forceinline__ void tr_add(LAS TrDesc* t, int& n, int& cum, const float* src, int ldw, int Ktot, int ncols, int nsrc0, bf16* dst, int ldd, int drow0, int map, const float* gain) {
    int z = 0; asm volatile("" : "+s"(z));
    asm volatile("" : "+s"(gain));
    t[n].src = src; t[n].dst = dst; t[n].gain = gain; t[n].ldw = ldw + z; t[n].ldd = ldd + z; t[n].nnb = ncols / 32 + z; t[n].nsrc0 = nsrc0 + z; t[n].drow0 = drow0 + z; t[n].map = map + z; t[n].cum = cum + z;
    cum += (Ktot / 64) * (ncols / 32); ++n;
}
__device__ __forceinline__ TrItem tr_lookup(const LAS TrDesc* t, int& d, int it) {
    while (it >= t[d + 1].cum) ++d;
    const int local = it - t[d].cum, nnb = t[d].nnb, kb = local / nnb, nb = local - kb * nnb, k0 = kb * 64, nl = nb * 32;
    const int mp = t[d].map;
    const int drow = t[d].drow0 + (mp == 1 ? ((nl >> 7) * 256 + (nl & 127)) : mp == 2 ? (256 * (nl >> 8) + 128 * ((nl >> 5) & 1) + 32 * ((((nl >> 7) & 1) << 1) + ((nl >> 6) & 1)))
                                 : mp == 3 ? (256 * ((nl & 1023) >> 6) + 128 * (nl >> 11) + 32 * (((nl & 1023) >> 4) & 3) + 4 * ((nl >> 10) & 1)) : nl); const int ldd = t[d].ldd;
    TrItem r; r.W = t[d].src; r.dst = t[d].dst + (size_t)drow * ldd + k0; r.gain = t[d].gain; r.ldw = t[d].ldw; r.ldd = ldd; r.k0 = k0; r.n0 = t[d].nsrc0 + nl; r.perm = (mp == 3) ? 1 : 0; return r;
}
__device__ __forceinline__ void tr_run(const LAS TrDesc* t, int total, LAS float* scr, int lane, int gw, int NGW) {
    const int per = (total + NGW - 1) / NGW, lo = gw * per, hi = (lo + per < total) ? lo + per : total;
    if (lo >= hi) return;
    int d = 0; TrItem cur = tr_lookup(t, d, lo); float va[32], vb[32];
    tr_load(cur, va, lane);
    for (int it = lo; it < hi; it += 2) {
        TrItem nx = cur; const bool h1 = it + 1 < hi;
        if (h1) { nx = tr_lookup(t, d, it + 1); tr_load(nx, vb, lane); }
        tr_finish(cur, va, scr, lane);
        if (!h1) break;
        const bool h2 = it + 2 < hi;
        if (h2) { cur = tr_lookup(t, d, it + 2); tr_load(cur, va, lane); }
        tr_finish(nx, vb, scr, lane);
    }
}

template <int DK, int DV, bool MOBA>
__device__ __forceinline__ void naive_attn_unit(LAS unsigned char* lds, const bf16* Q, int qp, int qhs, const bf16* K, int kp, int khs, const bf16* V, int vp, int vhs,
                                                bf16* O, int op, int b, int h, int qc, const int* sel, const int tid) {
    LAS float* Ks = (LAS float*)lds; LAS float* Vs = Ks + 64 * DK;
    const int qi = qc * 512 + tid;
    const size_t tok = (size_t)b * SEQ + qi;
    float q[DK];
    { const v4u* qsrc = (const v4u*)(Q + tok * qp + h * qhs);
#pragma unroll
      for (int c = 0; c < DK / 8; ++c) unpack8(qsrc[c], q + 8 * c); }
    float o[DV];
#pragma unroll
    for (int d = 0; d < DV; ++d) o[d] = 0.f;
    float m = -1e30f, l = 0.f;
    const int qblk = qi >> 8; unsigned mask = 0u;
    if (MOBA) { const int sv = sel[tok * 4 + h]; const int ns = (sv >> 12) & 3;
        if (ns > 0) mask |= 1u << (sv & 15); if (ns > 1) mask |= 1u << ((sv >> 4) & 15); if (ns > 2) mask |= 1u << ((sv >> 8) & 15); }
    const int ntile = qc * 8 + 8;
    const int wave_last = qc * 512 + (tid | 63);
    for (int kt = 0; kt < ntile; ++kt) {
        __syncthreads();
        const int k0 = kt * 64;
        for (int c = tid; c < 64 * (DK / 8); c += NTHR) { const int r = c / (DK / 8), ch = c - r * (DK / 8);
            const v4u w = *(const v4u*)(K + ((size_t)b * SEQ + k0 + r) * kp + h * khs + ch * 8); float f[8]; unpack8(w, f);
            LAS f32x4* d = (LAS f32x4*)(Ks + r * DK + ch * 8); d[0] = (f32x4){f[0], f[1], f[2], f[3]}; d[1] = (f32x4){f[4], f[5], f[6], f[7]}; }
        for (int c = tid; c < 64 * (DV / 8); c += NTHR) { const int r = c / (DV / 8), ch = c - r * (DV / 8);
            const v4u w = *(const v4u*)(V + ((size_t)b * SEQ + k0 + r) * vp + h * vhs + ch * 8); float f[8]; unpack8(w, f);
            LAS f32x4* d = (LAS f32x4*)(Vs + r * DV + ch * 8); d[0] = (f32x4){f[0], f[1], f[2], f[3]}; d[1] = (f32x4){f[4], f[5], f[6], f[7]}; }
        __syncthreads();
        if (k0 > wave_last) continue;
        const int nblk = k0 >> 8;
        bool tile_ok = true;
        if (MOBA) { tile_ok = (nblk == qblk) || ((mask >> nblk) & 1u); if (!__any(tile_ok)) continue; }
        for (int jj = 0; jj < 64; ++jj) {
            const int kj = k0 + jj;
            const bool ok = MOBA ? (tile_ok && (nblk != qblk || kj <= qi)) : (kj <= qi);
            if (ok) {
                const LAS f32x4* kr = (const LAS f32x4*)(Ks + jj * DK);
                float s0 = 0.f, s1 = 0.f;
#pragma unroll
                for (int c = 0; c < DK / 8; ++c) { const f32x4 a = kr[2 * c], bq = kr[2 * c + 1];
                    s0 += q[8 * c] * a[0]; s1 += q[8 * c + 1] * a[1]; s0 += q[8 * c + 2] * a[2]; s1 += q[8 * c + 3] * a[3];
                    s0 += q[8 * c + 4] * bq[0]; s1 += q[8 * c + 5] * bq[1]; s0 += q[8 * c + 6] * bq[2]; s1 += q[8 * c + 7] * bq[3]; }
                const float s = s0 + s1;
                if (s > m) { const float cf = __builtin_amdgcn_exp2f(m - s); l *= cf;
#pragma unroll
                    for (int d = 0; d < DV; ++d) o[d] *= cf;
                    m = s; }
                const float p = __builtin_amdgcn_exp2f(s - m); l += p;
                const LAS f32x4* vr = (const LAS f32x4*)(Vs + jj * DV);
#pragma unroll
                for (int c = 0; c < DV / 4; ++c) { const f32x4 a = vr[c]; o[4 * c] += p * a[0]; o[4 * c + 1] += p * a[1]; o[4 * c + 2] += p * a[2]; o[4 * c + 3] += p * a[3]; }
            }
        }
    }
    const float inv = 1.0f / l;
    v4u* od = (v4u*)(O + tok * op + h * DV);
#pragma unroll
    for (int c = 0; c < DV / 8; ++c) { float t8[8];
#pragma unroll
        for (int j = 0; j < 8; ++j) t8[j] = o[8 * c + j] * inv;
        od[c] = pack8(t8); }
    __syncthreads();
}

constexpr int SGU_P = 136;
__device__ __forceinline__ void sgu_unit(LAS unsigned char* lds, const bf16* PROJ, bf16* O, const float* __restrict__ lng, const float* __restrict__ lnb, const bf16* __restrict__ WM, const float* __restrict__ bs, int unit, const int tid) {
    LAS bf16* vnT = (LAS bf16*)lds;
    const int lane = tid & 63, wave = __builtin_amdgcn_readfirstlane(tid >> 6), r32 = lane & 31, hi = lane >> 5;
    const size_t t0 = (size_t)unit * 128;
    const f32x4 g4 = *(const f32x4*)(lng + 4 * lane), b4 = *(const f32x4*)(lnb + 4 * lane);
    bf16x8 wf[20];
    { const int g_ = wave >> 1; const bf16* wb = WM + ((size_t)(g_ * 128 + r32) * 128 + 8 * hi);
#pragma unroll
      for (int nt = 0; nt < 4; ++nt)
#pragma unroll
          for (int ks = 0; ks < 2 * nt + 2; ++ks) wf[nt * (nt + 1) + ks] = *(const bf16x8*)(wb + (size_t)(32 * nt) * 128 + 16 * ks); }
    {
        typedef unsigned u32x2v __attribute__((ext_vector_type(2)));
        u32x2v xr[16];
#pragma unroll
        for (int i = 0; i < 16; ++i) xr[i] = *(const u32x2v*)(PROJ + (t0 + wave * 16 + i) * PJ_LD + PJ_V + 4 * lane);
        unsigned ow[4][8];
#pragma unroll
        for (int i4 = 0; i4 < 4; ++i4) {
            float x[4][4], mu[4], var[4];
#pragma unroll
            for (int u = 0; u < 4; ++u) { const u32x2v r = xr[4 * i4 + u]; x[u][0] = bflo(r.x); x[u][1] = bfhi(r.x); x[u][2] = bflo(r.y); x[u][3] = bfhi(r.y); mu[u] = (x[u][0] + x[u][1]) + (x[u][2] + x[u][3]); }
#pragma unroll
            for (int u = 0; u < 4; ++u) mu[u] = wave_sum(mu[u]) * (1.0f / 256.0f);
#pragma unroll
            for (int u = 0; u < 4; ++u) { x[u][0] -= mu[u]; x[u][1] -= mu[u]; x[u][2] -= mu[u]; x[u][3] -= mu[u]; var[u] = (x[u][0] * x[u][0] + x[u][1] * x[u][1]) + (x[u][2] * x[u][2] + x[u][3] * x[u][3]); }
#pragma unroll
            for (int u = 0; u < 4; ++u) var[u] = wave_sum(var[u]) * (1.0f / 256.0f);
#pragma unroll
            for (int u = 0; u < 4; ++u) { const float rstd = rsqrtf(var[u] + EPS);
#pragma unroll
                for (int c = 0; c < 4; ++c) x[u][c] = x[u][c] * rstd * g4[c] + b4[c]; }
#pragma unroll
            for (int c = 0; c < 4; ++c) { ow[c][2 * i4] = pkbf(x[0][c], x[1][c]); ow[c][2 * i4 + 1] = pkbf(x[2][c], x[3][c]); }
        }
#pragma unroll
        for (int c = 0; c < 4; ++c) { LAS v4u* dst = (LAS v4u*)(vnT + (4 * lane + c) * SGU_P + wave * 16);
            dst[0] = (v4u){ow[c][0], ow[c][1], ow[c][2], ow[c][3]}; dst[1] = (v4u){ow[c][4], ow[c][5], ow[c][6], ow[c][7]}; }
    }
    __syncthreads();
    const int g = wave >> 1, dt = wave & 1;
    bf16x8 af[8];
#pragma unroll
    for (int ks = 0; ks < 8; ++ks) af[ks] = *(const LAS bf16x8*)(vnT + (g * 64 + dt * 32 + r32) * SGU_P + 16 * ks + 8 * hi);
    typedef float f32x16s __attribute__((ext_vector_type(16)));
    f32x16s acc[4];
#pragma unroll
    for (int nt = 0; nt < 4; ++nt) {
#pragma unroll
        for (int r = 0; r < 16; ++r) acc[nt][r] = 0.f;
#pragma unroll
        for (int ks = 0; ks < 2 * nt + 2; ++ks) {
            acc[nt] = __builtin_amdgcn_mfma_f32_32x32x16_bf16(af[ks], wf[nt * (nt + 1) + ks], acc[nt], 0, 0, 0);
        }
    }
    typedef unsigned u32x2v __attribute__((ext_vector_type(2)));
    u32x2v uva[4][4]; float biasv[4];
#pragma unroll
    for (int nt = 0; nt < 4; ++nt) { const int t = 32 * nt + r32; biasv[nt] = bs[g * 128 + t]; const bf16* up = PROJ + (t0 + t) * PJ_LD + PJ_U + g * 64 + dt * 32 + 4 * hi;
#pragma unroll
        for (int j = 0; j < 4; ++j) uva[nt][j] = *(const u32x2v*)(up + 8 * j); }
#pragma unroll
    for (int nt = 0; nt < 4; ++nt) {
        const int t = 32 * nt + r32; const float bias = biasv[nt];
        bf16* op = O + (t0 + t) * DM + g * 64 + dt * 32 + 4 * hi;
#pragma unroll
        for (int j = 0; j < 4; ++j) {
            const u32x2v uu = uva[nt][j];
            u32x2v w; w.x = pkbf(bflo(uu.x) * (acc[nt][4 * j] + bias), bfhi(uu.x) * (acc[nt][4 * j + 1] + bias)); w.y = pkbf(bflo(uu.y) * (acc[nt][4 * j + 2] + bias), bfhi(uu.y) * (acc[nt][4 * j + 3] + bias));
            *(u32x2v*)(op + 8 * j) = w;
        }
    }
    __syncthreads();
}

__device__ __forceinline__ void prep_block(LAS unsigned char* lds, bf16* PROJ, const float* __restrict__ ROPE, const float* __restrict__ qn, const float* __restrict__ kn, float* KMEAN, unsigned* kmx_out, int item, const int tid) {
    const int b = item >> 5, blk = (item >> 1) & 15, hf = item & 1;
    const int sub = tid & 7;
    const size_t tok0 = (size_t)b * SEQ + blk * 256 + hf * 128;
    float ksum[8] = {0.f, 0.f, 0.f, 0.f, 0.f, 0.f, 0.f, 0.f};
    float kmx = 0.f;
    f32x4 gq0 = *(const f32x4*)(qn + 8 * sub), gq1 = *(const f32x4*)(qn + 8 * sub + 4), gk0 = *(const f32x4*)(kn + 8 * sub), gk1 = *(const f32x4*)(kn + 8 * sub + 4);
    LAS float* rl = (LAS float*)(lds + 16384);
    { const f32x4 r = *(const f32x4*)(ROPE + (tok0 + (tid >> 2)) * 48 + 4 * (tid & 3)); *(LAS f32x4*)(rl + (tid >> 2) * 16 + 4 * (tid & 3)) = r; }
    v4u raw[16];
#pragma unroll
    for (int u = 0; u < 16; ++u) { const int row = u * 64 + (tid >> 3);
        const int tk = row >> 3, which = (row >> 2) & 1, hd = row & 3;
        raw[u] = *(const v4u*)(PROJ + (tok0 + tk) * PJ_LD + (which ? PJ_BK : PJ_BQ) + hd * 64 + 8 * sub); }
    __syncthreads();
#pragma unroll
    for (int u = 0; u < 16; ++u) { const int row = u * 64 + (tid >> 3);
        const int tk = row >> 3, which = (row >> 2) & 1, hd = row & 3;
        float v[8]; unpack8(raw[u], v);
        float ss = ((v[0] * v[0] + v[1] * v[1]) + (v[2] * v[2] + v[3] * v[3])) + ((v[4] * v[4] + v[5] * v[5]) + (v[6] * v[6] + v[7] * v[7]));
        ss += swz_xor<1>(ss); ss += swz_xor<2>(ss); ss += swz_xor<4>(ss);
        const float rstd = rsqrtf(ss * (1.0f / 64.0f) + EPS);
        const f32x4 g0 = which ? gk0 : gq0, g1 = which ? gk1 : gq1;
#pragma unroll
        for (int j = 0; j < 4; ++j) { v[j] *= rstd * g0[j]; v[4 + j] *= rstd * g1[j]; }
        f32x4 rp[4];
#pragma unroll
        for (int q = 0; q < 4; ++q) rp[q] = *(const LAS f32x4*)(rl + tk * 16 + 4 * q);
#pragma unroll
        for (int j = 0; j < 8; ++j) { const float other = swz_xor<1>(v[j]);
            if (sub < 2) { const float cs = rp[j >> 1][2 * (j & 1)], sn = rp[j >> 1][2 * (j & 1) + 1]; v[j] = (sub == 0) ? (v[j] * cs - other * sn) : (v[j] * cs + other * sn); } }
        if (!which) {
#pragma unroll
            for (int j = 0; j < 8; ++j) v[j] *= QS_B;
        } else {
            float s2 = ((v[0] * v[0] + v[1] * v[1]) + (v[2] * v[2] + v[3] * v[3])) + ((v[4] * v[4] + v[5] * v[5]) + (v[6] * v[6] + v[7] * v[7]));
            s2 += swz_xor<1>(s2); s2 += swz_xor<2>(s2); s2 += swz_xor<4>(s2); kmx = fmaxf(kmx, s2);
#pragma unroll
            for (int j = 0; j < 8; ++j) ksum[j] += v[j];
        }
        *(v4u*)(PROJ + (tok0 + tk) * PJ_LD + (which ? PJ_BK : PJ_BQ) + hd * 64 + 8 * sub) = pack8(v);
    }
    {
        LAS float* kl = (LAS float*)lds; if (((tid >> 5) & 1) && sub == 0) kl[(tid >> 6) * 4 + ((tid >> 3) & 3)] = kmx;
        LAS float* ks = (LAS float*)(lds + 4096);
        if ((tid >> 5) & 1) { LAS f32x4* kd = (LAS f32x4*)(ks + (tid >> 6) * 256 + ((tid >> 3) & 3) * 64 + 8 * sub); kd[0] = (f32x4){ksum[0], ksum[1], ksum[2], ksum[3]}; kd[1] = (f32x4){ksum[4], ksum[5], ksum[6], ksum[7]}; }
        __syncthreads();
        if (tid < 4) { float mx = 0.f;
#pragma unroll
            for (int w = 0; w < 8; ++w) mx = fmaxf(mx, kl[w * 4 + tid]);
            __hip_atomic_fetch_max(kmx_out + b * 4 + tid, __float_as_uint(mx), __ATOMIC_RELAXED, __HIP_MEMORY_SCOPE_AGENT); }
        if (tid >= 256) { const int hd = tid - 256; float s = 0.f;
#pragma unroll
            for (int w = 0; w < 8; ++w) s += ks[w * 256 + hd];
            KMEAN[(((size_t)(b * 4 + (hd >> 6)) * 16 + blk) * 2 + hf) * 64 + (hd & 63)] = s; }
    }
    __syncthreads();
}

__device__ __forceinline__ void conv_unit(LAS unsigned char* lds, const bf16* PROJ, bf16* O, const float* __restrict__ cw, const float* __restrict__ cb, const float* __restrict__ lng, const float* __restrict__ lnb, int unit, const int tid) {
    LAS float* zc = (LAS float*)lds;
    const int lane = tid & 63, wave = __builtin_amdgcn_readfirstlane(tid >> 6);
    const int b = unit >> 6, p0 = (unit & 63) * 64;
    const int ch = tid & 255, half = tid >> 8;
    {
        typedef unsigned u32x2v __attribute__((ext_vector_type(2)));
        u32x2v av[12], gv[12];
#pragma unroll
        for (int i = 0; i < 12; ++i) { const int r = wave + 8 * i, p = p0 - 30 + r; av[i] = (u32x2v){0u, 0u}; gv[i] = (u32x2v){0u, 0u};
            if (r < 94 && p >= 0) { const bf16* row = PROJ + ((size_t)b * SEQ + p) * PJ_LD; av[i] = *(const u32x2v*)(row + PJ_DA + 4 * lane); gv[i] = *(const u32x2v*)(row + PJ_DG + 4 * lane); } }
#pragma unroll
        for (int i = 0; i < 12; ++i) { const int r = wave + 8 * i;
            if (r < 94) *(LAS f32x4*)(zc + r * 256 + 4 * lane) = (f32x4){bflo(av[i].x) * fast_sigmoid(bflo(gv[i].x)), bfhi(av[i].x) * fast_sigmoid(bfhi(gv[i].x)), bflo(av[i].y) * fast_sigmoid(bflo(gv[i].y)), bfhi(av[i].y) * fast_sigmoid(bfhi(gv[i].y))}; }
    }
    float w[31];
#pragma unroll
    for (int j = 0; j < 31; ++j) w[j] = cw[j * 256 + ch];
    const float bias = cb[ch];
    __syncthreads();
    float acc[32];
    {
        float z[62];
#pragma unroll
        for (int j = 0; j < 62; ++j) z[j] = zc[(half * 32 + j) * 256 + ch];
#pragma unroll
        for (int t = 0; t < 32; ++t) { float a = bias;
#pragma unroll
            for (int j = 0; j < 31; ++j) a += w[j] * z[t + j];
            acc[t] = a; }
    }
    __syncthreads();
#pragma unroll
    for (int t = 0; t < 32; ++t) zc[(half * 32 + t) * 256 + ch] = acc[t];
    __syncthreads();
    const f32x4 g4 = *(const f32x4*)(lng + lane * 4), b4 = *(const f32x4*)(lnb + lane * 4);
    for (int i4 = 0; i4 < 2; ++i4) {
        f32x4 x[4]; float mu[4], var[4];
#pragma unroll
        for (int u = 0; u < 4; ++u) { x[u] = *(const LAS f32x4*)(zc + (wave * 8 + i4 * 4 + u) * 256 + lane * 4); mu[u] = (x[u][0] + x[u][1]) + (x[u][2] + x[u][3]); }
#pragma unroll
        for (int u = 0; u < 4; ++u) mu[u] = wave_sum(mu[u]) * (1.0f / 256.0f);
#pragma unroll
        for (int u = 0; u < 4; ++u) { x[u] = x[u] - mu[u]; var[u] = (x[u][0] * x[u][0] + x[u][1] * x[u][1]) + (x[u][2] * x[u][2] + x[u][3] * x[u][3]); }
#pragma unroll
        for (int u = 0; u < 4; ++u) var[u] = wave_sum(var[u]) * (1.0f / 256.0f);
#pragma unroll
        for (int u = 0; u < 4; ++u) { const float rstd = rsqrtf(var[u] + EPS);
            const float y0 = x[u][0] * rstd * g4[0] + b4[0], y1 = x[u][1] * rstd * g4[1] + b4[1], y2 = x[u][2] * rstd * g4[2] + b4[2], y3 = x[u][3] * rstd * g4[3] + b4[3];
            typedef unsigned u32x2v __attribute__((ext_vector_type(2)));
            u32x2v wv; wv.x = pkbf(fast_silu(y0), fast_silu(y1)); wv.y = pkbf(fast_silu(y2), fast_silu(y3));
            *(u32x2v*)(O + ((size_t)b * SEQ + p0 + wave * 8 + i4 * 4 + u) * DM + 768 + lane * 4) = wv; }
    }
    __syncthreads();
}

typedef float f32x16 __attribute__((ext_vector_type(16)));
template <int DK> struct AttnLds { static constexpr int KBYTES = 64 * DK * 2  , VP = 68, VBYTES = 64 * VP * 2, K0 = 0, K1 = KBYTES, V0 = 2 * KBYTES, V1 = 2 * KBYTES + VBYTES, UM = 2 * KBYTES + 2 * VBYTES; };
__device__ __forceinline__ float half_max(float v) { auto rr = __builtin_amdgcn_permlane32_swap(__float_as_uint(v), __float_as_uint(v), false, false); return fmaxf(__uint_as_float(rr[0]), __uint_as_float(rr[1])); }
#define ATT_FAST_BOUND 30.0f
__device__ __forceinline__ void softmax_fast(f32x16& s, float& l, bf16x8 (&p)[2], const bool diag, const bool blocked, const int qi, const int kbase) {
    if (diag) {
#pragma unroll
        for (int r = 0; r < 16; ++r) { const int key = kbase + (r & 3) + 8 * (r >> 2); if (key > qi) s[r] = -INFINITY; }
    }
    float sum = 0.f;
#pragma unroll
    for (int r = 0; r < 16; ++r) { const float e = __builtin_amdgcn_exp2f(s[r]); s[r] = e; sum += e; }
    v4u w0, w1;
    w0.x = pkbf(s[0], s[1]); w0.y = pkbf(s[2], s[3]); w0.z = pkbf(s[4], s[5]); w0.w = pkbf(s[6], s[7]);
    w1.x = pkbf(s[8], s[9]); w1.y = pkbf(s[10], s[11]); w1.z = pkbf(s[12], s[13]); w1.w = pkbf(s[14], s[15]);
    if (blocked) { sum = 0.f; w0 = (v4u){0u, 0u, 0u, 0u}; w1 = (v4u){0u, 0u, 0u, 0u}; }
    l += sum;
    p[0] = __builtin_bit_cast(bf16x8, w0); p[1] = __builtin_bit_cast(bf16x8, w1);
}
__device__ __forceinline__ void softmax_group(f32x16& s, f32x16 (&o)[2], float& m, float& l, bf16x8 (&p)[2], const bool diag, const bool blocked, const int qi, const int kbase) {
    if (diag) {
#pragma unroll
        for (int r = 0; r < 16; ++r) { const int key = kbase + (r & 3) + 8 * (r >> 2); if (key > qi) s[r] = -INFINITY; }
    }
    float mx = fmaxf(s[0], s[1]);
#pragma unroll
    for (int r = 2; r < 16; ++r) mx = fmaxf(mx, s[r]);
    mx = half_max(mx);
    if (blocked) mx = -INFINITY;
    const float mn = fmaxf(m, mx);
    const float ms = (mn == -INFINITY) ? 0.f : mn;
    const float alpha = __builtin_amdgcn_exp2f(m - ms);
    const float mse = blocked ? INFINITY : ms;
    float sum = 0.f;
#pragma unroll
    for (int r = 0; r < 16; ++r) { const float e = __builtin_amdgcn_exp2f(s[r] - mse); s[r] = e; sum += e; }
    l = l * alpha + sum; m = mn;
    if (__any(alpha != 1.f)) {
#pragma unroll
        for (int dt = 0; dt < 2; ++dt)
#pragma unroll
            for (int r = 0; r < 16; ++r) o[dt][r] *= alpha;
    }
#pragma unroll
    for (int st = 0; st < 2; ++st) { const int bs = 8 * st;
        v4u w; w.x = pkbf(s[bs], s[bs + 1]); w.y = pkbf(s[bs + 2], s[bs + 3]); w.z = pkbf(s[bs + 4], s[bs + 5]); w.w = pkbf(s[bs + 6], s[bs + 7]);
        p[st] = __builtin_bit_cast(bf16x8, w); }
}
template <int NKS, int DK>
__device__ __forceinline__ float qpost(bf16x8 (&qf)[NKS], const float* __restrict__ qgain, const float* __restrict__ tabrow, const int hi) {
    float qv[8 * NKS]; float ss = 0.f;
#pragma unroll
    for (int ks = 0; ks < NKS; ++ks) unpack8(__builtin_bit_cast(v4u, qf[ks]), qv + 8 * ks);
#pragma unroll
    for (int i = 0; i < 8 * NKS; ++i) ss += qv[i] * qv[i];
    const float rstd = rsqrtf(half_sum(ss) * (1.0f / (float)DK) + EPS);
#pragma unroll
    for (int ks = 0; ks < NKS; ++ks) { const f32x4 ga = *(const f32x4*)(qgain + 16 * ks + 8 * hi), gb = *(const f32x4*)(qgain + 16 * ks + 8 * hi + 4);
#pragma unroll
        for (int j = 0; j < 4; ++j) { qv[8 * ks + j] *= rstd * ga[j]; qv[8 * ks + 4 + j] *= rstd * gb[j]; } }
    const float* tb = tabrow + 16 + 16 * hi;
#pragma unroll
    for (int j = 0; j < 8; ++j) { const float cs = tb[2 * j], sn = tb[2 * j + 1], x1 = qv[32 + j], x2 = qv[40 + j]; qv[32 + j] = x1 * cs - x2 * sn; qv[40 + j] = x2 * cs + x1 * sn; }
    float q2 = 0.f;
#pragma unroll
    for (int i = 0; i < 8 * NKS; ++i) { qv[i] *= QS_C; q2 += qv[i] * qv[i]; }
#pragma unroll
    for (int ks = 0; ks < NKS; ++ks) qf[ks] = __builtin_bit_cast(bf16x8, pack8(qv + 8 * ks));
    return half_sum(q2);
}
template <int DK, bool MOBA, bool QPOST, int qp, int qhs, int kp, int khs, int vp, int vhs, int op>
__device__ __forceinline__ void attn_unit(LAS unsigned char* lds, const bf16* __restrict__ Q, const bf16* __restrict__ K,
                                          const bf16* __restrict__ V, bf16* O, const int b, const int h, const int qc, const float* __restrict__ kmean, const float* __restrict__ qgain, const float* __restrict__ rope, const unsigned* __restrict__ kmx, const int tid) {
    using L = AttnLds<DK>;
    constexpr int NKS = DK / 16, KCH = DK / 8;
    const int lane = tid & 63, w = __builtin_amdgcn_readfirstlane(tid >> 6), r32 = lane & 31, hi = lane >> 5;
    const int q0 = qc * 512;
    const size_t tokbase = (size_t)b * SEQ;
    const int g0 = w, g1 = 15 - w;
    const int qi0 = q0 + 32 * g0 + r32, qi1 = q0 + 32 * g1 + r32;
    const int tl0 = (q0 + 32 * g0 + 31) >> 6, tl1 = (q0 + 32 * g1 + 31) >> 6;
    const int ob0 = (q0 + 32 * g0) >> 8, ob1 = (q0 + 32 * g1) >> 8;
    bf16x8 qf0[NKS], qf1[NKS];
    { const bf16* p0 = Q + (tokbase + qi0) * qp + h * qhs + 8 * hi;
#pragma unroll
      for (int ks = 0; ks < NKS; ++ks) qf0[ks] = *(const bf16x8*)(p0 + 16 * ks); }
    float q2a = 0.f, q2b = 0.f;
    if (QPOST) { q2a = qpost<NKS, DK>(qf0, qgain, rope + (tokbase + qi0) * 48, hi); asm volatile("" ::: "memory"); }
    { const bf16* p1 = Q + (tokbase + qi1) * qp + h * qhs + 8 * hi;
#pragma unroll
      for (int ks = 0; ks < NKS; ++ks) qf1[ks] = *(const bf16x8*)(p1 + 16 * ks); }
    if (QPOST) { q2b = qpost<NKS, DK>(qf1, qgain, rope + (tokbase + qi1) * 48, hi); asm volatile("" ::: "memory"); }
    unsigned mk0 = 0u, mk1 = 0u, umask = 0xffffffffu;
    if (MOBA) {
        LAS float* kml = (LAS float*)(lds + L::UM + 16);
        { const float* kmg = kmean + (size_t)(b * 4 + h) * 16 * 128;
          for (int i = tid; i < 1024; i += NTHR) { const int n = i >> 6, d = i & 63; kml[i] = (kmg[n * 128 + d] + kmg[n * 128 + 64 + d]) * (1.0f / 256.0f); } }
        __syncthreads();
        const LAS float* km = kml + 8 * hi;
#pragma unroll
        for (int g = 0; g < 2; ++g) {
            float qv[8 * NKS];
#pragma unroll
            for (int ks = 0; ks < NKS; ++ks) unpack8(__builtin_bit_cast(v4u, g ? qf1[ks] : qf0[ks]), qv + 8 * ks);
            { float q2 = 0.f;
#pragma unroll
              for (int i = 0; i < 8 * NKS; ++i) q2 += qv[i] * qv[i];
              q2 = half_sum(q2); if (g) q2b = q2; else q2a = q2; }
            const int ob = g ? ob1 : ob0;
            float s0 = -INFINITY, s1 = -INFINITY, s2 = -INFINITY; int i0 = 0, i1 = 0, i2 = 0;
            for (int n = 0; n < ob; ++n) {
                const LAS float* kmp = km + n * 64; float sc = 0.f;
#pragma unroll
                for (int ks = 0; ks < NKS; ++ks) { const f32x4 ka = *(const LAS f32x4*)(kmp + 16 * ks), kb2 = *(const LAS f32x4*)(kmp + 16 * ks + 4);
                    sc += qv[8 * ks] * ka[0]; sc += qv[8 * ks + 1] * ka[1]; sc += qv[8 * ks + 2] * ka[2]; sc += qv[8 * ks + 3] * ka[3];
                    sc += qv[8 * ks + 4] * kb2[0]; sc += qv[8 * ks + 5] * kb2[1]; sc += qv[8 * ks + 6] * kb2[2]; sc += qv[8 * ks + 7] * kb2[3]; }
                sc = half_sum(sc);
                if (sc > s0) { s2 = s1; i2 = i1; s1 = s0; i1 = i0; s0 = sc; i0 = n; }
                else if (sc > s1) { s2 = s1; i2 = i1; s1 = sc; i1 = n; }
                else if (sc > s2) { s2 = sc; i2 = n; }
            }
            unsigned mk = 0u; if (ob > 0) mk |= 1u << i0; if (ob > 1) mk |= 1u << i1; if (ob > 2) mk |= 1u << i2;
            if (g) mk1 = mk; else mk0 = mk;
        }
        LAS unsigned* um = (LAS unsigned*)(lds + L::UM);
        if (tid == 0) *um = 0u;
        __syncthreads();
        __hip_atomic_fetch_or(um, mk0 | mk1, __ATOMIC_RELAXED, __HIP_MEMORY_SCOPE_WORKGROUP);
        __syncthreads();
        umask = *um;
    }
    const float k2m = __uint_as_float(__hip_atomic_load(kmx + b * 4 + h, __ATOMIC_RELAXED, __HIP_MEMORY_SCOPE_AGENT));
    const bool fast = __all(fmaxf(q2a, q2b) * k2m <= ATT_FAST_BOUND * ATT_FAST_BOUND);
    const int ntile = qc * 8 + 8;
    v4u vreg = {0u, 0u, 0u, 0u};
#define ATT_NEEDED(t) (!MOBA || ((t) >> 2) >= 2 * qc || ((umask >> ((t) >> 2)) & 1u))
#define ATT_LOADK(t, buf) do { const bf16* kt_ = K + (tokbase + (size_t)(t) * 64) * kp + h * khs; int ln_ = lane; asm volatile("" : "+v"(ln_)); \
        LAS unsigned char* kd_ = lds + ((buf) ? L::K1 : L::K0) + w * 1024; \
        __builtin_amdgcn_global_load_lds((const unsigned*)(kt_ + ln_ * kp + w * 8), (LAS unsigned*)kd_, 16, 0, 0); \
        if (DK == 96 && w < 4) __builtin_amdgcn_global_load_lds((const unsigned*)(kt_ + ln_ * kp + (8 + w) * 8), (LAS unsigned*)(kd_ + 8192), 16, 0, 0); } while (0)
#define ATT_LOADV(t) do { int t2_ = tid; asm volatile("" : "+v"(t2_)); const int vkey = t2_ >> 3, vch = t2_ & 7; \
        vreg = *(const v4u*)(V + (tokbase + (size_t)(t) * 64) * vp + (vkey * vp + h * vhs + vch * 8)); } while (0)
    unsigned krd_lane = (unsigned)(hi * 1024 + r32 * 16), vrd_lane = (unsigned)((r32 * L::VP + 4 * hi) * 2);
    asm volatile("" : "+v"(krd_lane), "+v"(vrd_lane));
#define ATT_STOREV(buf) do { int t2_ = tid; asm volatile("" : "+v"(t2_)); const int vkey = t2_ >> 3, vch = t2_ & 7; \
        LAS unsigned char* vtb_ = lds + ((buf) ? L::V1 : L::V0) + ((vch * 8) * L::VP + vkey) * 2; asm volatile("" : "+v"(vtb_)); LAS bf16* vt_ = (LAS bf16*)vtb_; \
        vt_[0 * L::VP] = (bf16)(vreg.x & 0xffffu); vt_[1 * L::VP] = (bf16)(vreg.x >> 16); vt_[2 * L::VP] = (bf16)(vreg.y & 0xffffu); vt_[3 * L::VP] = (bf16)(vreg.y >> 16); \
        vt_[4 * L::VP] = (bf16)(vreg.z & 0xffffu); vt_[5 * L::VP] = (bf16)(vreg.z >> 16); vt_[6 * L::VP] = (bf16)(vreg.w & 0xffffu); vt_[7 * L::VP] = (bf16)(vreg.w >> 16); } while (0)
    int t = 0; while (t < ntile && !ATT_NEEDED(t)) t += 4;
    ATT_LOADK(t, 0); ATT_LOADV(t); ATT_STOREV(0);
    asm volatile("s_waitcnt vmcnt(0)" ::: "memory");
    __syncthreads();
    f32x16 o0[2], o1[2];
#pragma unroll
    for (int dt = 0; dt < 2; ++dt)
#pragma unroll
        for (int r = 0; r < 16; ++r) { o0[dt][r] = 0.f; o1[dt][r] = 0.f; }
    float m0 = -INFINITY, m1 = -INFINITY, l0 = 0.f, l1 = 0.f;
    int cur = 0;
#define ATT_LOOP(FASTP) do { \
    while (t < ntile) { \
        int tn = t + 1; while (tn < ntile && (tn & 3) == 0 && !ATT_NEEDED(tn)) tn += 4; \
        if (tn < ntile) { ATT_LOADK(tn, cur ^ 1); ATT_LOADV(tn); }    \
        const int nblk = t >> 2; \
        bool a0 = (t <= tl0), a1 = (t <= tl1); \
        bool bl0 = false, bl1 = false; \
        if (MOBA) { \
            bl0 = (nblk != ob0) && !((mk0 >> nblk) & 1u); bl1 = (nblk != ob1) && !((mk1 >> nblk) & 1u); \
            a0 = a0 && __any(!bl0); a1 = a1 && __any(!bl1); \
        } \
        if (a0 || a1) { \
            const LAS unsigned char* kb = lds + (cur ? L::K1 : L::K0) + krd_lane; const LAS unsigned char* vb = lds + (cur ? L::V1 : L::V0) + vrd_lane; \
            asm volatile("" : "+v"(kb), "+v"(vb)); \
_Pragma("unroll") \
            for (int kt = 0; kt < 2; ++kt) { \
                f32x16 s0, s1; \
_Pragma("unroll") \
                for (int r = 0; r < 16; ++r) { s0[r] = 0.f; s1[r] = 0.f; } \
_Pragma("unroll") \
                for (int ks = 0; ks < NKS; ++ks) { \
                    const bf16x8 kf = *(const LAS bf16x8*)(kb + (2 * ks * 1024 + 32 * kt * 16)); \
                    if (a0) s0 = __builtin_amdgcn_mfma_f32_32x32x16_bf16(kf, qf0[ks], s0, 0, 0, 0); \
                    if (a1) s1 = __builtin_amdgcn_mfma_f32_32x32x16_bf16(kf, qf1[ks], s1, 0, 0, 0); \
                } \
                bf16x8 p0[2], p1[2]; \
                const int kbase = 64 * t + 32 * kt + 4 * hi; \
                if (a0) { if (FASTP) softmax_fast(s0, l0, p0, t == tl0, bl0, qi0, kbase); else softmax_group(s0, o0, m0, l0, p0, t == tl0, bl0, qi0, kbase); } \
                __builtin_amdgcn_sched_barrier(0);    \
                if (a1) { if (FASTP) softmax_fast(s1, l1, p1, t == tl1, bl1, qi1, kbase); else softmax_group(s1, o1, m1, l1, p1, t == tl1, bl1, qi1, kbase); } \
                __builtin_amdgcn_sched_barrier(0); \
_Pragma("unroll") \
                for (int st = 0; st < 2; ++st) \
_Pragma("unroll") \
                    for (int dt = 0; dt < 2; ++dt) { \
                        typedef unsigned u32x2v __attribute__((ext_vector_type(2))); \
                        const LAS unsigned char* vp_ = vb + (32 * dt * L::VP + 32 * kt + 16 * st) * 2; \
                        const u32x2v va = *(const LAS u32x2v*)vp_, vc = *(const LAS u32x2v*)(vp_ + 16); \
                        const v4u vv = {va.x, va.y, vc.x, vc.y}; const bf16x8 vf = __builtin_bit_cast(bf16x8, vv); \
                        if (a0) o0[dt] = __builtin_amdgcn_mfma_f32_32x32x16_bf16(vf, p0[st], o0[dt], 0, 0, 0); \
                        if (a1) o1[dt] = __builtin_amdgcn_mfma_f32_32x32x16_bf16(vf, p1[st], o1[dt], 0, 0, 0); \
                    } \
            } \
        } \
        if (tn < ntile) ATT_STOREV(cur ^ 1); \
        asm volatile("s_waitcnt vmcnt(0)" ::: "memory"); \
        __syncthreads(); \
        t = tn; cur ^= 1; \
    } \
    } while (0)
    if (fast) ATT_LOOP(true); else ATT_LOOP(false);
#undef ATT_LOOP
#undef ATT_NEEDED
#undef ATT_LOADK
#undef ATT_LOADV
#undef ATT_STOREV
    {
        typedef unsigned u32x2v __attribute__((ext_vector_type(2)));
        const float i0 = 1.0f / half_sum(l0), i1 = 1.0f / half_sum(l1);
        bf16* d0 = O + (tokbase + qi0) * op + h * 64 + 4 * hi; bf16* d1 = O + (tokbase + qi1) * op + h * 64 + 4 * hi;
#pragma unroll
        for (int dt = 0; dt < 2; ++dt)
#pragma unroll
            for (int j = 0; j < 4; ++j) {
                u32x2v wa; wa.x = pkbf(o0[dt][4 * j] * i0, o0[dt][4 * j + 1] * i0); wa.y = pkbf(o0[dt][4 * j + 2] * i0, o0[dt][4 * j + 3] * i0); *(u32x2v*)(d0 + 32 * dt + 8 * j) = wa;
                u32x2v wb; wb.x = pkbf(o1[dt][4 * j] * i1, o1[dt][4 * j + 1] * i1); wb.y = pkbf(o1[dt][4 * j + 2] * i1, o1[dt][4 * j + 3] * i1); *(u32x2v*)(d1 + 32 * dt + 8 * j) = wb;
            }
    }
}
struct Args { const void* in[31]; float* out; unsigned char* ws; int ph_lo, ph_hi; };
constexpr int N_PHASES = 1 + 8 + 11 + 8 + 11;
typedef const __attribute__((address_space(4))) Args* KArgs;
__device__ __forceinline__ KArgs kargs() { KArgs p = (KArgs)__builtin_amdgcn_kernarg_segment_ptr(); asm volatile("" : "+s"(p)); return p; }
#define IN_F(i) ((const float*)A->in[i])
#define WSP(type, off) ((type*)(ws + (off)))
#ifndef TPROBE
#define TPROBE 0
#endif
#define TP_BID 203
#define TP_ACC(lds) ((LAS unsigned long long*)((lds) + MISC_OFF + 64))
#define TP_BEGIN(id) unsigned long long tp0_##id = 0ull; if (TPROBE == (id)) { __syncthreads(); tp0_##id = __builtin_amdgcn_s_memrealtime(); }
#define TP_END(id, lds) if (TPROBE == (id)) { __syncthreads(); if (blockIdx.x == TP_BID && threadIdx.x == 0) *TP_ACC(lds) += __builtin_amdgcn_s_memrealtime() - tp0_##id; }
struct Ctx { int tid, lane, wave, G, bid, gw, NGW, gt, NGT; };
__device__ __forceinline__ Ctx mkctx(int wv) {
    Ctx c; unsigned m = ~0u; asm volatile("" : "+s"(m)); const int ln = (int)__builtin_amdgcn_mbcnt_hi(m, __builtin_amdgcn_mbcnt_lo(m, 0u));
    int b = blockIdx.x; asm volatile("" : "+s"(b)); int w = wv; asm volatile("" : "+s"(w));
    c.tid = w * 64 + ln; c.lane = ln; c.wave = w; c.G = gridDim.x; c.bid = b;
    c.gw = c.bid * NWAVES + c.wave; c.NGW = c.G * NWAVES; c.gt = c.bid * NTHR + c.tid; c.NGT = c.G * NTHR; return c; }

__device__ __forceinline__ void conv_mixer_weights(int wv, LAS unsigned char* lds, int l) {
    const Ctx c = mkctx(wv);
    KArgs A = kargs(); unsigned char* ws = A->ws;
    const int lane = c.lane, gw = c.gw, NGW = c.NGW, gt = c.gt, NGT = c.NGT;
    LAS float* scr = (LAS float*)(lds + RING_OFF + c.wave * 16384); LAS TrDesc* tab = (LAS TrDesc*)(lds + RING_OFF + TR_TAB_OFF); asm volatile("" : "+v"(tab));
    bf16* WINR = WSP(bf16, W_INR); bf16* WUQ = WSP(bf16, W_UQ); bf16* WUKV = WSP(bf16, W_UKV);
    int total = 0;
    if (c.tid == 0) {
        int n = 0, cum = 0;
        const float* an = IN_F(2) + l * DM; const float* win = IN_F(4) + (size_t)l * DM * IN_COLS;
        tr_add(tab, n, cum, win, IN_COLS, DM, 4096, 0, WSP(bf16, W_G), DM, 0, 3, an);
        tr_add(tab, n, cum, win, IN_COLS, DM, 1280, 4096, WINR, DM, 0, 0, an);
        tr_add(tab, n, cum, win, IN_COLS, DM, 512, 5728, WINR, DM, 1280, 0, an);
        tr_add(tab, n, cum, win, IN_COLS, DM, 352, 5376, WINR, DM, 1792, 0, an);
        tr_add(tab, n, cum, IN_F(13) + (size_t)l * 192 * 384, 384, 192, 384, 0, WUQ, 256, 0, 0, IN_F(11) + l * 192);
        tr_add(tab, n, cum, IN_F(14) + (size_t)l * 128 * 512, 512, 128, 512, 0, WUKV, 256, 0, 2, IN_F(12) + l * 128);
        for (int nb = 0; nb < 4; ++nb) tr_add(tab, n, cum, IN_F(21) + ((size_t)l * 4 + nb) * 256 * DM, DM, 256, DM, 0, WSP(bf16, W_B), 256, nb * 1024, 0, nullptr);
        tr_add(tab, n, cum, IN_F(22) + (size_t)l * DM * DM, DM, DM, DM, 0, WSP(bf16, W_OUT), DM, 0, 0, nullptr);
        tab[n].cum = cum; tab[31].cum = cum;
    }
    __syncthreads();
    total = tab[31].cum;
    tr_run(tab, total, scr, lane, gw, NGW);
    unsigned zz = 0u; asm volatile("" : "+v"(zz)); const v4u z4 = {zz, zz, zz, zz};
    for (int i = gt; i < 160 * DM / 8; i += NGT) ((v4u*)(WINR + (size_t)2144 * DM))[i] = z4;
    for (int i = gt; i < 128 * 256 / 8; i += NGT) ((v4u*)(WUQ + (size_t)384 * 256))[i] = z4;
    for (int i = gt; i < 384 * 8; i += NGT) ((v4u*)(WUQ + (size_t)(i >> 3) * 256 + 192))[i & 7] = z4;
    for (int i = gt; i < 512 * 16; i += NGT) ((v4u*)(WUKV + (size_t)(i >> 4) * 256 + 128))[i & 15] = z4;
    {
        const float* wsrc = IN_F(7) + (size_t)l * 4 * 128 * 128; bf16* wm = WSP(bf16, MS_WSGU);
        for (int i = gt; i < 4 * 128 * 128 / 8; i += NGT) {
            const int t = (i >> 4) & 127, s0 = (i & 15) * 8; const f32x4 a = *(const f32x4*)(wsrc + (size_t)i * 8), b = *(const f32x4*)(wsrc + (size_t)i * 8 + 4);
            float f[8] = {a[0], a[1], a[2], a[3], b[0], b[1], b[2], b[3]};
#pragma unroll
            for (int j = 0; j < 8; ++j) f[j] = (s0 + j <= t) ? f[j] : 0.f;
            *(v4u*)(wm + (size_t)i * 8) = pack8(f);
        }
    }
    __syncthreads();
}
__device__ __forceinline__ void conv_ffn_weights(int wv, LAS unsigned char* lds, int l, int first) {
    const Ctx c = mkctx(wv);
    if (c.bid < first) return;
    KArgs A = kargs(); unsigned char* ws = A->ws;
    LAS float* scr = (LAS float*)(lds + RING_OFF + c.wave * 16384); LAS TrDesc* tab = (LAS TrDesc*)(lds + RING_OFF + TR_TAB_OFF); asm volatile("" : "+v"(tab));
    if (c.tid == 0) {
        int n = 0, cum = 0; const bool moe = (l & 1) != 0; const int li = l >> 1; const float* fn = IN_F(3) + l * DM;
        if (!moe) {
            tr_add(tab, n, cum, IN_F(23) + (size_t)li * DM * FFN, FFN, DM, FFN, 0, WSP(bf16, W_F1), DM, 0, 1, fn);
            tr_add(tab, n, cum, IN_F(24) + (size_t)li * DM * FFN, FFN, DM, FFN, 0, WSP(bf16, W_F1), DM, 128, 1, fn);
            tr_add(tab, n, cum, IN_F(25) + (size_t)li * FFN * DM, DM, FFN, DM, 0, WSP(bf16, W_F2), FFN, 0, 0, nullptr);
        } else {
            for (int e = 0; e < NE; ++e) {
                tr_add(tab, n, cum, IN_F(28) + ((size_t)li * NE + e) * DM * EDIM, EDIM, DM, EDIM, 0, WSP(bf16, W_F1), DM, e * 2 * EDIM, 1, fn);
                tr_add(tab, n, cum, IN_F(29) + ((size_t)li * NE + e) * DM * EDIM, EDIM, DM, EDIM, 0, WSP(bf16, W_F1), DM, e * 2 * EDIM + 128, 1, fn);
                tr_add(tab, n, cum, IN_F(30) + ((size_t)li * NE + e) * EDIM * DM, DM, EDIM, DM, 0, WSP(bf16, W_F2), EDIM, e * DM, 0, nullptr);
            }
        }
        tab[n].cum = cum; tab[31].cum = cum;
    }
    __syncthreads();
    tr_run(tab, tab[31].cum, scr, c.lane, c.gw - first * NWAVES, c.NGW - first * NWAVES);
    __syncthreads();
}
__device__ __forceinline__ void ph_prologue(int wv, LAS unsigned char* lds) {
    conv_mixer_weights(wv, lds, 0);
    const Ctx c = mkctx(wv);
    KArgs A = kargs(); unsigned char* ws = A->ws;
    const int lane = c.lane, gw = c.gw, NGW = c.NGW, gt = c.gt, NGT = c.NGT;
    {
        const float* x_in = IN_F(0); const int* positions = (const int*)A->in[1];
        bf16* XB = WSP(bf16, WS_XB); float* SSA = WSP(float, WS_SSA); float* ROPE = WSP(float, WS_ROPE);
        for (int mrow = gw; mrow < T; mrow += NGW) {
            const f32x4* xr = (const f32x4*)(x_in + (size_t)mrow * DM) + lane; float s = 0.f;
            typedef unsigned u32x2v __attribute__((ext_vector_type(2)));
            u32x2v* o8 = (u32x2v*)(XB + (size_t)mrow * DM) + lane;
#pragma unroll
            for (int j = 0; j < 4; ++j) { const f32x4 v = xr[64 * j]; s += (v[0] * v[0] + v[1] * v[1]) + (v[2] * v[2] + v[3] * v[3]); u32x2v w; w.x = pkbf(v[0], v[1]); w.y = pkbf(v[2], v[3]); o8[64 * j] = w; }
            s = wave_sum(s);
            if (lane < 4) SSA[(size_t)mrow * 4 + lane] = (lane == 0) ? s : 0.f;
        }
        for (int i = gt; i < T * 24; i += NGT) {
            const int tok = i / 24, a = i - tok * 24;
            const float inv = (a < 8) ? powf(500000.0f, -(float)a * 0.125f) : powf(500000.0f, -(float)(a - 8) * 0.0625f);
            const float ang = (float)positions[tok] * inv; float sn, cs; sincosf(ang, &sn, &cs);
            ROPE[(size_t)tok * 48 + 2 * a] = cs; ROPE[(size_t)tok * 48 + 2 * a + 1] = sn;
        }
    }
}
__device__ __forceinline__ void ph_inproj(int wv, LAS unsigned char* lds, int l) {
    const Ctx c = mkctx(wv);
    KArgs A = kargs(); unsigned char* ws = A->ws;
    pg8::Gemm g{WSP(bf16, WS_XB), WSP(bf16, W_INR), DM, DM, DM}; pg8::StaticOrder S; S.init(T, PJ_LD, c.G, c.bid);
    pg8::EpiScale<0> E{WSP(bf16, B_PROJ), PJ_LD, pg8::RowScale{WSP(float, WS_SSA), 1}, WSP(float, WS_SSC)};
    pg8::gemm_phase<pg8::EpiScale<0>, pg8::StaticOrder, true, true>(lds + RING_OFF, g, S, E, c.tid);
    __syncthreads();
    { const Ctx c3 = mkctx(wv); const int rem = ((T / 256) * (PJ_LD / 256)) % c3.G; conv_ffn_weights(wv, lds, l, rem); }
}
__device__ __forceinline__ void mla_up_gemms(int wv, LAS unsigned char* lds, int l) {
    const Ctx c = mkctx(wv);
    { KArgs A = kargs(); unsigned char* ws = A->ws;
      pg8::Gemm g{WSP(bf16, B_PROJ) + PJ_CQ, WSP(bf16, W_UQ), PJ_LD, 256, 256}; pg8::StaticOrder S; S.init(T, 512, c.G, c.bid);
      pg8::EpiScale<0> E{WSP(bf16, B_QPRE), 512, pg8::RowScale{WSP(float, WS_SSC), 3}, nullptr};
      pg8::gemm_phase<pg8::EpiScale<0>, pg8::StaticOrder, true, true>(lds + RING_OFF, g, S, E, c.tid); }
    { KArgs A = kargs(); unsigned char* ws = A->ws;
      pg8::Gemm g{WSP(bf16, B_PROJ) + PJ_CKV, WSP(bf16, W_UKV), PJ_LD, 256, 256}; pg8::StaticOrder S; S.init(T, 512, c.G, c.bid);
      pg8::EpiKV E{WSP(bf16, B_CK), WSP(bf16, B_KVPRE), WSP(bf16, B_PROJ), WSP(float, WS_SSC), WSP(float, WS_ROPE), IN_F(16) + l * 96, (unsigned*)(ws + WS_CTL) + CW_KMX + (l * 2 + 1) * 32};
      pg8::gemm_phase<pg8::EpiKV, pg8::StaticOrder, true, true>(lds + RING_OFF, g, S, E, c.tid); }
}
__device__ __forceinline__ void ph_prep(int wv, LAS unsigned char* lds, int l) {
    TP_BEGIN(4) mla_up_gemms(wv, lds, l); TP_END(4, lds)
    {
        const Ctx c = mkctx(wv);
        KArgs A = kargs(); unsigned char* ws = A->ws;
        bf16* PROJ = WSP(bf16, B_PROJ); bf16* OB = WSP(bf16, B_O);
        TP_BEGIN(5) for (int it = c.bid; it < NB * 32; it += c.G) prep_block(lds + RING_OFF, PROJ, WSP(float, WS_ROPE), IN_F(9) + l * 64, IN_F(10) + l * 64, WSP(float, MS_KMEAN), (unsigned*)(ws + WS_CTL) + CW_KMX + (l * 2 + 0) * 32, it, c.tid); TP_END(5, lds)
        TP_BEGIN(6) for (int u = c.bid; u < T / 128; u += c.G) sgu_unit(lds + RING_OFF, PROJ, OB, IN_F(5) + l * 256, IN_F(6) + l * 256, WSP(bf16, MS_WSGU), IN_F(8) + l * 4 * 128, u, c.tid); TP_END(6, lds)
        TP_BEGIN(7) for (int u = c.bid; u < T / 64; u += c.G) conv_unit(lds + RING_OFF, PROJ, OB, IN_F(17) + (size_t)l * 31 * 256, IN_F(18) + l * 256, IN_F(19) + l * 256, IN_F(20) + l * 256, u, c.tid); TP_END(7, lds)
        __syncthreads();
    }
}
template <int WHICH>
__device__ __forceinline__ void mla_post_pass(const Ctx& c, int l) {
    KArgs A = kargs(); unsigned char* ws = A->ws;
    const float* gn = IN_F(WHICH ? 16 : 15) + l * 96;
    const bf16* PROJ = WSP(bf16, B_PROJ); const bf16* QPRE = WSP(bf16, B_QPRE); const bf16* KVPRE = WSP(bf16, B_KVPRE);
    bf16* DST = WHICH ? WSP(bf16, B_CK) : WSP(bf16, B_CQ); const float* ROPE = WSP(float, WS_ROPE);
    for (int idx = c.gt; idx < T * 4; idx += c.NGT) {
        const int tok = idx >> 2, h = idx & 3; const float* tab = ROPE + (size_t)tok * 48 + 16;
        float v[96]; float ss = 0.f;
        if (WHICH == 0) {
#pragma unroll
            for (int cc = 0; cc < 12; ++cc) unpack8(((const v4u*)(QPRE + (size_t)tok * 512 + h * 96))[cc], v + 8 * cc);
        } else {
#pragma unroll
            for (int cc = 0; cc < 8; ++cc) unpack8(((const v4u*)(KVPRE + (size_t)tok * 512 + h * 128))[cc], v + 8 * cc);
#pragma unroll
            for (int cc = 0; cc < 4; ++cc) unpack8(((const v4u*)(PROJ + (size_t)tok * PJ_LD + PJ_KR))[cc], v + 64 + 8 * cc);
        }
#pragma unroll
        for (int d = 0; d < 96; ++d) ss += v[d] * v[d];
        const float rstd = rsqrtf(ss * (1.0f / 96.0f) + EPS);
#pragma unroll
        for (int d = 0; d < 96; ++d) v[d] = v[d] * rstd * gn[d];
#pragma unroll
        for (int i = 0; i < 16; ++i) { const float cs = tab[2 * i], sn = tab[2 * i + 1], x1 = v[64 + i], x2 = v[80 + i]; v[64 + i] = x1 * cs - x2 * sn; v[80 + i] = x2 * cs + x1 * sn; }
        if (WHICH == 0) {
#pragma unroll
            for (int d = 0; d < 96; ++d) v[d] *= QS_C;
        }
        bf16* dst = DST + (size_t)tok * 384 + h * 96;
#pragma unroll
        for (int cc = 0; cc < 12; ++cc) ((v4u*)dst)[cc] = pack8(v + 8 * cc);
    }
}
__device__ __forceinline__ void ph_mla_post(int wv, int l) {
    { const Ctx c = mkctx(wv); mla_post_pass<0>(c, l); }
    { const Ctx c = mkctx(wv); mla_post_pass<1>(c, l); }
}
__device__ __forceinline__ void ph_attn(int wv, LAS unsigned char* lds, int l) {
    const Ctx c = mkctx(wv);
    for (int u = c.bid; u < NB * 4 * 8; u += c.G) {
        const int qc = u & 7, h = (u >> 3) & 3, b = u >> 5;
        TP_BEGIN(1) { KArgs A = kargs(); unsigned char* ws = A->ws;
          attn_unit<96, false, true, 512, 96, 384, 96, 256, 64, DM>(lds + RING_OFF, WSP(bf16, B_QPRE), WSP(bf16, B_CK), WSP(bf16, B_KVPRE), WSP(bf16, B_O) + 512, b, h, qc, nullptr, IN_F(15) + l * 96, WSP(float, WS_ROPE), (const unsigned*)(ws + WS_CTL) + CW_KMX + (l * 2 + 1) * 32, c.tid); } TP_END(1, lds)
        TP_BEGIN(2) { KArgs A = kargs(); unsigned char* ws = A->ws; bf16* PROJ = WSP(bf16, B_PROJ);
          attn_unit<64, true, false, PJ_LD, 64, PJ_LD, 64, PJ_LD, 64, DM>(lds + RING_OFF, PROJ + PJ_BQ, PROJ + PJ_BK, PROJ + PJ_BV, WSP(bf16, B_O) + 256, b, h, 7 - qc, WSP(float, MS_KMEAN), nullptr, nullptr, (const unsigned*)(ws + WS_CTL) + CW_KMX + (l * 2 + 0) * 32, c.tid); } TP_END(2, lds)
    }
}
__device__ __forceinline__ void ph_gates(int wv, LAS unsigned char* lds) {
    const Ctx c = mkctx(wv);
    KArgs A = kargs(); unsigned char* ws = A->ws;
    pg8::Gemm g{WSP(bf16, WS_XB), WSP(bf16, W_G), DM, DM, DM}; pg8::StaticOrder S; S.init(T, 4096, c.G, c.bid);
    pg8::EpiGates E{WSP(bf16, B_SG), pg8::RowScale{WSP(float, WS_SSA), 1}};
    pg8::gemm_phase<pg8::EpiGates, pg8::StaticOrder, true, true>(lds + RING_OFF, g, S, E, c.tid);
}
__device__ __forceinline__ void ph_merge(int wv, LAS unsigned char* lds) {
    const Ctx c = mkctx(wv);
    KArgs A = kargs(); unsigned char* ws = A->ws;
    pg8::Gemm g{WSP(bf16, B_O), WSP(bf16, W_B), DM, 256, 256}; pg8::MergeOrder S; S.so.init(T, DM, c.G, c.bid);
    pg8::EpiMerge E{WSP(bf16, B_SG), WSP(bf16, B_Y)};
    pg8::gemm_phase<pg8::EpiMerge, pg8::MergeOrder, true, true>(lds + RING_OFF, g, S, E, c.tid);
}
__device__ __forceinline__ void ph_wout(int wv, LAS unsigned char* lds, int l) {
    const Ctx c = mkctx(wv);
    KArgs A = kargs(); unsigned char* ws = A->ws;
    pg8::Gemm g{WSP(bf16, B_Y), WSP(bf16, W_OUT), DM, DM, DM}; pg8::StaticOrder S; S.init(T, DM, c.G, c.bid);
    pg8::EpiResidual E{WSP(bf16, WS_XB), WSP(float, WS_SSB), (LAS float*)(lds + EPI_RED_OFF)};
    pg8::gemm_phase<pg8::EpiResidual, pg8::StaticOrder, true, true>(lds + RING_OFF, g, S, E, c.tid);
}
__device__ __forceinline__ void ph_ffn_up(int wv, LAS unsigned char* lds) {
    const Ctx c = mkctx(wv);
    KArgs A = kargs(); unsigned char* ws = A->ws;
    pg8::Gemm g{WSP(bf16, WS_XB), WSP(bf16, W_F1), DM, DM, DM}; pg8::StaticOrder S; S.init(T, 2 * FFN, c.G, c.bid);
    pg8::EpiScale<2> E{WSP(bf16, B_HID), FFN, pg8::RowScale{WSP(float, WS_SSB), 1}, nullptr};
    pg8::gemm_phase<pg8::EpiScale<2>, pg8::StaticOrder, true, true>(lds + RING_OFF, g, S, E, c.tid);
}
__device__ __forceinline__ void ph_ffn_down(int wv, LAS unsigned char* lds, int l) {
    const Ctx c = mkctx(wv);
    KArgs A = kargs(); unsigned char* ws = A->ws;
    pg8::Gemm g{WSP(bf16, B_HID), WSP(bf16, W_F2), FFN, FFN, FFN}; pg8::StaticOrder S; S.init(T, DM, c.G, c.bid);
    pg8::EpiResidual E{WSP(bf16, WS_XB), WSP(float, WS_SSA), (LAS float*)(lds + EPI_RED_OFF)};
    pg8::gemm_phase<pg8::EpiResidual, pg8::StaticOrder, true, true>(lds + RING_OFF, g, S, E, c.tid);
    TP_BEGIN(9) if (l < DEPTH - 1) conv_mixer_weights(wv, lds, l + 1); TP_END(9, lds)
}
__device__ __forceinline__ int wave_sum_i(int v) {
    v += __builtin_amdgcn_ds_swizzle(v, (1 << 10) | 0x1f); v += __builtin_amdgcn_ds_swizzle(v, (2 << 10) | 0x1f); v += __builtin_amdgcn_ds_swizzle(v, (4 << 10) | 0x1f);
    v += __builtin_amdgcn_ds_swizzle(v, (8 << 10) | 0x1f); v += __builtin_amdgcn_ds_swizzle(v, (16 << 10) | 0x1f);
    auto rr = __builtin_amdgcn_permlane32_swap((unsigned)v, (unsigned)v, false, false); return (int)rr[0] + (int)rr[1];
}
__device__ __forceinline__ void ph_router(int wv, LAS unsigned char* lds, int l) {
    const Ctx c = mkctx(wv);
    KArgs A = kargs(); unsigned char* ws = A->ws; const int li = l >> 1; const int lane = c.lane;
    const float* fn = IN_F(3) + l * DM; const float* wr_ = IN_F(26) + (size_t)li * DM * NE; const float* rb = IN_F(27) + li * NE;
    const bf16* XBr = WSP(bf16, WS_XB); const float* SSB = WSP(float, WS_SSB); int* TOKE = WSP(int, MS_TOKE); float* TOKW = WSP(float, MS_TOKW);
    int* WCNT = WSP(int, MS_WCNT); int* WGCNT = WSP(int, MS_WGCNT);
    int cnt[8];
#pragma unroll
    for (int e = 0; e < 8; ++e) cnt[e] = 0;
    float wq[16][8];
#pragma unroll
    for (int j = 0; j < 4; ++j) { const int k0 = (64 * j + lane) * 4; const f32x4 gv = *(const f32x4*)(fn + k0);
#pragma unroll
        for (int q = 0; q < 4; ++q) { const f32x4 w0 = *(const f32x4*)(wr_ + (size_t)(k0 + q) * 8), w1 = *(const f32x4*)(wr_ + (size_t)(k0 + q) * 8 + 4);
#pragma unroll
            for (int e = 0; e < 4; ++e) { wq[4 * j + q][e] = gv[q] * w0[e]; wq[4 * j + q][4 + e] = gv[q] * w1[e]; } } }
    float rbv[8];
#pragma unroll
    for (int e = 0; e < 8; ++e) rbv[e] = rb[e];
    for (int tok0 = c.gw; tok0 < T; tok0 += 2 * c.NGW) {
        typedef unsigned u32x2v __attribute__((ext_vector_type(2)));
        f32x4 sp[2]; u32x2v xv[2][4]; bool ok[2];
#pragma unroll
        for (int u = 0; u < 2; ++u) { const int tok = tok0 + u * c.NGW; ok[u] = tok < T; const int tk = ok[u] ? tok : tok0;
            sp[u] = *(const f32x4*)(SSB + (size_t)tk * 4);
#pragma unroll
            for (int j = 0; j < 4; ++j) xv[u][j] = *(const u32x2v*)(XBr + (size_t)tk * DM + (64 * j + lane) * 4); }
        float pl[2][8];
#pragma unroll
        for (int u = 0; u < 2; ++u) { const float rstd = rsqrtf(((sp[u][0] + sp[u][1]) + (sp[u][2] + sp[u][3])) * (1.0f / 1024.0f) + EPS);
#pragma unroll
            for (int e = 0; e < 8; ++e) pl[u][e] = 0.f;
#pragma unroll
            for (int j = 0; j < 4; ++j)
#pragma unroll
                for (int q = 0; q < 4; ++q) { const unsigned xw = (q < 2) ? xv[u][j].x : xv[u][j].y; const float hv = ((q & 1) ? bfhi(xw) : bflo(xw)) * rstd;
#pragma unroll
                    for (int e = 0; e < 8; ++e) pl[u][e] += hv * wq[4 * j + q][e]; } }
#pragma unroll
        for (int e = 0; e < 8; ++e) { pl[0][e] = wave_sum(pl[0][e]) + rbv[e]; pl[1][e] = wave_sum(pl[1][e]) + rbv[e]; }
#pragma unroll
        for (int u = 0; u < 2; ++u) {
            int e0 = 0; float l0 = pl[u][0];
#pragma unroll
            for (int e = 1; e < 8; ++e) if (pl[u][e] > l0) { l0 = pl[u][e]; e0 = e; }
            int e1 = -1; float l1 = -INFINITY;
#pragma unroll
            for (int e = 0; e < 8; ++e) if (e != e0 && pl[u][e] > l1) { l1 = pl[u][e]; e1 = e; }
            const float tt = expf(l1 - l0); const float w0 = 1.0f / (1.0f + tt), w1 = tt / (1.0f + tt);
            if (ok[u]) {
#pragma unroll
                for (int e = 0; e < 8; ++e) cnt[e] += (e == e0 ? 1 : 0) + (e == e1 ? 1 : 0);
                const int tok = tok0 + u * c.NGW;
                if (lane == 0) { TOKE[tok * 2] = e0; TOKE[tok * 2 + 1] = e1; TOKW[tok * 2] = w0; TOKW[tok * 2 + 1] = w1; }
            }
        }
    }
    LAS int* red = (LAS int*)(lds + RING_OFF);
    int mine = 0;
#pragma unroll
    for (int e = 0; e < 8; ++e) mine = (lane == e) ? cnt[e] : mine;
    if (lane < 8) { WCNT[c.gw * 8 + lane] = mine; red[c.wave * 8 + lane] = mine; }
    __syncthreads();
    if (c.tid < 8) { int s = 0;
#pragma unroll
        for (int w = 0; w < NWAVES; ++w) s += red[w * 8 + c.tid];
        WGCNT[c.bid * 8 + c.tid] = s; }
    __syncthreads();
}
__device__ __forceinline__ void ph_assign(int wv, LAS unsigned char* lds, int l) {
    const Ctx c = mkctx(wv);
    KArgs A = kargs(); unsigned char* ws = A->ws; const int lane = c.lane;
    const float* SSB = WSP(float, WS_SSB); const int* TOKE = WSP(int, MS_TOKE); int* TOKS = WSP(int, MS_TOKS); float* RSSLOT = WSP(float, MS_RSSLOT);
    const int* WCNT = WSP(int, MS_WCNT); const int* WGCNT = WSP(int, MS_WGCNT); int* MTOT = WSP(int, MS_MTOT);
    const bf16* XB = WSP(bf16, WS_XB); bf16* XS = WSP(bf16, B_XS);
    int tot[8], bas[8];
#pragma unroll
    for (int e = 0; e < 8; ++e) { tot[e] = 0; bas[e] = 0; }
    for (int t = c.tid; t < c.G; t += NTHR) {
        typedef int i32x4 __attribute__((ext_vector_type(4)));
        const i32x4 a = *(const i32x4*)(WGCNT + t * 8), b = *(const i32x4*)(WGCNT + t * 8 + 4); const int lt = (t < c.bid) ? 1 : 0;
        tot[0] += a[0]; tot[1] += a[1]; tot[2] += a[2]; tot[3] += a[3]; tot[4] += b[0]; tot[5] += b[1]; tot[6] += b[2]; tot[7] += b[3];
        bas[0] += lt * a[0]; bas[1] += lt * a[1]; bas[2] += lt * a[2]; bas[3] += lt * a[3]; bas[4] += lt * b[0]; bas[5] += lt * b[1]; bas[6] += lt * b[2]; bas[7] += lt * b[3];
    }
    LAS int* red = (LAS int*)(lds + RING_OFF);
#pragma unroll
    for (int e = 0; e < 8; ++e) { tot[e] = wave_sum_i(tot[e]); bas[e] = wave_sum_i(bas[e]); }
    if (lane == 0) {
#pragma unroll
        for (int e = 0; e < 8; ++e) { red[c.wave * 16 + e] = tot[e]; red[c.wave * 16 + 8 + e] = bas[e]; } }
    __syncthreads();
#pragma unroll
    for (int e = 0; e < 8; ++e) { int st = 0, sb = 0;
#pragma unroll
        for (int w = 0; w < NWAVES; ++w) { st += red[w * 16 + e]; sb += red[w * 16 + 8 + e]; }
        tot[e] = st; bas[e] = sb; }
    int run[8]; { int acc = 0;
#pragma unroll
        for (int e = 0; e < 8; ++e) { run[e] = acc * 256 + bas[e]; acc += (tot[e] + 255) >> 8; } }
    if (c.bid == 0 && c.tid < 8) { int v = 0;
#pragma unroll
        for (int e = 0; e < 8; ++e) v = (c.tid == e) ? tot[e] : v;
        MTOT[c.tid] = v; }
    for (int w = 0; w < c.wave; ++w) {
        typedef int i32x4 __attribute__((ext_vector_type(4)));
        const i32x4 a = *(const i32x4*)(WCNT + (c.bid * NWAVES + w) * 8), b = *(const i32x4*)(WCNT + (c.bid * NWAVES + w) * 8 + 4);
        run[0] += a[0]; run[1] += a[1]; run[2] += a[2]; run[3] += a[3]; run[4] += b[0]; run[5] += b[1]; run[6] += b[2]; run[7] += b[3];
    }
    for (int tok0 = c.gw; tok0 < T; tok0 += 4 * c.NGW) {
        f32x4 sp[4]; int ee[4][2]; v4u ra[4], rb2[4]; bool ok[4];
#pragma unroll
        for (int u = 0; u < 4; ++u) { const int tok = tok0 + u * c.NGW; ok[u] = tok < T; const int tk = ok[u] ? tok : tok0;
            sp[u] = *(const f32x4*)(SSB + (size_t)tk * 4); ee[u][0] = TOKE[tk * 2]; ee[u][1] = TOKE[tk * 2 + 1];
            const v4u* src = (const v4u*)(XB + (size_t)tk * DM) + lane; ra[u] = src[0]; rb2[u] = src[64]; }
#pragma unroll
        for (int u = 0; u < 4; ++u) if (ok[u]) {
            const int tok = tok0 + u * c.NGW;
            const float rstd = rsqrtf(((sp[u][0] + sp[u][1]) + (sp[u][2] + sp[u][3])) * (1.0f / 1024.0f) + EPS);
            int s0 = 0, s1 = 0;
#pragma unroll
            for (int e = 0; e < 8; ++e) { if (e == ee[u][0]) { s0 = run[e]; run[e] += 1; } }
#pragma unroll
            for (int e = 0; e < 8; ++e) { if (e == ee[u][1]) { s1 = run[e]; run[e] += 1; } }
            if (lane == 0) { TOKS[tok * 2] = s0; TOKS[tok * 2 + 1] = s1; RSSLOT[s0] = rstd; RSSLOT[s1] = rstd; }
            v4u* d0 = (v4u*)(XS + (size_t)s0 * DM) + lane; v4u* d1 = (v4u*)(XS + (size_t)s1 * DM) + lane;
            d0[0] = ra[u]; d0[64] = rb2[u]; d1[0] = ra[u]; d1[64] = rb2[u];
        }
    }
    __syncthreads();
}
__device__ __forceinline__ void moe_panels(const int* mtot, int (&ps)[9]) { int acc = 0;
#pragma unroll
    for (int e = 0; e < 8; ++e) { ps[e] = acc; const int cn = __hip_atomic_load(mtot + e, RLX_AGENT); acc += (cn + 255) >> 8; } ps[8] = acc; }
__device__ __forceinline__ void ph_moe_up(int wv, LAS unsigned char* lds, int l) {
    const Ctx c = mkctx(wv);
    KArgs A = kargs(); unsigned char* ws = A->ws;
    pg8::MoeOrder S; S.nN = 11; moe_panels(WSP(int, MS_MTOT), S.ps);
    S.so.init(S.ps[8] * 256, 2 * EDIM, c.G, c.bid);
    pg8::Gemm g{WSP(bf16, B_XS), WSP(bf16, W_F1), DM, DM, DM};
    pg8::EpiScale<2> E{WSP(bf16, B_HIDM), EDIM, pg8::RowScale{WSP(float, MS_RSSLOT), 2}, nullptr};
    pg8::gemm_phase<pg8::EpiScale<2>, pg8::MoeOrder, true, true>(lds + RING_OFF, g, S, E, c.tid);
}
__device__ __forceinline__ void ph_moe_down(int wv, LAS unsigned char* lds, int l) {
    const Ctx c = mkctx(wv);
    KArgs A = kargs(); unsigned char* ws = A->ws;
    pg8::MoeOrder S; S.nN = 4; moe_panels(WSP(int, MS_MTOT), S.ps);
    S.so.init(S.ps[8] * 256, DM, c.G, c.bid);
    pg8::Gemm g{WSP(bf16, B_HIDM), WSP(bf16, W_F2), EDIM, EDIM, EDIM};
    pg8::EpiScale<0> E{WSP(bf16, B_Y2), DM, pg8::RowScale{nullptr, 0}, nullptr};
    pg8::gemm_phase<pg8::EpiScale<0>, pg8::MoeOrder, true, true>(lds + RING_OFF, g, S, E, c.tid);
}
__device__ __forceinline__ void ph_combine(int wv, LAS unsigned char* lds, int l) {
    const Ctx c = mkctx(wv);
    KArgs A = kargs(); unsigned char* ws = A->ws; const int lane = c.lane;
    float* xout = A->out; const bool fin = (l == DEPTH - 1);
    const int* TOKS = WSP(int, MS_TOKS); const float* TOKW = WSP(float, MS_TOKW); const bf16* Y2 = WSP(bf16, B_Y2); bf16* XB = WSP(bf16, WS_XB); float* SSA = WSP(float, WS_SSA);
    for (int tok0 = c.gw; tok0 < T; tok0 += 2 * c.NGW) {
        typedef unsigned u32x2v __attribute__((ext_vector_type(2)));
        int ss_[2][2]; float ww[2][2]; u32x2v xv[2][4]; bool ok[2];
#pragma unroll
        for (int u = 0; u < 2; ++u) { const int tok = tok0 + u * c.NGW; ok[u] = tok < T; const int tk = ok[u] ? tok : tok0;
            ss_[u][0] = TOKS[tk * 2]; ss_[u][1] = TOKS[tk * 2 + 1]; ww[u][0] = TOKW[tk * 2]; ww[u][1] = TOKW[tk * 2 + 1];
#pragma unroll
            for (int j = 0; j < 4; ++j) xv[u][j] = *((const u32x2v*)(XB + (size_t)tk * DM) + 64 * j + lane); }
        u32x2v ya[2][4], yb[2][4];
#pragma unroll
        for (int u = 0; u < 2; ++u)
#pragma unroll
            for (int j = 0; j < 4; ++j) { ya[u][j] = *((const u32x2v*)(Y2 + (size_t)ss_[u][0] * DM) + 64 * j + lane); yb[u][j] = *((const u32x2v*)(Y2 + (size_t)ss_[u][1] * DM) + 64 * j + lane); }
#pragma unroll
        for (int u = 0; u < 2; ++u) if (ok[u]) {
            const int tok = tok0 + u * c.NGW; const float w0 = ww[u][0], w1 = ww[u][1]; float ss = 0.f;
#pragma unroll
            for (int j = 0; j < 4; ++j) {
                const int c4 = 64 * j + lane; f32x4 x = {bflo(xv[u][j].x), bfhi(xv[u][j].x), bflo(xv[u][j].y), bfhi(xv[u][j].y)}; const u32x2v a = ya[u][j], b = yb[u][j];
                x[0] += w0 * bflo(a.x) + w1 * bflo(b.x); x[1] += w0 * bfhi(a.x) + w1 * bfhi(b.x); x[2] += w0 * bflo(a.y) + w1 * bflo(b.y); x[3] += w0 * bfhi(a.y) + w1 * bfhi(b.y);
                if (fin) *((f32x4*)(xout + (size_t)tok * DM) + c4) = x;
                u32x2v w; w.x = pkbf(x[0], x[1]); w.y = pkbf(x[2], x[3]); *((u32x2v*)(XB + (size_t)tok * DM) + c4) = w;
                ss += (x[0] * x[0] + x[1] * x[1]) + (x[2] * x[2] + x[3] * x[3]);
            }
            ss = wave_sum(ss);
            if (lane < 4) SSA[(size_t)tok * 4 + lane] = (lane == 0) ? ss : 0.f;
        }
    }
    if (l < DEPTH - 1) { __syncthreads(); conv_mixer_weights(wv, lds, l + 1); }
}

__global__ void __launch_bounds__(NTHR, 2) trunk_fwd(Args args) {
    extern __shared__ __attribute__((aligned(16))) unsigned char lds_raw[];
    LAS unsigned char* lds = (LAS unsigned char*)lds_raw;
    const int wv = __builtin_amdgcn_readfirstlane((int)threadIdx.x >> 6);
    for (int u = threadIdx.x; u < (LDS_BYTES - LDSCTL_OFF) / 4; u += NTHR) ((LAS unsigned*)(lds + LDSCTL_OFF))[u] = 0u;
    __syncthreads();
    volatile LAS unsigned* MISC = (volatile LAS unsigned*)(lds + MISC_OFF);
    XcdBarrier bar = xcd_barrier_post((unsigned*)((gu32*)(args.ws + WS_CTL) + CW_BAR), MISC + 8, (int)threadIdx.x);
    const int lo = args.ph_lo, hi = args.ph_hi;
    int pc = 0;
#define PH_BEGIN if (pc >= lo && pc < hi) {
#define PH_END if (pc + 1 < hi) xcd_barrier(bar, mkctx(wv).tid); } ++pc;
    PH_BEGIN ph_prologue(wv, lds); PH_END
    for (int l = 0; l < DEPTH; ++l) {
        PH_BEGIN ph_inproj(wv, lds, l); PH_END
        PH_BEGIN ph_prep(wv, lds, l); PH_END
        PH_BEGIN ph_attn(wv, lds, l); PH_END
        PH_BEGIN ph_gates(wv, lds); PH_END
        PH_BEGIN ph_merge(wv, lds); PH_END
        PH_BEGIN ph_wout(wv, lds, l); PH_END
        if (!(l & 1)) {
            PH_BEGIN ph_ffn_up(wv, lds); PH_END
            PH_BEGIN ph_ffn_down(wv, lds, l); PH_END
        } else {
            PH_BEGIN ph_router(wv, lds, l); PH_END
            PH_BEGIN ph_assign(wv, lds, l); PH_END
            PH_BEGIN ph_moe_up(wv, lds, l); PH_END
            PH_BEGIN ph_moe_down(wv, lds, l); PH_END
            PH_BEGIN ph_combine(wv, lds, l); PH_END
        }
    }
    if (TPROBE != 0 && blockIdx.x == TP_BID && threadIdx.x == 0) { const unsigned long long tt_ = *TP_ACC(lds), te_ = __builtin_amdgcn_s_memrealtime(); while (__builtin_amdgcn_s_memrealtime() - te_ < 7ull * tt_) __builtin_amdgcn_s_sleep(32); }
#undef PH_BEGIN
#undef PH_END
}

#ifndef MK_MULTI
#define MK_MULTI 0
#endif
extern "C" void kernel_launch(void* const* d_in, const int* in_sizes, int n_in, void* d_out, int out_size, void* d_ws, size_t ws_size, hipStream_t stream) {
    static int grid = 0;
    if (grid == 0) {
        if (n_in != 31 || out_size != T * DM || ws_size < WS_END) { fprintf(stderr, "kernel_launch: unexpected problem: n_in %d out %d ws %zu (need %zu)\n", n_in, out_size, ws_size, (size_t)WS_END); grid = -1; return; }
        int dev = 0, cus = 0;
        if (hipGetDevice(&dev) != hipSuccess || hipDeviceGetAttribute(&cus, hipDeviceAttributeMultiprocessorCount, dev) != hipSuccess) { grid = -1; return; }
        if (hipFuncSetAttribute((const void*)trunk_fwd, hipFuncAttributeMaxDynamicSharedMemorySize, LDS_BYTES) != hipSuccess) { fprintf(stderr, "kernel_launch: hipFuncSetAttribute failed\n"); grid = -1; return; }
        int per_cu = 0;
        if (hipOccupancyMaxActiveBlocksPerMultiprocessor(&per_cu, (const void*)trunk_fwd, NTHR, LDS_BYTES) != hipSuccess || per_cu < 1) fprintf(stderr, "kernel_launch: occupancy query says %d\n", per_cu);
        (void)hipGetLastError();
        grid = cus;
    }
    if (grid < 0) return;
    (void)hipMemsetAsync((char*)d_ws + WS_CTL, 0, CTL_ZERO_BYTES, stream);
    Args a{};
    for (int i = 0; i < 31; ++i) a.in[i] = d_in[i];
    a.out = (float*)d_out; a.ws = (unsigned char*)d_ws;
#if MK_MULTI
    for (int p = 0; p < N_PHASES; ++p) { a.ph_lo = p; a.ph_hi = p + 1; hipLaunchKernelGGL(trunk_fwd, dim3(grid), dim3(NTHR), LDS_BYTES, stream, a); }
#else
    a.ph_lo = 0; a.ph_hi = N_PHASES;
    hipLaunchKernelGGL(trunk_fwd, dim3(grid), dim3(NTHR), LDS_BYTES, stream, a);
#endif
}
```

```cpp
#include <hip/hip_runtime.h>
#include <cstdio>
#include <cstdint>
#include <cmath>
namespace pg8 {
#define PG8_LAS __attribute__((address_space(3)))
typedef unsigned short bf16_t;
typedef short bf16x8 __attribute__((ext_vector_type(8)));
typedef float f32x4 __attribute__((ext_vector_type(4)));
typedef unsigned u32x4 __attribute__((ext_vector_type(4)));
constexpr int BM = 256, BK = 64, HALF = 128, HTB = HALF * BK * 2  , STAGE_BYTES = 8 * HTB, NXCD = 8, WGM = 8;

__host__ __device__ __forceinline__ int lds_byte(int r, int c) { const int st = (r >> 4) * 2 + (c >> 5), rr = r & 15, cc = c & 31, ob = rr * 64 + cc * 2; return st * 1024 + (ob ^ (((ob >> 9) & 1) << 5)); }
__host__ __device__ __forceinline__ void stage_rc(int b, int& R, int& C) { const int st = b / 1024, sb = b % 1024, swz = sb ^ (((sb >> 9) & 1) << 5); R = (st >> 1) * 16 + swz / 64; C = (st & 1) * 32 + (swz % 64) / 2; }
__host__ __device__ __forceinline__ int perm32(int rho) { const int n = rho >> 4, i = rho & 15; return 8 * (i >> 2) + 4 * n + (i & 3); }

struct Unit { int pm, pn, pb, ak; };
struct Gemm { const bf16_t* A; const bf16_t* Bt; int lda, ldb, K; const PG8_LAS unsigned* gtab = nullptr; };

struct StaticOrder {
    int nM, nN, nwg, G, c;
    __host__ __device__ void init(int M, int N, int G_, int c_) { nM = M / BM; nN = N / BM; nwg = nM * nN; G = G_; c = c_; }
    __host__ __device__ bool next(int i, Unit& u) const {
        const long L = (long)i * G + c; if (L >= nwg) return false;
        int wgid = (int)L; { const int q = nwg / NXCD, r = nwg % NXCD, xcd = wgid % NXCD, off = wgid / NXCD; wgid = (xcd < r ? xcd * (q + 1) : r * (q + 1) + (xcd - r) * q) + off; }
        const int nig = WGM * nN, gid = wgid / nig, fm = gid * WGM, gsz = (nM - fm) < WGM ? (nM - fm) : WGM;
        u.pm = fm + ((wgid % nig) % gsz); u.pn = (wgid % nig) / gsz; u.pb = u.pn; u.ak = 0; return true;
    }
    __device__ __forceinline__ void a_ready(const Unit&) const {}
    __device__ __forceinline__ void done(const Unit&) const {}
};

template <class Epi, class Sched, bool ALIGN_EPI = false, bool SP2 = false, bool GATHER = false>
__device__ __forceinline__ void gemm_phase(PG8_LAS unsigned char* lds, const Gemm g, const Sched& S, const Epi& E, const int tid) {
    static_assert(!GATHER || SP2, "GATHER is written for the SP2 loop only");
    const int wid = __builtin_amdgcn_readfirstlane(tid >> 6), lane = tid & 63, wr = wid >> 2, wc = wid & 3, fr = lane & 15, fq = lane >> 4;
    const int K = g.K, nt = K / BK;
    unsigned voffA[2], voffB[2];
#pragma unroll
    for (int i = 0; i < 2; ++i) { int R, C; stage_rc(tid * 16 + i * 8192, R, C); const int Rb = Epi::PERM ? ((R & ~31) + perm32(R & 31)) : R;
        voffA[i] = GATHER ? (unsigned)(R * 256 + C * 2)   : (unsigned)(R * g.lda + C) * 2u; voffB[i] = (unsigned)(Rb * g.ldb + C) * 2u; }
    unsigned gc[2][2], gn[2][2];
#define PG8_GLOAD(dst, uidx) do { _Pragma("unroll") for (int _h = 0; _h < 2; ++_h) _Pragma("unroll") for (int _i = 0; _i < 2; ++_i) \
        dst[_h][_i] = g.gtab[(uidx) * 256 + _h * HALF + (voffA[_i] >> 8)] + (voffA[_i] & 255u); } while (0)
    const size_t kstep = (size_t)(BK * 2);
    const size_t hstepA = (size_t)HALF * g.lda * 2, hstepB = (size_t)HALF * g.ldb * 2;
    const size_t tstepA = 2 * hstepA, tstepB = 2 * hstepB;
    const unsigned ldsw = (unsigned)wid * 1024u;
#define PG8_SA(b, h) (((b) * 2 + (h)) * HTB)
#define PG8_SB(b, h) ((4 + (b) * 2 + (h)) * HTB)
#define PG8_STAGE(bufoff, gbase, voff) do { _Pragma("unroll") for (int _i = 0; _i < 2; ++_i) \
        __builtin_amdgcn_global_load_lds((const unsigned*)((const char*)(gbase) + (voff)[_i]), (PG8_LAS unsigned*)(lds + (bufoff) + ldsw + _i * 8192), 16, 0, 0); } while (0)
#define PG8_STAGE_A(bufoff, base, h, NX) do { if constexpr (GATHER) { unsigned _o[2] = {(NX) ? gn[h][0] : gc[h][0], (NX) ? gn[h][1] : gc[h][1]}; PG8_STAGE(bufoff, base, _o); } \
        else PG8_STAGE(bufoff, (base) + (h) * hstepA, voffA); } while (0)
#define PG8_LDA(dst, b, h) do { _Pragma("unroll") for (int m = 0; m < 4; ++m) _Pragma("unroll") for (int k = 0; k < 2; ++k) dst[m][k] = *(const PG8_LAS bf16x8*)(lds + PG8_SA(b, h) + aoff + m * 2048 + k * 1024); } while (0)
#define PG8_LDB(dst, b, h) do { _Pragma("unroll") for (int n = 0; n < 2; ++n) _Pragma("unroll") for (int k = 0; k < 2; ++k) dst[n][k] = *(const PG8_LAS bf16x8*)(lds + PG8_SB(b, h) + boff + n * 2048 + k * 1024); } while (0)
#define PG8_MMA(ai, bj, At, Bt) do { __builtin_amdgcn_s_setprio(1); _Pragma("unroll") for (int m = 0; m < 4; ++m) _Pragma("unroll") for (int n = 0; n < 2; ++n) _Pragma("unroll") for (int k = 0; k < 2; ++k) \
        acc[ai][bj][m][n] = __builtin_amdgcn_mfma_f32_16x16x32_bf16(Bt[n][k], At[m][k], acc[ai][bj][m][n], 0, 0, 0); __builtin_amdgcn_s_setprio(0); } while (0)
#define PG8_WAIT_V(n) asm volatile("s_waitcnt vmcnt(" #n ")" ::: "memory")
#define PG8_WAIT_L(n) asm volatile("s_waitcnt lgkmcnt(" #n ")" ::: "memory")
#define PG8_BAR __builtin_amdgcn_s_barrier()
#define PG8_SCHED __builtin_amdgcn_sched_barrier(0)
    Unit cur, nxt; int ui = 0;
    if (!S.next(0, cur)) return;
    f32x4 acc[2][2][4][2];
#pragma unroll
    for (int a = 0; a < 2; ++a)
#pragma unroll
        for (int b = 0; b < 2; ++b)
#pragma unroll
            for (int m = 0; m < 4; ++m)
#pragma unroll
                for (int n = 0; n < 2; ++n) acc[a][b][m][n] = (f32x4){0.f, 0.f, 0.f, 0.f};
    bf16x8 At[4][2], B0[2][2], B1[2][2];
    const char* cA = (const char*)g.A + (GATHER ? (size_t)0 : (size_t)cur.pm * tstepA) + (size_t)cur.ak * 2; const char* cB = (const char*)g.Bt + (size_t)cur.pb * tstepB;
    S.a_ready(cur);
    if constexpr (GATHER) { PG8_GLOAD(gc, 0); _Pragma("unroll") for (int _h = 0; _h < 2; ++_h) _Pragma("unroll") for (int _i = 0; _i < 2; ++_i) gn[_h][_i] = gc[_h][_i]; }
    if constexpr (SP2) {
        PG8_STAGE(PG8_SB(0, 0), cB, voffB); PG8_STAGE(PG8_SB(0, 1), cB + hstepB, voffB); PG8_STAGE_A(PG8_SA(0, 0), cA, 0, false); PG8_STAGE_A(PG8_SA(0, 1), cA, 1, false);
        if (wr == 1) PG8_BAR;
        PG8_WAIT_V(2); PG8_BAR;
        PG8_STAGE(PG8_SB(1, 0), cB + kstep, voffB); PG8_STAGE_A(PG8_SA(1, 0), cA + kstep, 0, false); PG8_STAGE(PG8_SB(1, 1), cB + hstepB + kstep, voffB);
        PG8_WAIT_V(6); PG8_BAR;
    } else {
        PG8_STAGE(PG8_SB(0, 0), cB, voffB); PG8_STAGE(PG8_SA(0, 0), cA, voffA); PG8_STAGE(PG8_SB(0, 1), cB + hstepB, voffB); PG8_STAGE(PG8_SA(0, 1), cA + hstepA, voffA);
        if (wr == 1) PG8_BAR;
        PG8_WAIT_V(4); PG8_BAR;
        PG8_STAGE(PG8_SB(1, 0), cB + kstep, voffB); PG8_STAGE(PG8_SA(1, 0), cA + kstep, voffA); PG8_STAGE(PG8_SB(1, 1), cB + hstepB + kstep, voffB);
        PG8_WAIT_V(6); PG8_BAR;
    }
    int lnr_ = lane; asm volatile("" : "+v"(lnr_));
    const int aoff = lds_byte(wr * 64 + (lnr_ & 15), (lnr_ >> 4) * 8), boff = lds_byte(wc * 32 + (lnr_ & 15), (lnr_ >> 4) * 8);
    for (;;) {
        const bool has_next = S.next(ui + 1, nxt);
        const char* nA = has_next ? (const char*)g.A + (GATHER ? (size_t)0 : (size_t)nxt.pm * tstepA) + (size_t)nxt.ak * 2 : cA; const char* nB = has_next ? (const char*)g.Bt + (size_t)nxt.pb * tstepB : cB;
        if constexpr (GATHER) { if (has_next) PG8_GLOAD(gn, ui + 1); }
        for (int t = 0; t < nt; t += 2) {
            const bool last = (t == nt - 2);
            const char* a1 = cA + (size_t)(t + 1) * kstep;
            const char* a2 = last ? nA : cA + (size_t)(t + 2) * kstep; const char* b2 = last ? nB : cB + (size_t)(t + 2) * kstep;
            const char* a3 = a2 + kstep; const char* b3 = b2 + kstep;
            if (last && has_next) S.a_ready(nxt);
            if constexpr (SP2) {
            PG8_LDB(B0, 0, 0); PG8_LDB(B1, 0, 1); PG8_SCHED; PG8_LDA(At, 0, 0); PG8_STAGE_A(PG8_SA(1, 1), a1, 1, false);
            PG8_WAIT_V(8); PG8_WAIT_L(0); PG8_BAR; PG8_MMA(0, 0, At, B0); PG8_MMA(0, 1, At, B1); PG8_BAR; PG8_SCHED;
            PG8_LDA(At, 0, 1); PG8_STAGE(PG8_SB(0, 0), b2, voffB); PG8_STAGE(PG8_SB(0, 1), b2 + hstepB, voffB); PG8_STAGE_A(PG8_SA(0, 0), a2, 0, last);
            PG8_WAIT_V(8); PG8_WAIT_L(0); PG8_BAR; PG8_MMA(1, 0, At, B0); PG8_MMA(1, 1, At, B1); PG8_BAR; PG8_SCHED;
            PG8_LDB(B0, 1, 0); PG8_LDB(B1, 1, 1); PG8_SCHED; PG8_LDA(At, 1, 0); PG8_STAGE_A(PG8_SA(0, 1), a2, 1, last);
            PG8_WAIT_V(8); PG8_WAIT_L(0); PG8_BAR; PG8_MMA(0, 0, At, B0); PG8_MMA(0, 1, At, B1); PG8_BAR; PG8_SCHED;
            PG8_LDA(At, 1, 1); PG8_STAGE(PG8_SB(1, 0), b3, voffB); PG8_STAGE(PG8_SB(1, 1), b3 + hstepB, voffB); PG8_STAGE_A(PG8_SA(1, 0), a3, 0, last);
            PG8_WAIT_V(8); PG8_WAIT_L(0); PG8_BAR; PG8_MMA(1, 0, At, B0); PG8_MMA(1, 1, At, B1); PG8_BAR; PG8_SCHED;
            } else {
            PG8_LDB(B0, 0, 0); PG8_SCHED; PG8_LDA(At, 0, 0); PG8_STAGE(PG8_SA(1, 1), a1 + hstepA, voffA);
            PG8_WAIT_L(8); PG8_BAR; PG8_WAIT_L(0); PG8_MMA(0, 0, At, B0); PG8_BAR; PG8_SCHED;
            PG8_LDB(B1, 0, 1); PG8_STAGE(PG8_SB(0, 0), b2, voffB);
            PG8_BAR; PG8_WAIT_L(0); PG8_MMA(0, 1, At, B1); PG8_BAR;
            PG8_LDA(At, 0, 1); PG8_STAGE(PG8_SA(0, 0), a2, voffA);
            PG8_BAR; PG8_WAIT_L(0); PG8_MMA(1, 0, At, B0); PG8_BAR; PG8_SCHED;
            PG8_STAGE(PG8_SB(0, 1), b2 + hstepB, voffB);
            PG8_WAIT_V(6); PG8_BAR; PG8_MMA(1, 1, At, B1); PG8_BAR;
            PG8_LDB(B0, 1, 0); PG8_SCHED; PG8_LDA(At, 1, 0); PG8_STAGE(PG8_SA(0, 1), a2 + hstepA, voffA);
            PG8_WAIT_L(8); PG8_BAR; PG8_WAIT_L(0); PG8_MMA(0, 0, At, B0); PG8_BAR; PG8_SCHED;
            PG8_LDB(B1, 1, 1); PG8_STAGE(PG8_SB(1, 0), b3, voffB);
            PG8_BAR; PG8_WAIT_L(0); PG8_MMA(0, 1, At, B1); PG8_BAR;
            PG8_LDA(At, 1, 1); PG8_STAGE(PG8_SA(1, 0), a3, voffA);
            PG8_BAR; PG8_WAIT_L(0); PG8_MMA(1, 0, At, B0); PG8_BAR; PG8_SCHED;
            PG8_STAGE(PG8_SB(1, 1), b3 + hstepB, voffB);
            PG8_WAIT_V(6); PG8_BAR; PG8_MMA(1, 1, At, B1); PG8_BAR;
            }
        }
        if constexpr (ALIGN_EPI) { if (wr == 0) PG8_BAR; }
        const bool keep = E(acc, cur, wr, wc, fr, fq);
        if (!has_next) break;
        if (!keep) {
#pragma unroll
        for (int a = 0; a < 2; ++a)
#pragma unroll
            for (int b = 0; b < 2; ++b)
#pragma unroll
                for (int m = 0; m < 4; ++m)
#pragma unroll
                    for (int n = 0; n < 2; ++n) acc[a][b][m][n] = (f32x4){0.f, 0.f, 0.f, 0.f};
        }
        cur = nxt; cA = nA; cB = nB; ++ui;
        if constexpr (GATHER) { _Pragma("unroll") for (int _h = 0; _h < 2; ++_h) _Pragma("unroll") for (int _i = 0; _i < 2; ++_i) gc[_h][_i] = gn[_h][_i]; }
        if constexpr (ALIGN_EPI) { if (wr == 1) PG8_BAR; }
    }
    PG8_WAIT_V(0);
    if constexpr (!ALIGN_EPI) { if (wr == 0) PG8_BAR; }
    PG8_BAR;
#undef PG8_SA
#undef PG8_SB
#undef PG8_STAGE
#undef PG8_STAGE_A
#undef PG8_GLOAD
#undef PG8_LDA
#undef PG8_LDB
#undef PG8_MMA
#undef PG8_WAIT_V
#undef PG8_WAIT_L
#undef PG8_BAR
#undef PG8_SCHED
}
}
#define GAS __attribute__((address_space(1)))
#define LAS __attribute__((address_space(3)))
typedef unsigned short bf16;
typedef unsigned v4u __attribute__((ext_vector_type(4)));
typedef float f32x4 __attribute__((ext_vector_type(4)));
typedef short bf16x8 __attribute__((ext_vector_type(8)));
typedef GAS unsigned gu32;
typedef GAS unsigned long long gu64;
#define RLX_AGENT __ATOMIC_RELAXED, __HIP_MEMORY_SCOPE_AGENT
#define LDS_WAIT() asm volatile("s_waitcnt lgkmcnt(0)" ::: "memory")
#define VM_WAIT() asm volatile("s_waitcnt vmcnt(0)" ::: "memory")
__device__ __forceinline__ unsigned long long rt() { return __builtin_amdgcn_s_memrealtime(); }
__device__ __forceinline__ unsigned f2bf(float f) { unsigned u = __builtin_bit_cast(unsigned, f); return (u + 0x7fffu + ((u >> 16) & 1u)) >> 16; }
__device__ __forceinline__ unsigned pk2(float lo, float hi) { return f2bf(lo) | (f2bf(hi) << 16); }

#define XB_TMO      128
#define XB_XCNT(j)  (256  + 64 * (j))
#define XB_XSUB(j)  (1280 + 64 * (j))
#define XB_XGEN(j)  (2304 + 64 * (j))
#define XB_TOP      3328
#define XB_TOPGEN   3392
#define XCD_BAR_WORDS 3456
#define XB_SPIN_CAP (1u << 18)

__device__ __forceinline__ unsigned xb_ld(unsigned* p)              { return __hip_atomic_load(p, __ATOMIC_RELAXED, __HIP_MEMORY_SCOPE_AGENT); }
__device__ __forceinline__ unsigned xb_add(unsigned* p, unsigned v) { return __hip_atomic_fetch_add(p, v, __ATOMIC_RELAXED, __HIP_MEMORY_SCOPE_AGENT); }
__device__ __forceinline__ unsigned xb_xcc_id() { return (unsigned)__builtin_amdgcn_s_getreg((3 << 11) | 20) & 0xFu; }
#define XB_SPIN(cond, bar) do { unsigned _sp = 0; while (cond) { __builtin_amdgcn_s_sleep(1); \
    if ((++_sp & 255u) == 0u) { if (xb_ld(&(bar)[XB_TMO])) break; if (_sp > XB_SPIN_CAP) { atomicAdd(&(bar)[XB_TMO], 1u); break; } } } } while (0)

struct XcdBarrier {
    unsigned* bar; unsigned x;
    volatile LAS unsigned* st;
};

__device__ __forceinline__ XcdBarrier xcd_barrier_post(unsigned* bar, volatile LAS unsigned* st, const int tid) {
    XcdBarrier b; b.bar = bar; b.x = xb_xcc_id(); b.st = st;
    if (tid == 0) (void)xb_add(&bar[XB_XCNT(b.x)], 1u);
    return b;
}
__device__ __forceinline__ void xcd_barrier_complete(unsigned* bar, unsigned x, unsigned& nloc, unsigned& nx) {
    const unsigned G = gridDim.x * gridDim.y * gridDim.z;
    unsigned sum, cnt, mine, sp = 0u;
    for (;;) {
        sum = 0u; cnt = 0u; mine = 0u;
#pragma unroll
        for (unsigned j = 0; j < 16; ++j) { const unsigned c = xb_ld(&bar[XB_XCNT(j)]); sum += c; cnt += (c > 0u) ? 1u : 0u; mine = (j == x) ? c : mine; }
        if (sum == G) break;
        __builtin_amdgcn_s_sleep(1);
        if ((++sp & 255u) == 0u) { if (xb_ld(&bar[XB_TMO])) break; if (sp > XB_SPIN_CAP) { atomicAdd(&bar[XB_TMO], 1u); break; } }
    }
    nloc = mine > 0u ? mine : 1u; nx = cnt > 0u ? cnt : 1u;
}

__device__ __forceinline__ void xcd_barrier(const XcdBarrier& b, const int tid) {
    asm volatile("s_waitcnt vmcnt(0)" ::: "memory");
    __syncthreads();
    if (tid == 0) {
        unsigned* bar = b.bar; asm volatile("" : "+s"(bar));
        __builtin_amdgcn_s_waitcnt(0);
        unsigned nloc = b.st[0], nx = b.st[1];
        if (nloc == 0u) { unsigned xl_ = b.x; asm volatile("" : "+s"(xl_)); xcd_barrier_complete(bar, xl_, nloc, nx); b.st[0] = nloc; b.st[1] = nx; }
        const unsigned old = xb_add(&bar[XB_XSUB(b.x)], 1u);
        const unsigned gen = old / nloc;
        if (old + 1u == (gen + 1u) * nloc) {
            __builtin_amdgcn_fence(__ATOMIC_RELEASE, "agent");
            asm volatile("s_waitcnt vmcnt(0)" ::: "memory");
            const unsigned og = xb_add(&bar[XB_TOP], 1u);
            const unsigned tg = og / nx;
            if (og + 1u == (tg + 1u) * nx) xb_add(&bar[XB_TOPGEN], 1u);
            else XB_SPIN(xb_ld(&bar[XB_TOPGEN]) == tg, bar);
            __builtin_amdgcn_fence(__ATOMIC_ACQUIRE, "agent");
            xb_add(&bar[XB_XGEN(b.x)], 1u);
            asm volatile("s_waitcnt vmcnt(0)" ::: "memory");
        } else {
            XB_SPIN(xb_ld(&bar[XB_XGEN(b.x)]) == gen, bar);
            __builtin_amdgcn_fence(__ATOMIC_ACQUIRE, "agent");
            asm volatile("s_waitcnt vmcnt(0)" ::: "memory");
        }
    }
    __syncthreads();
}
constexpr int NB = 8, SEQ = 4096, DM = 1024, T = NB * SEQ, DEPTH = 4, IN_COLS = 6240;
constexpr int FFN = 2816, NE = 8, EDIM = 1408;
constexpr float EPS = 1e-6f, LOG2E = 1.4426950408889634f;
constexpr int PJ_LD = 2304, PJ_U = 0, PJ_V = 256, PJ_BQ = 512, PJ_BK = 768, PJ_BV = 1024, PJ_DA = 1280, PJ_DG = 1536, PJ_CQ = 1792, PJ_CKV = 1984, PJ_KR = 2112;
constexpr float QS_B = 0.125f * LOG2E;
constexpr float QS_C = 0.10206207261596577f * LOG2E;
constexpr int NWAVES = 8, NTHR = 512;

constexpr size_t MiB = 1u << 20;
constexpr size_t WS_CTL = 0, CTL_ZERO_BYTES = 1 * MiB;
constexpr size_t WS_SSA = 1 * MiB, WS_SSB = 3 * MiB;
constexpr size_t WS_ROPE = 5 * MiB;
constexpr size_t WS_MISC = 11 * MiB;
constexpr size_t MS_RSCQ = WS_MISC, MS_RSCKV = WS_MISC + 128 * 1024, MS_SEL = WS_MISC + 256 * 1024, MS_KMEAN = WS_MISC + 768 * 1024,
                 MS_TOKE = WS_MISC + 1024 * 1024, MS_TOKW = WS_MISC + 1280 * 1024, MS_TOKS = WS_MISC + 1536 * 1024, MS_RSSLOT = WS_MISC + 1792 * 1024,
                 MS_WCNT = WS_MISC + 2304 * 1024, MS_WGCNT = WS_MISC + 2560 * 1024, MS_MTOT = WS_MISC + 2816 * 1024, MS_WSGU = WS_MISC + 2880 * 1024;
constexpr size_t WS_W = 14 * MiB;
constexpr size_t W_INR = WS_W, W_G = WS_W + 4 * MiB + 512 * 1024, W_UQ = WS_W + 12 * MiB + 512 * 1024, W_UKV = W_UQ + 256 * 1024, W_B = WS_W + 13 * MiB, W_OUT = WS_W + 15 * MiB,
                 W_F1 = WS_W + 17 * MiB, W_F2 = WS_W + 61 * MiB;
constexpr size_t WS_TOKIDX = 99 * MiB + 512 * 1024;
constexpr size_t WS_SSC = 98 * MiB;
constexpr size_t WS_XB = 100 * MiB;
constexpr size_t WS_BIG = 164 * MiB;
constexpr size_t B_PROJ = WS_BIG, B_QPRE = WS_BIG + 144 * MiB, B_KVPRE = WS_BIG + 176 * MiB  , B_CQ = WS_BIG + 208 * MiB, B_CK = WS_BIG + 232 * MiB, B_O = WS_BIG + 256 * MiB;
constexpr size_t B_SG = WS_BIG, B_Y = WS_BIG + 320 * MiB;
constexpr size_t B_HID = WS_BIG;
constexpr size_t B_XS = WS_BIG, B_HIDM = WS_BIG + 132 * MiB, B_Y2 = WS_BIG;
constexpr size_t WS_END = WS_BIG + 384 * MiB;
constexpr int MOE_ROWS_MAX = 65536 + 8 * 256;
static_assert(B_HIDM + (size_t)MOE_ROWS_MAX * EDIM * 2 <= WS_END && (size_t)MOE_ROWS_MAX * 1024 * 2 <= 132 * MiB, "moe map");
constexpr int CW_TMO = 0, CW_BAR = 4096, CW_MOE = 8192, CW_KMX = 9216;

constexpr int RING_OFF = 0, RING_BYTES = 131072;
constexpr int LDSCTL_OFF = RING_BYTES, MISC_OFF = LDSCTL_OFF + 320;
constexpr int LDS_BYTES = 163840;
constexpr int KV_AUX_OFF = 136192;
constexpr int EPI_RED_OFF = 132096;

typedef float f32x2 __attribute__((ext_vector_type(2)));
typedef __bf16 bf16x2_t __attribute__((ext_vector_type(2)));
__device__ __forceinline__ unsigned pkbf(float lo, float hi) { f32x2 v = {lo, hi}; bf16x2_t b = __builtin_convertvector(v, bf16x2_t); return __builtin_bit_cast(unsigned, b); }
__device__ __forceinline__ float bflo(unsigned w) { return __uint_as_float(w << 16); }
__device__ __forceinline__ float bfhi(unsigned w) { return __uint_as_float(w & 0xffff0000u); }
__device__ __forceinline__ float bf1(bf16 b) { return __uint_as_float((unsigned)b << 16); }
__device__ __forceinline__ void unpack8(const v4u w, float* o) { o[0] = bflo(w.x); o[1] = bfhi(w.x); o[2] = bflo(w.y); o[3] = bfhi(w.y); o[4] = bflo(w.z); o[5] = bfhi(w.z); o[6] = bflo(w.w); o[7] = bfhi(w.w); }
__device__ __forceinline__ v4u pack8(const float* o) { v4u w; w.x = pkbf(o[0], o[1]); w.y = pkbf(o[2], o[3]); w.z = pkbf(o[4], o[5]); w.w = pkbf(o[6], o[7]); return w; }
template <int X> __device__ __forceinline__ float swz_xor(float v) { return __int_as_float(__builtin_amdgcn_ds_swizzle(__float_as_int(v), (X << 10) | 0x1f)); }
__device__ __forceinline__ float half_sum(float v) { auto rr = __builtin_amdgcn_permlane32_swap(__float_as_uint(v), __float_as_uint(v), false, false); return __uint_as_float(rr[0]) + __uint_as_float(rr[1]); }
__device__ __forceinline__ float wave_sum(float v) {
    v += swz_xor<1>(v); v += swz_xor<2>(v); v += swz_xor<4>(v); v += swz_xor<8>(v); v += swz_xor<16>(v);
    return half_sum(v);
}
__device__ __forceinline__ float fast_sigmoid(float x) { return __builtin_amdgcn_rcpf(1.0f + __builtin_amdgcn_exp2f(-x * LOG2E)); }
__device__ __forceinline__ float fast_silu(float x) { return x * fast_sigmoid(x); }
namespace pg8 {
struct RowScale { const float* p; int mode; };
__device__ __forceinline__ float row_scale(const RowScale& rs, int row) {
    if (rs.mode == 0) return 1.f;
    if (rs.mode == 2) return rs.p[row];
    if (rs.mode == 3) { const f32x4 p = *(const f32x4*)(rs.p + (size_t)row * 12); return rsqrtf(((p[0] + p[1]) + (p[2] + p[3])) * (1.0f / 192.0f) + EPS); }
    if (rs.mode == 4) { const f32x4 p = *(const f32x4*)(rs.p + (size_t)row * 12 + 4); return rsqrtf(((p[0] + p[1]) + (p[2] + p[3])) * (1.0f / 128.0f) + EPS); }
    { const f32x4 p = *(const f32x4*)(rs.p + (size_t)row * 4); return rsqrtf(((p[0] + p[1]) + (p[2] + p[3])) * (1.0f / 1024.0f) + EPS); }
}
template <int ACT> struct EpiScale {
    static constexpr bool PERM = true;
    bf16_t* O; int ldc; RowScale rs; float* ssc;
    __device__ __forceinline__ bool operator()(f32x4 (&acc)[2][2][4][2], const Unit& u, int wr, int wc, int fr, int fq) const {
        const int row0 = u.pm * BM + wr * 64 + fr;
        float scv[2][4];
#pragma unroll
        for (int ai = 0; ai < 2; ++ai)
#pragma unroll
            for (int m = 0; m < 4; ++m) scv[ai][m] = row_scale(rs, row0 + ai * HALF + m * 16);
#pragma unroll
        for (int ai = 0; ai < 2; ++ai)
#pragma unroll
            for (int m = 0; m < 4; ++m) {
                const int row = row0 + ai * HALF + m * 16; const float sc = scv[ai][m];
                if (ACT == 2) {
                    bf16_t* rowp = O + (size_t)row * ldc + u.pn * HALF + wc * 32 + 8 * fq;
                    const f32x4 g0 = acc[ai][0][m][0] * sc, g1 = acc[ai][0][m][1] * sc, u0 = acc[ai][1][m][0] * sc, u1 = acc[ai][1][m][1] * sc;
                    u32x4 w; w.x = pkbf(fast_silu(g0[0]) * u0[0], fast_silu(g0[1]) * u0[1]); w.y = pkbf(fast_silu(g0[2]) * u0[2], fast_silu(g0[3]) * u0[3]);
                    w.z = pkbf(fast_silu(g1[0]) * u1[0], fast_silu(g1[1]) * u1[1]); w.w = pkbf(fast_silu(g1[2]) * u1[2], fast_silu(g1[3]) * u1[3]);
                    *(u32x4*)rowp = w;
                } else {
                    bf16_t* rowp = O + (size_t)row * ldc + u.pn * BM + wc * 32 + 8 * fq;
                    float sq[2] = {0.f, 0.f};
#pragma unroll
                    for (int bj = 0; bj < 2; ++bj) {
                        f32x4 v0 = acc[ai][bj][m][0] * sc, v1 = acc[ai][bj][m][1] * sc;
                        if (ACT == 0) sq[bj] = ((v0[0] * v0[0] + v0[1] * v0[1]) + (v0[2] * v0[2] + v0[3] * v0[3])) + ((v1[0] * v1[0] + v1[1] * v1[1]) + (v1[2] * v1[2] + v1[3] * v1[3]));
                        if (ACT == 1) {
#pragma unroll
                            for (int j = 0; j < 4; ++j) { v0[j] = fmaxf(fast_sigmoid(v0[j]), 8.6736174e-19f); v1[j] = fmaxf(fast_sigmoid(v1[j]), 8.6736174e-19f); }
                        }
                        u32x4 w; w.x = pkbf(v0[0], v0[1]); w.y = pkbf(v0[2], v0[3]); w.z = pkbf(v1[0], v1[1]); w.w = pkbf(v1[2], v1[3]);
                        *(u32x4*)(rowp + bj * HALF) = w;
                    }
                    if (ACT == 0 && ssc != nullptr && (u.pn == 7 || u.pn == 8)) {
                        float a = (u.pn == 7) ? (sq[0] + (wc < 2 ? sq[1] : 0.f)) : sq[0];
                        float c = sq[1];
                        a += swz_xor<16>(a); a = half_sum(a); c += swz_xor<16>(c); c = half_sum(c);
                        if (fq == 0) {
                            float* sp = ssc + (size_t)row * 12;
                            if (u.pn == 7) { sp[wc] = a; if (wc >= 2) sp[4 + wc] = c; }
                            else { if (wc < 2) sp[4 + wc] = a; if (wc == 2) sp[8] = a; }
                        }
                    }
                }
            }
        return false;
    }
};
struct EpiResidual {
    static constexpr bool PERM = false;
    bf16_t* xb; float* ssp; PG8_LAS float* red;
    __device__ __forceinline__ bool operator()(f32x4 (&acc)[2][2][4][2], const Unit& u, int wr, int wc, int fr, int fq) const {
        typedef unsigned u32x2v __attribute__((ext_vector_type(2)));
        const int row0 = u.pm * BM + wr * 64 + fr, col0 = u.pn * BM + wc * 32 + 4 * fq;
#pragma unroll
        for (int ai = 0; ai < 2; ++ai) {
            u32x2v bv[4][2][2];
#pragma unroll
            for (int m = 0; m < 4; ++m)
#pragma unroll
                for (int bj = 0; bj < 2; ++bj)
#pragma unroll
                    for (int n = 0; n < 2; ++n) bv[m][bj][n] = *(const u32x2v*)(xb + (size_t)(row0 + ai * HALF + m * 16) * DM + col0 + bj * HALF + n * 16);
#pragma unroll
            for (int m = 0; m < 4; ++m) {
                const int row = row0 + ai * HALF + m * 16; const size_t off = (size_t)row * DM + col0; float ss = 0.f;
#pragma unroll
                for (int bj = 0; bj < 2; ++bj)
#pragma unroll
                    for (int n = 0; n < 2; ++n) {
                        const size_t o2 = off + bj * HALF + n * 16; const u32x2v bb = bv[m][bj][n]; const f32x4 a = acc[ai][bj][m][n];
                        const f32x4 o = {bflo(bb.x) + a[0], bfhi(bb.x) + a[1], bflo(bb.y) + a[2], bfhi(bb.y) + a[3]};
                        u32x2v w; w.x = pkbf(o[0], o[1]); w.y = pkbf(o[2], o[3]); *(u32x2v*)(xb + o2) = w;
                        ss += (o[0] * o[0] + o[1] * o[1]) + (o[2] * o[2] + o[3] * o[3]);
                    }
                ss += swz_xor<16>(ss); ss = half_sum(ss);
                if (fq == 0) red[(ai * HALF + wr * 64 + m * 16 + fr) * 4 + wc] = ss;
            }
        }
        asm volatile("s_waitcnt lgkmcnt(0)" ::: "memory"); __builtin_amdgcn_s_barrier(); asm volatile("" ::: "memory");
        const int t = (wr * 4 + wc) * 64 + fq * 16 + fr;
        if (t < 256) { const f32x4 p = *(const PG8_LAS f32x4*)(red + t * 4); ssp[(size_t)(u.pm * BM + t) * 4 + u.pn] = (p[0] + p[1]) + (p[2] + p[3]); }
        return false;
    }
};
struct EpiKV {
    static constexpr bool PERM = true;
    bf16_t* CK; bf16_t* VB; const float* ckn; unsigned* kmx;
    PG8_LAS unsigned char* aux;
    __device__ __forceinline__ bool operator()(f32x4 (&acc)[2][2][4][2], const Unit& u, int wr, int wc, int fr, int fq) const {
        typedef unsigned u32x2v __attribute__((ext_vector_type(2)));
        unsigned mk_ = ~0u; asm volatile("" : "+s"(mk_)); const int ln_ = (int)__builtin_amdgcn_mbcnt_hi(mk_, __builtin_amdgcn_mbcnt_lo(mk_, 0u)); fr = ln_ & 15; fq = ln_ >> 4;
        PG8_LAS float* RS = (PG8_LAS float*)aux; PG8_LAS bf16_t* RK = (PG8_LAS bf16_t*)(aux + 2048);
        const int hh = 2 * u.pn + (wc >> 1); const bool isv = (wc & 1) != 0; const int lr0 = wr * 64 + fr; const size_t rowb = (size_t)u.pm * BM;
        if (isv) {
#pragma unroll
            for (int ai = 0; ai < 2; ++ai)
#pragma unroll
                for (int m = 0; m < 4; ++m) { const int lr = lr0 + ai * HALF + m * 16; const float rs = RS[lr * 2];
#pragma unroll
                    for (int bj = 0; bj < 2; ++bj) { const f32x4 v0 = acc[ai][bj][m][0] * rs, v1 = acc[ai][bj][m][1] * rs;
                        u32x4 w; w.x = pkbf(v0[0], v0[1]); w.y = pkbf(v0[2], v0[3]); w.z = pkbf(v1[0], v1[1]); w.w = pkbf(v1[2], v1[3]);
                        *(u32x4*)(VB + (rowb + lr) * 256 + hh * 64 + 32 * bj + 8 * fq) = w; } }
        } else {
            float k2max = 0.f;
            PG8_LAS const float* GN = (PG8_LAS const float*)(aux + 18432);
#pragma unroll
            for (int ai = 0; ai < 2; ++ai)
#pragma unroll
                for (int m = 0; m < 4; ++m) {
                    const int lr = lr0 + ai * HALF + m * 16; const f32x2 rr2 = *(const PG8_LAS f32x2*)(RS + lr * 2); const float rs = rr2[0];
                    const u32x2v k1 = *(const PG8_LAS u32x2v*)(RK + lr * 32 + 4 * fq), k2 = *(const PG8_LAS u32x2v*)(RK + lr * 32 + 16 + 4 * fq);
                    float ss = 0.f;
#pragma unroll
                    for (int bj = 0; bj < 2; ++bj)
#pragma unroll
                        for (int n = 0; n < 2; ++n) { const f32x4 a = acc[ai][bj][m][n]; ss += (a[0] * a[0] + a[1] * a[1]) + (a[2] * a[2] + a[3] * a[3]); }
                    ss += swz_xor<16>(ss); ss = half_sum(ss); ss *= rs * rs;
                    const float rk = rsqrtf((ss + rr2[1]) * (1.0f / 96.0f) + EPS); const float rr = rs * rk;
                    bf16_t* kd = CK + (rowb + lr) * 384 + hh * 96; float kn2 = 0.f;
#pragma unroll
                    for (int bj = 0; bj < 2; ++bj) {
                        const f32x4 a = acc[ai][bj][m][0] * rr * *(PG8_LAS const f32x4*)(GN + 32 * bj + 8 * fq), b = acc[ai][bj][m][1] * rr * *(PG8_LAS const f32x4*)(GN + 32 * bj + 8 * fq + 4);
                        kn2 += ((a[0] * a[0] + a[1] * a[1]) + (a[2] * a[2] + a[3] * a[3])) + ((b[0] * b[0] + b[1] * b[1]) + (b[2] * b[2] + b[3] * b[3]));
                        u32x4 w; w.x = pkbf(a[0], a[1]); w.y = pkbf(a[2], a[3]); w.z = pkbf(b[0], b[1]); w.w = pkbf(b[2], b[3]);
                        *(u32x4*)(kd + 32 * bj + 8 * fq) = w; }
                    const float y1[4] = {bflo(k1.x) * rk, bfhi(k1.x) * rk, bflo(k1.y) * rk, bfhi(k1.y) * rk}, y2[4] = {bflo(k2.x) * rk, bfhi(k2.x) * rk, bflo(k2.y) * rk, bfhi(k2.y) * rk};
                    u32x2v w1, w2; w1.x = pkbf(y1[0], y1[1]); w1.y = pkbf(y1[2], y1[3]); w2.x = pkbf(y2[0], y2[1]); w2.y = pkbf(y2[2], y2[3]);
                    *(u32x2v*)(kd + 64 + 4 * fq) = w1; *(u32x2v*)(kd + 80 + 4 * fq) = w2;
                    kn2 += ((y1[0] * y1[0] + y2[0] * y2[0]) + (y1[1] * y1[1] + y2[1] * y2[1])) + ((y1[2] * y1[2] + y2[2] * y2[2]) + (y1[3] * y1[3] + y2[3] * y2[3]));
                    kn2 += swz_xor<16>(kn2); kn2 = half_sum(kn2); k2max = fmaxf(k2max, kn2);
                    asm volatile("" ::: "memory");
                }
            k2max = fmaxf(k2max, swz_xor<1>(k2max)); k2max = fmaxf(k2max, swz_xor<2>(k2max)); k2max = fmaxf(k2max, swz_xor<4>(k2max)); k2max = fmaxf(k2max, swz_xor<8>(k2max));
            if (fr == 0 && fq == 0) __hip_atomic_fetch_max(kmx + ((u.pm * BM) / SEQ) * 4 + hh, __float_as_uint(k2max), __ATOMIC_RELAXED, __HIP_MEMORY_SCOPE_AGENT);
        }
        return false;
    }
};
struct EpiGates {
    static constexpr bool PERM = true;
    bf16_t* RG; RowScale rs;
    __device__ __forceinline__ bool operator()(f32x4 (&acc)[2][2][4][2], const Unit& u, int wr, int wc, int fr, int fq) const {
        typedef unsigned u32x2v __attribute__((ext_vector_type(2)));
        const int row0 = u.pm * BM + wr * 64 + fr, oc = u.pn * 64 + wc * 16 + fq * 4;
        float scv[2][4];
#pragma unroll
        for (int ai = 0; ai < 2; ++ai)
#pragma unroll
            for (int m = 0; m < 4; ++m) scv[ai][m] = row_scale(rs, row0 + ai * HALF + m * 16);
#pragma unroll
        for (int ai = 0; ai < 2; ++ai)
#pragma unroll
            for (int m = 0; m < 4; ++m) {
                const int row = row0 + ai * HALF + m * 16; const float sc = scv[ai][m];
                f32x4 s[4];
#pragma unroll
                for (int b = 0; b < 4; ++b) { const f32x4 g = acc[ai][b >> 1][m][b & 1] * sc;
#pragma unroll
                    for (int j = 0; j < 4; ++j) s[b][j] = fminf(1.0f + __builtin_amdgcn_exp2f(-g[j] * LOG2E), 1.1529215e18f); }
                bf16_t* rp = RG + (size_t)row * 4096 + oc;
#pragma unroll
                for (int b = 0; b < 4; ++b) { f32x4 r;
#pragma unroll
                    for (int j = 0; j < 4; ++j) r[j] = (b < 3 ? s[b + 1][j] : 1.0f) * __builtin_amdgcn_rcpf(s[b][j]);
                    u32x2v w; w.x = pkbf(r[0], r[1]); w.y = pkbf(r[2], r[3]); *(u32x2v*)(rp + b * 1024) = w; }
            }
        return false;
    }
};
struct EpiMerge {
    static constexpr bool PERM = true;
    const bf16_t* SG; bf16_t* Y;
    __device__ __forceinline__ bool operator()(f32x4 (&acc)[2][2][4][2], const Unit& u, int wr, int wc, int fr, int fq) const {
        const int n = u.ak >> 8; const int row0 = u.pm * BM + wr * 64 + fr, col0 = u.pn * BM + wc * 32 + 8 * fq;
        u32x4 av[2][4][2];
#pragma unroll
        for (int ai = 0; ai < 2; ++ai)
#pragma unroll
            for (int m = 0; m < 4; ++m)
#pragma unroll
                for (int bj = 0; bj < 2; ++bj) av[ai][m][bj] = *(const u32x4*)(SG + (size_t)(row0 + ai * HALF + m * 16) * 4096 + n * 1024 + col0 + bj * HALF);
#pragma unroll
        for (int ai = 0; ai < 2; ++ai)
#pragma unroll
            for (int m = 0; m < 4; ++m) {
                const int row = row0 + ai * HALF + m * 16;
#pragma unroll
                for (int bj = 0; bj < 2; ++bj) {
                    float sa[8]; unpack8(av[ai][m][bj], sa);
#pragma unroll
                    for (int j = 0; j < 4; ++j) { acc[ai][bj][m][0][j] *= sa[j]; acc[ai][bj][m][1][j] *= sa[4 + j]; }
                    if (n == 3) {
                        float o[8];
#pragma unroll
                        for (int j = 0; j < 4; ++j) { o[j] = acc[ai][bj][m][0][j]; o[4 + j] = acc[ai][bj][m][1][j]; }
                        *(u32x4*)(Y + (size_t)row * DM + col0 + bj * HALF) = pack8(o);
                    }
                }
            }
        return n < 3;
    }
};
struct MergeOrder {
    StaticOrder so;
    __device__ bool next(int i, Unit& u) const { if (!so.next(i >> 2, u)) return false; const int n = i & 3; u.pb = n * 4 + u.pn; u.ak = n * 256; return true; }
    __device__ __forceinline__ void a_ready(const Unit&) const {}
    __device__ __forceinline__ void done(const Unit&) const {}
};
struct MoeOrder {
    StaticOrder so; int nN; int ps[9];
    __device__ bool next(int i, Unit& u) const {
        if (!so.next(i, u)) return false; int e = 0;
#pragma unroll
        for (int k = 1; k < 8; ++k) e = (u.pm >= ps[k]) ? k : e;
        u.pb = e * nN + u.pn; u.ak = 0; return true; }
    __device__ __forceinline__ void a_ready(const Unit&) const {}
    __device__ __forceinline__ void done(const Unit&) const {}
};
}

struct TrDesc { const float* src; bf16* dst; const float* gain; int ldw, ldd, nnb, nsrc0, drow0, map, cum, pad; };
constexpr int TR_TAB_OFF = 8448;
struct TrItem { const float* W; bf16* dst; const float* gain; int ldw, ldd, k0, n0, perm; };
__device__ __forceinline__ void tr_load(const TrItem& it, float (&v)[32], int lane) {
#pragma unroll
    for (int i = 0; i < 32; ++i) { const int kk = 2 * i + (lane >> 5); v[i] = it.W[(size_t)(it.k0 + kk) * it.ldw + it.n0 + (lane & 31)]; }
}
__device__ __forceinline__ void tr_finish(const TrItem& it, float (&v)[32], LAS float* scr, int lane) {
    if (it.gain) {
#pragma unroll
        for (int i = 0; i < 32; ++i) v[i] *= it.gain[it.k0 + 2 * i + (lane >> 5)];
    }
#pragma unroll
    for (int i = 0; i < 32; ++i) scr[(2 * i + (lane >> 5)) * 33 + (lane & 31)] = v[i];
    LDS_WAIT(); asm volatile("" ::: "memory");
    const int c = lane & 7;
#pragma unroll
    for (int j = 0; j < 4; ++j) { const int n = (lane >> 3) + 8 * j; const LAS float* s = scr + (8 * c) * 33 + n;
        v4u o; o.x = pkbf(s[0 * 33], s[1 * 33]); o.y = pkbf(s[2 * 33], s[3 * 33]); o.z = pkbf(s[4 * 33], s[5 * 33]); o.w = pkbf(s[6 * 33], s[7 * 33]);
        const int nr = it.perm ? (32 * (n >> 4) + 8 * ((n >> 2) & 3) + (n & 3)) : n;
        *(v4u*)(it.dst + (size_t)nr * it.ldd + 8 * c) = o; }
    LDS_WAIT(); asm volatile("" ::: "memory");
}
__device__ __forceinline__ void tr_add(LAS TrDesc* t, int& n, int& cum, const float* src, int ldw, int Ktot, int ncols, int nsrc0, bf16* dst, int ldd, int drow0, int map, const float* gain) {
    int z = 0; asm volatile("" : "+s"(z));
    asm volatile("" : "+s"(gain));
    t[n].src = src; t[n].dst = dst; t[n].gain = gain; t[n].ldw = ldw + z; t[n].ldd = ldd + z; t[n].nnb = ncols / 32 + z; t[n].nsrc0 = nsrc0 + z; t[n].drow0 = drow0 + z; t[n].map = map + z; t[n].cum = cum + z;
    cum += (Ktot / 64) * (ncols / 32); ++n;
}
__device__ __forceinline__ TrItem tr_lookup(const LAS TrDesc* t, int& d, int it) {
    while (it >= t[d + 1].cum) ++d;
    const int local = it - t[d].cum, nnb = t[d].nnb, kb = local / nnb, nb = local - kb * nnb, k0 = kb * 64, nl = nb * 32;
    const int mp = t[d].map;
    const int drow = t[d].drow0 + (mp == 1 ? ((nl >> 7) * 256 + (nl & 127)) : mp == 2 ? (256 * (nl >> 8) + 128 * ((nl >> 5) & 1) + 32 * ((((nl >> 7) & 1) << 1) + ((nl >> 6) & 1)))
                                 : mp == 3 ? (256 * ((nl & 1023) >> 6) + 128 * (nl >> 11) + 32 * (((nl & 1023) >> 4) & 3) + 4 * ((nl >> 10) & 1)) : nl); const int ldd = t[d].ldd;
    TrItem r; r.W = t[d].src; r.dst = t[d].dst + (size_t)drow * ldd + k0; r.gain = t[d].gain; r.ldw = t[d].ldw; r.ldd = ldd; r.k0 = k0; r.n0 = t[d].nsrc0 + nl; r.perm = (mp == 3) ? 1 : 0; return r;
}
__device__ __forceinline__ void tr_run(const LAS TrDesc* t, int total, LAS float* scr, int lane, int gw, int NGW, int ibeg = 0, int iend = -1) {
    if (iend < 0) iend = total;
    const int cntI = iend - ibeg, per = (cntI + NGW - 1) / NGW, lo = ibeg + gw * per, hi = (lo + per < iend) ? lo + per : iend;
    if (lo >= hi) return;
    int d = 0; TrItem cur = tr_lookup(t, d, lo); float va[32], vb[32];
    tr_load(cur, va, lane);
    for (int it = lo; it < hi; it += 2) {
        TrItem nx = cur; const bool h1 = it + 1 < hi;
        if (h1) { nx = tr_lookup(t, d, it + 1); tr_load(nx, vb, lane); }
        tr_finish(cur, va, scr, lane);
        if (!h1) break;
        const bool h2 = it + 2 < hi;
        if (h2) { cur = tr_lookup(t, d, it + 2); tr_load(cur, va, lane); }
        tr_finish(nx, vb, scr, lane);
    }
}

template <int DK, int DV, bool MOBA>
__device__ __forceinline__ void naive_attn_unit(LAS unsigned char* lds, const bf16* Q, int qp, int qhs, const bf16* K, int kp, int khs, const bf16* V, int vp, int vhs,
                                                bf16* O, int op, int b, int h, int qc, const int* sel, const int tid) {
    LAS float* Ks = (LAS float*)lds; LAS float* Vs = Ks + 64 * DK;
    const int qi = qc * 512 + tid;
    const size_t tok = (size_t)b * SEQ + qi;
    float q[DK];
    { const v4u* qsrc = (const v4u*)(Q + tok * qp + h * qhs);
#pragma unroll
      for (int c = 0; c < DK / 8; ++c) unpack8(qsrc[c], q + 8 * c); }
    float o[DV];
#pragma unroll
    for (int d = 0; d < DV; ++d) o[d] = 0.f;
    float m = -1e30f, l = 0.f;
    const int qblk = qi >> 8; unsigned mask = 0u;
    if (MOBA) { const int sv = sel[tok * 4 + h]; const int ns = (sv >> 12) & 3;
        if (ns > 0) mask |= 1u << (sv & 15); if (ns > 1) mask |= 1u << ((sv >> 4) & 15); if (ns > 2) mask |= 1u << ((sv >> 8) & 15); }
    const int ntile = qc * 8 + 8;
    const int wave_last = qc * 512 + (tid | 63);
    for (int kt = 0; kt < ntile; ++kt) {
        __syncthreads();
        const int k0 = kt * 64;
        for (int c = tid; c < 64 * (DK / 8); c += NTHR) { const int r = c / (DK / 8), ch = c - r * (DK / 8);
            const v4u w = *(const v4u*)(K + ((size_t)b * SEQ + k0 + r) * kp + h * khs + ch * 8); float f[8]; unpack8(w, f);
            LAS f32x4* d = (LAS f32x4*)(Ks + r * DK + ch * 8); d[0] = (f32x4){f[0], f[1], f[2], f[3]}; d[1] = (f32x4){f[4], f[5], f[6], f[7]}; }
        for (int c = tid; c < 64 * (DV / 8); c += NTHR) { const int r = c / (DV / 8), ch = c - r * (DV / 8);
            const v4u w = *(const v4u*)(V + ((size_t)b * SEQ + k0 + r) * vp + h * vhs + ch * 8); float f[8]; unpack8(w, f);
            LAS f32x4* d = (LAS f32x4*)(Vs + r * DV + ch * 8); d[0] = (f32x4){f[0], f[1], f[2], f[3]}; d[1] = (f32x4){f[4], f[5], f[6], f[7]}; }
        __syncthreads();
        if (k0 > wave_last) continue;
        const int nblk = k0 >> 8;
        bool tile_ok = true;
        if (MOBA) { tile_ok = (nblk == qblk) || ((mask >> nblk) & 1u); if (!__any(tile_ok)) continue; }
        for (int jj = 0; jj < 64; ++jj) {
            const int kj = k0 + jj;
            const bool ok = MOBA ? (tile_ok && (nblk != qblk || kj <= qi)) : (kj <= qi);
            if (ok) {
                const LAS f32x4* kr = (const LAS f32x4*)(Ks + jj * DK);
                float s0 = 0.f, s1 = 0.f;
#pragma unroll
                for (int c = 0; c < DK / 8; ++c) { const f32x4 a = kr[2 * c], bq = kr[2 * c + 1];
                    s0 += q[8 * c] * a[0]; s1 += q[8 * c + 1] * a[1]; s0 += q[8 * c + 2] * a[2]; s1 += q[8 * c + 3] * a[3];
                    s0 += q[8 * c + 4] * bq[0]; s1 += q[8 * c + 5] * bq[1]; s0 += q[8 * c + 6] * bq[2]; s1 += q[8 * c + 7] * bq[3]; }
                const float s = s0 + s1;
                if (s > m) { const float cf = __builtin_amdgcn_exp2f(m - s); l *= cf;
#pragma unroll
                    for (int d = 0; d < DV; ++d) o[d] *= cf;
                    m = s; }
                const float p = __builtin_amdgcn_exp2f(s - m); l += p;
                const LAS f32x4* vr = (const LAS f32x4*)(Vs + jj * DV);
#pragma unroll
                for (int c = 0; c < DV / 4; ++c) { const f32x4 a = vr[c]; o[4 * c] += p * a[0]; o[4 * c + 1] += p * a[1]; o[4 * c + 2] += p * a[2]; o[4 * c + 3] += p * a[3]; }
            }
        }
    }
    const float inv = 1.0f / l;
    v4u* od = (v4u*)(O + tok * op + h * DV);
#pragma unroll
    for (int c = 0; c < DV / 8; ++c) { float t8[8];
#pragma unroll
        for (int j = 0; j < 8; ++j) t8[j] = o[8 * c + j] * inv;
        od[c] = pack8(t8); }
    __syncthreads();
}

__device__ __forceinline__ void kv_prepass(LAS unsigned char* aux, const bf16* PROJ, const float* ssc, const float* rope, const float* __restrict__ ckn, int pm, const int tid) {
    LAS float* RS = (LAS float*)aux; LAS bf16* RK = (LAS bf16*)(aux + 2048);
    __syncthreads();
    const int r = tid >> 1, hf = tid & 1; const size_t row = (size_t)pm * 256 + r;
    const v4u a1 = *(const v4u*)(PROJ + row * PJ_LD + PJ_KR + 8 * hf), a2 = *(const v4u*)(PROJ + row * PJ_LD + PJ_KR + 16 + 8 * hf);
    const float* tb = rope + row * 48 + 16 + 16 * hf; f32x4 tt[4];
#pragma unroll
    for (int q = 0; q < 4; ++q) tt[q] = *(const f32x4*)(tb + 4 * q);
    const f32x4 ga0 = *(const f32x4*)(ckn + 64 + 8 * hf), ga1 = *(const f32x4*)(ckn + 68 + 8 * hf), gb0 = *(const f32x4*)(ckn + 80 + 8 * hf), gb1 = *(const f32x4*)(ckn + 84 + 8 * hf);
    const f32x4 pp = *(const f32x4*)(ssc + row * 12 + 4); const float s8 = ssc[row * 12 + 8];
    const float ga[8] = {ga0[0], ga0[1], ga0[2], ga0[3], ga1[0], ga1[1], ga1[2], ga1[3]}, gb[8] = {gb0[0], gb0[1], gb0[2], gb0[3], gb1[0], gb1[1], gb1[2], gb1[3]};
    v4u w1, w2;
#pragma unroll
    for (int q = 0; q < 4; ++q) {
        const float xa = bflo(a1[q]) * ga[2 * q], xb = bfhi(a1[q]) * ga[2 * q + 1], za = bflo(a2[q]) * gb[2 * q], zb = bfhi(a2[q]) * gb[2 * q + 1];
        w1[q] = pkbf(xa * tt[q][0] - za * tt[q][1], xb * tt[q][2] - zb * tt[q][3]); w2[q] = pkbf(za * tt[q][0] + xa * tt[q][1], zb * tt[q][2] + xb * tt[q][3]); }
    *(LAS v4u*)(RK + r * 32 + 8 * hf) = w1; *(LAS v4u*)(RK + r * 32 + 16 + 8 * hf) = w2;
    if (hf == 0) { RS[r * 2] = rsqrtf(((pp[0] + pp[1]) + (pp[2] + pp[3])) * (1.0f / 128.0f) + EPS); RS[r * 2 + 1] = s8; }
    if (tid < 16) *(LAS f32x4*)(aux + 18432 + tid * 16) = *(const f32x4*)(ckn + 4 * tid);
    __syncthreads();
}

constexpr int SGU_P = 136;
__device__ __forceinline__ void sgu_unit(LAS unsigned char* lds, const bf16* PROJ, bf16* O, const float* __restrict__ lng, const float* __restrict__ lnb, const bf16* __restrict__ WM, const float* __restrict__ bs, int unit, const int tid) {
    LAS bf16* vnT = (LAS bf16*)lds;
    const int lane = tid & 63, wave = __builtin_amdgcn_readfirstlane(tid >> 6), r32 = lane & 31, hi = lane >> 5;
    const size_t t0 = (size_t)unit * 128;
    const f32x4 g4 = *(const f32x4*)(lng + 4 * lane), b4 = *(const f32x4*)(lnb + 4 * lane);
    bf16x8 wf[20];
    { const int g_ = wave >> 1; const bf16* wb = WM + ((size_t)(g_ * 128 + r32) * 128 + 8 * hi);
#pragma unroll
      for (int nt = 0; nt < 4; ++nt)
#pragma unroll
          for (int ks = 0; ks < 2 * nt + 2; ++ks) wf[nt * (nt + 1) + ks] = *(const bf16x8*)(wb + (size_t)(32 * nt) * 128 + 16 * ks); }
    {
        typedef unsigned u32x2v __attribute__((ext_vector_type(2)));
        u32x2v xr[16];
#pragma unroll
        for (int i = 0; i < 16; ++i) xr[i] = *(const u32x2v*)(PROJ + (t0 + wave * 16 + i) * PJ_LD + PJ_V + 4 * lane);
        unsigned ow[4][8];
#pragma unroll
        for (int i4 = 0; i4 < 4; ++i4) {
            float x[4][4], mu[4], var[4];
#pragma unroll
            for (int u = 0; u < 4; ++u) { const u32x2v r = xr[4 * i4 + u]; x[u][0] = bflo(r.x); x[u][1] = bfhi(r.x); x[u][2] = bflo(r.y); x[u][3] = bfhi(r.y); mu[u] = (x[u][0] + x[u][1]) + (x[u][2] + x[u][3]); }
#pragma unroll
            for (int u = 0; u < 4; ++u) mu[u] = wave_sum(mu[u]) * (1.0f / 256.0f);
#pragma unroll
            for (int u = 0; u < 4; ++u) { x[u][0] -= mu[u]; x[u][1] -= mu[u]; x[u][2] -= mu[u]; x[u][3] -= mu[u]; var[u] = (x[u][0] * x[u][0] + x[u][1] * x[u][1]) + (x[u][2] * x[u][2] + x[u][3] * x[u][3]); }
#pragma unroll
            for (int u = 0; u < 4; ++u) var[u] = wave_sum(var[u]) * (1.0f / 256.0f);
#pragma unroll
            for (int u = 0; u < 4; ++u) { const float rstd = rsqrtf(var[u] + EPS);
#pragma unroll
                for (int c = 0; c < 4; ++c) x[u][c] = x[u][c] * rstd * g4[c] + b4[c]; }
#pragma unroll
            for (int c = 0; c < 4; ++c) { ow[c][2 * i4] = pkbf(x[0][c], x[1][c]); ow[c][2 * i4 + 1] = pkbf(x[2][c], x[3][c]); }
        }
#pragma unroll
        for (int c = 0; c < 4; ++c) { LAS v4u* dst = (LAS v4u*)(vnT + (4 * lane + c) * SGU_P + wave * 16);
            dst[0] = (v4u){ow[c][0], ow[c][1], ow[c][2], ow[c][3]}; dst[1] = (v4u){ow[c][4], ow[c][5], ow[c][6], ow[c][7]}; }
    }
    __syncthreads();
    const int g = wave >> 1, dt = wave & 1;
    bf16x8 af[8];
#pragma unroll
    for (int ks = 0; ks < 8; ++ks) af[ks] = *(const LAS bf16x8*)(vnT + (g * 64 + dt * 32 + r32) * SGU_P + 16 * ks + 8 * hi);
    typedef float f32x16s __attribute__((ext_vector_type(16)));
    f32x16s acc[4];
#pragma unroll
    for (int nt = 0; nt < 4; ++nt) {
#pragma unroll
        for (int r = 0; r < 16; ++r) acc[nt][r] = 0.f;
#pragma unroll
        for (int ks = 0; ks < 2 * nt + 2; ++ks) {
            acc[nt] = __builtin_amdgcn_mfma_f32_32x32x16_bf16(af[ks], wf[nt * (nt + 1) + ks], acc[nt], 0, 0, 0);
        }
    }
    typedef unsigned u32x2v __attribute__((ext_vector_type(2)));
    u32x2v uva[4][4]; float biasv[4];
#pragma unroll
    for (int nt = 0; nt < 4; ++nt) { const int t = 32 * nt + r32; biasv[nt] = bs[g * 128 + t]; const bf16* up = PROJ + (t0 + t) * PJ_LD + PJ_U + g * 64 + dt * 32 + 4 * hi;
#pragma unroll
        for (int j = 0; j < 4; ++j) uva[nt][j] = *(const u32x2v*)(up + 8 * j); }
#pragma unroll
    for (int nt = 0; nt < 4; ++nt) {
        const int t = 32 * nt + r32; const float bias = biasv[nt];
        bf16* op = O + (t0 + t) * DM + g * 64 + dt * 32 + 4 * hi;
#pragma unroll
        for (int j = 0; j < 4; ++j) {
            const u32x2v uu = uva[nt][j];
            u32x2v w; w.x = pkbf(bflo(uu.x) * (acc[nt][4 * j] + bias), bfhi(uu.x) * (acc[nt][4 * j + 1] + bias)); w.y = pkbf(bflo(uu.y) * (acc[nt][4 * j + 2] + bias), bfhi(uu.y) * (acc[nt][4 * j + 3] + bias));
            *(u32x2v*)(op + 8 * j) = w;
        }
    }
    __syncthreads();
}

__device__ __forceinline__ void prep_block(LAS unsigned char* lds, bf16* PROJ, const float* __restrict__ ROPE, const float* __restrict__ qn, const float* __restrict__ kn, float* KMEAN, unsigned* kmx_out, int item, const int tid) {
    const int b = item >> 5, blk = (item >> 1) & 15, hf = item & 1;
    const int sub = tid & 7;
    const size_t tok0 = (size_t)b * SEQ + blk * 256 + hf * 128;
    float ksum[8] = {0.f, 0.f, 0.f, 0.f, 0.f, 0.f, 0.f, 0.f};
    float kmx = 0.f;
    f32x4 gq0 = *(const f32x4*)(qn + 8 * sub), gq1 = *(const f32x4*)(qn + 8 * sub + 4), gk0 = *(const f32x4*)(kn + 8 * sub), gk1 = *(const f32x4*)(kn + 8 * sub + 4);
    LAS float* rl = (LAS float*)(lds + 16384);
    { const f32x4 r = *(const f32x4*)(ROPE + (tok0 + (tid >> 2)) * 48 + 4 * (tid & 3)); *(LAS f32x4*)(rl + (tid >> 2) * 16 + 4 * (tid & 3)) = r; }
    v4u raw[16];
#pragma unroll
    for (int u = 0; u < 16; ++u) { const int row = u * 64 + (tid >> 3);
        const int tk = row >> 3, which = (row >> 2) & 1, hd = row & 3;
        raw[u] = *(const v4u*)(PROJ + (tok0 + tk) * PJ_LD + (which ? PJ_BK : PJ_BQ) + hd * 64 + 8 * sub); }
    __syncthreads();
#pragma unroll
    for (int u = 0; u < 16; ++u) { const int row = u * 64 + (tid >> 3);
        const int tk = row >> 3, which = (row >> 2) & 1, hd = row & 3;
        float v[8]; unpack8(raw[u], v);
        float ss = ((v[0] * v[0] + v[1] * v[1]) + (v[2] * v[2] + v[3] * v[3])) + ((v[4] * v[4] + v[5] * v[5]) + (v[6] * v[6] + v[7] * v[7]));
        ss += swz_xor<1>(ss); ss += swz_xor<2>(ss); ss += swz_xor<4>(ss);
        const float rstd = rsqrtf(ss * (1.0f / 64.0f) + EPS);
        const f32x4 g0 = which ? gk0 : gq0, g1 = which ? gk1 : gq1;
#pragma unroll
        for (int j = 0; j < 4; ++j) { v[j] *= rstd * g0[j]; v[4 + j] *= rstd * g1[j]; }
        f32x4 rp[4];
#pragma unroll
        for (int q = 0; q < 4; ++q) rp[q] = *(const LAS f32x4*)(rl + tk * 16 + 4 * q);
#pragma unroll
        for (int j = 0; j < 8; ++j) { const float other = swz_xor<1>(v[j]);
            if (sub < 2) { const float cs = rp[j >> 1][2 * (j & 1)], sn = rp[j >> 1][2 * (j & 1) + 1]; v[j] = (sub == 0) ? (v[j] * cs - other * sn) : (v[j] * cs + other * sn); } }
        if (!which) {
#pragma unroll
            for (int j = 0; j < 8; ++j) v[j] *= QS_B;
        } else {
            float s2 = ((v[0] * v[0] + v[1] * v[1]) + (v[2] * v[2] + v[3] * v[3])) + ((v[4] * v[4] + v[5] * v[5]) + (v[6] * v[6] + v[7] * v[7]));
            s2 += swz_xor<1>(s2); s2 += swz_xor<2>(s2); s2 += swz_xor<4>(s2); kmx = fmaxf(kmx, s2);
#pragma unroll
            for (int j = 0; j < 8; ++j) ksum[j] += v[j];
        }
        *(v4u*)(PROJ + (tok0 + tk) * PJ_LD + (which ? PJ_BK : PJ_BQ) + hd * 64 + 8 * sub) = pack8(v);
    }
    {
        LAS float* kl = (LAS float*)lds; if (((tid >> 5) & 1) && sub == 0) kl[(tid >> 6) * 4 + ((tid >> 3) & 3)] = kmx;
        LAS float* ks = (LAS float*)(lds + 4096);
        if ((tid >> 5) & 1) { LAS f32x4* kd = (LAS f32x4*)(ks + (tid >> 6) * 256 + ((tid >> 3) & 3) * 64 + 8 * sub); kd[0] = (f32x4){ksum[0], ksum[1], ksum[2], ksum[3]}; kd[1] = (f32x4){ksum[4], ksum[5], ksum[6], ksum[7]}; }
        __syncthreads();
        if (tid < 4) { float mx = 0.f;
#pragma unroll
            for (int w = 0; w < 8; ++w) mx = fmaxf(mx, kl[w * 4 + tid]);
            __hip_atomic_fetch_max(kmx_out + b * 4 + tid, __float_as_uint(mx), __ATOMIC_RELAXED, __HIP_MEMORY_SCOPE_AGENT); }
        if (tid >= 256) { const int hd = tid - 256; float s = 0.f;
#pragma unroll
            for (int w = 0; w < 8; ++w) s += ks[w * 256 + hd];
            KMEAN[(((size_t)(b * 4 + (hd >> 6)) * 16 + blk) * 2 + hf) * 64 + (hd & 63)] = s; }
    }
    __syncthreads();
}

__device__ __forceinline__ void conv_unit(LAS unsigned char* lds, const bf16* PROJ, bf16* O, const float* __restrict__ cw, const float* __restrict__ cb, const float* __restrict__ lng, const float* __restrict__ lnb, int unit, const int tid) {
    LAS float* zc = (LAS float*)lds;
    const int lane = tid & 63, wave = __builtin_amdgcn_readfirstlane(tid >> 6);
    const int b = unit >> 6, p0 = (unit & 63) * 64;
    const int ch = tid & 255, half = tid >> 8;
    {
        typedef unsigned u32x2v __attribute__((ext_vector_type(2)));
        u32x2v av[12], gv[12];
#pragma unroll
        for (int i = 0; i < 12; ++i) { const int r = wave + 8 * i, p = p0 - 30 + r; av[i] = (u32x2v){0u, 0u}; gv[i] = (u32x2v){0u, 0u};
            if (r < 94 && p >= 0) { const bf16* row = PROJ + ((size_t)b * SEQ + p) * PJ_LD; av[i] = *(const u32x2v*)(row + PJ_DA + 4 * lane); gv[i] = *(const u32x2v*)(row + PJ_DG + 4 * lane); } }
#pragma unroll
        for (int i = 0; i < 12; ++i) { const int r = wave + 8 * i;
            if (r < 94) *(LAS f32x4*)(zc + r * 256 + 4 * lane) = (f32x4){bflo(av[i].x) * fast_sigmoid(bflo(gv[i].x)), bfhi(av[i].x) * fast_sigmoid(bfhi(gv[i].x)), bflo(av[i].y) * fast_sigmoid(bflo(gv[i].y)), bfhi(av[i].y) * fast_sigmoid(bfhi(gv[i].y))}; }
    }
    float w[31];
#pragma unroll
    for (int j = 0; j < 31; ++j) w[j] = cw[j * 256 + ch];
    const float bias = cb[ch];
    __syncthreads();
    float acc[32];
    {
        float z[62];
#pragma unroll
        for (int j = 0; j < 62; ++j) z[j] = zc[(half * 32 + j) * 256 + ch];
#pragma unroll
        for (int t = 0; t < 32; ++t) { float a = bias;
#pragma unroll
            for (int j = 0; j < 31; ++j) a += w[j] * z[t + j];
            acc[t] = a; }
    }
    __syncthreads();
#pragma unroll
    for (int t = 0; t < 32; ++t) zc[(half * 32 + t) * 256 + ch] = acc[t];
    __syncthreads();
    const f32x4 g4 = *(const f32x4*)(lng + lane * 4), b4 = *(const f32x4*)(lnb + lane * 4);
    for (int i4 = 0; i4 < 2; ++i4) {
        f32x4 x[4]; float mu[4], var[4];
#pragma unroll
        for (int u = 0; u < 4; ++u) { x[u] = *(const LAS f32x4*)(zc + (wave * 8 + i4 * 4 + u) * 256 + lane * 4); mu[u] = (x[u][0] + x[u][1]) + (x[u][2] + x[u][3]); }
#pragma unroll
        for (int u = 0; u < 4; ++u) mu[u] = wave_sum(mu[u]) * (1.0f / 256.0f);
#pragma unroll
        for (int u = 0; u < 4; ++u) { x[u] = x[u] - mu[u]; var[u] = (x[u][0] * x[u][0] + x[u][1] * x[u][1]) + (x[u][2] * x[u][2] + x[u][3] * x[u][3]); }
#pragma unroll
        for (int u = 0; u < 4; ++u) var[u] = wave_sum(var[u]) * (1.0f / 256.0f);
#pragma unroll
        for (int u = 0; u < 4; ++u) { const float rstd = rsqrtf(var[u] + EPS);
            const float y0 = x[u][0] * rstd * g4[0] + b4[0], y1 = x[u][1] * rstd * g4[1] + b4[1], y2 = x[u][2] * rstd * g4[2] + b4[2], y3 = x[u][3] * rstd * g4[3] + b4[3];
            typedef unsigned u32x2v __attribute__((ext_vector_type(2)));
            u32x2v wv; wv.x = pkbf(fast_silu(y0), fast_silu(y1)); wv.y = pkbf(fast_silu(y2), fast_silu(y3));
            *(u32x2v*)(O + ((size_t)b * SEQ + p0 + wave * 8 + i4 * 4 + u) * DM + 768 + lane * 4) = wv; }
    }
    __syncthreads();
}

typedef float f32x16 __attribute__((ext_vector_type(16)));
template <int DK> struct AttnLds { static constexpr int KBYTES = 64 * DK * 2  , VP = 68, VBYTES = 64 * VP * 2, K0 = 0, K1 = KBYTES, V0 = 2 * KBYTES  , UM = 2 * KBYTES + 3 * VBYTES; };
__device__ __forceinline__ float half_max(float v) { auto rr = __builtin_amdgcn_permlane32_swap(__float_as_uint(v), __float_as_uint(v), false, false); return fmaxf(__uint_as_float(rr[0]), __uint_as_float(rr[1])); }
#define ATT_FAST_BOUND 30.0f
__device__ __forceinline__ void softmax_fast(f32x16& s, float& l, bf16x8 (&p)[2], const bool diag, const bool blocked, const int qi, const int kbase) {
    if (diag) {
#pragma unroll
        for (int r = 0; r < 16; ++r) { const int key = kbase + (r & 3) + 8 * (r >> 2); if (key > qi) s[r] = -INFINITY; }
    }
    float sum = 0.f;
#pragma unroll
    for (int r = 0; r < 16; ++r) { const float e = __builtin_amdgcn_exp2f(s[r]); s[r] = e; sum += e; }
    v4u w0, w1;
    w0.x = pkbf(s[0], s[1]); w0.y = pkbf(s[2], s[3]); w0.z = pkbf(s[4], s[5]); w0.w = pkbf(s[6], s[7]);
    w1.x = pkbf(s[8], s[9]); w1.y = pkbf(s[10], s[11]); w1.z = pkbf(s[12], s[13]); w1.w = pkbf(s[14], s[15]);
    if (blocked) { sum = 0.f; w0 = (v4u){0u, 0u, 0u, 0u}; w1 = (v4u){0u, 0u, 0u, 0u}; }
    l += sum;
    p[0] = __builtin_bit_cast(bf16x8, w0); p[1] = __builtin_bit_cast(bf16x8, w1);
}
__device__ __forceinline__ void softmax_group(f32x16& s, f32x16 (&o)[2], float& m, float& l, bf16x8 (&p)[2], const bool diag, const bool blocked, const int qi, const int kbase) {
    if (diag) {
#pragma unroll
        for (int r = 0; r < 16; ++r) { const int key = kbase + (r & 3) + 8 * (r >> 2); if (key > qi) s[r] = -INFINITY; }
    }
    float mx = fmaxf(s[0], s[1]);
#pragma unroll
    for (int r = 2; r < 16; ++r) mx = fmaxf(mx, s[r]);
    mx = half_max(mx);
    if (blocked) mx = -INFINITY;
    const float mn = fmaxf(m, mx);
    const float ms = (mn == -INFINITY) ? 0.f : mn;
    const float alpha = __builtin_amdgcn_exp2f(m - ms);
    const float mse = blocked ? INFINITY : ms;
    float sum = 0.f;
#pragma unroll
    for (int r = 0; r < 16; ++r) { const float e = __builtin_amdgcn_exp2f(s[r] - mse); s[r] = e; sum += e; }
    l = l * alpha + sum; m = mn;
    if (__any(alpha != 1.f)) {
#pragma unroll
        for (int dt = 0; dt < 2; ++dt)
#pragma unroll
            for (int r = 0; r < 16; ++r) o[dt][r] *= alpha;
    }
#pragma unroll
    for (int st = 0; st < 2; ++st) { const int bs = 8 * st;
        v4u w; w.x = pkbf(s[bs], s[bs + 1]); w.y = pkbf(s[bs + 2], s[bs + 3]); w.z = pkbf(s[bs + 4], s[bs + 5]); w.w = pkbf(s[bs + 6], s[bs + 7]);
        p[st] = __builtin_bit_cast(bf16x8, w); }
}
template <int NKS, int DK>
__device__ __forceinline__ float qpost(bf16x8 (&qf)[NKS], const float* __restrict__ qgain, const float* __restrict__ tabrow, const int hi) {
    float qv[8 * NKS]; float ss = 0.f;
#pragma unroll
    for (int ks = 0; ks < NKS; ++ks) unpack8(__builtin_bit_cast(v4u, qf[ks]), qv + 8 * ks);
#pragma unroll
    for (int i = 0; i < 8 * NKS; ++i) ss += qv[i] * qv[i];
    const float rstd = rsqrtf(half_sum(ss) * (1.0f / (float)DK) + EPS);
#pragma unroll
    for (int ks = 0; ks < NKS; ++ks) { const f32x4 ga = *(const f32x4*)(qgain + 16 * ks + 8 * hi), gb = *(const f32x4*)(qgain + 16 * ks + 8 * hi + 4);
#pragma unroll
        for (int j = 0; j < 4; ++j) { qv[8 * ks + j] *= rstd * ga[j]; qv[8 * ks + 4 + j] *= rstd * gb[j]; } }
    const float* tb = tabrow + 16 + 16 * hi;
#pragma unroll
    for (int j = 0; j < 8; ++j) { const float cs = tb[2 * j], sn = tb[2 * j + 1], x1 = qv[32 + j], x2 = qv[40 + j]; qv[32 + j] = x1 * cs - x2 * sn; qv[40 + j] = x2 * cs + x1 * sn; }
    float q2 = 0.f;
#pragma unroll
    for (int i = 0; i < 8 * NKS; ++i) { qv[i] *= QS_C; q2 += qv[i] * qv[i]; }
#pragma unroll
    for (int ks = 0; ks < NKS; ++ks) qf[ks] = __builtin_bit_cast(bf16x8, pack8(qv + 8 * ks));
    return half_sum(q2);
}
template <int DK, bool MOBA, bool QPOST, int qp, int qhs, int kp, int khs, int vp, int vhs, int op>
__device__ __forceinline__ void attn_unit(LAS unsigned char* lds, const bf16* __restrict__ Q, const bf16* __restrict__ K,
                                          const bf16* __restrict__ V, bf16* O, const int b, const int h, const int qc, const float* __restrict__ kmean, const float* __restrict__ qgain, const float* __restrict__ rope, const unsigned* __restrict__ kmx, const int tid) {
    using L = AttnLds<DK>;
    constexpr int NKS = DK / 16, KCH = DK / 8;
    const int lane = tid & 63, w = __builtin_amdgcn_readfirstlane(tid >> 6), r32 = lane & 31, hi = lane >> 5;
    const int q0 = qc * 512;
    const size_t tokbase = (size_t)b * SEQ;
    const int g0 = w, g1 = 15 - w;
    const int qi0 = q0 + 32 * g0 + r32, qi1 = q0 + 32 * g1 + r32;
    const int tl0 = (q0 + 32 * g0 + 31) >> 6, tl1 = (q0 + 32 * g1 + 31) >> 6;
    const int ob0 = (q0 + 32 * g0) >> 8, ob1 = (q0 + 32 * g1) >> 8;
    bf16x8 qf0[NKS], qf1[NKS];
    { const bf16* p0 = Q + (tokbase + qi0) * qp + h * qhs + 8 * hi;
#pragma unroll
      for (int ks = 0; ks < NKS; ++ks) qf0[ks] = *(const bf16x8*)(p0 + 16 * ks); }
    float q2a = 0.f, q2b = 0.f;
    if (QPOST) { q2a = qpost<NKS, DK>(qf0, qgain, rope + (tokbase + qi0) * 48, hi); asm volatile("" ::: "memory"); }
    { const bf16* p1 = Q + (tokbase + qi1) * qp + h * qhs + 8 * hi;
#pragma unroll
      for (int ks = 0; ks < NKS; ++ks) qf1[ks] = *(const bf16x8*)(p1 + 16 * ks); }
    if (QPOST) { q2b = qpost<NKS, DK>(qf1, qgain, rope + (tokbase + qi1) * 48, hi); asm volatile("" ::: "memory"); }
    unsigned mk0 = 0u, mk1 = 0u, umask = 0xffffffffu;
    if (MOBA) {
        LAS float* kml = (LAS float*)(lds + L::UM + 16);
        { const float* kmg = kmean + (size_t)(b * 4 + h) * 16 * 128;
          for (int i = tid; i < 1024; i += NTHR) { const int n = i >> 6, d = i & 63; kml[i] = (kmg[n * 128 + d] + kmg[n * 128 + 64 + d]) * (1.0f / 256.0f); } }
        __syncthreads();
        const LAS float* km = kml + 8 * hi;
#pragma unroll
        for (int g = 0; g < 2; ++g) {
            float qv[8 * NKS];
#pragma unroll
            for (int ks = 0; ks < NKS; ++ks) unpack8(__builtin_bit_cast(v4u, g ? qf1[ks] : qf0[ks]), qv + 8 * ks);
            { float q2 = 0.f;
#pragma unroll
              for (int i = 0; i < 8 * NKS; ++i) q2 += qv[i] * qv[i];
              q2 = half_sum(q2); if (g) q2b = q2; else q2a = q2; }
            const int ob = g ? ob1 : ob0;
            float s0 = -INFINITY, s1 = -INFINITY, s2 = -INFINITY; int i0 = 0, i1 = 0, i2 = 0;
            for (int n = 0; n < ob; ++n) {
                const LAS float* kmp = km + n * 64; float sc = 0.f;
#pragma unroll
                for (int ks = 0; ks < NKS; ++ks) { const f32x4 ka = *(const LAS f32x4*)(kmp + 16 * ks), kb2 = *(const LAS f32x4*)(kmp + 16 * ks + 4);
                    sc += qv[8 * ks] * ka[0]; sc += qv[8 * ks + 1] * ka[1]; sc += qv[8 * ks + 2] * ka[2]; sc += qv[8 * ks + 3] * ka[3];
                    sc += qv[8 * ks + 4] * kb2[0]; sc += qv[8 * ks + 5] * kb2[1]; sc += qv[8 * ks + 6] * kb2[2]; sc += qv[8 * ks + 7] * kb2[3]; }
                sc = half_sum(sc);
                if (sc > s0) { s2 = s1; i2 = i1; s1 = s0; i1 = i0; s0 = sc; i0 = n; }
                else if (sc > s1) { s2 = s1; i2 = i1; s1 = sc; i1 = n; }
                else if (sc > s2) { s2 = sc; i2 = n; }
            }
            unsigned mk = 0u; if (ob > 0) mk |= 1u << i0; if (ob > 1) mk |= 1u << i1; if (ob > 2) mk |= 1u << i2;
            if (g) mk1 = mk; else mk0 = mk;
        }
        LAS unsigned* um = (LAS unsigned*)(lds + L::UM);
        if (tid == 0) *um = 0u;
        __syncthreads();
        __hip_atomic_fetch_or(um, mk0 | mk1, __ATOMIC_RELAXED, __HIP_MEMORY_SCOPE_WORKGROUP);
        __syncthreads();
        umask = *um;
    }
    const float k2m = __uint_as_float(__hip_atomic_load(kmx + b * 4 + h, __ATOMIC_RELAXED, __HIP_MEMORY_SCOPE_AGENT));
    const bool fast = __all(fmaxf(q2a, q2b) * k2m <= ATT_FAST_BOUND * ATT_FAST_BOUND);
    const int ntile = qc * 8 + 8;
    v4u vreg = {0u, 0u, 0u, 0u};
#define ATT_NEEDED(t) (!MOBA || ((t) >> 2) >= 2 * qc || ((umask >> ((t) >> 2)) & 1u))
#define ATT_LOADK(t, buf) do { const bf16* kt_ = K + (tokbase + (size_t)(t) * 64) * kp + h * khs; int ln_ = lane; asm volatile("" : "+v"(ln_)); \
        LAS unsigned char* kd_ = lds + ((buf) ? L::K1 : L::K0) + w * 1024; \
        __builtin_amdgcn_global_load_lds((const unsigned*)(kt_ + ln_ * kp + w * 8), (LAS unsigned*)kd_, 16, 0, 0); \
        if (DK == 96 && w < 4) __builtin_amdgcn_global_load_lds((const unsigned*)(kt_ + ln_ * kp + (8 + w) * 8), (LAS unsigned*)(kd_ + 8192), 16, 0, 0); } while (0)
#define ATT_LOADV(t) do { int t2_ = tid; asm volatile("" : "+v"(t2_)); const int vkey = t2_ >> 3, vch = t2_ & 7; \
        vreg = *(const v4u*)(V + (tokbase + (size_t)(t) * 64) * vp + (vkey * vp + h * vhs + vch * 8)); } while (0)
    unsigned krd_lane = (unsigned)(hi * 1024 + r32 * 16), vrd_lane = (unsigned)((r32 * L::VP + 4 * hi) * 2);
    asm volatile("" : "+v"(krd_lane), "+v"(vrd_lane));
#define ATT_STOREV(buf) do { int t2_ = tid; asm volatile("" : "+v"(t2_)); const int vkey = t2_ >> 3, vch = t2_ & 7; \
        LAS unsigned char* vtb_ = lds + L::V0 + (buf) * L::VBYTES + ((vch * 8) * L::VP + vkey) * 2; asm volatile("" : "+v"(vtb_)); LAS bf16* vt_ = (LAS bf16*)vtb_; \
        vt_[0 * L::VP] = (bf16)(vreg.x & 0xffffu); vt_[1 * L::VP] = (bf16)(vreg.x >> 16); vt_[2 * L::VP] = (bf16)(vreg.y & 0xffffu); vt_[3 * L::VP] = (bf16)(vreg.y >> 16); \
        vt_[4 * L::VP] = (bf16)(vreg.z & 0xffffu); vt_[5 * L::VP] = (bf16)(vreg.z >> 16); vt_[6 * L::VP] = (bf16)(vreg.w & 0xffffu); vt_[7 * L::VP] = (bf16)(vreg.w >> 16); } while (0)
    int t = 0; while (t < ntile && !ATT_NEEDED(t)) t += 4;
    ATT_LOADK(t, 0); ATT_LOADV(t); ATT_STOREV(0);
    asm volatile("s_waitcnt vmcnt(0)" ::: "memory");
    __syncthreads();
    f32x16 o0[2], o1[2];
#pragma unroll
    for (int dt = 0; dt < 2; ++dt)
#pragma unroll
        for (int r = 0; r < 16; ++r) { o0[dt][r] = 0.f; o1[dt][r] = 0.f; }
    float m0 = -INFINITY, m1 = -INFINITY, l0 = 0.f, l1 = 0.f;
    int cur = 0, vs = 0;
    const bool defer = (w >= 4);
    bool pend = false, pa0 = false, pa1 = false; int pvs = 0;
    bf16x8 p0[2], p1[2];
#pragma unroll
    for (int st = 0; st < 2; ++st) { p0[st] = (bf16x8){0, 0, 0, 0, 0, 0, 0, 0}; p1[st] = (bf16x8){0, 0, 0, 0, 0, 0, 0, 0}; }
#define ATT_QK(kt) do { \
_Pragma("unroll") \
        for (int r = 0; r < 16; ++r) { s0[r] = 0.f; s1[r] = 0.f; } \
_Pragma("unroll") \
        for (int ks = 0; ks < NKS; ++ks) { \
            const bf16x8 kf = *(const LAS bf16x8*)(kb + (2 * ks * 1024 + 32 * (kt) * 16)); \
            if (a0) s0 = __builtin_amdgcn_mfma_f32_32x32x16_bf16(kf, qf0[ks], s0, 0, 0, 0); \
            if (a1) s1 = __builtin_amdgcn_mfma_f32_32x32x16_bf16(kf, qf1[ks], s1, 0, 0, 0); \
        } } while (0)
#define ATT_SM(FASTP, kt) do { \
        const int kbase = 64 * t + 32 * (kt) + 4 * hi; \
        if (a0) { if (FASTP) softmax_fast(s0, l0, p0, t == tl0, bl0, qi0, kbase); else softmax_group(s0, o0, m0, l0, p0, t == tl0, bl0, qi0, kbase); } \
        __builtin_amdgcn_sched_barrier(0);    \
        if (a1) { if (FASTP) softmax_fast(s1, l1, p1, t == tl1, bl1, qi1, kbase); else softmax_group(s1, o1, m1, l1, p1, t == tl1, bl1, qi1, kbase); } \
        __builtin_amdgcn_sched_barrier(0); } while (0)
#define ATT_PV(vbase, kt, A0, A1) do { \
_Pragma("unroll") \
        for (int st = 0; st < 2; ++st) \
_Pragma("unroll") \
            for (int dt = 0; dt < 2; ++dt) { \
                typedef unsigned u32x2v __attribute__((ext_vector_type(2))); \
                const LAS unsigned char* vp_ = (vbase) + (32 * dt * L::VP + 32 * (kt) + 16 * st) * 2; \
                const u32x2v va = *(const LAS u32x2v*)vp_, vc = *(const LAS u32x2v*)(vp_ + 16); \
                const v4u vv = {va.x, va.y, vc.x, vc.y}; const bf16x8 vf = __builtin_bit_cast(bf16x8, vv); \
                if (A0) o0[dt] = __builtin_amdgcn_mfma_f32_32x32x16_bf16(vf, p0[st], o0[dt], 0, 0, 0); \
                if (A1) o1[dt] = __builtin_amdgcn_mfma_f32_32x32x16_bf16(vf, p1[st], o1[dt], 0, 0, 0); \
            } } while (0)
#define ATT_LOOP(FASTP) do { \
    while (t < ntile) { \
        int tn = t + 1; while (tn < ntile && (tn & 3) == 0 && !ATT_NEEDED(tn)) tn += 4; \
        if (tn < ntile) { ATT_LOADK(tn, cur ^ 1); ATT_LOADV(tn); }    \
        if (pend) { const LAS unsigned char* vbp = lds + L::V0 + pvs * L::VBYTES + vrd_lane; asm volatile("" : "+v"(vbp)); ATT_PV(vbp, 1, pa0, pa1); pend = false; } \
        const int nblk = t >> 2; \
        bool a0 = (t <= tl0), a1 = (t <= tl1); \
        bool bl0 = false, bl1 = false; \
        if (MOBA) { \
            bl0 = (nblk != ob0) && !((mk0 >> nblk) & 1u); bl1 = (nblk != ob1) && !((mk1 >> nblk) & 1u); \
            a0 = a0 && __any(!bl0); a1 = a1 && __any(!bl1); \
        } \
        if (a0 || a1) { \
            const LAS unsigned char* kb = lds + (cur ? L::K1 : L::K0) + krd_lane; const LAS unsigned char* vb = lds + L::V0 + vs * L::VBYTES + vrd_lane; \
            asm volatile("" : "+v"(kb), "+v"(vb)); \
            f32x16 s0, s1; \
            ATT_QK(0); ATT_SM(FASTP, 0); ATT_PV(vb, 0, a0, a1); \
            ATT_QK(1); ATT_SM(FASTP, 1); \
            if (!defer) ATT_PV(vb, 1, a0, a1); else { pend = true; pa0 = a0; pa1 = a1; pvs = vs; } \
        } \
        const int vsn = (vs == 2) ? 0 : vs + 1; \
        if (tn < ntile) ATT_STOREV(vsn); \
        asm volatile("s_waitcnt vmcnt(0)" ::: "memory"); \
        __syncthreads(); \
        t = tn; cur ^= 1; vs = vsn; \
    } \
    if (pend) { const LAS unsigned char* vbp = lds + L::V0 + pvs * L::VBYTES + vrd_lane; asm volatile("" : "+v"(vbp)); ATT_PV(vbp, 1, pa0, pa1); pend = false; } \
    } while (0)
    if (fast) ATT_LOOP(true); else ATT_LOOP(false);
#undef ATT_LOOP
#undef ATT_QK
#undef ATT_SM
#undef ATT_PV
#undef ATT_NEEDED
#undef ATT_LOADK
#undef ATT_LOADV
#undef ATT_STOREV
    {
        typedef unsigned u32x2v __attribute__((ext_vector_type(2)));
        const float i0 = 1.0f / half_sum(l0), i1 = 1.0f / half_sum(l1);
        bf16* d0 = O + (tokbase + qi0) * op + h * 64 + 4 * hi; bf16* d1 = O + (tokbase + qi1) * op + h * 64 + 4 * hi;
#pragma unroll
        for (int dt = 0; dt < 2; ++dt)
#pragma unroll
            for (int j = 0; j < 4; ++j) {
                u32x2v wa; wa.x = pkbf(o0[dt][4 * j] * i0, o0[dt][4 * j + 1] * i0); wa.y = pkbf(o0[dt][4 * j + 2] * i0, o0[dt][4 * j + 3] * i0); *(u32x2v*)(d0 + 32 * dt + 8 * j) = wa;
                u32x2v wb; wb.x = pkbf(o1[dt][4 * j] * i1, o1[dt][4 * j + 1] * i1); wb.y = pkbf(o1[dt][4 * j + 2] * i1, o1[dt][4 * j + 3] * i1); *(u32x2v*)(d1 + 32 * dt + 8 * j) = wb;
            }
    }
}
struct Args { const void* in[31]; float* out; unsigned char* ws; int ph_lo, ph_hi; };
constexpr int N_PHASES = 1 + 8 + 11 + 8 + 11;
typedef const __attribute__((address_space(4))) Args* KArgs;
__device__ __forceinline__ KArgs kargs() { KArgs p = (KArgs)__builtin_amdgcn_kernarg_segment_ptr(); asm volatile("" : "+s"(p)); return p; }
#define IN_F(i) ((const float*)A->in[i])
#define WSP(type, off) ((type*)(ws + (off)))
#ifndef TPROBE
#define TPROBE 0
#endif
#define TP_BID 203
#define TP_ACC(lds) ((LAS unsigned long long*)((lds) + MISC_OFF + 64))
#define TP_BEGIN(id) unsigned long long tp0_##id = 0ull; if (TPROBE == (id)) { __syncthreads(); tp0_##id = __builtin_amdgcn_s_memrealtime(); }
#define TP_END(id, lds) if (TPROBE == (id)) { __syncthreads(); if (blockIdx.x == TP_BID && threadIdx.x == 0) *TP_ACC(lds) += __builtin_amdgcn_s_memrealtime() - tp0_##id; }
struct Ctx { int tid, lane, wave, G, bid, gw, NGW, gt, NGT; };
__device__ __forceinline__ Ctx mkctx(int wv) {
    Ctx c; unsigned m = ~0u; asm volatile("" : "+s"(m)); const int ln = (int)__builtin_amdgcn_mbcnt_hi(m, __builtin_amdgcn_mbcnt_lo(m, 0u));
    int b = blockIdx.x; asm volatile("" : "+s"(b)); int w = wv; asm volatile("" : "+s"(w));
    c.tid = w * 64 + ln; c.lane = ln; c.wave = w; c.G = gridDim.x; c.bid = b;
    c.gw = c.bid * NWAVES + c.wave; c.NGW = c.G * NWAVES; c.gt = c.bid * NTHR + c.tid; c.NGT = c.G * NTHR; return c; }

__device__ __forceinline__ void conv_mixer_weights(int wv, LAS unsigned char* lds, int l) {
    const Ctx c = mkctx(wv);
    KArgs A = kargs(); unsigned char* ws = A->ws;
    const int lane = c.lane, gw = c.gw, NGW = c.NGW, gt = c.gt, NGT = c.NGT;
    LAS float* scr = (LAS float*)(lds + RING_OFF + c.wave * 16384); LAS TrDesc* tab = (LAS TrDesc*)(lds + RING_OFF + TR_TAB_OFF); asm volatile("" : "+v"(tab));
    bf16* WINR = WSP(bf16, W_INR); bf16* WUQ = WSP(bf16, W_UQ); bf16* WUKV = WSP(bf16, W_UKV);
    int total = 0;
    if (c.tid == 0) {
        int n = 0, cum = 0;
        const float* an = IN_F(2) + l * DM; const float* win = IN_F(4) + (size_t)l * DM * IN_COLS;
        tr_add(tab, n, cum, win, IN_COLS, DM, 4096, 0, WSP(bf16, W_G), DM, 0, 3, an);
        tr_add(tab, n, cum, win, IN_COLS, DM, 1280, 4096, WINR, DM, 0, 0, an);
        tr_add(tab, n, cum, win, IN_COLS, DM, 512, 5728, WINR, DM, 1280, 0, an);
        tr_add(tab, n, cum, win, IN_COLS, DM, 352, 5376, WINR, DM, 1792, 0, an);
        tr_add(tab, n, cum, IN_F(13) + (size_t)l * 192 * 384, 384, 192, 384, 0, WUQ, 256, 0, 0, IN_F(11) + l * 192);
        tr_add(tab, n, cum, IN_F(14) + (size_t)l * 128 * 512, 512, 128, 512, 0, WUKV, 256, 0, 2, IN_F(12) + l * 128);
        for (int nb = 0; nb < 4; ++nb) tr_add(tab, n, cum, IN_F(21) + ((size_t)l * 4 + nb) * 256 * DM, DM, 256, DM, 0, WSP(bf16, W_B), 256, nb * 1024, 0, nullptr);
        tr_add(tab, n, cum, IN_F(22) + (size_t)l * DM * DM, DM, DM, DM, 0, WSP(bf16, W_OUT), DM, 0, 0, nullptr);
        tab[n].cum = cum; tab[31].cum = cum;
    }
    __syncthreads();
    total = tab[31].cum;
    tr_run(tab, total, scr, lane, gw, NGW);
    unsigned zz = 0u; asm volatile("" : "+v"(zz)); const v4u z4 = {zz, zz, zz, zz};
    for (int i = gt; i < 160 * DM / 8; i += NGT) ((v4u*)(WINR + (size_t)2144 * DM))[i] = z4;
    for (int i = gt; i < 128 * 256 / 8; i += NGT) ((v4u*)(WUQ + (size_t)384 * 256))[i] = z4;
    for (int i = gt; i < 384 * 8; i += NGT) ((v4u*)(WUQ + (size_t)(i >> 3) * 256 + 192))[i & 7] = z4;
    for (int i = gt; i < 512 * 16; i += NGT) ((v4u*)(WUKV + (size_t)(i >> 4) * 256 + 128))[i & 15] = z4;
    {
        const float* wsrc = IN_F(7) + (size_t)l * 4 * 128 * 128; bf16* wm = WSP(bf16, MS_WSGU);
        for (int i = gt; i < 4 * 128 * 128 / 8; i += NGT) {
            const int t = (i >> 4) & 127, s0 = (i & 15) * 8; const f32x4 a = *(const f32x4*)(wsrc + (size_t)i * 8), b = *(const f32x4*)(wsrc + (size_t)i * 8 + 4);
            float f[8] = {a[0], a[1], a[2], a[3], b[0], b[1], b[2], b[3]};
#pragma unroll
            for (int j = 0; j < 8; ++j) f[j] = (s0 + j <= t) ? f[j] : 0.f;
            *(v4u*)(wm + (size_t)i * 8) = pack8(f);
        }
    }
    __syncthreads();
}
__device__ __forceinline__ void conv_ffn_weights(int wv, LAS unsigned char* lds, int l, int first, int part, int vbid = -1, int vG = 0) {
    const Ctx c = mkctx(wv);
    if (vbid < 0 && c.bid < first) return;
    KArgs A = kargs(); unsigned char* ws = A->ws;
    LAS float* scr = (LAS float*)(lds + RING_OFF + c.wave * 16384); LAS TrDesc* tab = (LAS TrDesc*)(lds + RING_OFF + TR_TAB_OFF); asm volatile("" : "+v"(tab));
    if (c.tid == 0) {
        int n = 0, cum = 0; const bool moe = (l & 1) != 0; const int li = l >> 1; const float* fn = IN_F(3) + l * DM;
        if (!moe) {
            tr_add(tab, n, cum, IN_F(23) + (size_t)li * DM * FFN, FFN, DM, FFN, 0, WSP(bf16, W_F1), DM, 0, 1, fn);
            tr_add(tab, n, cum, IN_F(24) + (size_t)li * DM * FFN, FFN, DM, FFN, 0, WSP(bf16, W_F1), DM, 128, 1, fn);
            tr_add(tab, n, cum, IN_F(25) + (size_t)li * FFN * DM, DM, FFN, DM, 0, WSP(bf16, W_F2), FFN, 0, 0, nullptr);
        } else {
            for (int e = 0; e < NE; ++e) {
                tr_add(tab, n, cum, IN_F(28) + ((size_t)li * NE + e) * DM * EDIM, EDIM, DM, EDIM, 0, WSP(bf16, W_F1), DM, e * 2 * EDIM, 1, fn);
                tr_add(tab, n, cum, IN_F(29) + ((size_t)li * NE + e) * DM * EDIM, EDIM, DM, EDIM, 0, WSP(bf16, W_F1), DM, e * 2 * EDIM + 128, 1, fn);
                tr_add(tab, n, cum, IN_F(30) + ((size_t)li * NE + e) * EDIM * DM, DM, EDIM, DM, 0, WSP(bf16, W_F2), EDIM, e * DM, 0, nullptr);
            }
        }
        tab[n].cum = cum; tab[31].cum = cum;
    }
    __syncthreads();
    { const int tot = tab[31].cum, cut = tot / 3; const int gwv = (vbid < 0) ? c.gw - first * NWAVES : vbid * NWAVES + c.wave, ngwv = (vbid < 0) ? c.NGW - first * NWAVES : vG * NWAVES;
      tr_run(tab, tot, scr, c.lane, gwv, ngwv, part == 2 ? cut : 0, part == 1 ? cut : tot); }
    __syncthreads();
}
__device__ __forceinline__ void ph_prologue(int wv, LAS unsigned char* lds) {
    conv_mixer_weights(wv, lds, 0);
    const Ctx c = mkctx(wv);
    KArgs A = kargs(); unsigned char* ws = A->ws;
    const int lane = c.lane, gw = c.gw, NGW = c.NGW, gt = c.gt, NGT = c.NGT;
    {
        const float* x_in = IN_F(0); const int* positions = (const int*)A->in[1];
        bf16* XB = WSP(bf16, WS_XB); float* SSA = WSP(float, WS_SSA); float* ROPE = WSP(float, WS_ROPE);
        for (int mrow = gw; mrow < T; mrow += NGW) {
            const f32x4* xr = (const f32x4*)(x_in + (size_t)mrow * DM) + lane; float s = 0.f;
            typedef unsigned u32x2v __attribute__((ext_vector_type(2)));
            u32x2v* o8 = (u32x2v*)(XB + (size_t)mrow * DM) + lane;
#pragma unroll
            for (int j = 0; j < 4; ++j) { const f32x4 v = xr[64 * j]; s += (v[0] * v[0] + v[1] * v[1]) + (v[2] * v[2] + v[3] * v[3]); u32x2v w; w.x = pkbf(v[0], v[1]); w.y = pkbf(v[2], v[3]); o8[64 * j] = w; }
            s = wave_sum(s);
            if (lane < 4) SSA[(size_t)mrow * 4 + lane] = (lane == 0) ? s : 0.f;
        }
        for (int i = gt; i < T * 24; i += NGT) {
            const int tok = i / 24, a = i - tok * 24;
            const float inv = (a < 8) ? powf(500000.0f, -(float)a * 0.125f) : powf(500000.0f, -(float)(a - 8) * 0.0625f);
            const float ang = (float)positions[tok] * inv; float sn, cs; sincosf(ang, &sn, &cs);
            ROPE[(size_t)tok * 48 + 2 * a] = cs; ROPE[(size_t)tok * 48 + 2 * a + 1] = sn;
        }
    }
}
__device__ __forceinline__ void ph_inproj(int wv, LAS unsigned char* lds, int l) {
    const Ctx c = mkctx(wv);
    KArgs A = kargs(); unsigned char* ws = A->ws;
    pg8::Gemm g{WSP(bf16, WS_XB), WSP(bf16, W_INR), DM, DM, DM}; pg8::StaticOrder S; S.init(T, PJ_LD, c.G, c.bid);
    pg8::EpiScale<0> E{WSP(bf16, B_PROJ), PJ_LD, pg8::RowScale{WSP(float, WS_SSA), 1}, WSP(float, WS_SSC)};
    pg8::gemm_phase<pg8::EpiScale<0>, pg8::StaticOrder, true, true>(lds + RING_OFF, g, S, E, c.tid);
    __syncthreads();
    { const Ctx c3 = mkctx(wv); const int rem = ((T / 256) * (PJ_LD / 256)) % c3.G; conv_ffn_weights(wv, lds, l, rem, (l & 1) ? 1 : 0); }
}
__device__ __forceinline__ void mla_up_gemms(int wv, LAS unsigned char* lds, int l) {
    const Ctx c = mkctx(wv);
    { KArgs A = kargs(); unsigned char* ws = A->ws;
      pg8::Gemm g{WSP(bf16, B_PROJ) + PJ_CQ, WSP(bf16, W_UQ), PJ_LD, 256, 256}; pg8::StaticOrder S; S.init(T, 512, c.G, c.bid);
      pg8::EpiScale<0> E{WSP(bf16, B_QPRE), 512, pg8::RowScale{WSP(float, WS_SSC), 3}, nullptr};
      pg8::gemm_phase<pg8::EpiScale<0>, pg8::StaticOrder, true, true>(lds + RING_OFF, g, S, E, c.tid); }
    { KArgs A = kargs(); unsigned char* ws = A->ws;
      pg8::Gemm g{WSP(bf16, B_PROJ) + PJ_CKV, WSP(bf16, W_UKV), PJ_LD, 256, 256}; pg8::StaticOrder S; S.init(T, 512, c.G, c.bid);
      { pg8::Unit u0; if (S.next(0, u0)) { const Ctx c2 = mkctx(wv); kv_prepass(lds + KV_AUX_OFF, WSP(bf16, B_PROJ), WSP(float, WS_SSC), WSP(float, WS_ROPE), IN_F(16) + l * 96, u0.pm, c2.tid); } }
      pg8::EpiKV E{WSP(bf16, B_CK), WSP(bf16, B_KVPRE), IN_F(16) + l * 96, (unsigned*)(ws + WS_CTL) + CW_KMX + (l * 2 + 1) * 32, lds + KV_AUX_OFF};
      pg8::gemm_phase<pg8::EpiKV, pg8::StaticOrder, true, true>(lds + RING_OFF, g, S, E, c.tid); }
}
__device__ __forceinline__ void ph_prep(int wv, LAS unsigned char* lds, int l) {
    TP_BEGIN(4) mla_up_gemms(wv, lds, l); TP_END(4, lds)
    {
        const Ctx c = mkctx(wv);
        KArgs A = kargs(); unsigned char* ws = A->ws;
        bf16* PROJ = WSP(bf16, B_PROJ); bf16* OB = WSP(bf16, B_O);
        TP_BEGIN(5) for (int it = c.bid; it < NB * 32; it += c.G) prep_block(lds + RING_OFF, PROJ, WSP(float, WS_ROPE), IN_F(9) + l * 64, IN_F(10) + l * 64, WSP(float, MS_KMEAN), (unsigned*)(ws + WS_CTL) + CW_KMX + (l * 2 + 0) * 32, it, c.tid); TP_END(5, lds)
        TP_BEGIN(6) for (int u = c.bid; u < T / 128; u += c.G) sgu_unit(lds + RING_OFF, PROJ, OB, IN_F(5) + l * 256, IN_F(6) + l * 256, WSP(bf16, MS_WSGU), IN_F(8) + l * 4 * 128, u, c.tid); TP_END(6, lds)
        TP_BEGIN(7) for (int u = c.bid; u < T / 64; u += c.G) conv_unit(lds + RING_OFF, PROJ, OB, IN_F(17) + (size_t)l * 31 * 256, IN_F(18) + l * 256, IN_F(19) + l * 256, IN_F(20) + l * 256, u, c.tid); TP_END(7, lds)
        __syncthreads();
    }
}
template <int WHICH>
__device__ __forceinline__ void mla_post_pass(const Ctx& c, int l) {
    KArgs A = kargs(); unsigned char* ws = A->ws;
    const float* gn = IN_F(WHICH ? 16 : 15) + l * 96;
    const bf16* PROJ = WSP(bf16, B_PROJ); const bf16* QPRE = WSP(bf16, B_QPRE); const bf16* KVPRE = WSP(bf16, B_KVPRE);
    bf16* DST = WHICH ? WSP(bf16, B_CK) : WSP(bf16, B_CQ); const float* ROPE = WSP(float, WS_ROPE);
    for (int idx = c.gt; idx < T * 4; idx += c.NGT) {
        const int tok = idx >> 2, h = idx & 3; const float* tab = ROPE + (size_t)tok * 48 + 16;
        float v[96]; float ss = 0.f;
        if (WHICH == 0) {
#pragma unroll
            for (int cc = 0; cc < 12; ++cc) unpack8(((const v4u*)(QPRE + (size_t)tok * 512 + h * 96))[cc], v + 8 * cc);
        } else {
#pragma unroll
            for (int cc = 0; cc < 8; ++cc) unpack8(((const v4u*)(KVPRE + (size_t)tok * 512 + h * 128))[cc], v + 8 * cc);
#pragma unroll
            for (int cc = 0; cc < 4; ++cc) unpack8(((const v4u*)(PROJ + (size_t)tok * PJ_LD + PJ_KR))[cc], v + 64 + 8 * cc);
        }
#pragma unroll
        for (int d = 0; d < 96; ++d) ss += v[d] * v[d];
        const float rstd = rsqrtf(ss * (1.0f / 96.0f) + EPS);
#pragma unroll
        for (int d = 0; d < 96; ++d) v[d] = v[d] * rstd * gn[d];
#pragma unroll
        for (int i = 0; i < 16; ++i) { const float cs = tab[2 * i], sn = tab[2 * i + 1], x1 = v[64 + i], x2 = v[80 + i]; v[64 + i] = x1 * cs - x2 * sn; v[80 + i] = x2 * cs + x1 * sn; }
        if (WHICH == 0) {
#pragma unroll
            for (int d = 0; d < 96; ++d) v[d] *= QS_C;
        }
        bf16* dst = DST + (size_t)tok * 384 + h * 96;
#pragma unroll
        for (int cc = 0; cc < 12; ++cc) ((v4u*)dst)[cc] = pack8(v + 8 * cc);
    }
}
__device__ __forceinline__ void ph_mla_post(int wv, int l) {
    { const Ctx c = mkctx(wv); mla_post_pass<0>(c, l); }
    { const Ctx c = mkctx(wv); mla_post_pass<1>(c, l); }
}
__device__ __forceinline__ void ph_attn(int wv, LAS unsigned char* lds, int l) {
    constexpr int CW_ATT = 10240;
    for (;;) {
        const Ctx c = mkctx(wv);
        KArgs A0 = kargs();
        volatile LAS unsigned* bcw = (volatile LAS unsigned*)(lds + EPI_RED_OFF);
        __syncthreads();
        if (c.tid == 0) *bcw = __hip_atomic_fetch_add((unsigned*)(A0->ws + WS_CTL) + CW_ATT + l, 1u, __ATOMIC_RELAXED, __HIP_MEMORY_SCOPE_AGENT);
        __syncthreads();
        const unsigned idx = *bcw;
        constexpr unsigned NATT = NB * 4 * 16, NCV = 256;
        if (idx >= NATT + ((l & 1) ? NCV : 0u)) break;
        if (idx >= NATT) { conv_ffn_weights(wv, lds, l, 0, 2, (int)(idx - NATT), (int)NCV); continue; }
        const int kind = (int)(idx >> 5), bh = (int)(idx & 31), qc = 7 - (kind >> 1), h = bh & 3, b = bh >> 2;
        if ((kind & 1) == 0) {
            TP_BEGIN(1) { KArgs A = kargs(); unsigned char* ws = A->ws;
              attn_unit<96, false, true, 512, 96, 384, 96, 256, 64, DM>(lds + RING_OFF, WSP(bf16, B_QPRE), WSP(bf16, B_CK), WSP(bf16, B_KVPRE), WSP(bf16, B_O) + 512, b, h, qc, nullptr, IN_F(15) + l * 96, WSP(float, WS_ROPE), (const unsigned*)(ws + WS_CTL) + CW_KMX + (l * 2 + 1) * 32, c.tid); } TP_END(1, lds)
        } else {
            TP_BEGIN(2) { KArgs A = kargs(); unsigned char* ws = A->ws; bf16* PROJ = WSP(bf16, B_PROJ);
              attn_unit<64, true, false, PJ_LD, 64, PJ_LD, 64, PJ_LD, 64, DM>(lds + RING_OFF, PROJ + PJ_BQ, PROJ + PJ_BK, PROJ + PJ_BV, WSP(bf16, B_O) + 256, b, h, qc, WSP(float, MS_KMEAN), nullptr, nullptr, (const unsigned*)(ws + WS_CTL) + CW_KMX + (l * 2 + 0) * 32, c.tid); } TP_END(2, lds)
        }
    }
}
__device__ __forceinline__ void ph_gates(int wv, LAS unsigned char* lds) {
    const Ctx c = mkctx(wv);
    KArgs A = kargs(); unsigned char* ws = A->ws;
    pg8::Gemm g{WSP(bf16, WS_XB), WSP(bf16, W_G), DM, DM, DM}; pg8::StaticOrder S; S.init(T, 4096, c.G, c.bid);
    pg8::EpiGates E{WSP(bf16, B_SG), pg8::RowScale{WSP(float, WS_SSA), 1}};
    pg8::gemm_phase<pg8::EpiGates, pg8::StaticOrder, true, true>(lds + RING_OFF, g, S, E, c.tid);
}
__device__ __forceinline__ void ph_merge(int wv, LAS unsigned char* lds) {
    const Ctx c = mkctx(wv);
    KArgs A = kargs(); unsigned char* ws = A->ws;
    pg8::Gemm g{WSP(bf16, B_O), WSP(bf16, W_B), DM, 256, 256}; pg8::MergeOrder S; S.so.init(T, DM, c.G, c.bid);
    pg8::EpiMerge E{WSP(bf16, B_SG), WSP(bf16, B_Y)};
    pg8::gemm_phase<pg8::EpiMerge, pg8::MergeOrder, true, true>(lds + RING_OFF, g, S, E, c.tid);
}
__device__ __forceinline__ void ph_wout(int wv, LAS unsigned char* lds, int l) {
    const Ctx c = mkctx(wv);
    KArgs A = kargs(); unsigned char* ws = A->ws;
    pg8::Gemm g{WSP(bf16, B_Y), WSP(bf16, W_OUT), DM, DM, DM}; pg8::StaticOrder S; S.init(T, DM, c.G, c.bid);
    pg8::EpiResidual E{WSP(bf16, WS_XB), WSP(float, WS_SSB), (LAS float*)(lds + EPI_RED_OFF)};
    pg8::gemm_phase<pg8::EpiResidual, pg8::StaticOrder, true, true>(lds + RING_OFF, g, S, E, c.tid);
}
__device__ __forceinline__ void ph_ffn_up(int wv, LAS unsigned char* lds) {
    const Ctx c = mkctx(wv);
    KArgs A = kargs(); unsigned char* ws = A->ws;
    pg8::Gemm g{WSP(bf16, WS_XB), WSP(bf16, W_F1), DM, DM, DM}; pg8::StaticOrder S; S.init(T, 2 * FFN, c.G, c.bid);
    pg8::EpiScale<2> E{WSP(bf16, B_HID), FFN, pg8::RowScale{WSP(float, WS_SSB), 1}, nullptr};
    pg8::gemm_phase<pg8::EpiScale<2>, pg8::StaticOrder, true, true>(lds + RING_OFF, g, S, E, c.tid);
}
__device__ __forceinline__ void ph_ffn_down(int wv, LAS unsigned char* lds, int l) {
    const Ctx c = mkctx(wv);
    KArgs A = kargs(); unsigned char* ws = A->ws;
    pg8::Gemm g{WSP(bf16, B_HID), WSP(bf16, W_F2), FFN, FFN, FFN}; pg8::StaticOrder S; S.init(T, DM, c.G, c.bid);
    pg8::EpiResidual E{WSP(bf16, WS_XB), WSP(float, WS_SSA), (LAS float*)(lds + EPI_RED_OFF)};
    pg8::gemm_phase<pg8::EpiResidual, pg8::StaticOrder, true, true>(lds + RING_OFF, g, S, E, c.tid);
    TP_BEGIN(9) if (l < DEPTH - 1) conv_mixer_weights(wv, lds, l + 1); TP_END(9, lds)
}
__device__ __forceinline__ int wave_sum_i(int v) {
    v += __builtin_amdgcn_ds_swizzle(v, (1 << 10) | 0x1f); v += __builtin_amdgcn_ds_swizzle(v, (2 << 10) | 0x1f); v += __builtin_amdgcn_ds_swizzle(v, (4 << 10) | 0x1f);
    v += __builtin_amdgcn_ds_swizzle(v, (8 << 10) | 0x1f); v += __builtin_amdgcn_ds_swizzle(v, (16 << 10) | 0x1f);
    auto rr = __builtin_amdgcn_permlane32_swap((unsigned)v, (unsigned)v, false, false); return (int)rr[0] + (int)rr[1];
}
__device__ __forceinline__ void ph_router(int wv, LAS unsigned char* lds, int l) {
    const Ctx c = mkctx(wv);
    KArgs A = kargs(); unsigned char* ws = A->ws; const int li = l >> 1; const int lane = c.lane;
    const float* fn = IN_F(3) + l * DM; const float* wr_ = IN_F(26) + (size_t)li * DM * NE; const float* rb = IN_F(27) + li * NE;
    const bf16* XBr = WSP(bf16, WS_XB); const float* SSB = WSP(float, WS_SSB); int* TOKE = WSP(int, MS_TOKE); float* TOKW = WSP(float, MS_TOKW);
    int* WCNT = WSP(int, MS_WCNT); int* WGCNT = WSP(int, MS_WGCNT);
    { unsigned* TOKIDX = WSP(unsigned, WS_TOKIDX); for (int i = c.gt; i < MOE_ROWS_MAX; i += c.NGT) TOKIDX[i] = 0u; }
    int cnt[8];
#pragma unroll
    for (int e = 0; e < 8; ++e) cnt[e] = 0;
    float wq[16][8];
#pragma unroll
    for (int j = 0; j < 4; ++j) { const int k0 = (64 * j + lane) * 4; const f32x4 gv = *(const f32x4*)(fn + k0);
#pragma unroll
        for (int q = 0; q < 4; ++q) { const f32x4 w0 = *(const f32x4*)(wr_ + (size_t)(k0 + q) * 8), w1 = *(const f32x4*)(wr_ + (size_t)(k0 + q) * 8 + 4);
#pragma unroll
            for (int e = 0; e < 4; ++e) { wq[4 * j + q][e] = gv[q] * w0[e]; wq[4 * j + q][4 + e] = gv[q] * w1[e]; } } }
    float rbv[8];
#pragma unroll
    for (int e = 0; e < 8; ++e) rbv[e] = rb[e];
    for (int tok0 = c.gw; tok0 < T; tok0 += 2 * c.NGW) {
        typedef unsigned u32x2v __attribute__((ext_vector_type(2)));
        f32x4 sp[2]; u32x2v xv[2][4]; bool ok[2];
#pragma unroll
        for (int u = 0; u < 2; ++u) { const int tok = tok0 + u * c.NGW; ok[u] = tok < T; const int tk = ok[u] ? tok : tok0;
            sp[u] = *(const f32x4*)(SSB + (size_t)tk * 4);
#pragma unroll
            for (int j = 0; j < 4; ++j) xv[u][j] = *(const u32x2v*)(XBr + (size_t)tk * DM + (64 * j + lane) * 4); }
        float pl[2][8];
#pragma unroll
        for (int u = 0; u < 2; ++u) { const float rstd = rsqrtf(((sp[u][0] + sp[u][1]) + (sp[u][2] + sp[u][3])) * (1.0f / 1024.0f) + EPS);
#pragma unroll
            for (int e = 0; e < 8; ++e) pl[u][e] = 0.f;
#pragma unroll
            for (int j = 0; j < 4; ++j)
#pragma unroll
                for (int q = 0; q < 4; ++q) { const unsigned xw = (q < 2) ? xv[u][j].x : xv[u][j].y; const float hv = ((q & 1) ? bfhi(xw) : bflo(xw)) * rstd;
#pragma unroll
                    for (int e = 0; e < 8; ++e) pl[u][e] += hv * wq[4 * j + q][e]; } }
#pragma unroll
        for (int e = 0; e < 8; ++e) { pl[0][e] = wave_sum(pl[0][e]) + rbv[e]; pl[1][e] = wave_sum(pl[1][e]) + rbv[e]; }
#pragma unroll
        for (int u = 0; u < 2; ++u) {
            int e0 = 0; float l0 = pl[u][0];
#pragma unroll
            for (int e = 1; e < 8; ++e) if (pl[u][e] > l0) { l0 = pl[u][e]; e0 = e; }
            int e1 = -1; float l1 = -INFINITY;
#pragma unroll
            for (int e = 0; e < 8; ++e) if (e != e0 && pl[u][e] > l1) { l1 = pl[u][e]; e1 = e; }
            const float tt = expf(l1 - l0); const float w0 = 1.0f / (1.0f + tt), w1 = tt / (1.0f + tt);
            if (ok[u]) {
#pragma unroll
                for (int e = 0; e < 8; ++e) cnt[e] += (e == e0 ? 1 : 0) + (e == e1 ? 1 : 0);
                const int tok = tok0 + u * c.NGW;
                if (lane == 0) { TOKE[tok * 2] = e0; TOKE[tok * 2 + 1] = e1; TOKW[tok * 2] = w0; TOKW[tok * 2 + 1] = w1; }
            }
        }
    }
    LAS int* red = (LAS int*)(lds + RING_OFF);
    int mine = 0;
#pragma unroll
    for (int e = 0; e < 8; ++e) mine = (lane == e) ? cnt[e] : mine;
    if (lane < 8) { WCNT[c.gw * 8 + lane] = mine; red[c.wave * 8 + lane] = mine; }
    __syncthreads();
    if (c.tid < 8) { int s = 0;
#pragma unroll
        for (int w = 0; w < NWAVES; ++w) s += red[w * 8 + c.tid];
        WGCNT[c.bid * 8 + c.tid] = s; }
    __syncthreads();
}
__device__ __forceinline__ void ph_assign(int wv, LAS unsigned char* lds, int l) {
    const Ctx c = mkctx(wv);
    KArgs A = kargs(); unsigned char* ws = A->ws; const int lane = c.lane;
    const float* SSB = WSP(float, WS_SSB); const int* TOKE = WSP(int, MS_TOKE); int* TOKS = WSP(int, MS_TOKS); float* RSSLOT = WSP(float, MS_RSSLOT);
    const int* WCNT = WSP(int, MS_WCNT); const int* WGCNT = WSP(int, MS_WGCNT); int* MTOT = WSP(int, MS_MTOT);
    unsigned* TOKIDX = WSP(unsigned, WS_TOKIDX);
    int tot[8], bas[8];
#pragma unroll
    for (int e = 0; e < 8; ++e) { tot[e] = 0; bas[e] = 0; }
    for (int t = c.tid; t < c.G; t += NTHR) {
        typedef int i32x4 __attribute__((ext_vector_type(4)));
        const i32x4 a = *(const i32x4*)(WGCNT + t * 8), b = *(const i32x4*)(WGCNT + t * 8 + 4); const int lt = (t < c.bid) ? 1 : 0;
        tot[0] += a[0]; tot[1] += a[1]; tot[2] += a[2]; tot[3] += a[3]; tot[4] += b[0]; tot[5] += b[1]; tot[6] += b[2]; tot[7] += b[3];
        bas[0] += lt * a[0]; bas[1] += lt * a[1]; bas[2] += lt * a[2]; bas[3] += lt * a[3]; bas[4] += lt * b[0]; bas[5] += lt * b[1]; bas[6] += lt * b[2]; bas[7] += lt * b[3];
    }
    LAS int* red = (LAS int*)(lds + RING_OFF);
#pragma unroll
    for (int e = 0; e < 8; ++e) { tot[e] = wave_sum_i(tot[e]); bas[e] = wave_sum_i(bas[e]); }
    if (lane == 0) {
#pragma unroll
        for (int e = 0; e < 8; ++e) { red[c.wave * 16 + e] = tot[e]; red[c.wave * 16 + 8 + e] = bas[e]; } }
    __syncthreads();
#pragma unroll
    for (int e = 0; e < 8; ++e) { int st = 0, sb = 0;
#pragma unroll
        for (int w = 0; w < NWAVES; ++w) { st += red[w * 16 + e]; sb += red[w * 16 + 8 + e]; }
        tot[e] = st; bas[e] = sb; }
    int run[8]; { int acc = 0;
#pragma unroll
        for (int e = 0; e < 8; ++e) { run[e] = acc * 256 + bas[e]; acc += (tot[e] + 255) >> 8; } }
    if (c.bid == 0 && c.tid < 8) { int v = 0;
#pragma unroll
        for (int e = 0; e < 8; ++e) v = (c.tid == e) ? tot[e] : v;
        MTOT[c.tid] = v; }
    for (int w = 0; w < c.wave; ++w) {
        typedef int i32x4 __attribute__((ext_vector_type(4)));
        const i32x4 a = *(const i32x4*)(WCNT + (c.bid * NWAVES + w) * 8), b = *(const i32x4*)(WCNT + (c.bid * NWAVES + w) * 8 + 4);
        run[0] += a[0]; run[1] += a[1]; run[2] += a[2]; run[3] += a[3]; run[4] += b[0]; run[5] += b[1]; run[6] += b[2]; run[7] += b[3];
    }
    for (int tok0 = c.gw; tok0 < T; tok0 += 4 * c.NGW) {
        f32x4 sp[4]; int ee[4][2]; bool ok[4];
#pragma unroll
        for (int u = 0; u < 4; ++u) { const int tok = tok0 + u * c.NGW; ok[u] = tok < T; const int tk = ok[u] ? tok : tok0;
            sp[u] = *(const f32x4*)(SSB + (size_t)tk * 4); ee[u][0] = TOKE[tk * 2]; ee[u][1] = TOKE[tk * 2 + 1]; }
#pragma unroll
        for (int u = 0; u < 4; ++u) if (ok[u]) {
            const int tok = tok0 + u * c.NGW;
            const float rstd = rsqrtf(((sp[u][0] + sp[u][1]) + (sp[u][2] + sp[u][3])) * (1.0f / 1024.0f) + EPS);
            int s0 = 0, s1 = 0;
#pragma unroll
            for (int e = 0; e < 8; ++e) { if (e == ee[u][0]) { s0 = run[e]; run[e] += 1; } }
#pragma unroll
            for (int e = 0; e < 8; ++e) { if (e == ee[u][1]) { s1 = run[e]; run[e] += 1; } }
            if (lane == 0) { TOKS[tok * 2] = s0; TOKS[tok * 2 + 1] = s1; RSSLOT[s0] = rstd; RSSLOT[s1] = rstd; TOKIDX[s0] = (unsigned)tok * (DM * 2); TOKIDX[s1] = (unsigned)tok * (DM * 2); }
        }
    }
    __syncthreads();
}
__device__ __forceinline__ void moe_panels(const int* mtot, int (&ps)[9]) { int acc = 0;
#pragma unroll
    for (int e = 0; e < 8; ++e) { ps[e] = acc; const int cn = __hip_atomic_load(mtot + e, RLX_AGENT); acc += (cn + 255) >> 8; } ps[8] = acc; }
__device__ __forceinline__ void ph_moe_up(int wv, LAS unsigned char* lds, int l) {
    const Ctx c = mkctx(wv);
    KArgs A = kargs(); unsigned char* ws = A->ws;
    pg8::MoeOrder S; S.nN = 11; moe_panels(WSP(int, MS_MTOT), S.ps);
    S.so.init(S.ps[8] * 256, 2 * EDIM, c.G, c.bid);
    LAS unsigned* gtab = (LAS unsigned*)(lds + KV_AUX_OFF);
    { const unsigned* TOKIDX = WSP(unsigned, WS_TOKIDX);
      for (int ui = 0; ui < 16; ++ui) { pg8::Unit u; if (!S.next(ui, u)) break; if (c.tid < 256) gtab[ui * 256 + c.tid] = TOKIDX[u.pm * 256 + c.tid]; }
      __syncthreads(); }
    pg8::Gemm g{WSP(bf16, WS_XB), WSP(bf16, W_F1), DM, DM, DM, gtab};
    pg8::EpiScale<2> E{WSP(bf16, B_HIDM), EDIM, pg8::RowScale{WSP(float, MS_RSSLOT), 2}, nullptr};
    { const Ctx c2 = mkctx(wv); pg8::gemm_phase<pg8::EpiScale<2>, pg8::MoeOrder, true, true, true>(lds + RING_OFF, g, S, E, c2.tid); }
}
__device__ __forceinline__ void ph_moe_down(int wv, LAS unsigned char* lds, int l) {
    const Ctx c = mkctx(wv);
    KArgs A = kargs(); unsigned char* ws = A->ws;
    pg8::MoeOrder S; S.nN = 4; moe_panels(WSP(int, MS_MTOT), S.ps);
    S.so.init(S.ps[8] * 256, DM, c.G, c.bid);
    pg8::Gemm g{WSP(bf16, B_HIDM), WSP(bf16, W_F2), EDIM, EDIM, EDIM};
    pg8::EpiScale<0> E{WSP(bf16, B_Y2), DM, pg8::RowScale{nullptr, 0}, nullptr};
    pg8::gemm_phase<pg8::EpiScale<0>, pg8::MoeOrder, true, true>(lds + RING_OFF, g, S, E, c.tid);
}
__device__ __forceinline__ void ph_combine(int wv, LAS unsigned char* lds, int l) {
    const Ctx c = mkctx(wv);
    KArgs A = kargs(); unsigned char* ws = A->ws; const int lane = c.lane;
    float* xout = A->out; const bool fin = (l == DEPTH - 1);
    const int* TOKS = WSP(int, MS_TOKS); const float* TOKW = WSP(float, MS_TOKW); const bf16* Y2 = WSP(bf16, B_Y2); bf16* XB = WSP(bf16, WS_XB); float* SSA = WSP(float, WS_SSA);
    for (int tok0 = c.gw; tok0 < T; tok0 += 2 * c.NGW) {
        typedef unsigned u32x2v __attribute__((ext_vector_type(2)));
        int ss_[2][2]; float ww[2][2]; u32x2v xv[2][4]; bool ok[2];
#pragma unroll
        for (int u = 0; u < 2; ++u) { const int tok = tok0 + u * c.NGW; ok[u] = tok < T; const int tk = ok[u] ? tok : tok0;
            ss_[u][0] = TOKS[tk * 2]; ss_[u][1] = TOKS[tk * 2 + 1]; ww[u][0] = TOKW[tk * 2]; ww[u][1] = TOKW[tk * 2 + 1];
#pragma unroll
            for (int j = 0; j < 4; ++j) xv[u][j] = *((const u32x2v*)(XB + (size_t)tk * DM) + 64 * j + lane); }
        u32x2v ya[2][4], yb[2][4];
#pragma unroll
        for (int u = 0; u < 2; ++u)
#pragma unroll
            for (int j = 0; j < 4; ++j) { ya[u][j] = *((const u32x2v*)(Y2 + (size_t)ss_[u][0] * DM) + 64 * j + lane); yb[u][j] = *((const u32x2v*)(Y2 + (size_t)ss_[u][1] * DM) + 64 * j + lane); }
#pragma unroll
        for (int u = 0; u < 2; ++u) if (ok[u]) {
            const int tok = tok0 + u * c.NGW; const float w0 = ww[u][0], w1 = ww[u][1]; float ss = 0.f;
#pragma unroll
            for (int j = 0; j < 4; ++j) {
                const int c4 = 64 * j + lane; f32x4 x = {bflo(xv[u][j].x), bfhi(xv[u][j].x), bflo(xv[u][j].y), bfhi(xv[u][j].y)}; const u32x2v a = ya[u][j], b = yb[u][j];
                x[0] += w0 * bflo(a.x) + w1 * bflo(b.x); x[1] += w0 * bfhi(a.x) + w1 * bfhi(b.x); x[2] += w0 * bflo(a.y) + w1 * bflo(b.y); x[3] += w0 * bfhi(a.y) + w1 * bfhi(b.y);
                if (fin) *((f32x4*)(xout + (size_t)tok * DM) + c4) = x;
                u32x2v w; w.x = pkbf(x[0], x[1]); w.y = pkbf(x[2], x[3]); *((u32x2v*)(XB + (size_t)tok * DM) + c4) = w;
                ss += (x[0] * x[0] + x[1] * x[1]) + (x[2] * x[2] + x[3] * x[3]);
            }
            ss = wave_sum(ss);
            if (lane < 4) SSA[(size_t)tok * 4 + lane] = (lane == 0) ? ss : 0.f;
        }
    }
    if (l < DEPTH - 1) { __syncthreads(); conv_mixer_weights(wv, lds, l + 1); }
}

__global__ void __launch_bounds__(NTHR, 2) trunk_fwd(Args args) {
    extern __shared__ __attribute__((aligned(16))) unsigned char lds_raw[];
    LAS unsigned char* lds = (LAS unsigned char*)lds_raw;
    const int wv = __builtin_amdgcn_readfirstlane((int)threadIdx.x >> 6);
    for (int u = threadIdx.x; u < (LDS_BYTES - LDSCTL_OFF) / 4; u += NTHR) ((LAS unsigned*)(lds + LDSCTL_OFF))[u] = 0u;
    __syncthreads();
    volatile LAS unsigned* MISC = (volatile LAS unsigned*)(lds + MISC_OFF);
    XcdBarrier bar = xcd_barrier_post((unsigned*)((gu32*)(args.ws + WS_CTL) + CW_BAR), MISC + 8, (int)threadIdx.x);
    const int lo = args.ph_lo, hi = args.ph_hi;
    int pc = 0;
#define PH_BEGIN if (pc >= lo && pc < hi) {
#define PH_END if (pc + 1 < hi) xcd_barrier(bar, mkctx(wv).tid); } ++pc;
    PH_BEGIN ph_prologue(wv, lds); PH_END
    for (int l = 0; l < DEPTH; ++l) {
        PH_BEGIN ph_inproj(wv, lds, l); PH_END
        PH_BEGIN ph_prep(wv, lds, l); PH_END
        PH_BEGIN ph_attn(wv, lds, l); PH_END
        PH_BEGIN ph_gates(wv, lds); PH_END
        PH_BEGIN ph_merge(wv, lds); PH_END
        PH_BEGIN ph_wout(wv, lds, l); PH_END
        if (!(l & 1)) {
            PH_BEGIN ph_ffn_up(wv, lds); PH_END
            PH_BEGIN ph_ffn_down(wv, lds, l); PH_END
        } else {
            PH_BEGIN ph_router(wv, lds, l); PH_END
            PH_BEGIN ph_assign(wv, lds, l); PH_END
            PH_BEGIN ph_moe_up(wv, lds, l); PH_END
            PH_BEGIN ph_moe_down(wv, lds, l); PH_END
            PH_BEGIN ph_combine(wv, lds, l); PH_END
        }
    }
    if (TPROBE != 0 && blockIdx.x == TP_BID && threadIdx.x == 0) { const unsigned long long tt_ = *TP_ACC(lds), te_ = __builtin_amdgcn_s_memrealtime(); while (__builtin_amdgcn_s_memrealtime() - te_ < 7ull * tt_) __builtin_amdgcn_s_sleep(32); }
#undef PH_BEGIN
#undef PH_END
}

#ifndef MK_MULTI
#define MK_MULTI 0
#endif
extern "C" void kernel_launch(void* const* d_in, const int* in_sizes, int n_in, void* d_out, int out_size, void* d_ws, size_t ws_size, hipStream_t stream) {
    static int grid = 0;
    if (grid == 0) {
        if (n_in != 31 || out_size != T * DM || ws_size < WS_END) { fprintf(stderr, "kernel_launch: unexpected problem: n_in %d out %d ws %zu (need %zu)\n", n_in, out_size, ws_size, (size_t)WS_END); grid = -1; return; }
        int dev = 0, cus = 0;
        if (hipGetDevice(&dev) != hipSuccess || hipDeviceGetAttribute(&cus, hipDeviceAttributeMultiprocessorCount, dev) != hipSuccess) { grid = -1; return; }
        if (hipFuncSetAttribute((const void*)trunk_fwd, hipFuncAttributeMaxDynamicSharedMemorySize, LDS_BYTES) != hipSuccess) { fprintf(stderr, "kernel_launch: hipFuncSetAttribute failed\n"); grid = -1; return; }
        int per_cu = 0;
        if (hipOccupancyMaxActiveBlocksPerMultiprocessor(&per_cu, (const void*)trunk_fwd, NTHR, LDS_BYTES) != hipSuccess || per_cu < 1) fprintf(stderr, "kernel_launch: occupancy query says %d\n", per_cu);
        (void)hipGetLastError();
        if (cus < (T / 256) * 2) { fprintf(stderr, "kernel_launch: %d CUs: the kv up-projection phase needs one workgroup per unit (256)\n", cus); grid = -1; return; }
        grid = cus;
    }
    if (grid < 0) return;
    (void)hipMemsetAsync((char*)d_ws + WS_CTL, 0, CTL_ZERO_BYTES, stream);
    Args a{};
    for (int i = 0; i < 31; ++i) a.in[i] = d_in[i];
    a.out = (float*)d_out; a.ws = (unsigned char*)d_ws;
#if MK_MULTI
    for (int p = 0; p < N_PHASES; ++p) { a.ph_lo = p; a.ph_hi = p + 1; hipLaunchKernelGGL(trunk_fwd, dim3(grid), dim3(NTHR), LDS_BYTES, stream, a); }
#else
    a.ph_lo = 0; a.ph_hi = N_PHASES;
    hipLaunchKernelGGL(trunk_fwd, dim3(grid), dim3(NTHR), LDS_BYTES, stream, a);
#endif
}
```
